# Optimizing an MI355X kernel written in HIP

```python
import math
import jax, jax.numpy as jnp
from jax import lax
import numpy as np

D_MODEL = 1024
BATCH = 4
SEQ = 4096
DEPTH = 2

GRID_W = 64
CTX_LEN = 256
N_MIXERS = 4
GROUP_W = D_MODEL // N_MIXERS
MIX_W = N_MIXERS * GROUP_W
NORM_EPS = 1e-6
GLA_HEADS = 4
GLA_DV = GROUP_W // GLA_HEADS
GLA_DK = GLA_DV // 2
GLA_GATE_RANK = 16
GLA_TAU = 16.0
GLA_CHUNK = 64
ROPE_BASE = 10000.0
NA_HEADS = 4
NA_DH = GROUP_W // NA_HEADS
NA_KR = 8
NA_KC = 16
S5_GROUP = 16
S5_GROUPS = GROUP_W // S5_GROUP
S5_STATE = 64
POOL_WINDOWS = (2, 4, 8, 16)
POOL_GW = GROUP_W // len(POOL_WINDOWS)
CTX_SPLIT = (GLA_HEADS * GLA_DK, GROUP_W, GLA_GATE_RANK, GLA_GATE_RANK, GROUP_W, GROUP_W, GROUP_W)
LAT_SPLIT = (GLA_HEADS * GLA_DK, GROUP_W, GROUP_W, MIX_W)
N_CTX_COLS = sum(CTX_SPLIT)
N_IN_COLS = N_CTX_COLS + sum(LAT_SPLIT)

kernel_name = "hybrid_parallel_head_groups_diffusion_block"


def rmsnorm(x, g):
    xf = x.astype(jnp.float32)
    y = xf * lax.rsqrt(jnp.mean(xf * xf, axis=-1, keepdims=True) + NORM_EPS)
    return (y * g.astype(jnp.float32)).astype(x.dtype)


def split_cols(p, sizes):
    idx = [int(i) for i in np.cumsum(sizes)[:-1]]
    return jnp.split(p, idx, axis=-1)


def flip_seq(a):
    return jnp.flip(a, axis=1)


def axial_rope_tables(n_tokens):
    t = jnp.arange(n_tokens)
    half = GLA_DK // 2
    freqs = ROPE_BASE ** (-jnp.arange(0, half, 2, dtype=jnp.float32) / half)
    def table(pos):
        ang = pos.astype(jnp.float32)[:, None] * freqs[None, :]
        ang = jnp.concatenate([ang, ang], axis=-1)
        return jnp.cos(ang)[:, None, :], jnp.sin(ang)[:, None, :]
    return table(t // GRID_W) + table(t % GRID_W)


def rotate_half(x):
    x1, x2 = jnp.split(x, 2, axis=-1)
    return jnp.concatenate([-x2, x1], axis=-1)


def apply_axial_rope(x, tables):
    cos_r, sin_r, cos_c, sin_c = tables
    xr, xc = jnp.split(x, 2, axis=-1)
    return jnp.concatenate([xr * cos_r + rotate_half(xr) * sin_r,
                            xc * cos_c + rotate_half(xc) * sin_c], axis=-1)


def gla_chunked(q, k, v, logg, s0):
    bsz, n_tok, n_h, _ = q.shape
    dv = v.shape[-1]
    n_chunks = n_tok // GLA_CHUNK
    def to_chunks(a):
        return a.reshape(bsz, n_chunks, GLA_CHUNK, n_h, a.shape[-1]).transpose(1, 0, 3, 2, 4)
    lower = jnp.tril(jnp.ones((GLA_CHUNK, GLA_CHUNK), dtype=bool))
    def step(state, inp):
        qc, kc, vc, gc = inp
        b = jnp.cumsum(gc, axis=-2)
        diff = b[:, :, :, None, :] - b[:, :, None, :, :]
        decay = jnp.exp(jnp.where(lower[:, :, None], diff, -jnp.inf))
        att = jnp.einsum('bhid,bhjd,bhijd->bhij', qc, kc, decay)
        o = (jnp.einsum('bhij,bhje->bhie', att, vc)
             + jnp.einsum('bhid,bhde->bhie', qc * jnp.exp(b), state))
        b_last = b[:, :, -1:, :]
        state = (jnp.exp(b_last)[:, :, 0, :, None] * state
                 + jnp.einsum('bhjd,bhje->bhde', kc * jnp.exp(b_last - b), vc))
        return state, o
    _, o = lax.scan(step, s0, (to_chunks(q), to_chunks(k), to_chunks(v), to_chunks(logg)))
    return o.transpose(1, 0, 3, 2, 4).reshape(bsz, n_tok, n_h, dv)


def gla_final_state(k, v, logg):
    b = jnp.cumsum(logg, axis=1)
    return jnp.einsum('bnhd,bnhe->bhde', k * jnp.exp(b[:, -1:] - b), v)


def gla_head_norm(o, g):
    y = o * lax.rsqrt(jnp.mean(o * o, axis=-1, keepdims=True) + NORM_EPS) * g.astype(jnp.float32)
    return y.reshape(o.shape[0], o.shape[1], GLA_HEADS * GLA_DV)


def gla_mixer(q, k, v, gf, gb, kc, vc, gfc, gbc, qc, w_gate, b_gate, g_norm, rope):
    f32 = jnp.float32
    def heads(a, d):
        return a.astype(f32).reshape(a.shape[0], a.shape[1], GLA_HEADS, d)
    def log_gate(g_lr, direction):
        z = jnp.einsum('bnr,re->bne', g_lr.astype(f32), w_gate[direction].astype(f32)) + b_gate[direction].astype(f32)
        return heads(jax.nn.log_sigmoid(z) / GLA_TAU, GLA_DK)
    kch, vch = heads(kc, GLA_DK), heads(vc, GLA_DV)
    lgc_f, lgc_b = log_gate(gfc, 0), log_gate(gbc, 1)
    s_f = gla_final_state(kch, vch, lgc_f)
    s_b = gla_final_state(flip_seq(kch), flip_seq(vch), flip_seq(lgc_b))
    qh = apply_axial_rope(heads(q, GLA_DK), rope) * GLA_DK ** -0.5
    kh = apply_axial_rope(heads(k, GLA_DK), rope)
    vh = heads(v, GLA_DV)
    o = (gla_chunked(qh, kh, vh, log_gate(gf, 0), s_f)
         + flip_seq(gla_chunked(flip_seq(qh), flip_seq(kh), flip_seq(vh), flip_seq(log_gate(gb, 1)), s_b)))
    y = gla_head_norm(o, g_norm)
    y_ctx = None
    if qc is not None:
        qch = heads(qc, GLA_DK) * GLA_DK ** -0.5
        zero = jnp.zeros_like(s_f)
        oc = (gla_chunked(qch, kch, vch, lgc_f, zero)
              + flip_seq(gla_chunked(flip_seq(qch), flip_seq(kch), flip_seq(vch), flip_seq(lgc_b), zero)))
        y_ctx = gla_head_norm(oc, g_norm)
    return y, y_ctx


def na_mixer(q, k, v, kc, vc, qc, rpb, rows):
    f32 = jnp.float32
    bsz, n_tok, _ = q.shape
    scale = NA_DH ** -0.5
    kr = min(NA_KR, rows)
    def grid(a):
        return a.astype(f32).reshape(bsz, rows, GRID_W, NA_HEADS, NA_DH).transpose(0, 3, 1, 2, 4)
    def seq_heads(a):
        return a.astype(f32).reshape(a.shape[0], a.shape[1], NA_HEADS, NA_DH).transpose(0, 2, 1, 3)
    qg, kg, vg = grid(q) * scale, grid(k), grid(v)
    kch, vch = seq_heads(kc), seq_heads(vc)
    r = jnp.arange(rows)
    row_idx = jnp.clip(r - kr // 2, 0, rows - kr)[:, None] + jnp.arange(kr)[None, :]
    col = jnp.arange(GRID_W)
    cs = jnp.clip(col - NA_KC // 2, 0, GRID_W - NA_KC)
    col_mask = (col[None, :] >= cs[:, None]) & (col[None, :] < cs[:, None] + NA_KC)
    ro = row_idx - r[:, None] + (NA_KR - 1)
    co = jnp.clip(col[None, :] - col[:, None], -(NA_KC - 1), NA_KC - 1) + (NA_KC - 1)
    bias = rpb.astype(f32)[:, ro[:, None, :, None], co[None, :, None, :]]
    k_rows, v_rows = kg[:, :, row_idx], vg[:, :, row_idx]
    s_win = jnp.einsum('bhrqd,bhrikd->bhrqik', qg, k_rows) + bias[None]
    s_win = jnp.where(col_mask[:, None, :], s_win, -jnp.inf)
    s_ctx = jnp.einsum('bhrqd,bhnd->bhrqn', qg, kch)
    n_win = kr * GRID_W
    p = jax.nn.softmax(jnp.concatenate([s_win.reshape(bsz, NA_HEADS, rows, GRID_W, n_win), s_ctx], axis=-1), axis=-1)
    o = (jnp.einsum('bhrqik,bhrikd->bhrqd', p[..., :n_win].reshape(s_win.shape), v_rows)
         + jnp.einsum('bhrqn,bhnd->bhrqd', p[..., n_win:], vch))
    y = o.transpose(0, 2, 3, 1, 4).reshape(bsz, n_tok, NA_HEADS * NA_DH)
    y_ctx = None
    if qc is not None:
        pc = jax.nn.softmax(jnp.einsum('bhnd,bhmd->bhnm', seq_heads(qc) * scale, kch), axis=-1)
        oc = jnp.einsum('bhnm,bhmd->bhnd', pc, vch)
        y_ctx = oc.transpose(0, 2, 1, 3).reshape(qc.shape[0], qc.shape[1], NA_HEADS * NA_DH)
    return y, y_ctx


def s5_discretise(lam_re, lam_im, log_dt, b_re, b_im):
    dt = jnp.exp(log_dt)[:, None]
    mag = jnp.exp(lam_re * dt)
    ang = lam_im * dt
    lb_re, lb_im = mag * jnp.cos(ang), mag * jnp.sin(ang)
    num_re, num_im = lb_re - 1.0, lb_im
    den = lam_re * lam_re + lam_im * lam_im
    coef_re = ((num_re * lam_re + num_im * lam_im) / den)[..., None]
    coef_im = ((num_im * lam_re - num_re * lam_im) / den)[..., None]
    bb_re = coef_re * b_re - coef_im * b_im
    bb_im = coef_re * b_im + coef_im * b_re
    return lb_re, lb_im, bb_re, bb_im


def complex_affine_combine(e1, e2):
    a1r, a1i, b1r, b1i = e1
    a2r, a2i, b2r, b2i = e2
    return (a1r * a2r - a1i * a2i, a1r * a2i + a1i * a2r,
            a2r * b1r - a2i * b1i + b2r, a2r * b1i + a2i * b1r + b2i)


def s5_scan(u, disc, x0, reverse):
    lb_re, lb_im, bb_re, bb_im = disc
    bu_re = jnp.einsum('bngh,gph->bngp', u, bb_re)
    bu_im = jnp.einsum('bngh,gph->bngp', u, bb_im)
    a_re = jnp.broadcast_to(lb_re, bu_re.shape)
    a_im = jnp.broadcast_to(lb_im, bu_im.shape)
    ar, ai, xr, xi = lax.associative_scan(complex_affine_combine, (a_re, a_im, bu_re, bu_im), reverse=reverse, axis=1)
    if x0 is not None:
        x0r, x0i = x0[0][:, None], x0[1][:, None]
        xr, xi = xr + ar * x0r - ai * x0i, xi + ar * x0i + ai * x0r
    return xr, xi


def s5_readout(xr, xi, c_re, c_im):
    y = (jnp.einsum('bngp,ghp->bngh', xr, c_re.astype(jnp.float32))
         - jnp.einsum('bngp,ghp->bngh', xi, c_im.astype(jnp.float32)))
    return y.reshape(y.shape[0], y.shape[1], S5_GROUPS * S5_GROUP)


def s5_glu(y, w, b):
    g = jax.nn.gelu(y)
    return g * jax.nn.sigmoid(g @ w.astype(jnp.float32) + b.astype(jnp.float32))


def s5_mixer(u, uc, ctx_out, lam_re, lam_im, log_dt, b_re, b_im, c_re, c_im, d_skip, w_glu, b_glu):
    f32 = jnp.float32
    def groups(a):
        return a.astype(f32).reshape(a.shape[0], a.shape[1], S5_GROUPS, S5_GROUP)
    ul, ucg = groups(u), groups(uc)
    d_skip = d_skip.astype(f32)
    y = u.astype(f32) * d_skip
    yc = uc.astype(f32) * d_skip if ctx_out else None
    for direction, rev in enumerate((False, True)):
        disc = s5_discretise(lam_re[direction].astype(f32), lam_im[direction].astype(f32),
                             log_dt[direction].astype(f32), b_re[direction].astype(f32), b_im[direction].astype(f32))
        xcr, xci = s5_scan(ucg, disc, None, rev)
        fin = 0 if rev else -1
        xr, xi = s5_scan(ul, disc, (xcr[:, fin], xci[:, fin]), rev)
        y = y + s5_readout(xr, xi, c_re[direction], c_im[direction])
        if ctx_out:
            yc = yc + s5_readout(xcr, xci, c_re[direction], c_im[direction])
    return s5_glu(y, w_glu, b_glu), (s5_glu(yc, w_glu, b_glu) if ctx_out else None)


def centred_mean(u, w):
    n = u.shape[1]
    csum = jnp.concatenate([jnp.zeros_like(u[:, :1]), jnp.cumsum(u, axis=1)], axis=1)
    t = jnp.arange(n)
    lo = jnp.clip(t - w // 2, 0, n)
    hi = jnp.clip(t - w // 2 + w, 0, n)
    return (csum[:, hi] - csum[:, lo]) / (hi - lo).astype(u.dtype)[None, :, None]


def pool_mixer(u, w_pool, scale):
    uf = u.astype(jnp.float32)
    parts = jnp.split(uf, len(POOL_WINDOWS), axis=-1)
    outs = [jnp.einsum('bnc,ce->bne', centred_mean(g, w) - g, w_pool[i].astype(jnp.float32))
            for i, (g, w) in enumerate(zip(parts, POOL_WINDOWS))]
    return jnp.concatenate(outs, axis=-1) * scale.astype(jnp.float32)


def setup_inputs(seed: int = 0) -> dict:
    key = jax.random.key(seed)
    ks = jax.random.split(key, 32)
    f32 = jnp.float32
    def nrm(k, shape, std):
        return std * jax.random.normal(k, shape, f32)
    L = DEPTH
    lam_im0 = jnp.pi * jnp.arange(S5_STATE, dtype=f32)
    return {
        "x": nrm(ks[0], (BATCH, SEQ, D_MODEL), 1.0),
        "c": nrm(ks[1], (BATCH, D_MODEL), 1.0),
        "ctx": nrm(ks[2], (BATCH, CTX_LEN, D_MODEL), 1.0),
        "c_ctx": nrm(ks[3], (D_MODEL,), 1.0),
        "w_mod": nrm(ks[4], (L, D_MODEL, 3 * D_MODEL), 0.5 * D_MODEL ** -0.5),
        "b_mod": nrm(ks[5], (L, 3 * D_MODEL), 0.02),
        "g_pre": 1.0 + nrm(ks[6], (L, D_MODEL), 0.02),
        "g_post": 1.0 + nrm(ks[7], (L, D_MODEL), 0.02),
        "w_in": nrm(ks[8], (L, D_MODEL, N_IN_COLS), D_MODEL ** -0.5),
        "w_out": nrm(ks[9], (L, MIX_W, D_MODEL), MIX_W ** -0.5),
        "gla_w_gate": nrm(ks[10], (L, 2, GLA_GATE_RANK, GLA_HEADS * GLA_DK), GLA_GATE_RANK ** -0.5),
        "gla_b_gate": nrm(ks[11], (L, 2, GLA_HEADS * GLA_DK), 0.1),
        "gla_g_norm": 1.0 + nrm(ks[12], (L, GLA_DV), 0.02),
        "na_rpb": nrm(ks[13], (L, NA_HEADS, 2 * NA_KR - 1, 2 * NA_KC - 1), 0.1),
        "s5_lam_re": -0.5 + nrm(ks[14], (L, 2, S5_GROUPS, S5_STATE), 0.01),
        "s5_lam_im": lam_im0 + nrm(ks[15], (L, 2, S5_GROUPS, S5_STATE), 0.01),
        "s5_log_dt": jax.random.uniform(ks[16], (L, 2, S5_GROUPS), f32, math.log(1e-3), math.log(1e-1)),
        "s5_b_re": nrm(ks[17], (L, 2, S5_GROUPS, S5_STATE, S5_GROUP), (2.0 * S5_GROUP) ** -0.5),
        "s5_b_im": nrm(ks[18], (L, 2, S5_GROUPS, S5_STATE, S5_GROUP), (2.0 * S5_GROUP) ** -0.5),
        "s5_c_re": nrm(ks[19], (L, 2, S5_GROUPS, S5_GROUP, S5_STATE), S5_STATE ** -0.5),
        "s5_c_im": nrm(ks[20], (L, 2, S5_GROUPS, S5_GROUP, S5_STATE), S5_STATE ** -0.5),
        "s5_d": nrm(ks[21], (L, GROUP_W), 1.0),
        "s5_w_glu": nrm(ks[22], (L, GROUP_W, GROUP_W), GROUP_W ** -0.5),
        "s5_b_glu": nrm(ks[23], (L, GROUP_W), 0.02),
        "pool_w": nrm(ks[24], (L, len(POOL_WINDOWS), POOL_GW, POOL_GW), POOL_GW ** -0.5),
        "pool_scale": 1.0 + nrm(ks[25], (L, GROUP_W), 0.02),
    }


def reference(x, c, ctx, c_ctx, w_mod, b_mod, g_pre, g_post, w_in, w_out,
              gla_w_gate, gla_b_gate, gla_g_norm, na_rpb,
              s5_lam_re, s5_lam_im, s5_log_dt, s5_b_re, s5_b_im, s5_c_re, s5_c_im, s5_d, s5_w_glu, s5_b_glu,
              pool_w, pool_scale):
    dt = x.dtype
    n_tok = x.shape[1]
    rows = n_tok // GRID_W
    rope = axial_rope_tables(n_tok)
    xc = ctx
    for l in range(DEPTH):
        last = l == DEPTH - 1
        shift, scale, gate = jnp.split(jax.nn.silu(c) @ w_mod[l] + b_mod[l], 3, axis=-1)
        shift_c, scale_c, gate_c = jnp.split(jax.nn.silu(c_ctx) @ w_mod[l] + b_mod[l], 3, axis=-1)
        h = rmsnorm(x, g_pre[l]) * (1.0 + scale[:, None]) + shift[:, None]
        hc = rmsnorm(xc, g_pre[l]) * (1.0 + scale_c) + shift_c
        p_kv, p_q = jnp.split(h @ w_in[l], [N_CTX_COLS], axis=-1)
        gla_k, gla_v, gla_gf, gla_gb, na_k, na_v, s5_u = split_cols(p_kv, CTX_SPLIT)
        gla_q, na_q, pool_u, gate_cols = split_cols(p_q, LAT_SPLIT)
        if last:
            pc_kv = hc @ w_in[l][:, :N_CTX_COLS]
            gla_qc = na_qc = pool_uc = gate_cols_c = None
        else:
            pc_kv, pc_q = jnp.split(hc @ w_in[l], [N_CTX_COLS], axis=-1)
            gla_qc, na_qc, pool_uc, gate_cols_c = split_cols(pc_q, LAT_SPLIT)
        gla_kc, gla_vc, gla_gfc, gla_gbc, na_kc, na_vc, s5_uc = split_cols(pc_kv, CTX_SPLIT)
        y_gla, yc_gla = gla_mixer(gla_q, gla_k, gla_v, gla_gf, gla_gb, gla_kc, gla_vc, gla_gfc, gla_gbc, gla_qc,
                                  gla_w_gate[l], gla_b_gate[l], gla_g_norm[l], rope)
        y_na, yc_na = na_mixer(na_q, na_k, na_v, na_kc, na_vc, na_qc, na_rpb[l], rows)
        y_s5, yc_s5 = s5_mixer(s5_u, s5_uc, not last, s5_lam_re[l], s5_lam_im[l], s5_log_dt[l], s5_b_re[l],
                               s5_b_im[l], s5_c_re[l], s5_c_im[l], s5_d[l], s5_w_glu[l], s5_b_glu[l])
        y_pool = pool_mixer(pool_u, pool_w[l], pool_scale[l])
        y = jnp.concatenate([y_gla, y_na, y_s5, y_pool], axis=-1).astype(dt) * jax.nn.silu(gate_cols)
        x = x + gate[:, None] * rmsnorm(y @ w_out[l], g_post[l])
        if not last:
            yc_pool = pool_mixer(pool_uc, pool_w[l], pool_scale[l])
            yc = jnp.concatenate([yc_gla, yc_na, yc_s5, yc_pool], axis=-1).astype(dt) * jax.nn.silu(gate_cols_c)
            xc = xc + gate_c * rmsnorm(yc @ w_out[l], g_post[l])
    return x
```

```cpp
#include <hip/hip_runtime.h>
#include <stdint.h>
#include <math.h>

typedef unsigned short bf16_t;
__device__ __forceinline__ float bf2f(bf16_t v) { return __uint_as_float(((unsigned)v) << 16); }
__device__ __forceinline__ bf16_t f2bf(float f) { unsigned u = __float_as_uint(f); return (bf16_t)((u + 0x7fffu + ((u >> 16) & 1u)) >> 16); }

constexpr int DM = 1024, NB = 4, SEQ = 4096, NCTX = 256, GW = 64;
constexpr int NLAT = NB * SEQ;
constexpr int NCT = NB * NCTX;
constexpr int MTOT = NLAT + NCT;
constexpr int NIN = 2848, NP = 3072;
constexpr int C_GK = 0, C_GV = 128, C_GF = 384, C_GB = 400, C_NK = 416, C_NV = 672, C_SU = 928, C_GQ = 1184, C_NQ = 1312, C_PU = 1568, C_GATE = 1824;
constexpr float EPS = 1e-6f;

constexpr size_t OFF_WIN = 0;
constexpr size_t OFF_WOUT = OFF_WIN + (size_t)2 * NP * DM * 2;
constexpr size_t OFF_MOD = OFF_WOUT + (size_t)2 * DM * DM * 2;
constexpr size_t OFF_H = OFF_MOD + (size_t)2 * 5 * 3072 * 4 + 1024;
constexpr size_t OFF_P = OFF_H + (size_t)MTOT * DM * 2;
constexpr size_t OFF_XC = OFF_P + (size_t)MTOT * NP * 2;
constexpr size_t OFF_LG = OFF_XC + (size_t)NCT * DM * 4;
constexpr size_t OFF_OG = OFF_LG + (size_t)2 * MTOT * 128 * 4;
constexpr size_t OFF_SY = OFF_OG + (size_t)MTOT * 256 * 4;
constexpr size_t OFF_END = OFF_SY + (size_t)MTOT * 256 * 4;
static_assert(OFF_END <= (size_t)256 * 1024 * 1024, "ws");

struct Inputs {
    const float *x, *c, *ctx, *c_ctx, *w_mod, *b_mod, *g_pre, *g_post, *w_in, *w_out, *gla_w_gate, *gla_b_gate, *gla_g_norm, *na_rpb,
        *s5_lam_re, *s5_lam_im, *s5_log_dt, *s5_b_re, *s5_b_im, *s5_c_re, *s5_c_im, *s5_d, *s5_w_glu, *s5_b_glu, *pool_w, *pool_scale;
};

__device__ __forceinline__ float silu_f(float v) { return v / (1.f + expf(-v)); }
__device__ __forceinline__ float sigmoid_f(float v) { return 1.f / (1.f + expf(-v)); }
__device__ __forceinline__ float gelu_tanh_f(float v) { const float k = 0.7978845608028654f; return 0.5f * v * (1.f + tanhf(k * (v + 0.044715f * v * v * v))); }
__device__ __forceinline__ float logsigmoid_f(float z) { return fminf(z, 0.f) - log1pf(expf(-fabsf(z))); }

__global__ void k_transpose_w(const float* W, int K, int N, int Npad, bf16_t* WT) {
    __shared__ float t[32][33];
    const int n0 = blockIdx.x * 32, k0 = blockIdx.y * 32;
    const int tx = threadIdx.x & 31, ty = threadIdx.x >> 5;
    for (int i = ty; i < 32; i += 8) { const int n = n0 + tx; t[i][tx] = (n < N) ? W[(size_t)(k0 + i) * N + n] : 0.f; }
    __syncthreads();
    for (int i = ty; i < 32; i += 8) { const int n = n0 + i; if (n < Npad) WT[(size_t)n * K + k0 + tx] = f2bf(t[tx][i]); }
}

__global__ void k_mod(Inputs in, float* MOD) {
    const int n = blockIdx.x * 256 + threadIdx.x, j = blockIdx.y, l = blockIdx.z;
    const float* cv = (j < 4) ? in.c + j * DM : in.c_ctx;
    const float* w = in.w_mod + (size_t)l * DM * 3072;
    float acc = 0.f;
    for (int k = 0; k < DM; ++k) acc += silu_f(cv[k]) * w[(size_t)k * 3072 + n];
    MOD[((size_t)l * 5 + j) * 3072 + n] = acc + in.b_mod[l * 3072 + n];
}

__global__ void k_norm(const float* xlat, const float* xctx, const float* g_pre, const float* MODl, bf16_t* H) {
    const int row = blockIdx.x; const int tid = threadIdx.x;
    const float* xr = row < NLAT ? xlat + (size_t)row * DM : xctx + (size_t)(row - NLAT) * DM;
    const int j = row < NLAT ? row / SEQ : 4;
    __shared__ float red[256];
    float v[4]; float s = 0.f;
    for (int i = 0; i < 4; ++i) { v[i] = xr[tid + 256 * i]; s += v[i] * v[i]; }
    red[tid] = s; __syncthreads();
    for (int o = 128; o > 0; o >>= 1) { if (tid < o) red[tid] += red[tid + o]; __syncthreads(); }
    const float rstd = rsqrtf(red[0] / DM + EPS);
    const float* shift = MODl + j * 3072; const float* scale = shift + 1024;
    for (int i = 0; i < 4; ++i) { const int k = tid + 256 * i; const float y = v[i] * rstd * g_pre[k]; H[(size_t)row * DM + k] = f2bf(y * (1.f + scale[k]) + shift[k]); }
}

template <bool OUT_BF16>
__global__ void __launch_bounds__(256) k_gemm(const bf16_t* A, const bf16_t* Bt, void* C, int M, int N, int K, int ldc) {
    __shared__ float As[64][33], Bs[64][33];
    const int m0 = blockIdx.y * 64, n0 = blockIdx.x * 64;
    const int tx = threadIdx.x & 15, ty = threadIdx.x >> 4;
    float acc[4][4] = {};
    for (int k0 = 0; k0 < K; k0 += 32) {
        for (int i = threadIdx.x; i < 64 * 32; i += 256) { const int r = i >> 5, kk = i & 31;
            As[r][kk] = bf2f(A[(size_t)(m0 + r) * K + k0 + kk]); Bs[r][kk] = bf2f(Bt[(size_t)(n0 + r) * K + k0 + kk]); }
        __syncthreads();
        for (int kk = 0; kk < 32; ++kk) { float a[4], b[4];
            for (int i = 0; i < 4; ++i) { a[i] = As[ty + 16 * i][kk]; b[i] = Bs[tx + 16 * i][kk]; }
            for (int i = 0; i < 4; ++i) for (int j = 0; j < 4; ++j) acc[i][j] += a[i] * b[j]; }
        __syncthreads();
    }
    for (int i = 0; i < 4; ++i) for (int j = 0; j < 4; ++j) { const size_t o = (size_t)(m0 + ty + 16 * i) * ldc + n0 + tx + 16 * j;
        if (OUT_BF16) ((bf16_t*)C)[o] = f2bf(acc[i][j]); else ((float*)C)[o] = acc[i][j]; }
}

__global__ void k_lg(const bf16_t* P, const float* w_gate  , const float* b_gate  , float* LG) {
    const int row = blockIdx.x, dir = blockIdx.y, e = threadIdx.x;
    const bf16_t* pr = P + (size_t)row * NP + (dir ? C_GB : C_GF);
    float z = b_gate[dir * 128 + e];
    for (int r = 0; r < 16; ++r) z += bf2f(pr[r]) * w_gate[(dir * 16 + r) * 128 + e];
    LG[((size_t)dir * MTOT + row) * 128 + e] = logsigmoid_f(z) * (1.f / 16.f);
}

__global__ void k_gla(const bf16_t* P, const float* LG, float* OG, int dir, int last) {
    const int b = blockIdx.x >> 2, h = blockIdx.x & 3, e = threadIdx.x;
    __shared__ float ctab[64][8], stab[64][8];
    __shared__ float sa[32], sk[32], sq[32];
    for (int i = threadIdx.x; i < 512; i += 64) { const int pos = i >> 3, j = i & 7; const float f = powf(10000.f, -(float)j / 8.f); const float a = (float)pos * f; ctab[pos][j] = cosf(a); stab[pos][j] = sinf(a); }
    __syncthreads();
    float S[32];
    for (int d = 0; d < 32; ++d) S[d] = 0.f;
    const float qs = 0.17677669529663687f;
    const int d = e & 31;
    for (int i = 0; i < NCTX + SEQ; ++i) {
        size_t row; bool lat; int t = 0;
        if (i < NCTX) { const int n = dir ? NCTX - 1 - i : i; row = NLAT + b * NCTX + n; lat = false; }
        else { const int ii = i - NCTX; t = dir ? SEQ - 1 - ii : ii; row = (size_t)b * SEQ + t; lat = true; }
        const bf16_t* pr = P + row * NP;
        const int colb = (e < 32 ? C_GK : C_GQ) + h * 32;
        float val = bf2f(pr[colb + d]);
        if (lat) {
            const int half = d >> 4, i16 = d & 15, j = i16 & 7; const int pos = half ? (t & 63) : (t >> 6);
            const float cs = ctab[pos][j], sn = stab[pos][j];
            const int dp = (i16 < 8) ? d + 8 : d - 8; const float sg = (i16 < 8) ? -1.f : 1.f;
            val = val * cs + sg * bf2f(pr[colb + dp]) * sn;
        }
        if (e < 32) { sk[d] = val; sa[d] = expf(LG[((size_t)dir * MTOT + row) * 128 + h * 32 + d]); } else sq[d] = val * qs;
        __syncthreads();
        const float v = bf2f(pr[C_GV + h * 64 + e]); float o = 0.f;
        for (int dd = 0; dd < 32; ++dd) { S[dd] = sa[dd] * S[dd] + sk[dd] * v; o += sq[dd] * S[dd]; }
        if (lat || !last) { float* op = OG + row * 256 + h * 64 + e; if (dir) *op += o; else *op = o; }
        __syncthreads();
    }
}

__global__ void k_gla_fin(const float* OG, const bf16_t* P, const float* g_norm, bf16_t* Y, int row_lo) {
    const int row = row_lo + blockIdx.x, tid = threadIdx.x;
    __shared__ float red[256];
    const float o = OG[(size_t)row * 256 + tid]; red[tid] = o * o; __syncthreads();
    for (int s = 32; s > 0; s >>= 1) { if ((tid & 63) < s) red[tid] += red[tid + s]; __syncthreads(); }
    const float ms = red[tid & ~63] * (1.f / 64.f);
    const float y = o * rsqrtf(ms + EPS) * g_norm[tid & 63];
    Y[(size_t)row * DM + tid] = f2bf(y * silu_f(bf2f(P[(size_t)row * NP + C_GATE + tid])));
}

__global__ void k_na(const bf16_t* P, const float* rpb  , bf16_t* Y, int row_lo) {
    const int row = row_lo + blockIdx.x, h = blockIdx.y, tid = threadIdx.x;
    __shared__ float q[64], sc[384], red[64]; __shared__ int key[384];
    const bool lat = row < NLAT;
    const int b = lat ? row / SEQ : (row - NLAT) / NCTX;
    q[tid] = bf2f(P[(size_t)row * NP + C_NQ + h * 64 + tid]) * 0.125f;
    __syncthreads();
    const int nk = lat ? 384 : 256;
    int r = 0, c = 0, R0 = 0, cs = 0;
    if (lat) { const int t = row % SEQ; r = t >> 6; c = t & 63; R0 = min(max(r - 4, 0), 56); cs = min(max(c - 8, 0), 48); }
    for (int kk = tid; kk < nk; kk += 64) {
        int krow; float bias = 0.f;
        if (lat && kk < 128) { const int i = kk >> 4, j = kk & 15; const int kr_ = R0 + i, kc_ = cs + j; krow = b * SEQ + kr_ * 64 + kc_;
            const int ro = kr_ - r + 7; const int co = min(max(kc_ - c, -15), 15) + 15; bias = rpb[(h * 15 + ro) * 31 + co]; }
        else krow = NLAT + b * NCTX + (lat ? kk - 128 : kk);
        key[kk] = krow;
        const bf16_t* kp = P + (size_t)krow * NP + C_NK + h * 64; float s = 0.f;
        for (int d = 0; d < 64; ++d) s += q[d] * bf2f(kp[d]);
        sc[kk] = s + bias;
    }
    __syncthreads();
    float m = -INFINITY; for (int kk = tid; kk < nk; kk += 64) m = fmaxf(m, sc[kk]);
    red[tid] = m; __syncthreads();
    for (int s = 32; s > 0; s >>= 1) { if (tid < s) red[tid] = fmaxf(red[tid], red[tid + s]); __syncthreads(); }
    m = red[0]; __syncthreads();
    float l = 0.f; for (int kk = tid; kk < nk; kk += 64) { const float p = expf(sc[kk] - m); sc[kk] = p; l += p; }
    red[tid] = l; __syncthreads();
    for (int s = 32; s > 0; s >>= 1) { if (tid < s) red[tid] += red[tid + s]; __syncthreads(); }
    l = red[0];
    float o = 0.f;
    for (int kk = 0; kk < nk; ++kk) o += sc[kk] * bf2f(P[(size_t)key[kk] * NP + C_NV + h * 64 + tid]);
    o /= l;
    const int col = 256 + h * 64 + tid;
    Y[(size_t)row * DM + col] = f2bf(o * silu_f(bf2f(P[(size_t)row * NP + C_GATE + col])));
}

__global__ void k_s5(const bf16_t* P, Inputs in, int l, float* SY, int dir, int last) {
    const int b = blockIdx.x >> 4, g = blockIdx.x & 15, p = threadIdx.x;
    const int dg = (l * 2 + dir) * 16 + g;
    const float dt = expf(in.s5_log_dt[dg]);
    const float lre = in.s5_lam_re[dg * 64 + p], lim = in.s5_lam_im[dg * 64 + p];
    const float mag = expf(lre * dt), ang = lim * dt;
    const float lbr = mag * cosf(ang), lbi = mag * sinf(ang);
    const float nr = lbr - 1.f, ni = lbi, den = lre * lre + lim * lim;
    const float cr = (nr * lre + ni * lim) / den, ci = (ni * lre - nr * lim) / den;
    float bbr[16], bbi[16], cre[16], cim[16];
    for (int h = 0; h < 16; ++h) { const float br = in.s5_b_re[((size_t)dg * 64 + p) * 16 + h], bi = in.s5_b_im[((size_t)dg * 64 + p) * 16 + h];
        bbr[h] = cr * br - ci * bi; bbi[h] = cr * bi + ci * br;
        cre[h] = in.s5_c_re[((size_t)dg * 16 + h) * 64 + p]; cim[h] = in.s5_c_im[((size_t)dg * 16 + h) * 64 + p]; }
    __shared__ float part[16][65];
    float xr = 0.f, xi = 0.f;
    for (int i = 0; i < NCTX + SEQ; ++i) {
        size_t row; bool wr;
        if (i < NCTX) { const int n = dir ? NCTX - 1 - i : i; row = NLAT + b * NCTX + n; wr = !last; }
        else { const int ii = i - NCTX; const int t = dir ? SEQ - 1 - ii : ii; row = (size_t)b * SEQ + t; wr = true; }
        const bf16_t* up = P + row * NP + C_SU + g * 16;
        float bur = 0.f, bui = 0.f;
        for (int h = 0; h < 16; ++h) { const float u = bf2f(up[h]); bur += u * bbr[h]; bui += u * bbi[h]; }
        const float nxr = lbr * xr - lbi * xi + bur, nxi = lbr * xi + lbi * xr + bui; xr = nxr; xi = nxi;
        if (wr) {
            for (int h = 0; h < 16; ++h) part[h][p] = xr * cre[h] - xi * cim[h];
            __syncthreads();
            const int hh = p >> 2, q4 = p & 3; float s = 0.f;
            for (int k = 0; k < 16; ++k) s += part[hh][q4 * 16 + k];
            s += __shfl_xor(s, 1); s += __shfl_xor(s, 2);
            if (q4 == 0) { float* op = SY + row * 256 + g * 16 + hh; if (dir) *op += s; else *op = s; }
            __syncthreads();
        }
    }
}

__global__ void k_s5_glu(const float* SY, const bf16_t* P, const float* d_skip, const float* w_glu  , const float* b_glu, bf16_t* Y, int row_lo) {
    const int row = row_lo + blockIdx.x, n = threadIdx.x;
    __shared__ float gsh[256];
    const float u = bf2f(P[(size_t)row * NP + C_SU + n]);
    const float y = u * d_skip[n] + SY[(size_t)row * 256 + n];
    const float gv = gelu_tanh_f(y); gsh[n] = gv; __syncthreads();
    float z = b_glu[n];
    for (int k = 0; k < 256; ++k) z += gsh[k] * w_glu[k * 256 + n];
    const float o = gv * sigmoid_f(z);
    const int col = 512 + n;
    Y[(size_t)row * DM + col] = f2bf(o * silu_f(bf2f(P[(size_t)row * NP + C_GATE + col])));
}

__global__ void k_pool(const bf16_t* P, const float* pool_w  , const float* pool_scale, bf16_t* Y, int row_lo) {
    const int row = row_lo + blockIdx.x, n = threadIdx.x;
    const bool lat = row < NLAT; const int len = lat ? SEQ : NCTX;
    const int base = lat ? (row / SEQ) * SEQ : NLAT + ((row - NLAT) / NCTX) * NCTX; const int t = row - base;
    const int part = n >> 6; const int w = 2 << part;
    const int lo = min(max(t - w / 2, 0), len), hi = min(max(t - w / 2 + w, 0), len);
    float s = 0.f;
    for (int tt = lo; tt < hi; ++tt) s += bf2f(P[(size_t)(base + tt) * NP + C_PU + n]);
    __shared__ float m[256];
    m[n] = s / (float)(hi - lo) - bf2f(P[(size_t)row * NP + C_PU + n]); __syncthreads();
    float o = 0.f; const int e = n & 63;
    for (int cc = 0; cc < 64; ++cc) o += m[part * 64 + cc] * pool_w[(part * 64 + cc) * 64 + e];
    o *= pool_scale[n];
    const int col = 768 + n;
    Y[(size_t)row * DM + col] = f2bf(o * silu_f(bf2f(P[(size_t)row * NP + C_GATE + col])));
}

__global__ void k_out(const float* O, const float* xlat, const float* xctx, const float* g_post, const float* MODl, float* outlat, float* outctx) {
    const int row = blockIdx.x, tid = threadIdx.x;
    const bool lat = row < NLAT; const int j = lat ? row / SEQ : 4;
    const float* xr = lat ? xlat + (size_t)row * DM : xctx + (size_t)(row - NLAT) * DM;
    float* orow = lat ? outlat + (size_t)row * DM : outctx + (size_t)(row - NLAT) * DM;
    __shared__ float red[256];
    float v[4]; float s = 0.f;
    for (int i = 0; i < 4; ++i) { v[i] = O[(size_t)row * DM + tid + 256 * i]; s += v[i] * v[i]; }
    red[tid] = s; __syncthreads();
    for (int o = 128; o > 0; o >>= 1) { if (tid < o) red[tid] += red[tid + o]; __syncthreads(); }
    const float rstd = rsqrtf(red[0] / DM + EPS);
    const float* gate = MODl + j * 3072 + 2048;
    for (int i = 0; i < 4; ++i) { const int k = tid + 256 * i; orow[k] = xr[k] + gate[k] * (v[i] * rstd * g_post[k]); }
}

extern "C" void kernel_launch(void* const* d_in, const int* in_sizes, int n_in, void* d_out, int out_size, void* d_ws, size_t ws_size, hipStream_t stream) {
    Inputs in;
    const float** ip = (const float**)&in;
    for (int i = 0; i < 26; ++i) ip[i] = (const float*)d_in[i];
    char* ws = (char*)d_ws;
    bf16_t* WIN = (bf16_t*)(ws + OFF_WIN); bf16_t* WOUT = (bf16_t*)(ws + OFF_WOUT); float* MOD = (float*)(ws + OFF_MOD);
    bf16_t* H = (bf16_t*)(ws + OFF_H); bf16_t* Y = H; bf16_t* P = (bf16_t*)(ws + OFF_P); float* O = (float*)(ws + OFF_P);
    float* XC = (float*)(ws + OFF_XC); float* LG = (float*)(ws + OFF_LG); float* OG = (float*)(ws + OFF_OG); float* SY = (float*)(ws + OFF_SY);
    float* out = (float*)d_out;
    for (int l = 0; l < 2; ++l) {
        k_transpose_w<<<dim3(NP / 32, DM / 32), 256, 0, stream>>>(in.w_in + (size_t)l * DM * NIN, DM, NIN, NP, WIN + (size_t)l * NP * DM);
        k_transpose_w<<<dim3(DM / 32, DM / 32), 256, 0, stream>>>(in.w_out + (size_t)l * DM * DM, DM, DM, DM, WOUT + (size_t)l * DM * DM);
    }
    k_mod<<<dim3(12, 5, 2), 256, 0, stream>>>(in, MOD);
    for (int l = 0; l < 2; ++l) {
        const int last = (l == 1);
        const float* xlat = l == 0 ? in.x : out; const float* xctx = l == 0 ? in.ctx : XC;
        const float* MODl = MOD + (size_t)l * 5 * 3072;
        const int nrows = last ? NLAT : MTOT;
        k_norm<<<MTOT, 256, 0, stream>>>(xlat, xctx, in.g_pre + l * DM, MODl, H);
        k_gemm<true><<<dim3(NP / 64, MTOT / 64), 256, 0, stream>>>(H, WIN + (size_t)l * NP * DM, P, MTOT, NP, DM, NP);
        k_lg<<<dim3(MTOT, 2), 128, 0, stream>>>(P, in.gla_w_gate + l * 2 * 16 * 128, in.gla_b_gate + l * 2 * 128, LG);
        k_gla<<<16, 64, 0, stream>>>(P, LG, OG, 0, last);
        k_gla<<<16, 64, 0, stream>>>(P, LG, OG, 1, last);
        k_gla_fin<<<nrows, 256, 0, stream>>>(OG, P, in.gla_g_norm + l * 64, Y, 0);
        k_na<<<dim3(nrows, 4), 64, 0, stream>>>(P, in.na_rpb + l * 4 * 15 * 31, Y, 0);
        k_s5<<<64, 64, 0, stream>>>(P, in, l, SY, 0, last);
        k_s5<<<64, 64, 0, stream>>>(P, in, l, SY, 1, last);
        k_s5_glu<<<nrows, 256, 0, stream>>>(SY, P, in.s5_d + l * 256, in.s5_w_glu + l * 65536, in.s5_b_glu + l * 256, Y, 0);
        k_pool<<<nrows, 256, 0, stream>>>(P, in.pool_w + l * 4 * 64 * 64, in.pool_scale + l * 256, Y, 0);
        k_gemm<false><<<dim3(DM / 64, nrows / 64), 256, 0, stream>>>(Y, WOUT + (size_t)l * DM * DM, O, nrows, DM, DM, DM);
        k_out<<<nrows, 256, 0, stream>>>(O, xlat, xctx, in.g_post + l * DM, MODl, out, XC);
    }
}
```

```cpp
#include <hip/hip_runtime.h>
#include <hip/hip_cooperative_groups.h>
#include <stdint.h>
#include <math.h>
#include <cstdio>
#include <cstring>

typedef unsigned short bf16_t;
__device__ __forceinline__ float bf2f(bf16_t v) { return __uint_as_float(((unsigned)v) << 16); }
__device__ __forceinline__ bf16_t f2bf(float f) { unsigned u = __float_as_uint(f); return (bf16_t)((u + 0x7fffu + ((u >> 16) & 1u)) >> 16); }

constexpr int DM = 1024, NB = 4, SEQ = 4096, NCTX = 256, GW = 64;
constexpr int NLAT = NB * SEQ;
constexpr int NCT = NB * NCTX;
constexpr int MTOT = NLAT + NCT;
constexpr int NIN = 2848, NP = 3072;
constexpr int C_GK = 0, C_GV = 128, C_GF = 384, C_GB = 400, C_NK = 416, C_NV = 672, C_SU = 928, C_GQ = 1184, C_NQ = 1312, C_PU = 1568, C_GATE = 1824;
constexpr float EPS = 1e-6f;

constexpr size_t OFF_CTL = 0, CTL_BYTES = 256 * 1024;
constexpr size_t OFF_WIN = OFF_CTL + CTL_BYTES;
constexpr size_t OFF_WOUT = OFF_WIN + (size_t)2 * NP * DM * 2;
constexpr size_t OFF_MOD = OFF_WOUT + (size_t)2 * DM * DM * 2;
constexpr size_t OFF_H = OFF_MOD + (size_t)2 * 5 * 3072 * 4 + 1024;
constexpr size_t OFF_P = OFF_H + (size_t)MTOT * DM * 2;
constexpr size_t OFF_XC = OFF_P + (size_t)MTOT * NP * 2;
constexpr size_t OFF_LG = OFF_XC + (size_t)NCT * DM * 4;
constexpr size_t OFF_OG = OFF_LG + (size_t)2 * MTOT * 128 * 4;
constexpr size_t OFF_SY = OFF_OG + (size_t)MTOT * 256 * 4;
constexpr size_t OFF_END = OFF_SY + (size_t)MTOT * 256 * 4;
static_assert(OFF_END <= (size_t)256 * 1024 * 1024, "ws");

struct Inputs {
    const float *x, *c, *ctx, *c_ctx, *w_mod, *b_mod, *g_pre, *g_post, *w_in, *w_out, *gla_w_gate, *gla_b_gate, *gla_g_norm, *na_rpb,
        *s5_lam_re, *s5_lam_im, *s5_log_dt, *s5_b_re, *s5_b_im, *s5_c_re, *s5_c_im, *s5_d, *s5_w_glu, *s5_b_glu, *pool_w, *pool_scale;
};

__device__ __forceinline__ float silu_f(float v) { return v / (1.f + expf(-v)); }
__device__ __forceinline__ float sigmoid_f(float v) { return 1.f / (1.f + expf(-v)); }
__device__ __forceinline__ float gelu_tanh_f(float v) { const float k = 0.7978845608028654f; return 0.5f * v * (1.f + tanhf(k * (v + 0.044715f * v * v * v))); }
__device__ __forceinline__ float logsigmoid_f(float z) { return fminf(z, 0.f) - log1pf(expf(-fabsf(z))); }

__global__ void k_transpose_w(const float* W, int K, int N, int Npad, bf16_t* WT) {
    __shared__ float t[32][33];
    const int n0 = blockIdx.x * 32, k0 = blockIdx.y * 32;
    const int tx = threadIdx.x & 31, ty = threadIdx.x >> 5;
    for (int i = ty; i < 32; i += 8) { const int n = n0 + tx; t[i][tx] = (n < N) ? W[(size_t)(k0 + i) * N + n] : 0.f; }
    __syncthreads();
    for (int i = ty; i < 32; i += 8) { const int n = n0 + i; if (n < Npad) WT[(size_t)n * K + k0 + tx] = f2bf(t[tx][i]); }
}

__global__ void k_mod(Inputs in, float* MOD) {
    const int n = blockIdx.x * 256 + threadIdx.x, j = blockIdx.y, l = blockIdx.z;
    const float* cv = (j < 4) ? in.c + j * DM : in.c_ctx;
    const float* w = in.w_mod + (size_t)l * DM * 3072;
    float acc = 0.f;
    for (int k = 0; k < DM; ++k) acc += silu_f(cv[k]) * w[(size_t)k * 3072 + n];
    MOD[((size_t)l * 5 + j) * 3072 + n] = acc + in.b_mod[l * 3072 + n];
}

__global__ void k_norm(const float* xlat, const float* xctx, const float* g_pre, const float* MODl, bf16_t* H) {
    const int row = blockIdx.x; const int tid = threadIdx.x;
    const float* xr = row < NLAT ? xlat + (size_t)row * DM : xctx + (size_t)(row - NLAT) * DM;
    const int j = row < NLAT ? row / SEQ : 4;
    __shared__ float red[256];
    float v[4]; float s = 0.f;
    for (int i = 0; i < 4; ++i) { v[i] = xr[tid + 256 * i]; s += v[i] * v[i]; }
    red[tid] = s; __syncthreads();
    for (int o = 128; o > 0; o >>= 1) { if (tid < o) red[tid] += red[tid + o]; __syncthreads(); }
    const float rstd = rsqrtf(red[0] / DM + EPS);
    const float* shift = MODl + j * 3072; const float* scale = shift + 1024;
    for (int i = 0; i < 4; ++i) { const int k = tid + 256 * i; const float y = v[i] * rstd * g_pre[k]; H[(size_t)row * DM + k] = f2bf(y * (1.f + scale[k]) + shift[k]); }
}

template <bool OUT_BF16>
__global__ void __launch_bounds__(256) k_gemm(const bf16_t* A, const bf16_t* Bt, void* C, int M, int N, int K, int ldc) {
    __shared__ float As[64][33], Bs[64][33];
    const int m0 = blockIdx.y * 64, n0 = blockIdx.x * 64;
    const int tx = threadIdx.x & 15, ty = threadIdx.x >> 4;
    float acc[4][4] = {};
    for (int k0 = 0; k0 < K; k0 += 32) {
        for (int i = threadIdx.x; i < 64 * 32; i += 256) { const int r = i >> 5, kk = i & 31;
            As[r][kk] = bf2f(A[(size_t)(m0 + r) * K + k0 + kk]); Bs[r][kk] = bf2f(Bt[(size_t)(n0 + r) * K + k0 + kk]); }
        __syncthreads();
        for (int kk = 0; kk < 32; ++kk) { float a[4], b[4];
            for (int i = 0; i < 4; ++i) { a[i] = As[ty + 16 * i][kk]; b[i] = Bs[tx + 16 * i][kk]; }
            for (int i = 0; i < 4; ++i) for (int j = 0; j < 4; ++j) acc[i][j] += a[i] * b[j]; }
        __syncthreads();
    }
    for (int i = 0; i < 4; ++i) for (int j = 0; j < 4; ++j) { const size_t o = (size_t)(m0 + ty + 16 * i) * ldc + n0 + tx + 16 * j;
        if (OUT_BF16) ((bf16_t*)C)[o] = f2bf(acc[i][j]); else ((float*)C)[o] = acc[i][j]; }
}

__global__ void k_lg(const bf16_t* P, const float* w_gate  , const float* b_gate  , float* LG) {
    const int row = blockIdx.x, dir = blockIdx.y, e = threadIdx.x;
    const bf16_t* pr = P + (size_t)row * NP + (dir ? C_GB : C_GF);
    float z = b_gate[dir * 128 + e];
    for (int r = 0; r < 16; ++r) z += bf2f(pr[r]) * w_gate[(dir * 16 + r) * 128 + e];
    LG[((size_t)dir * MTOT + row) * 128 + e] = logsigmoid_f(z) * (1.f / 16.f);
}

__global__ void k_gla(const bf16_t* P, const float* LG, float* OG, int dir, int last) {
    const int b = blockIdx.x >> 2, h = blockIdx.x & 3, e = threadIdx.x;
    __shared__ float ctab[64][8], stab[64][8];
    __shared__ float sa[32], sk[32], sq[32];
    for (int i = threadIdx.x; i < 512; i += 64) { const int pos = i >> 3, j = i & 7; const float f = powf(10000.f, -(float)j / 8.f); const float a = (float)pos * f; ctab[pos][j] = cosf(a); stab[pos][j] = sinf(a); }
    __syncthreads();
    float S[32];
    for (int d = 0; d < 32; ++d) S[d] = 0.f;
    const float qs = 0.17677669529663687f;
    const int d = e & 31;
    for (int i = 0; i < NCTX + SEQ; ++i) {
        size_t row; bool lat; int t = 0;
        if (i < NCTX) { const int n = dir ? NCTX - 1 - i : i; row = NLAT + b * NCTX + n; lat = false; }
        else { const int ii = i - NCTX; t = dir ? SEQ - 1 - ii : ii; row = (size_t)b * SEQ + t; lat = true; }
        const bf16_t* pr = P + row * NP;
        const int colb = (e < 32 ? C_GK : C_GQ) + h * 32;
        float val = bf2f(pr[colb + d]);
        if (lat) {
            const int half = d >> 4, i16 = d & 15, j = i16 & 7; const int pos = half ? (t & 63) : (t >> 6);
            const float cs = ctab[pos][j], sn = stab[pos][j];
            const int dp = (i16 < 8) ? d + 8 : d - 8; const float sg = (i16 < 8) ? -1.f : 1.f;
            val = val * cs + sg * bf2f(pr[colb + dp]) * sn;
        }
        if (e < 32) { sk[d] = val; sa[d] = expf(LG[((size_t)dir * MTOT + row) * 128 + h * 32 + d]); } else sq[d] = val * qs;
        __syncthreads();
        const float v = bf2f(pr[C_GV + h * 64 + e]); float o = 0.f;
        for (int dd = 0; dd < 32; ++dd) { S[dd] = sa[dd] * S[dd] + sk[dd] * v; o += sq[dd] * S[dd]; }
        if (lat || !last) { float* op = OG + row * 256 + h * 64 + e; if (dir) *op += o; else *op = o; }
        __syncthreads();
    }
}

__global__ void k_gla_fin(const float* OG, const bf16_t* P, const float* g_norm, bf16_t* Y, int row_lo) {
    const int row = row_lo + blockIdx.x, tid = threadIdx.x;
    __shared__ float red[256];
    const float o = OG[(size_t)row * 256 + tid]; red[tid] = o * o; __syncthreads();
    for (int s = 32; s > 0; s >>= 1) { if ((tid & 63) < s) red[tid] += red[tid + s]; __syncthreads(); }
    const float ms = red[tid & ~63] * (1.f / 64.f);
    const float y = o * rsqrtf(ms + EPS) * g_norm[tid & 63];
    Y[(size_t)row * DM + tid] = f2bf(y * silu_f(bf2f(P[(size_t)row * NP + C_GATE + tid])));
}

__global__ void k_na(const bf16_t* P, const float* rpb  , bf16_t* Y, int row_lo) {
    const int row = row_lo + blockIdx.x, h = blockIdx.y, tid = threadIdx.x;
    __shared__ float q[64], sc[384], red[64]; __shared__ int key[384];
    const bool lat = row < NLAT;
    const int b = lat ? row / SEQ : (row - NLAT) / NCTX;
    q[tid] = bf2f(P[(size_t)row * NP + C_NQ + h * 64 + tid]) * 0.125f;
    __syncthreads();
    const int nk = lat ? 384 : 256;
    int r = 0, c = 0, R0 = 0, cs = 0;
    if (lat) { const int t = row % SEQ; r = t >> 6; c = t & 63; R0 = min(max(r - 4, 0), 56); cs = min(max(c - 8, 0), 48); }
    for (int kk = tid; kk < nk; kk += 64) {
        int krow; float bias = 0.f;
        if (lat && kk < 128) { const int i = kk >> 4, j = kk & 15; const int kr_ = R0 + i, kc_ = cs + j; krow = b * SEQ + kr_ * 64 + kc_;
            const int ro = kr_ - r + 7; const int co = min(max(kc_ - c, -15), 15) + 15; bias = rpb[(h * 15 + ro) * 31 + co]; }
        else krow = NLAT + b * NCTX + (lat ? kk - 128 : kk);
        key[kk] = krow;
        const bf16_t* kp = P + (size_t)krow * NP + C_NK + h * 64; float s = 0.f;
        for (int d = 0; d < 64; ++d) s += q[d] * bf2f(kp[d]);
        sc[kk] = s + bias;
    }
    __syncthreads();
    float m = -INFINITY; for (int kk = tid; kk < nk; kk += 64) m = fmaxf(m, sc[kk]);
    red[tid] = m; __syncthreads();
    for (int s = 32; s > 0; s >>= 1) { if (tid < s) red[tid] = fmaxf(red[tid], red[tid + s]); __syncthreads(); }
    m = red[0]; __syncthreads();
    float l = 0.f; for (int kk = tid; kk < nk; kk += 64) { const float p = expf(sc[kk] - m); sc[kk] = p; l += p; }
    red[tid] = l; __syncthreads();
    for (int s = 32; s > 0; s >>= 1) { if (tid < s) red[tid] += red[tid + s]; __syncthreads(); }
    l = red[0];
    float o = 0.f;
    for (int kk = 0; kk < nk; ++kk) o += sc[kk] * bf2f(P[(size_t)key[kk] * NP + C_NV + h * 64 + tid]);
    o /= l;
    const int col = 256 + h * 64 + tid;
    Y[(size_t)row * DM + col] = f2bf(o * silu_f(bf2f(P[(size_t)row * NP + C_GATE + col])));
}

__global__ void k_s5(const bf16_t* P, Inputs in, int l, float* SY, int dir, int last) {
    const int b = blockIdx.x >> 4, g = blockIdx.x & 15, p = threadIdx.x;
    const int dg = (l * 2 + dir) * 16 + g;
    const float dt = expf(in.s5_log_dt[dg]);
    const float lre = in.s5_lam_re[dg * 64 + p], lim = in.s5_lam_im[dg * 64 + p];
    const float mag = expf(lre * dt), ang = lim * dt;
    const float lbr = mag * cosf(ang), lbi = mag * sinf(ang);
    const float nr = lbr - 1.f, ni = lbi, den = lre * lre + lim * lim;
    const float cr = (nr * lre + ni * lim) / den, ci = (ni * lre - nr * lim) / den;
    float bbr[16], bbi[16], cre[16], cim[16];
    for (int h = 0; h < 16; ++h) { const float br = in.s5_b_re[((size_t)dg * 64 + p) * 16 + h], bi = in.s5_b_im[((size_t)dg * 64 + p) * 16 + h];
        bbr[h] = cr * br - ci * bi; bbi[h] = cr * bi + ci * br;
        cre[h] = in.s5_c_re[((size_t)dg * 16 + h) * 64 + p]; cim[h] = in.s5_c_im[((size_t)dg * 16 + h) * 64 + p]; }
    __shared__ float part[16][65];
    float xr = 0.f, xi = 0.f;
    for (int i = 0; i < NCTX + SEQ; ++i) {
        size_t row; bool wr;
        if (i < NCTX) { const int n = dir ? NCTX - 1 - i : i; row = NLAT + b * NCTX + n; wr = !last; }
        else { const int ii = i - NCTX; const int t = dir ? SEQ - 1 - ii : ii; row = (size_t)b * SEQ + t; wr = true; }
        const bf16_t* up = P + row * NP + C_SU + g * 16;
        float bur = 0.f, bui = 0.f;
        for (int h = 0; h < 16; ++h) { const float u = bf2f(up[h]); bur += u * bbr[h]; bui += u * bbi[h]; }
        const float nxr = lbr * xr - lbi * xi + bur, nxi = lbr * xi + lbi * xr + bui; xr = nxr; xi = nxi;
        if (wr) {
            for (int h = 0; h < 16; ++h) part[h][p] = xr * cre[h] - xi * cim[h];
            __syncthreads();
            const int hh = p >> 2, q4 = p & 3; float s = 0.f;
            for (int k = 0; k < 16; ++k) s += part[hh][q4 * 16 + k];
            s += __shfl_xor(s, 1); s += __shfl_xor(s, 2);
            if (q4 == 0) { float* op = SY + row * 256 + g * 16 + hh; if (dir) *op += s; else *op = s; }
            __syncthreads();
        }
    }
}

__global__ void k_s5_glu(const float* SY, const bf16_t* P, const float* d_skip, const float* w_glu  , const float* b_glu, bf16_t* Y, int row_lo) {
    const int row = row_lo + blockIdx.x, n = threadIdx.x;
    __shared__ float gsh[256];
    const float u = bf2f(P[(size_t)row * NP + C_SU + n]);
    const float y = u * d_skip[n] + SY[(size_t)row * 256 + n];
    const float gv = gelu_tanh_f(y); gsh[n] = gv; __syncthreads();
    float z = b_glu[n];
    for (int k = 0; k < 256; ++k) z += gsh[k] * w_glu[k * 256 + n];
    const float o = gv * sigmoid_f(z);
    const int col = 512 + n;
    Y[(size_t)row * DM + col] = f2bf(o * silu_f(bf2f(P[(size_t)row * NP + C_GATE + col])));
}

__global__ void k_pool(const bf16_t* P, const float* pool_w  , const float* pool_scale, bf16_t* Y, int row_lo) {
    const int row = row_lo + blockIdx.x, n = threadIdx.x;
    const bool lat = row < NLAT; const int len = lat ? SEQ : NCTX;
    const int base = lat ? (row / SEQ) * SEQ : NLAT + ((row - NLAT) / NCTX) * NCTX; const int t = row - base;
    const int part = n >> 6; const int w = 2 << part;
    const int lo = min(max(t - w / 2, 0), len), hi = min(max(t - w / 2 + w, 0), len);
    float s = 0.f;
    for (int tt = lo; tt < hi; ++tt) s += bf2f(P[(size_t)(base + tt) * NP + C_PU + n]);
    __shared__ float m[256];
    m[n] = s / (float)(hi - lo) - bf2f(P[(size_t)row * NP + C_PU + n]); __syncthreads();
    float o = 0.f; const int e = n & 63;
    for (int cc = 0; cc < 64; ++cc) o += m[part * 64 + cc] * pool_w[(part * 64 + cc) * 64 + e];
    o *= pool_scale[n];
    const int col = 768 + n;
    Y[(size_t)row * DM + col] = f2bf(o * silu_f(bf2f(P[(size_t)row * NP + C_GATE + col])));
}

__global__ void k_out(const float* O, const float* xlat, const float* xctx, const float* g_post, const float* MODl, float* outlat, float* outctx) {
    const int row = blockIdx.x, tid = threadIdx.x;
    const bool lat = row < NLAT; const int j = lat ? row / SEQ : 4;
    const float* xr = lat ? xlat + (size_t)row * DM : xctx + (size_t)(row - NLAT) * DM;
    float* orow = lat ? outlat + (size_t)row * DM : outctx + (size_t)(row - NLAT) * DM;
    __shared__ float red[256];
    float v[4]; float s = 0.f;
    for (int i = 0; i < 4; ++i) { v[i] = O[(size_t)row * DM + tid + 256 * i]; s += v[i] * v[i]; }
    red[tid] = s; __syncthreads();
    for (int o = 128; o > 0; o >>= 1) { if (tid < o) red[tid] += red[tid + o]; __syncthreads(); }
    const float rstd = rsqrtf(red[0] / DM + EPS);
    const float* gate = MODl + j * 3072 + 2048;
    for (int i = 0; i < 4; ++i) { const int k = tid + 256 * i; orow[k] = xr[k] + gate[k] * (v[i] * rstd * g_post[k]); }
}

#define LAS __attribute__((address_space(3)))
namespace pg8 {
#define PG8_LAS __attribute__((address_space(3)))
typedef unsigned short bf16_t;
typedef short bf16x8 __attribute__((ext_vector_type(8)));
typedef float f32x4 __attribute__((ext_vector_type(4)));
typedef unsigned u32x4 __attribute__((ext_vector_type(4)));
constexpr int BM = 256, BK = 64, HALF = 128, HTB = HALF * BK * 2  , STAGE_BYTES = 8 * HTB, NXCD = 8, WGM = 8;

__host__ __device__ __forceinline__ int lds_byte(int r, int c) { const int st = (r >> 4) * 2 + (c >> 5), rr = r & 15, cc = c & 31, ob = rr * 64 + cc * 2; return st * 1024 + (ob ^ (((ob >> 9) & 1) << 5)); }
__host__ __device__ __forceinline__ void stage_rc(int b, int& R, int& C) { const int st = b / 1024, sb = b % 1024, swz = sb ^ (((sb >> 9) & 1) << 5); R = (st >> 1) * 16 + swz / 64; C = (st & 1) * 32 + (swz % 64) / 2; }
__host__ __device__ __forceinline__ int perm32(int rho) { const int n = rho >> 4, i = rho & 15; return 8 * (i >> 2) + 4 * n + (i & 3); }

struct Unit { int pm, pn; };
struct Gemm { const bf16_t* A; const bf16_t* Bt; int M, N, K; };

struct StaticOrder {
    int nM, nN, nwg, G, c;
    __host__ __device__ void init(int M, int N, int G_, int c_) { nM = M / BM; nN = N / BM; nwg = nM * nN; G = G_; c = c_; }
    __host__ __device__ bool next(int i, Unit& u) const {
        const long L = (long)i * G + c; if (L >= nwg) return false;
        int wgid = (int)L; { const int q = nwg / NXCD, r = nwg % NXCD, xcd = wgid % NXCD, off = wgid / NXCD; wgid = (xcd < r ? xcd * (q + 1) : r * (q + 1) + (xcd - r) * q) + off; }
        const int nig = WGM * nN, gid = wgid / nig, fm = gid * WGM, gsz = (nM - fm) < WGM ? (nM - fm) : WGM;
        u.pm = fm + ((wgid % nig) % gsz); u.pn = (wgid % nig) / gsz; return true;
    }
    __device__ __forceinline__ void a_ready(const Unit&) const {}
    __device__ __forceinline__ void done(const Unit&) const {}
};

__device__ __forceinline__ unsigned cvt_pk_bf16(float lo, float hi) { unsigned r; asm volatile("v_cvt_pk_bf16_f32 %0, %1, %2" : "=v"(r) : "v"(lo), "v"(hi)); return r; }
typedef float f32x2 __attribute__((ext_vector_type(2)));
__device__ __forceinline__ f32x2 gelu_pk(f32x2 v) {
    const f32x2 av = __builtin_elementwise_abs(v), d = av * 0.2316418882f + 1.0f;
    f32x2 t; t.x = __builtin_amdgcn_rcpf(d.x); t.y = __builtin_amdgcn_rcpf(d.y);
    f32x2 q = t * 0.5307027145f + (-0.7265760135f); q = q * t + 0.7107068705f; q = q * t + (-0.142248368f); q = q * t + 0.127414796f; q = q * t;
    const f32x2 s = (v * v) * (-0.72134752044f);
    f32x2 e; e.x = __builtin_amdgcn_exp2f(s.x); e.y = __builtin_amdgcn_exp2f(s.y);
    const f32x2 m = v * (q * e), r = v - m;
    f32x2 o; o.x = v.x < 0.f ? m.x : r.x; o.y = v.y < 0.f ? m.y : r.y; return o;
}

template <int ACT  > struct EpiBf16 {
    static constexpr bool PERM = true, AFTER_DRAIN = false; static_assert(ACT == 0 || ACT == 1, "EpiBf16: ACT is 0 (none) or 1 (gelu_pk)");
    bf16_t* O; int ldc; const float* bias; int split_cols; size_t split_stride; float scale0;
    __device__ __forceinline__ void operator()(const f32x4 (&acc)[2][2][4][2], const Unit& u, int wr, int wc, int fr, int fq) const {
        const int row0 = u.pm * BM + wr * 64 + fr; int colt = u.pn * BM; bf16_t* base = O;
        float sc = 1.f; if (split_cols) { const int t = colt / split_cols; base += (size_t)t * split_stride; colt -= t * split_cols; if (t == 0) sc = scale0; }
        const int col0 = colt + wc * 32 + 8 * fq, bcol0 = u.pn * BM + wc * 32 + 8 * fq;
        f32x4 bv[2][2];
#pragma unroll
        for (int bj = 0; bj < 2; ++bj)
#pragma unroll
            for (int n = 0; n < 2; ++n) bv[bj][n] = bias ? *(const f32x4*)(bias + bcol0 + bj * HALF + 4 * n) : (f32x4){0.f, 0.f, 0.f, 0.f};
#pragma unroll
        for (int ai = 0; ai < 2; ++ai)
#pragma unroll
            for (int m = 0; m < 4; ++m) { bf16_t* rowp = base + (size_t)(row0 + ai * HALF + m * 16) * ldc + col0;
#pragma unroll
                for (int bj = 0; bj < 2; ++bj) { f32x4 v0 = acc[ai][bj][m][0] + bv[bj][0], v1 = acc[ai][bj][m][1] + bv[bj][1];
                    if (ACT == 1) { f32x2 a = gelu_pk((f32x2){v0[0], v0[1]}), b = gelu_pk((f32x2){v0[2], v0[3]}), c = gelu_pk((f32x2){v1[0], v1[1]}), d = gelu_pk((f32x2){v1[2], v1[3]});
                        v0 = (f32x4){a.x, a.y, b.x, b.y}; v1 = (f32x4){c.x, c.y, d.x, d.y}; }
                    v0 = v0 * sc; v1 = v1 * sc; u32x4 w; w.x = cvt_pk_bf16(v0[0], v0[1]); w.y = cvt_pk_bf16(v0[2], v0[3]); w.z = cvt_pk_bf16(v1[0], v1[1]); w.w = cvt_pk_bf16(v1[2], v1[3]);
                    *(u32x4*)(rowp + bj * HALF) = w; } }
    }
};
struct EpiF32 {
    static constexpr bool PERM = false, AFTER_DRAIN = false;
    float* C; int ldc; const float* bias;
    __device__ __forceinline__ void operator()(const f32x4 (&acc)[2][2][4][2], const Unit& u, int wr, int wc, int fr, int fq) const {
        const int row0 = u.pm * BM + wr * 64 + fr, col0 = u.pn * BM + wc * 32 + 4 * fq;
        f32x4 bv[2][2];
#pragma unroll
        for (int bj = 0; bj < 2; ++bj)
#pragma unroll
            for (int n = 0; n < 2; ++n) bv[bj][n] = bias ? *(const f32x4*)(bias + col0 + bj * HALF + n * 16) : (f32x4){0.f, 0.f, 0.f, 0.f};
#pragma unroll
        for (int ai = 0; ai < 2; ++ai)
#pragma unroll
            for (int m = 0; m < 4; ++m) { float* rowp = C + (size_t)(row0 + ai * HALF + m * 16) * ldc + col0;
#pragma unroll
                for (int bj = 0; bj < 2; ++bj)
#pragma unroll
                    for (int n = 0; n < 2; ++n) *(f32x4*)(rowp + bj * HALF + n * 16) = acc[ai][bj][m][n] + bv[bj][n]; }
    }
};
template <class Epi, class Sched, bool ALIGN_EPI = false, bool SP2 = false>
__device__ __forceinline__ void gemm_phase(PG8_LAS unsigned char* lds, const Gemm g, const Sched& S, const Epi& E) {
    const int tid = threadIdx.x, wid = __builtin_amdgcn_readfirstlane(tid >> 6), lane = tid & 63, wr = wid >> 2, wc = wid & 3, fr = lane & 15, fq = lane >> 4;
    const int K = g.K, nt = K / BK;
    unsigned voffA[2], voffB[2];
#pragma unroll
    for (int i = 0; i < 2; ++i) { int R, C; stage_rc(tid * 16 + i * 8192, R, C); const int Rb = Epi::PERM ? ((R & ~31) + perm32(R & 31)) : R;
        voffA[i] = (unsigned)(R * K + C) * 2u; voffB[i] = (unsigned)(Rb * K + C) * 2u; }
    const size_t kstep = (size_t)(BK * 2);
    const size_t hstep = (size_t)HALF * K * 2;
    const size_t tstep = 2 * hstep;
    const unsigned ldsw = (unsigned)wid * 1024u;
    const int aoff = lds_byte(wr * 64 + fr, fq * 8), boff = lds_byte(wc * 32 + fr, fq * 8);
#define PG8_SA(b, h) (((b) * 2 + (h)) * HTB)
#define PG8_SB(b, h) ((4 + (b) * 2 + (h)) * HTB)
#define PG8_STAGE(bufoff, gbase, voff) do { _Pragma("unroll") for (int _i = 0; _i < 2; ++_i) \
        __builtin_amdgcn_global_load_lds((const unsigned*)((const char*)(gbase) + (voff)[_i]), (PG8_LAS unsigned*)(lds + (bufoff) + ldsw + _i * 8192), 16, 0, 0); } while (0)
#define PG8_LDA(dst, b, h) do { _Pragma("unroll") for (int m = 0; m < 4; ++m) _Pragma("unroll") for (int k = 0; k < 2; ++k) dst[m][k] = *(const PG8_LAS bf16x8*)(lds + PG8_SA(b, h) + aoff + m * 2048 + k * 1024); } while (0)
#define PG8_LDB(dst, b, h) do { _Pragma("unroll") for (int n = 0; n < 2; ++n) _Pragma("unroll") for (int k = 0; k < 2; ++k) dst[n][k] = *(const PG8_LAS bf16x8*)(lds + PG8_SB(b, h) + boff + n * 2048 + k * 1024); } while (0)
#define PG8_MMA(ai, bj, At, Bt) do { __builtin_amdgcn_s_setprio(1); _Pragma("unroll") for (int m = 0; m < 4; ++m) _Pragma("unroll") for (int n = 0; n < 2; ++n) _Pragma("unroll") for (int k = 0; k < 2; ++k) \
        acc[ai][bj][m][n] = __builtin_amdgcn_mfma_f32_16x16x32_bf16(Bt[n][k], At[m][k], acc[ai][bj][m][n], 0, 0, 0); __builtin_amdgcn_s_setprio(0); } while (0)
#define PG8_WAIT_V(n) asm volatile("s_waitcnt vmcnt(" #n ")" ::: "memory")
#define PG8_WAIT_L(n) asm volatile("s_waitcnt lgkmcnt(" #n ")" ::: "memory")
#define PG8_BAR __builtin_amdgcn_s_barrier()
#define PG8_SCHED __builtin_amdgcn_sched_barrier(0)
    Unit cur, nxt; int ui = 0;
    if (!S.next(0, cur)) return;
    f32x4 acc[2][2][4][2];
#pragma unroll
    for (int a = 0; a < 2; ++a)
#pragma unroll
        for (int b = 0; b < 2; ++b)
#pragma unroll
            for (int m = 0; m < 4; ++m)
#pragma unroll
                for (int n = 0; n < 2; ++n) acc[a][b][m][n] = (f32x4){0.f, 0.f, 0.f, 0.f};
    bf16x8 At[4][2], B0[2][2], B1[2][2];
    const char* cA = (const char*)g.A + (size_t)cur.pm * tstep; const char* cB = (const char*)g.Bt + (size_t)cur.pn * tstep;
    S.a_ready(cur);
    if constexpr (SP2) {
        PG8_STAGE(PG8_SB(0, 0), cB, voffB); PG8_STAGE(PG8_SB(0, 1), cB + hstep, voffB); PG8_STAGE(PG8_SA(0, 0), cA, voffA); PG8_STAGE(PG8_SA(0, 1), cA + hstep, voffA);
        if (wr == 1) PG8_BAR;
        PG8_WAIT_V(2); PG8_BAR;
        PG8_STAGE(PG8_SB(1, 0), cB + kstep, voffB); PG8_STAGE(PG8_SA(1, 0), cA + kstep, voffA); PG8_STAGE(PG8_SB(1, 1), cB + hstep + kstep, voffB);
        PG8_WAIT_V(6); PG8_BAR;
    } else {
        PG8_STAGE(PG8_SB(0, 0), cB, voffB); PG8_STAGE(PG8_SA(0, 0), cA, voffA); PG8_STAGE(PG8_SB(0, 1), cB + hstep, voffB); PG8_STAGE(PG8_SA(0, 1), cA + hstep, voffA);
        if (wr == 1) PG8_BAR;
        PG8_WAIT_V(4); PG8_BAR;
        PG8_STAGE(PG8_SB(1, 0), cB + kstep, voffB); PG8_STAGE(PG8_SA(1, 0), cA + kstep, voffA); PG8_STAGE(PG8_SB(1, 1), cB + hstep + kstep, voffB);
        PG8_WAIT_V(6); PG8_BAR;
    }
    for (;;) {
        const bool has_next = S.next(ui + 1, nxt);
        const char* nA = has_next ? (const char*)g.A + (size_t)nxt.pm * tstep : cA; const char* nB = has_next ? (const char*)g.Bt + (size_t)nxt.pn * tstep : cB;
        for (int t = 0; t < nt; t += 2) {
            const bool last = (t == nt - 2);
            const char* a1 = cA + (size_t)(t + 1) * kstep;
            const char* a2 = last ? nA : cA + (size_t)(t + 2) * kstep; const char* b2 = last ? nB : cB + (size_t)(t + 2) * kstep;
            const char* a3 = a2 + kstep; const char* b3 = b2 + kstep;
            if (last && has_next) S.a_ready(nxt);
            if constexpr (SP2) {
            PG8_LDB(B0, 0, 0); PG8_LDB(B1, 0, 1); PG8_SCHED; PG8_LDA(At, 0, 0); PG8_STAGE(PG8_SA(1, 1), a1 + hstep, voffA);
            PG8_WAIT_V(8); PG8_WAIT_L(0); PG8_BAR; PG8_MMA(0, 0, At, B0); PG8_MMA(0, 1, At, B1); PG8_BAR; PG8_SCHED;
            PG8_LDA(At, 0, 1); PG8_STAGE(PG8_SB(0, 0), b2, voffB); PG8_STAGE(PG8_SB(0, 1), b2 + hstep, voffB); PG8_STAGE(PG8_SA(0, 0), a2, voffA);
            PG8_WAIT_V(8); PG8_WAIT_L(0); PG8_BAR; PG8_MMA(1, 0, At, B0); PG8_MMA(1, 1, At, B1); PG8_BAR; PG8_SCHED;
            PG8_LDB(B0, 1, 0); PG8_LDB(B1, 1, 1); PG8_SCHED; PG8_LDA(At, 1, 0); PG8_STAGE(PG8_SA(0, 1), a2 + hstep, voffA);
            PG8_WAIT_V(8); PG8_WAIT_L(0); PG8_BAR; PG8_MMA(0, 0, At, B0); PG8_MMA(0, 1, At, B1); PG8_BAR; PG8_SCHED;
            PG8_LDA(At, 1, 1); PG8_STAGE(PG8_SB(1, 0), b3, voffB); PG8_STAGE(PG8_SB(1, 1), b3 + hstep, voffB); PG8_STAGE(PG8_SA(1, 0), a3, voffA);
            PG8_WAIT_V(8); PG8_WAIT_L(0); PG8_BAR; PG8_MMA(1, 0, At, B0); PG8_MMA(1, 1, At, B1); PG8_BAR; PG8_SCHED;
            } else {
            PG8_LDB(B0, 0, 0); PG8_SCHED; PG8_LDA(At, 0, 0); PG8_STAGE(PG8_SA(1, 1), a1 + hstep, voffA);
            PG8_WAIT_L(8); PG8_BAR; PG8_WAIT_L(0); PG8_MMA(0, 0, At, B0); PG8_BAR; PG8_SCHED;
            PG8_LDB(B1, 0, 1); PG8_STAGE(PG8_SB(0, 0), b2, voffB);
            PG8_BAR; PG8_WAIT_L(0); PG8_MMA(0, 1, At, B1); PG8_BAR;
            PG8_LDA(At, 0, 1); PG8_STAGE(PG8_SA(0, 0), a2, voffA);
            PG8_BAR; PG8_WAIT_L(0); PG8_MMA(1, 0, At, B0); PG8_BAR; PG8_SCHED;
            PG8_STAGE(PG8_SB(0, 1), b2 + hstep, voffB);
            PG8_WAIT_V(6); PG8_BAR; PG8_MMA(1, 1, At, B1); PG8_BAR;
            PG8_LDB(B0, 1, 0); PG8_SCHED; PG8_LDA(At, 1, 0); PG8_STAGE(PG8_SA(0, 1), a2 + hstep, voffA);
            PG8_WAIT_L(8); PG8_BAR; PG8_WAIT_L(0); PG8_MMA(0, 0, At, B0); PG8_BAR; PG8_SCHED;
            PG8_LDB(B1, 1, 1); PG8_STAGE(PG8_SB(1, 0), b3, voffB);
            PG8_BAR; PG8_WAIT_L(0); PG8_MMA(0, 1, At, B1); PG8_BAR;
            PG8_LDA(At, 1, 1); PG8_STAGE(PG8_SA(1, 0), a3, voffA);
            PG8_BAR; PG8_WAIT_L(0); PG8_MMA(1, 0, At, B0); PG8_BAR; PG8_SCHED;
            PG8_STAGE(PG8_SB(1, 1), b3 + hstep, voffB);
            PG8_WAIT_V(6); PG8_BAR; PG8_MMA(1, 1, At, B1); PG8_BAR;
            }
        }
        if constexpr (ALIGN_EPI) { if (wr == 0) PG8_BAR; }
        if constexpr (!Epi::AFTER_DRAIN) { E(acc, cur, wr, wc, fr, fq); S.done(cur); }
        if (!has_next) break;
#pragma unroll
        for (int a = 0; a < 2; ++a)
#pragma unroll
            for (int b = 0; b < 2; ++b)
#pragma unroll
                for (int m = 0; m < 4; ++m)
#pragma unroll
                    for (int n = 0; n < 2; ++n) acc[a][b][m][n] = (f32x4){0.f, 0.f, 0.f, 0.f};
        cur = nxt; cA = nA; cB = nB; ++ui;
        if constexpr (ALIGN_EPI) { if (wr == 1) PG8_BAR; }
    }
    PG8_WAIT_V(0);
    if constexpr (!ALIGN_EPI) { if (wr == 0) PG8_BAR; }
    PG8_BAR;
    if constexpr (Epi::AFTER_DRAIN) { E.fused(acc, cur, wr, wc, fr, fq, lds, wid, lane); S.done(cur); }
#undef PG8_SA
#undef PG8_SB
#undef PG8_STAGE
#undef PG8_LDA
#undef PG8_LDB
#undef PG8_MMA
#undef PG8_WAIT_V
#undef PG8_WAIT_L
#undef PG8_BAR
#undef PG8_SCHED
}
}
#define XB_TMO      128
#define XB_XCNT(j)  (256  + 64 * (j))
#define XB_XSUB(j)  (1280 + 64 * (j))
#define XB_XGEN(j)  (2304 + 64 * (j))
#define XB_TOP      3328
#define XB_TOPGEN   3392
#define XCD_BAR_WORDS 3456
#define XB_SPIN_CAP (1u << 18)

__device__ __forceinline__ unsigned xb_ld(unsigned* p)              { return __hip_atomic_load(p, __ATOMIC_RELAXED, __HIP_MEMORY_SCOPE_AGENT); }
__device__ __forceinline__ unsigned xb_add(unsigned* p, unsigned v) { return __hip_atomic_fetch_add(p, v, __ATOMIC_RELAXED, __HIP_MEMORY_SCOPE_AGENT); }
__device__ __forceinline__ unsigned xb_xcc_id() { return (unsigned)__builtin_amdgcn_s_getreg((3 << 11) | 20) & 0xFu; }
#define XB_SPIN(cond, bar) do { unsigned _sp = 0; while (cond) { __builtin_amdgcn_s_sleep(1); \
    if ((++_sp & 255u) == 0u) { if (xb_ld(&(bar)[XB_TMO])) break; if (_sp > XB_SPIN_CAP) { atomicAdd(&(bar)[XB_TMO], 1u); break; } } } } while (0)

struct XcdBarrier {
    unsigned* bar; unsigned x;
    volatile LAS unsigned* st;
};

__device__ __forceinline__ XcdBarrier xcd_barrier_post(unsigned* bar, volatile LAS unsigned* st) {
    XcdBarrier b; b.bar = bar; b.x = xb_xcc_id(); b.st = st;
    if (threadIdx.x == 0) (void)xb_add(&bar[XB_XCNT(b.x)], 1u);
    return b;
}
__device__ __forceinline__ void xcd_barrier_complete(unsigned* bar, unsigned x, unsigned& nloc, unsigned& nx) {
    const unsigned G = gridDim.x * gridDim.y * gridDim.z;
    unsigned sum, cnt, mine, sp = 0u;
    for (;;) {
        sum = 0u; cnt = 0u; mine = 0u;
#pragma unroll
        for (unsigned j = 0; j < 16; ++j) { const unsigned c = xb_ld(&bar[XB_XCNT(j)]); sum += c; cnt += (c > 0u) ? 1u : 0u; mine = (j == x) ? c : mine; }
        if (sum == G) break;
        __builtin_amdgcn_s_sleep(1);
        if ((++sp & 255u) == 0u) { if (xb_ld(&bar[XB_TMO])) break; if (sp > XB_SPIN_CAP) { atomicAdd(&bar[XB_TMO], 1u); break; } }
    }
    nloc = mine > 0u ? mine : 1u; nx = cnt > 0u ? cnt : 1u;
}

__device__ __forceinline__ void xcd_barrier(const XcdBarrier& b) {
    asm volatile("s_waitcnt vmcnt(0)" ::: "memory");
    __syncthreads();
    if (threadIdx.x == 0) {
        unsigned* bar = b.bar;
        __builtin_amdgcn_s_waitcnt(0);
        unsigned nloc = b.st[0], nx = b.st[1];
        if (nloc == 0u) { xcd_barrier_complete(bar, b.x, nloc, nx); b.st[0] = nloc; b.st[1] = nx; }
        const unsigned old = xb_add(&bar[XB_XSUB(b.x)], 1u);
        const unsigned gen = old / nloc;
        if (old + 1u == (gen + 1u) * nloc) {
            __builtin_amdgcn_fence(__ATOMIC_RELEASE, "agent");
            asm volatile("s_waitcnt vmcnt(0)" ::: "memory");
            const unsigned og = xb_add(&bar[XB_TOP], 1u);
            const unsigned tg = og / nx;
            if (og + 1u == (tg + 1u) * nx) xb_add(&bar[XB_TOPGEN], 1u);
            else XB_SPIN(xb_ld(&bar[XB_TOPGEN]) == tg, bar);
            __builtin_amdgcn_fence(__ATOMIC_ACQUIRE, "agent");
            xb_add(&bar[XB_XGEN(b.x)], 1u);
            asm volatile("s_waitcnt vmcnt(0)" ::: "memory");
        } else {
            XB_SPIN(xb_ld(&bar[XB_XGEN(b.x)]) == gen, bar);
            __builtin_amdgcn_fence(__ATOMIC_ACQUIRE, "agent");
            asm volatile("s_waitcnt vmcnt(0)" ::: "memory");
        }
    }
    __syncthreads();
}
#define GAS __attribute__((address_space(1)))
typedef float f32x4 __attribute__((ext_vector_type(4)));
typedef unsigned u32x2 __attribute__((ext_vector_type(2)));
typedef unsigned u32x4 __attribute__((ext_vector_type(4)));
typedef short bf16x8 __attribute__((ext_vector_type(8)));
constexpr int NTHR = 512, NWV = 8;
constexpr int RING_BYTES = 131072, MISC_OFF = RING_BYTES + 320, LDS_BYTES = 147456;
constexpr int CW_BAR = 1024;

struct KArgs { Inputs in; float* out; unsigned char* ws; int ph_lo, ph_hi, li, pad; };

__device__ __forceinline__ float wave_sum(float v) {
#pragma unroll
    for (int o = 1; o < 64; o <<= 1) v += __shfl_xor(v, o);
    return v;
}
__device__ __forceinline__ unsigned pk2(float lo, float hi) { return (unsigned)f2bf(lo) | ((unsigned)f2bf(hi) << 16); }
#define LDS_FENCE() asm volatile("s_waitcnt lgkmcnt(0)" ::: "memory")

constexpr int PH_PRO = 0;
constexpr int PH_L0 = 1, PH_PER_LAYER = 6;
constexpr int PH_FIN = PH_L0 + 2 * PH_PER_LAYER;
constexpr int PH_END = PH_FIN + 1;

__device__ __forceinline__ void transpose_item(const float* W, int K, int N, bf16_t* WT, LAS float* scr, int item, int lane) {
    const int nblk = N / 32, kb = item / nblk, nb = item % nblk, k0 = 64 * kb, n0 = 32 * nb;
#pragma unroll 8
    for (int i = 0; i < 32; ++i) { const int kk = 2 * i + (lane >> 5); scr[kk * 33 + (lane & 31)] = W[(size_t)(k0 + kk) * N + n0 + (lane & 31)]; }
    LDS_FENCE();
    const int c = lane & 7;
#pragma unroll
    for (int j = 0; j < 4; ++j) { const int n = (lane >> 3) + 8 * j; const LAS float* s = scr + (8 * c) * 33 + n;
        u32x4 o; o.x = pk2(s[0 * 33], s[1 * 33]); o.y = pk2(s[2 * 33], s[3 * 33]); o.z = pk2(s[4 * 33], s[5 * 33]); o.w = pk2(s[6 * 33], s[7 * 33]);
        *(u32x4*)(WT + (size_t)(n0 + n) * K + k0 + 8 * c) = o; }
    LDS_FENCE();
}

__device__ __forceinline__ void ph_prologue(const KArgs& a, LAS unsigned char* lds, int tid, int wave, int lane) {
    const Inputs& in = a.in;
    float* MOD = (float*)(a.ws + OFF_MOD);
    LAS float* sil = (LAS float*)lds;
    LAS float* part = (LAS float*)(lds + 5 * 1024 * 4);
    if ((int)blockIdx.x < 192) {
        for (int i = tid; i < 5 * 1024; i += NTHR) { const int j = i >> 10, k = i & 1023; const float cv = j < 4 ? in.c[j * DM + k] : in.c_ctx[k]; sil[i] = cv / (1.f + expf(-cv)); }
        __syncthreads();
        for (int it = blockIdx.x; it < 192; it += gridDim.x) {
            const int l = it / 96, nb = it % 96, n = nb * 32 + (lane & 31), k0 = wave * 128 + (lane >> 5) * 64;
            const float* w = in.w_mod + (size_t)l * DM * 3072 + n;
            float acc[5] = {0.f, 0.f, 0.f, 0.f, 0.f};
#pragma unroll 8
            for (int kk = 0; kk < 64; ++kk) { const float wv = w[(size_t)(k0 + kk) * 3072];
#pragma unroll
                for (int j = 0; j < 5; ++j) acc[j] += sil[j * 1024 + k0 + kk] * wv; }
#pragma unroll
            for (int j = 0; j < 5; ++j) { acc[j] += __shfl_xor(acc[j], 32); if (lane < 32) part[(wave * 5 + j) * 32 + lane] = acc[j]; }
            __syncthreads();
            if (tid < 160) { const int j = tid >> 5, c = tid & 31; float s = in.b_mod[l * 3072 + nb * 32 + c];
#pragma unroll
                for (int w8 = 0; w8 < 8; ++w8) s += part[(w8 * 5 + j) * 32 + c];
                MOD[((size_t)l * 5 + j) * 3072 + nb * 32 + c] = s; }
            __syncthreads();
        }
    }
    __syncthreads();
    LAS float* scr = (LAS float*)(lds + wave * 16384);
    const int gw = blockIdx.x * NWV + wave, NGW = gridDim.x * NWV;
    constexpr int I_IN = (DM / 64) * (NIN / 32), I_OUT = (DM / 64) * (DM / 32), I_PAD = NP - NIN;
    constexpr int I_L = I_IN + I_OUT + I_PAD;
    bf16_t* WIN = (bf16_t*)(a.ws + OFF_WIN); bf16_t* WOUT = (bf16_t*)(a.ws + OFF_WOUT);
    for (int it = gw; it < 2 * I_L; it += NGW) {
        const int l = it / I_L; int r = it % I_L;
        if (r < I_IN) { transpose_item(in.w_in + (size_t)l * DM * NIN, DM, NIN, WIN + (size_t)l * NP * DM, scr, r, lane); continue; } r -= I_IN;
        if (r < I_OUT) { transpose_item(in.w_out + (size_t)l * DM * DM, DM, DM, WOUT + (size_t)l * DM * DM, scr, r, lane); continue; } r -= I_OUT;
        u32x4* zp = (u32x4*)(WIN + ((size_t)l * NP + NIN + r) * DM);
        zp[lane] = (u32x4){0u, 0u, 0u, 0u}; zp[lane + 64] = (u32x4){0u, 0u, 0u, 0u};
    }
}

__device__ __forceinline__ void ph_post_pre(const KArgs& a, int lprev, int lnext, int wave, int lane) {
    const Inputs& in = a.in;
    const float* MOD = (const float*)(a.ws + OFF_MOD);
    const float* O = (const float*)(a.ws + OFF_P);
    float* XC = (float*)(a.ws + OFF_XC);
    bf16_t* H = (bf16_t*)(a.ws + OFF_H);
    const int gw = blockIdx.x * NWV + wave, NGW = gridDim.x * NWV;
    const int nrows = (lnext < 2) ? MTOT : NLAT;
    for (int row = gw; row < nrows; row += NGW) {
        const bool lat = row < NLAT; const int j = lat ? row / SEQ : 4;
        const float* xr; float* xw = nullptr;
        if (lprev <= 0) xr = lat ? in.x + (size_t)row * DM : in.ctx + (size_t)(row - NLAT) * DM;
        else xr = lat ? a.out + (size_t)row * DM : XC + (size_t)(row - NLAT) * DM;
        const bool post = (lprev >= 0) && (lat || lprev == 0);
        if (post) xw = lat ? a.out + (size_t)row * DM : XC + (size_t)(row - NLAT) * DM;
        f32x4 v[4];
#pragma unroll
        for (int q = 0; q < 4; ++q) v[q] = *(const f32x4*)(xr + 4 * lane + 256 * q);
        if (post) {
            f32x4 o[4]; float s = 0.f;
#pragma unroll
            for (int q = 0; q < 4; ++q) { o[q] = *(const f32x4*)(O + (size_t)row * DM + 4 * lane + 256 * q); s += (o[q].x * o[q].x + o[q].y * o[q].y) + (o[q].z * o[q].z + o[q].w * o[q].w); }
            const float rstd = rsqrtf(wave_sum(s) * (1.f / DM) + EPS);
            const float* gate = MOD + ((size_t)lprev * 5 + j) * 3072 + 2048; const float* gp = in.g_post + lprev * DM;
#pragma unroll
            for (int q = 0; q < 4; ++q) { const f32x4 gt = *(const f32x4*)(gate + 4 * lane + 256 * q), gg = *(const f32x4*)(gp + 4 * lane + 256 * q);
                v[q] = v[q] + gt * (o[q] * rstd * gg); *(f32x4*)(xw + 4 * lane + 256 * q) = v[q]; }
        }
        if (lnext < 2) {
            float s = 0.f;
#pragma unroll
            for (int q = 0; q < 4; ++q) s += (v[q].x * v[q].x + v[q].y * v[q].y) + (v[q].z * v[q].z + v[q].w * v[q].w);
            const float rstd = rsqrtf(wave_sum(s) * (1.f / DM) + EPS);
            const float* shift = MOD + ((size_t)lnext * 5 + j) * 3072; const float* scale = shift + 1024; const float* gp = in.g_pre + lnext * DM;
#pragma unroll
            for (int q = 0; q < 4; ++q) { const int k = 4 * lane + 256 * q; const f32x4 sh = *(const f32x4*)(shift + k), sc = *(const f32x4*)(scale + k), gg = *(const f32x4*)(gp + k);
                const f32x4 hv = (v[q] * rstd * gg) * (sc + 1.f) + sh;
                u32x2 w; w.x = pk2(hv.x, hv.y); w.y = pk2(hv.z, hv.w); *(u32x2*)(H + (size_t)row * DM + k) = w; }
        }
    }
}

__global__ void __launch_bounds__(NTHR, 2) mega(KArgs a) {
    extern __shared__ __attribute__((aligned(16))) unsigned char lds_raw[];
    LAS unsigned char* lds = (LAS unsigned char*)lds_raw;
    const int tid = threadIdx.x, lane = tid & 63, wave = __builtin_amdgcn_readfirstlane(tid >> 6);
    volatile LAS unsigned* MISC = (volatile LAS unsigned*)(lds + MISC_OFF);
    for (int u = tid; u < (LDS_BYTES - RING_BYTES) / 4; u += NTHR) ((LAS unsigned*)(lds + RING_BYTES))[u] = 0u;
    __syncthreads();
    unsigned* ctl = (unsigned*)(a.ws + OFF_CTL);
    XcdBarrier bar = xcd_barrier_post(ctl + CW_BAR + a.li * XCD_BAR_WORDS, MISC + 8);
    const int lo = a.ph_lo, hi = a.ph_hi;
    bool first_seam = true;
#define IN(k) (lo <= (k) && (k) < hi)
#define SEAM(k) do { if (IN(k) && IN((k) + 1)) { if (first_seam) { cooperative_groups::this_grid().sync(); first_seam = false; } xcd_barrier(bar); } } while (0)
    if (IN(PH_PRO)) { ph_prologue(a, lds, tid, wave, lane); }
    SEAM(PH_PRO);
#define LAYER(l) do { \
        constexpr int pb = PH_L0 + (l) * PH_PER_LAYER; \
        constexpr int nrows_out = ((l) == 1) ? NLAT : MTOT; \
        if (IN(pb + 0)) { ph_post_pre(a, (l) - 1, (l), wave, lane); } \
        SEAM(pb + 0); \
        if (IN(pb + 1)) { \
            pg8::Gemm g{(const bf16_t*)(a.ws + OFF_H), (const bf16_t*)(a.ws + OFF_WIN) + (size_t)(l) * NP * DM, MTOT, NP, DM}; \
            pg8::StaticOrder S; S.init(MTOT, NP, gridDim.x, blockIdx.x); \
            pg8::EpiBf16<0> E{(bf16_t*)(a.ws + OFF_P), NP, nullptr, 0, 0, 1.f}; \
            pg8::gemm_phase<pg8::EpiBf16<0>, pg8::StaticOrder, true, true>(lds, g, S, E); \
        } \
        SEAM(pb + 1); \
        SEAM(pb + 2); SEAM(pb + 3); SEAM(pb + 4); \
        if (IN(pb + 5)) { \
            pg8::Gemm g{(const bf16_t*)(a.ws + OFF_H), (const bf16_t*)(a.ws + OFF_WOUT) + (size_t)(l) * DM * DM, nrows_out, DM, DM}; \
            pg8::StaticOrder S; S.init(nrows_out, DM, gridDim.x, blockIdx.x); \
            pg8::EpiF32 E{(float*)(a.ws + OFF_P), DM, nullptr}; \
            pg8::gemm_phase<pg8::EpiF32, pg8::StaticOrder, true, true>(lds, g, S, E); \
        } \
        SEAM(pb + 5); \
    } while (0)
    LAYER(0);
    LAYER(1);
#undef LAYER
    if (IN(PH_FIN)) { ph_post_pre(a, 1, 2, wave, lane); }
#undef IN
#undef SEAM
}

static int g_grid = 0;
static void launch_mega(const KArgs& base, int lo, int hi, int li, hipStream_t stream) {
    KArgs a = base; a.ph_lo = lo; a.ph_hi = hi; a.li = li; a.pad = 0;
    void* args[] = {(void*)&a};
    hipError_t e = hipLaunchCooperativeKernel((const void*)mega, dim3(g_grid), dim3(NTHR), args, LDS_BYTES, stream);
    if (e != hipSuccess) fprintf(stderr, "cooperative launch failed: %s (grid %d)\n", hipGetErrorString(e), g_grid);
}

extern "C" void kernel_launch(void* const* d_in, const int* in_sizes, int n_in, void* d_out, int out_size, void* d_ws, size_t ws_size, hipStream_t stream) {
    if (g_grid == 0) {
        int dev = 0, cus = 0, per_cu = 0;
        hipGetDevice(&dev);
        hipDeviceGetAttribute(&cus, hipDeviceAttributeMultiprocessorCount, dev);
        hipFuncSetAttribute((const void*)mega, hipFuncAttributeMaxDynamicSharedMemorySize, LDS_BYTES);
        hipOccupancyMaxActiveBlocksPerMultiprocessor(&per_cu, (const void*)mega, NTHR, LDS_BYTES);
        if (per_cu < 1) per_cu = 1;
        g_grid = cus * per_cu;
        if (g_grid != 256) fprintf(stderr, "note: grid %d (cus %d x %d)\n", g_grid, cus, per_cu);
    }
    KArgs base;
    memset(&base, 0, sizeof(base));
    const float** ip = (const float**)&base.in;
    for (int i = 0; i < 26; ++i) ip[i] = (const float*)d_in[i];
    base.out = (float*)d_out; base.ws = (unsigned char*)d_ws;
    const Inputs& in = base.in;
    char* ws = (char*)d_ws;
    bf16_t* Y = (bf16_t*)(ws + OFF_H); bf16_t* P = (bf16_t*)(ws + OFF_P);
    float* LG = (float*)(ws + OFF_LG); float* OG = (float*)(ws + OFF_OG); float* SY = (float*)(ws + OFF_SY);
    hipMemsetAsync(ws + OFF_CTL, 0, CTL_BYTES, stream);
    int li = 0;
    launch_mega(base, PH_PRO, PH_L0 + 2, li++, stream);
    for (int l = 0; l < 2; ++l) {
        const int last = (l == 1); const int nrows = last ? NLAT : MTOT; const int pb = PH_L0 + l * PH_PER_LAYER;
        k_lg<<<dim3(MTOT, 2), 128, 0, stream>>>(P, in.gla_w_gate + l * 2 * 16 * 128, in.gla_b_gate + l * 2 * 128, LG);
        k_gla<<<16, 64, 0, stream>>>(P, LG, OG, 0, last);
        k_gla<<<16, 64, 0, stream>>>(P, LG, OG, 1, last);
        k_gla_fin<<<nrows, 256, 0, stream>>>(OG, P, in.gla_g_norm + l * 64, Y, 0);
        k_na<<<dim3(nrows, 4), 64, 0, stream>>>(P, in.na_rpb + l * 4 * 15 * 31, Y, 0);
        k_s5<<<64, 64, 0, stream>>>(P, in, l, SY, 0, last);
        k_s5<<<64, 64, 0, stream>>>(P, in, l, SY, 1, last);
        k_s5_glu<<<nrows, 256, 0, stream>>>(SY, P, in.s5_d + l * 256, in.s5_w_glu + l * 65536, in.s5_b_glu + l * 256, Y, 0);
        k_pool<<<nrows, 256, 0, stream>>>(P, in.pool_w + l * 4 * 64 * 64, in.pool_scale + l * 256, Y, 0);
        if (l == 0) launch_mega(base, pb + 5, pb + PH_PER_LAYER + 2, li++, stream);
        else launch_mega(base, pb + 5, PH_END, li++, stream);
    }
}
```

```cpp
#include <hip/hip_runtime.h>
#include <hip/hip_cooperative_groups.h>
#include <stdint.h>
#include <math.h>
#include <cstdio>
#include <cstring>

typedef unsigned short bf16_t;
__device__ __forceinline__ float bf2f(bf16_t v) { return __uint_as_float(((unsigned)v) << 16); }
__device__ __forceinline__ bf16_t f2bf(float f) { unsigned u = __float_as_uint(f); return (bf16_t)((u + 0x7fffu + ((u >> 16) & 1u)) >> 16); }

constexpr int DM = 1024, NB = 4, SEQ = 4096, NCTX = 256, GW = 64;
constexpr int NLAT = NB * SEQ;
constexpr int NCT = NB * NCTX;
constexpr int MTOT = NLAT + NCT;
constexpr int NIN = 2848, NP = 3072;
constexpr int C_GK = 0, C_GV = 128, C_GF = 384, C_GB = 400, C_NK = 416, C_NV = 672, C_SU = 928, C_GQ = 1184, C_NQ = 1312, C_PU = 1568, C_GATE = 1824;
constexpr float EPS = 1e-6f;

constexpr size_t OFF_CTL = 0, CTL_BYTES = 256 * 1024;
constexpr size_t OFF_WIN = OFF_CTL + CTL_BYTES;
constexpr size_t OFF_WOUT = OFF_WIN + (size_t)2 * NP * DM * 2;
constexpr size_t OFF_MOD = OFF_WOUT + (size_t)2 * DM * DM * 2;
constexpr size_t OFF_H = OFF_MOD + (size_t)2 * 5 * 3072 * 4 + 1024;
constexpr size_t OFF_P = OFF_H + (size_t)MTOT * DM * 2;
constexpr size_t OFF_XC = OFF_P + (size_t)MTOT * NP * 2;
constexpr size_t OFF_LG = OFF_XC + (size_t)NCT * DM * 4;
constexpr size_t OFF_OG = OFF_LG + (size_t)2 * MTOT * 128 * 4;
constexpr size_t OFF_SY = OFF_OG + (size_t)MTOT * 256 * 4;
constexpr size_t OFF_VTL = OFF_SY + (size_t)MTOT * 256 * 4;
constexpr size_t OFF_VTC = OFF_VTL + (size_t)1024 * SEQ * 2;
constexpr size_t OFF_WPT = OFF_VTC + (size_t)1024 * NCTX * 2;
constexpr size_t OFF_END = OFF_WPT + (size_t)2 * 4 * 64 * 64 * 2;
static_assert(OFF_END <= (size_t)256 * 1024 * 1024, "ws");

struct Inputs {
    const float *x, *c, *ctx, *c_ctx, *w_mod, *b_mod, *g_pre, *g_post, *w_in, *w_out, *gla_w_gate, *gla_b_gate, *gla_g_norm, *na_rpb,
        *s5_lam_re, *s5_lam_im, *s5_log_dt, *s5_b_re, *s5_b_im, *s5_c_re, *s5_c_im, *s5_d, *s5_w_glu, *s5_b_glu, *pool_w, *pool_scale;
};

__device__ __forceinline__ float silu_f(float v) { return v / (1.f + expf(-v)); }
__device__ __forceinline__ float sigmoid_f(float v) { return 1.f / (1.f + expf(-v)); }
__device__ __forceinline__ float gelu_tanh_f(float v) { const float k = 0.7978845608028654f; return 0.5f * v * (1.f + tanhf(k * (v + 0.044715f * v * v * v))); }
__device__ __forceinline__ float logsigmoid_f(float z) { return fminf(z, 0.f) - log1pf(expf(-fabsf(z))); }

__global__ void k_transpose_w(const float* W, int K, int N, int Npad, bf16_t* WT) {
    __shared__ float t[32][33];
    const int n0 = blockIdx.x * 32, k0 = blockIdx.y * 32;
    const int tx = threadIdx.x & 31, ty = threadIdx.x >> 5;
    for (int i = ty; i < 32; i += 8) { const int n = n0 + tx; t[i][tx] = (n < N) ? W[(size_t)(k0 + i) * N + n] : 0.f; }
    __syncthreads();
    for (int i = ty; i < 32; i += 8) { const int n = n0 + i; if (n < Npad) WT[(size_t)n * K + k0 + tx] = f2bf(t[tx][i]); }
}

__global__ void k_mod(Inputs in, float* MOD) {
    const int n = blockIdx.x * 256 + threadIdx.x, j = blockIdx.y, l = blockIdx.z;
    const float* cv = (j < 4) ? in.c + j * DM : in.c_ctx;
    const float* w = in.w_mod + (size_t)l * DM * 3072;
    float acc = 0.f;
    for (int k = 0; k < DM; ++k) acc += silu_f(cv[k]) * w[(size_t)k * 3072 + n];
    MOD[((size_t)l * 5 + j) * 3072 + n] = acc + in.b_mod[l * 3072 + n];
}

__global__ void k_norm(const float* xlat, const float* xctx, const float* g_pre, const float* MODl, bf16_t* H) {
    const int row = blockIdx.x; const int tid = threadIdx.x;
    const float* xr = row < NLAT ? xlat + (size_t)row * DM : xctx + (size_t)(row - NLAT) * DM;
    const int j = row < NLAT ? row / SEQ : 4;
    __shared__ float red[256];
    float v[4]; float s = 0.f;
    for (int i = 0; i < 4; ++i) { v[i] = xr[tid + 256 * i]; s += v[i] * v[i]; }
    red[tid] = s; __syncthreads();
    for (int o = 128; o > 0; o >>= 1) { if (tid < o) red[tid] += red[tid + o]; __syncthreads(); }
    const float rstd = rsqrtf(red[0] / DM + EPS);
    const float* shift = MODl + j * 3072; const float* scale = shift + 1024;
    for (int i = 0; i < 4; ++i) { const int k = tid + 256 * i; const float y = v[i] * rstd * g_pre[k]; H[(size_t)row * DM + k] = f2bf(y * (1.f + scale[k]) + shift[k]); }
}

template <bool OUT_BF16>
__global__ void __launch_bounds__(256) k_gemm(const bf16_t* A, const bf16_t* Bt, void* C, int M, int N, int K, int ldc) {
    __shared__ float As[64][33], Bs[64][33];
    const int m0 = blockIdx.y * 64, n0 = blockIdx.x * 64;
    const int tx = threadIdx.x & 15, ty = threadIdx.x >> 4;
    float acc[4][4] = {};
    for (int k0 = 0; k0 < K; k0 += 32) {
        for (int i = threadIdx.x; i < 64 * 32; i += 256) { const int r = i >> 5, kk = i & 31;
            As[r][kk] = bf2f(A[(size_t)(m0 + r) * K + k0 + kk]); Bs[r][kk] = bf2f(Bt[(size_t)(n0 + r) * K + k0 + kk]); }
        __syncthreads();
        for (int kk = 0; kk < 32; ++kk) { float a[4], b[4];
            for (int i = 0; i < 4; ++i) { a[i] = As[ty + 16 * i][kk]; b[i] = Bs[tx + 16 * i][kk]; }
            for (int i = 0; i < 4; ++i) for (int j = 0; j < 4; ++j) acc[i][j] += a[i] * b[j]; }
        __syncthreads();
    }
    for (int i = 0; i < 4; ++i) for (int j = 0; j < 4; ++j) { const size_t o = (size_t)(m0 + ty + 16 * i) * ldc + n0 + tx + 16 * j;
        if (OUT_BF16) ((bf16_t*)C)[o] = f2bf(acc[i][j]); else ((float*)C)[o] = acc[i][j]; }
}

__global__ void k_lg(const bf16_t* P, const float* w_gate  , const float* b_gate  , float* LG) {
    const int row = blockIdx.x, dir = blockIdx.y, e = threadIdx.x;
    const bf16_t* pr = P + (size_t)row * NP + (dir ? C_GB : C_GF);
    float z = b_gate[dir * 128 + e];
    for (int r = 0; r < 16; ++r) z += bf2f(pr[r]) * w_gate[(dir * 16 + r) * 128 + e];
    LG[((size_t)dir * MTOT + row) * 128 + e] = logsigmoid_f(z) * (1.f / 16.f);
}

__global__ void k_gla(const bf16_t* P, const float* LG, float* OG, int dir, int last) {
    const int b = blockIdx.x >> 2, h = blockIdx.x & 3, e = threadIdx.x;
    __shared__ float ctab[64][8], stab[64][8];
    __shared__ float sa[32], sk[32], sq[32];
    for (int i = threadIdx.x; i < 512; i += 64) { const int pos = i >> 3, j = i & 7; const float f = powf(10000.f, -(float)j / 8.f); const float a = (float)pos * f; ctab[pos][j] = cosf(a); stab[pos][j] = sinf(a); }
    __syncthreads();
    float S[32];
    for (int d = 0; d < 32; ++d) S[d] = 0.f;
    const float qs = 0.17677669529663687f;
    const int d = e & 31;
    for (int i = 0; i < NCTX + SEQ; ++i) {
        size_t row; bool lat; int t = 0;
        if (i < NCTX) { const int n = dir ? NCTX - 1 - i : i; row = NLAT + b * NCTX + n; lat = false; }
        else { const int ii = i - NCTX; t = dir ? SEQ - 1 - ii : ii; row = (size_t)b * SEQ + t; lat = true; }
        const bf16_t* pr = P + row * NP;
        const int colb = (e < 32 ? C_GK : C_GQ) + h * 32;
        float val = bf2f(pr[colb + d]);
        if (lat) {
            const int half = d >> 4, i16 = d & 15, j = i16 & 7; const int pos = half ? (t & 63) : (t >> 6);
            const float cs = ctab[pos][j], sn = stab[pos][j];
            const int dp = (i16 < 8) ? d + 8 : d - 8; const float sg = (i16 < 8) ? -1.f : 1.f;
            val = val * cs + sg * bf2f(pr[colb + dp]) * sn;
        }
        if (e < 32) { sk[d] = val; sa[d] = expf(LG[((size_t)dir * MTOT + row) * 128 + h * 32 + d]); } else sq[d] = val * qs;
        __syncthreads();
        const float v = bf2f(pr[C_GV + h * 64 + e]); float o = 0.f;
        for (int dd = 0; dd < 32; ++dd) { S[dd] = sa[dd] * S[dd] + sk[dd] * v; o += sq[dd] * S[dd]; }
        if (lat || !last) { float* op = OG + row * 256 + h * 64 + e; if (dir) *op += o; else *op = o; }
        __syncthreads();
    }
}

__global__ void k_gla_fin(const float* OG, const bf16_t* P, const float* g_norm, bf16_t* Y, int row_lo) {
    const int row = row_lo + blockIdx.x, tid = threadIdx.x;
    __shared__ float red[256];
    const float o = OG[(size_t)row * 256 + tid]; red[tid] = o * o; __syncthreads();
    for (int s = 32; s > 0; s >>= 1) { if ((tid & 63) < s) red[tid] += red[tid + s]; __syncthreads(); }
    const float ms = red[tid & ~63] * (1.f / 64.f);
    const float y = o * rsqrtf(ms + EPS) * g_norm[tid & 63];
    Y[(size_t)row * DM + tid] = f2bf(y * silu_f(bf2f(P[(size_t)row * NP + C_GATE + tid])));
}

__global__ void k_na(const bf16_t* P, const float* rpb  , bf16_t* Y, int row_lo) {
    const int row = row_lo + blockIdx.x, h = blockIdx.y, tid = threadIdx.x;
    __shared__ float q[64], sc[384], red[64]; __shared__ int key[384];
    const bool lat = row < NLAT;
    const int b = lat ? row / SEQ : (row - NLAT) / NCTX;
    q[tid] = bf2f(P[(size_t)row * NP + C_NQ + h * 64 + tid]) * 0.125f;
    __syncthreads();
    const int nk = lat ? 384 : 256;
    int r = 0, c = 0, R0 = 0, cs = 0;
    if (lat) { const int t = row % SEQ; r = t >> 6; c = t & 63; R0 = min(max(r - 4, 0), 56); cs = min(max(c - 8, 0), 48); }
    for (int kk = tid; kk < nk; kk += 64) {
        int krow; float bias = 0.f;
        if (lat && kk < 128) { const int i = kk >> 4, j = kk & 15; const int kr_ = R0 + i, kc_ = cs + j; krow = b * SEQ + kr_ * 64 + kc_;
            const int ro = kr_ - r + 7; const int co = min(max(kc_ - c, -15), 15) + 15; bias = rpb[(h * 15 + ro) * 31 + co]; }
        else krow = NLAT + b * NCTX + (lat ? kk - 128 : kk);
        key[kk] = krow;
        const bf16_t* kp = P + (size_t)krow * NP + C_NK + h * 64; float s = 0.f;
        for (int d = 0; d < 64; ++d) s += q[d] * bf2f(kp[d]);
        sc[kk] = s + bias;
    }
    __syncthreads();
    float m = -INFINITY; for (int kk = tid; kk < nk; kk += 64) m = fmaxf(m, sc[kk]);
    red[tid] = m; __syncthreads();
    for (int s = 32; s > 0; s >>= 1) { if (tid < s) red[tid] = fmaxf(red[tid], red[tid + s]); __syncthreads(); }
    m = red[0]; __syncthreads();
    float l = 0.f; for (int kk = tid; kk < nk; kk += 64) { const float p = expf(sc[kk] - m); sc[kk] = p; l += p; }
    red[tid] = l; __syncthreads();
    for (int s = 32; s > 0; s >>= 1) { if (tid < s) red[tid] += red[tid + s]; __syncthreads(); }
    l = red[0];
    float o = 0.f;
    for (int kk = 0; kk < nk; ++kk) o += sc[kk] * bf2f(P[(size_t)key[kk] * NP + C_NV + h * 64 + tid]);
    o /= l;
    const int col = 256 + h * 64 + tid;
    Y[(size_t)row * DM + col] = f2bf(o * silu_f(bf2f(P[(size_t)row * NP + C_GATE + col])));
}

__global__ void k_s5(const bf16_t* P, Inputs in, int l, float* SY, int dir, int last) {
    const int b = blockIdx.x >> 4, g = blockIdx.x & 15, p = threadIdx.x;
    const int dg = (l * 2 + dir) * 16 + g;
    const float dt = expf(in.s5_log_dt[dg]);
    const float lre = in.s5_lam_re[dg * 64 + p], lim = in.s5_lam_im[dg * 64 + p];
    const float mag = expf(lre * dt), ang = lim * dt;
    const float lbr = mag * cosf(ang), lbi = mag * sinf(ang);
    const float nr = lbr - 1.f, ni = lbi, den = lre * lre + lim * lim;
    const float cr = (nr * lre + ni * lim) / den, ci = (ni * lre - nr * lim) / den;
    float bbr[16], bbi[16], cre[16], cim[16];
    for (int h = 0; h < 16; ++h) { const float br = in.s5_b_re[((size_t)dg * 64 + p) * 16 + h], bi = in.s5_b_im[((size_t)dg * 64 + p) * 16 + h];
        bbr[h] = cr * br - ci * bi; bbi[h] = cr * bi + ci * br;
        cre[h] = in.s5_c_re[((size_t)dg * 16 + h) * 64 + p]; cim[h] = in.s5_c_im[((size_t)dg * 16 + h) * 64 + p]; }
    __shared__ float part[16][65];
    float xr = 0.f, xi = 0.f;
    for (int i = 0; i < NCTX + SEQ; ++i) {
        size_t row; bool wr;
        if (i < NCTX) { const int n = dir ? NCTX - 1 - i : i; row = NLAT + b * NCTX + n; wr = !last; }
        else { const int ii = i - NCTX; const int t = dir ? SEQ - 1 - ii : ii; row = (size_t)b * SEQ + t; wr = true; }
        const bf16_t* up = P + row * NP + C_SU + g * 16;
        float bur = 0.f, bui = 0.f;
        for (int h = 0; h < 16; ++h) { const float u = bf2f(up[h]); bur += u * bbr[h]; bui += u * bbi[h]; }
        const float nxr = lbr * xr - lbi * xi + bur, nxi = lbr * xi + lbi * xr + bui; xr = nxr; xi = nxi;
        if (wr) {
            for (int h = 0; h < 16; ++h) part[h][p] = xr * cre[h] - xi * cim[h];
            __syncthreads();
            const int hh = p >> 2, q4 = p & 3; float s = 0.f;
            for (int k = 0; k < 16; ++k) s += part[hh][q4 * 16 + k];
            s += __shfl_xor(s, 1); s += __shfl_xor(s, 2);
            if (q4 == 0) { float* op = SY + row * 256 + g * 16 + hh; if (dir) *op += s; else *op = s; }
            __syncthreads();
        }
    }
}

__global__ void k_s5_glu(const float* SY, const bf16_t* P, const float* d_skip, const float* w_glu  , const float* b_glu, bf16_t* Y, int row_lo) {
    const int row = row_lo + blockIdx.x, n = threadIdx.x;
    __shared__ float gsh[256];
    const float u = bf2f(P[(size_t)row * NP + C_SU + n]);
    const float y = u * d_skip[n] + SY[(size_t)row * 256 + n];
    const float gv = gelu_tanh_f(y); gsh[n] = gv; __syncthreads();
    float z = b_glu[n];
    for (int k = 0; k < 256; ++k) z += gsh[k] * w_glu[k * 256 + n];
    const float o = gv * sigmoid_f(z);
    const int col = 512 + n;
    Y[(size_t)row * DM + col] = f2bf(o * silu_f(bf2f(P[(size_t)row * NP + C_GATE + col])));
}

__global__ void k_pool(const bf16_t* P, const float* pool_w  , const float* pool_scale, bf16_t* Y, int row_lo) {
    const int row = row_lo + blockIdx.x, n = threadIdx.x;
    const bool lat = row < NLAT; const int len = lat ? SEQ : NCTX;
    const int base = lat ? (row / SEQ) * SEQ : NLAT + ((row - NLAT) / NCTX) * NCTX; const int t = row - base;
    const int part = n >> 6; const int w = 2 << part;
    const int lo = min(max(t - w / 2, 0), len), hi = min(max(t - w / 2 + w, 0), len);
    float s = 0.f;
    for (int tt = lo; tt < hi; ++tt) s += bf2f(P[(size_t)(base + tt) * NP + C_PU + n]);
    __shared__ float m[256];
    m[n] = s / (float)(hi - lo) - bf2f(P[(size_t)row * NP + C_PU + n]); __syncthreads();
    float o = 0.f; const int e = n & 63;
    for (int cc = 0; cc < 64; ++cc) o += m[part * 64 + cc] * pool_w[(part * 64 + cc) * 64 + e];
    o *= pool_scale[n];
    const int col = 768 + n;
    Y[(size_t)row * DM + col] = f2bf(o * silu_f(bf2f(P[(size_t)row * NP + C_GATE + col])));
}

__global__ void k_out(const float* O, const float* xlat, const float* xctx, const float* g_post, const float* MODl, float* outlat, float* outctx) {
    const int row = blockIdx.x, tid = threadIdx.x;
    const bool lat = row < NLAT; const int j = lat ? row / SEQ : 4;
    const float* xr = lat ? xlat + (size_t)row * DM : xctx + (size_t)(row - NLAT) * DM;
    float* orow = lat ? outlat + (size_t)row * DM : outctx + (size_t)(row - NLAT) * DM;
    __shared__ float red[256];
    float v[4]; float s = 0.f;
    for (int i = 0; i < 4; ++i) { v[i] = O[(size_t)row * DM + tid + 256 * i]; s += v[i] * v[i]; }
    red[tid] = s; __syncthreads();
    for (int o = 128; o > 0; o >>= 1) { if (tid < o) red[tid] += red[tid + o]; __syncthreads(); }
    const float rstd = rsqrtf(red[0] / DM + EPS);
    const float* gate = MODl + j * 3072 + 2048;
    for (int i = 0; i < 4; ++i) { const int k = tid + 256 * i; orow[k] = xr[k] + gate[k] * (v[i] * rstd * g_post[k]); }
}

#define LAS __attribute__((address_space(3)))
namespace pg8 {
#define PG8_LAS __attribute__((address_space(3)))
typedef unsigned short bf16_t;
typedef short bf16x8 __attribute__((ext_vector_type(8)));
typedef float f32x4 __attribute__((ext_vector_type(4)));
typedef unsigned u32x4 __attribute__((ext_vector_type(4)));
constexpr int BM = 256, BK = 64, HALF = 128, HTB = HALF * BK * 2  , STAGE_BYTES = 8 * HTB, NXCD = 8, WGM = 8;

__host__ __device__ __forceinline__ int lds_byte(int r, int c) { const int st = (r >> 4) * 2 + (c >> 5), rr = r & 15, cc = c & 31, ob = rr * 64 + cc * 2; return st * 1024 + (ob ^ (((ob >> 9) & 1) << 5)); }
__host__ __device__ __forceinline__ void stage_rc(int b, int& R, int& C) { const int st = b / 1024, sb = b % 1024, swz = sb ^ (((sb >> 9) & 1) << 5); R = (st >> 1) * 16 + swz / 64; C = (st & 1) * 32 + (swz % 64) / 2; }
__host__ __device__ __forceinline__ int perm32(int rho) { const int n = rho >> 4, i = rho & 15; return 8 * (i >> 2) + 4 * n + (i & 3); }

struct Unit { int pm, pn; };
struct Gemm { const bf16_t* A; const bf16_t* Bt; int M, N, K; };

struct StaticOrder {
    int nM, nN, nwg, G, c;
    __host__ __device__ void init(int M, int N, int G_, int c_) { nM = M / BM; nN = N / BM; nwg = nM * nN; G = G_; c = c_; }
    __host__ __device__ bool next(int i, Unit& u) const {
        const long L = (long)i * G + c; if (L >= nwg) return false;
        int wgid = (int)L; { const int q = nwg / NXCD, r = nwg % NXCD, xcd = wgid % NXCD, off = wgid / NXCD; wgid = (xcd < r ? xcd * (q + 1) : r * (q + 1) + (xcd - r) * q) + off; }
        const int nig = WGM * nN, gid = wgid / nig, fm = gid * WGM, gsz = (nM - fm) < WGM ? (nM - fm) : WGM;
        u.pm = fm + ((wgid % nig) % gsz); u.pn = (wgid % nig) / gsz; return true;
    }
    __device__ __forceinline__ void a_ready(const Unit&) const {}
    __device__ __forceinline__ void done(const Unit&) const {}
};

__device__ __forceinline__ unsigned cvt_pk_bf16(float lo, float hi) { unsigned r; asm volatile("v_cvt_pk_bf16_f32 %0, %1, %2" : "=v"(r) : "v"(lo), "v"(hi)); return r; }
typedef float f32x2 __attribute__((ext_vector_type(2)));
__device__ __forceinline__ f32x2 gelu_pk(f32x2 v) {
    const f32x2 av = __builtin_elementwise_abs(v), d = av * 0.2316418882f + 1.0f;
    f32x2 t; t.x = __builtin_amdgcn_rcpf(d.x); t.y = __builtin_amdgcn_rcpf(d.y);
    f32x2 q = t * 0.5307027145f + (-0.7265760135f); q = q * t + 0.7107068705f; q = q * t + (-0.142248368f); q = q * t + 0.127414796f; q = q * t;
    const f32x2 s = (v * v) * (-0.72134752044f);
    f32x2 e; e.x = __builtin_amdgcn_exp2f(s.x); e.y = __builtin_amdgcn_exp2f(s.y);
    const f32x2 m = v * (q * e), r = v - m;
    f32x2 o; o.x = v.x < 0.f ? m.x : r.x; o.y = v.y < 0.f ? m.y : r.y; return o;
}

template <int ACT  > struct EpiBf16 {
    static constexpr bool PERM = true, AFTER_DRAIN = false; static_assert(ACT == 0 || ACT == 1, "EpiBf16: ACT is 0 (none) or 1 (gelu_pk)");
    bf16_t* O; int ldc; const float* bias; int split_cols; size_t split_stride; float scale0;
    __device__ __forceinline__ void operator()(const f32x4 (&acc)[2][2][4][2], const Unit& u, int wr, int wc, int fr, int fq) const {
        const int row0 = u.pm * BM + wr * 64 + fr; int colt = u.pn * BM; bf16_t* base = O;
        float sc = 1.f; if (split_cols) { const int t = colt / split_cols; base += (size_t)t * split_stride; colt -= t * split_cols; if (t == 0) sc = scale0; }
        const int col0 = colt + wc * 32 + 8 * fq, bcol0 = u.pn * BM + wc * 32 + 8 * fq;
        f32x4 bv[2][2];
#pragma unroll
        for (int bj = 0; bj < 2; ++bj)
#pragma unroll
            for (int n = 0; n < 2; ++n) bv[bj][n] = bias ? *(const f32x4*)(bias + bcol0 + bj * HALF + 4 * n) : (f32x4){0.f, 0.f, 0.f, 0.f};
#pragma unroll
        for (int ai = 0; ai < 2; ++ai)
#pragma unroll
            for (int m = 0; m < 4; ++m) { bf16_t* rowp = base + (size_t)(row0 + ai * HALF + m * 16) * ldc + col0;
#pragma unroll
                for (int bj = 0; bj < 2; ++bj) { f32x4 v0 = acc[ai][bj][m][0] + bv[bj][0], v1 = acc[ai][bj][m][1] + bv[bj][1];
                    if (ACT == 1) { f32x2 a = gelu_pk((f32x2){v0[0], v0[1]}), b = gelu_pk((f32x2){v0[2], v0[3]}), c = gelu_pk((f32x2){v1[0], v1[1]}), d = gelu_pk((f32x2){v1[2], v1[3]});
                        v0 = (f32x4){a.x, a.y, b.x, b.y}; v1 = (f32x4){c.x, c.y, d.x, d.y}; }
                    v0 = v0 * sc; v1 = v1 * sc; u32x4 w; w.x = cvt_pk_bf16(v0[0], v0[1]); w.y = cvt_pk_bf16(v0[2], v0[3]); w.z = cvt_pk_bf16(v1[0], v1[1]); w.w = cvt_pk_bf16(v1[2], v1[3]);
                    *(u32x4*)(rowp + bj * HALF) = w; } }
    }
};
struct EpiF32 {
    static constexpr bool PERM = false, AFTER_DRAIN = false;
    float* C; int ldc; const float* bias;
    __device__ __forceinline__ void operator()(const f32x4 (&acc)[2][2][4][2], const Unit& u, int wr, int wc, int fr, int fq) const {
        const int row0 = u.pm * BM + wr * 64 + fr, col0 = u.pn * BM + wc * 32 + 4 * fq;
        f32x4 bv[2][2];
#pragma unroll
        for (int bj = 0; bj < 2; ++bj)
#pragma unroll
            for (int n = 0; n < 2; ++n) bv[bj][n] = bias ? *(const f32x4*)(bias + col0 + bj * HALF + n * 16) : (f32x4){0.f, 0.f, 0.f, 0.f};
#pragma unroll
        for (int ai = 0; ai < 2; ++ai)
#pragma unroll
            for (int m = 0; m < 4; ++m) { float* rowp = C + (size_t)(row0 + ai * HALF + m * 16) * ldc + col0;
#pragma unroll
                for (int bj = 0; bj < 2; ++bj)
#pragma unroll
                    for (int n = 0; n < 2; ++n) *(f32x4*)(rowp + bj * HALF + n * 16) = acc[ai][bj][m][n] + bv[bj][n]; }
    }
};
template <class Epi, class Sched, bool ALIGN_EPI = false, bool SP2 = false>
__device__ __forceinline__ void gemm_phase(PG8_LAS unsigned char* lds, const Gemm g, const Sched& S, const Epi& E) {
    const int tid = threadIdx.x, wid = __builtin_amdgcn_readfirstlane(tid >> 6), lane = tid & 63, wr = wid >> 2, wc = wid & 3, fr = lane & 15, fq = lane >> 4;
    const int K = g.K, nt = K / BK;
    unsigned voffA[2], voffB[2];
#pragma unroll
    for (int i = 0; i < 2; ++i) { int R, C; stage_rc(tid * 16 + i * 8192, R, C); const int Rb = Epi::PERM ? ((R & ~31) + perm32(R & 31)) : R;
        voffA[i] = (unsigned)(R * K + C) * 2u; voffB[i] = (unsigned)(Rb * K + C) * 2u; }
    const size_t kstep = (size_t)(BK * 2);
    const size_t hstep = (size_t)HALF * K * 2;
    const size_t tstep = 2 * hstep;
    const unsigned ldsw = (unsigned)wid * 1024u;
    const int aoff = lds_byte(wr * 64 + fr, fq * 8), boff = lds_byte(wc * 32 + fr, fq * 8);
#define PG8_SA(b, h) (((b) * 2 + (h)) * HTB)
#define PG8_SB(b, h) ((4 + (b) * 2 + (h)) * HTB)
#define PG8_STAGE(bufoff, gbase, voff) do { _Pragma("unroll") for (int _i = 0; _i < 2; ++_i) \
        __builtin_amdgcn_global_load_lds((const unsigned*)((const char*)(gbase) + (voff)[_i]), (PG8_LAS unsigned*)(lds + (bufoff) + ldsw + _i * 8192), 16, 0, 0); } while (0)
#define PG8_LDA(dst, b, h) do { _Pragma("unroll") for (int m = 0; m < 4; ++m) _Pragma("unroll") for (int k = 0; k < 2; ++k) dst[m][k] = *(const PG8_LAS bf16x8*)(lds + PG8_SA(b, h) + aoff + m * 2048 + k * 1024); } while (0)
#define PG8_LDB(dst, b, h) do { _Pragma("unroll") for (int n = 0; n < 2; ++n) _Pragma("unroll") for (int k = 0; k < 2; ++k) dst[n][k] = *(const PG8_LAS bf16x8*)(lds + PG8_SB(b, h) + boff + n * 2048 + k * 1024); } while (0)
#define PG8_MMA(ai, bj, At, Bt) do { __builtin_amdgcn_s_setprio(1); _Pragma("unroll") for (int m = 0; m < 4; ++m) _Pragma("unroll") for (int n = 0; n < 2; ++n) _Pragma("unroll") for (int k = 0; k < 2; ++k) \
        acc[ai][bj][m][n] = __builtin_amdgcn_mfma_f32_16x16x32_bf16(Bt[n][k], At[m][k], acc[ai][bj][m][n], 0, 0, 0); __builtin_amdgcn_s_setprio(0); } while (0)
#define PG8_WAIT_V(n) asm volatile("s_waitcnt vmcnt(" #n ")" ::: "memory")
#define PG8_WAIT_L(n) asm volatile("s_waitcnt lgkmcnt(" #n ")" ::: "memory")
#define PG8_BAR __builtin_amdgcn_s_barrier()
#define PG8_SCHED __builtin_amdgcn_sched_barrier(0)
    Unit cur, nxt; int ui = 0;
    if (!S.next(0, cur)) return;
    f32x4 acc[2][2][4][2];
#pragma unroll
    for (int a = 0; a < 2; ++a)
#pragma unroll
        for (int b = 0; b < 2; ++b)
#pragma unroll
            for (int m = 0; m < 4; ++m)
#pragma unroll
                for (int n = 0; n < 2; ++n) acc[a][b][m][n] = (f32x4){0.f, 0.f, 0.f, 0.f};
    bf16x8 At[4][2], B0[2][2], B1[2][2];
    const char* cA = (const char*)g.A + (size_t)cur.pm * tstep; const char* cB = (const char*)g.Bt + (size_t)cur.pn * tstep;
    S.a_ready(cur);
    if constexpr (SP2) {
        PG8_STAGE(PG8_SB(0, 0), cB, voffB); PG8_STAGE(PG8_SB(0, 1), cB + hstep, voffB); PG8_STAGE(PG8_SA(0, 0), cA, voffA); PG8_STAGE(PG8_SA(0, 1), cA + hstep, voffA);
        if (wr == 1) PG8_BAR;
        PG8_WAIT_V(2); PG8_BAR;
        PG8_STAGE(PG8_SB(1, 0), cB + kstep, voffB); PG8_STAGE(PG8_SA(1, 0), cA + kstep, voffA); PG8_STAGE(PG8_SB(1, 1), cB + hstep + kstep, voffB);
        PG8_WAIT_V(6); PG8_BAR;
    } else {
        PG8_STAGE(PG8_SB(0, 0), cB, voffB); PG8_STAGE(PG8_SA(0, 0), cA, voffA); PG8_STAGE(PG8_SB(0, 1), cB + hstep, voffB); PG8_STAGE(PG8_SA(0, 1), cA + hstep, voffA);
        if (wr == 1) PG8_BAR;
        PG8_WAIT_V(4); PG8_BAR;
        PG8_STAGE(PG8_SB(1, 0), cB + kstep, voffB); PG8_STAGE(PG8_SA(1, 0), cA + kstep, voffA); PG8_STAGE(PG8_SB(1, 1), cB + hstep + kstep, voffB);
        PG8_WAIT_V(6); PG8_BAR;
    }
    for (;;) {
        const bool has_next = S.next(ui + 1, nxt);
        const char* nA = has_next ? (const char*)g.A + (size_t)nxt.pm * tstep : cA; const char* nB = has_next ? (const char*)g.Bt + (size_t)nxt.pn * tstep : cB;
        for (int t = 0; t < nt; t += 2) {
            const bool last = (t == nt - 2);
            const char* a1 = cA + (size_t)(t + 1) * kstep;
            const char* a2 = last ? nA : cA + (size_t)(t + 2) * kstep; const char* b2 = last ? nB : cB + (size_t)(t + 2) * kstep;
            const char* a3 = a2 + kstep; const char* b3 = b2 + kstep;
            if (last && has_next) S.a_ready(nxt);
            if constexpr (SP2) {
            PG8_LDB(B0, 0, 0); PG8_LDB(B1, 0, 1); PG8_SCHED; PG8_LDA(At, 0, 0); PG8_STAGE(PG8_SA(1, 1), a1 + hstep, voffA);
            PG8_WAIT_V(8); PG8_WAIT_L(0); PG8_BAR; PG8_MMA(0, 0, At, B0); PG8_MMA(0, 1, At, B1); PG8_BAR; PG8_SCHED;
            PG8_LDA(At, 0, 1); PG8_STAGE(PG8_SB(0, 0), b2, voffB); PG8_STAGE(PG8_SB(0, 1), b2 + hstep, voffB); PG8_STAGE(PG8_SA(0, 0), a2, voffA);
            PG8_WAIT_V(8); PG8_WAIT_L(0); PG8_BAR; PG8_MMA(1, 0, At, B0); PG8_MMA(1, 1, At, B1); PG8_BAR; PG8_SCHED;
            PG8_LDB(B0, 1, 0); PG8_LDB(B1, 1, 1); PG8_SCHED; PG8_LDA(At, 1, 0); PG8_STAGE(PG8_SA(0, 1), a2 + hstep, voffA);
            PG8_WAIT_V(8); PG8_WAIT_L(0); PG8_BAR; PG8_MMA(0, 0, At, B0); PG8_MMA(0, 1, At, B1); PG8_BAR; PG8_SCHED;
            PG8_LDA(At, 1, 1); PG8_STAGE(PG8_SB(1, 0), b3, voffB); PG8_STAGE(PG8_SB(1, 1), b3 + hstep, voffB); PG8_STAGE(PG8_SA(1, 0), a3, voffA);
            PG8_WAIT_V(8); PG8_WAIT_L(0); PG8_BAR; PG8_MMA(1, 0, At, B0); PG8_MMA(1, 1, At, B1); PG8_BAR; PG8_SCHED;
            } else {
            PG8_LDB(B0, 0, 0); PG8_SCHED; PG8_LDA(At, 0, 0); PG8_STAGE(PG8_SA(1, 1), a1 + hstep, voffA);
            PG8_WAIT_L(8); PG8_BAR; PG8_WAIT_L(0); PG8_MMA(0, 0, At, B0); PG8_BAR; PG8_SCHED;
            PG8_LDB(B1, 0, 1); PG8_STAGE(PG8_SB(0, 0), b2, voffB);
            PG8_BAR; PG8_WAIT_L(0); PG8_MMA(0, 1, At, B1); PG8_BAR;
            PG8_LDA(At, 0, 1); PG8_STAGE(PG8_SA(0, 0), a2, voffA);
            PG8_BAR; PG8_WAIT_L(0); PG8_MMA(1, 0, At, B0); PG8_BAR; PG8_SCHED;
            PG8_STAGE(PG8_SB(0, 1), b2 + hstep, voffB);
            PG8_WAIT_V(6); PG8_BAR; PG8_MMA(1, 1, At, B1); PG8_BAR;
            PG8_LDB(B0, 1, 0); PG8_SCHED; PG8_LDA(At, 1, 0); PG8_STAGE(PG8_SA(0, 1), a2 + hstep, voffA);
            PG8_WAIT_L(8); PG8_BAR; PG8_WAIT_L(0); PG8_MMA(0, 0, At, B0); PG8_BAR; PG8_SCHED;
            PG8_LDB(B1, 1, 1); PG8_STAGE(PG8_SB(1, 0), b3, voffB);
            PG8_BAR; PG8_WAIT_L(0); PG8_MMA(0, 1, At, B1); PG8_BAR;
            PG8_LDA(At, 1, 1); PG8_STAGE(PG8_SA(1, 0), a3, voffA);
            PG8_BAR; PG8_WAIT_L(0); PG8_MMA(1, 0, At, B0); PG8_BAR; PG8_SCHED;
            PG8_STAGE(PG8_SB(1, 1), b3 + hstep, voffB);
            PG8_WAIT_V(6); PG8_BAR; PG8_MMA(1, 1, At, B1); PG8_BAR;
            }
        }
        if constexpr (ALIGN_EPI) { if (wr == 0) PG8_BAR; }
        if constexpr (!Epi::AFTER_DRAIN) { E(acc, cur, wr, wc, fr, fq); S.done(cur); }
        if (!has_next) break;
#pragma unroll
        for (int a = 0; a < 2; ++a)
#pragma unroll
            for (int b = 0; b < 2; ++b)
#pragma unroll
                for (int m = 0; m < 4; ++m)
#pragma unroll
                    for (int n = 0; n < 2; ++n) acc[a][b][m][n] = (f32x4){0.f, 0.f, 0.f, 0.f};
        cur = nxt; cA = nA; cB = nB; ++ui;
        if constexpr (ALIGN_EPI) { if (wr == 1) PG8_BAR; }
    }
    PG8_WAIT_V(0);
    if constexpr (!ALIGN_EPI) { if (wr == 0) PG8_BAR; }
    PG8_BAR;
    if constexpr (Epi::AFTER_DRAIN) { E.fused(acc, cur, wr, wc, fr, fq, lds, wid, lane); S.done(cur); }
#undef PG8_SA
#undef PG8_SB
#undef PG8_STAGE
#undef PG8_LDA
#undef PG8_LDB
#undef PG8_MMA
#undef PG8_WAIT_V
#undef PG8_WAIT_L
#undef PG8_BAR
#undef PG8_SCHED
}
}
#define XB_TMO      128
#define XB_XCNT(j)  (256  + 64 * (j))
#define XB_XSUB(j)  (1280 + 64 * (j))
#define XB_XGEN(j)  (2304 + 64 * (j))
#define XB_TOP      3328
#define XB_TOPGEN   3392
#define XCD_BAR_WORDS 3456
#define XB_SPIN_CAP (1u << 18)

__device__ __forceinline__ unsigned xb_ld(unsigned* p)              { return __hip_atomic_load(p, __ATOMIC_RELAXED, __HIP_MEMORY_SCOPE_AGENT); }
__device__ __forceinline__ unsigned xb_add(unsigned* p, unsigned v) { return __hip_atomic_fetch_add(p, v, __ATOMIC_RELAXED, __HIP_MEMORY_SCOPE_AGENT); }
__device__ __forceinline__ unsigned xb_xcc_id() { return (unsigned)__builtin_amdgcn_s_getreg((3 << 11) | 20) & 0xFu; }
#define XB_SPIN(cond, bar) do { unsigned _sp = 0; while (cond) { __builtin_amdgcn_s_sleep(1); \
    if ((++_sp & 255u) == 0u) { if (xb_ld(&(bar)[XB_TMO])) break; if (_sp > XB_SPIN_CAP) { atomicAdd(&(bar)[XB_TMO], 1u); break; } } } } while (0)

struct XcdBarrier {
    unsigned* bar; unsigned x;
    volatile LAS unsigned* st;
};

__device__ __forceinline__ XcdBarrier xcd_barrier_post(unsigned* bar, volatile LAS unsigned* st) {
    XcdBarrier b; b.bar = bar; b.x = xb_xcc_id(); b.st = st;
    if (threadIdx.x == 0) (void)xb_add(&bar[XB_XCNT(b.x)], 1u);
    return b;
}
__device__ __forceinline__ void xcd_barrier_complete(unsigned* bar, unsigned x, unsigned& nloc, unsigned& nx) {
    const unsigned G = gridDim.x * gridDim.y * gridDim.z;
    unsigned sum, cnt, mine, sp = 0u;
    for (;;) {
        sum = 0u; cnt = 0u; mine = 0u;
#pragma unroll
        for (unsigned j = 0; j < 16; ++j) { const unsigned c = xb_ld(&bar[XB_XCNT(j)]); sum += c; cnt += (c > 0u) ? 1u : 0u; mine = (j == x) ? c : mine; }
        if (sum == G) break;
        __builtin_amdgcn_s_sleep(1);
        if ((++sp & 255u) == 0u) { if (xb_ld(&bar[XB_TMO])) break; if (sp > XB_SPIN_CAP) { atomicAdd(&bar[XB_TMO], 1u); break; } }
    }
    nloc = mine > 0u ? mine : 1u; nx = cnt > 0u ? cnt : 1u;
}

__device__ __forceinline__ void xcd_barrier(const XcdBarrier& b) {
    asm volatile("s_waitcnt vmcnt(0)" ::: "memory");
    __syncthreads();
    if (threadIdx.x == 0) {
        unsigned* bar = b.bar;
        __builtin_amdgcn_s_waitcnt(0);
        unsigned nloc = b.st[0], nx = b.st[1];
        if (nloc == 0u) { xcd_barrier_complete(bar, b.x, nloc, nx); b.st[0] = nloc; b.st[1] = nx; }
        const unsigned old = xb_add(&bar[XB_XSUB(b.x)], 1u);
        const unsigned gen = old / nloc;
        if (old + 1u == (gen + 1u) * nloc) {
            __builtin_amdgcn_fence(__ATOMIC_RELEASE, "agent");
            asm volatile("s_waitcnt vmcnt(0)" ::: "memory");
            const unsigned og = xb_add(&bar[XB_TOP], 1u);
            const unsigned tg = og / nx;
            if (og + 1u == (tg + 1u) * nx) xb_add(&bar[XB_TOPGEN], 1u);
            else XB_SPIN(xb_ld(&bar[XB_TOPGEN]) == tg, bar);
            __builtin_amdgcn_fence(__ATOMIC_ACQUIRE, "agent");
            xb_add(&bar[XB_XGEN(b.x)], 1u);
            asm volatile("s_waitcnt vmcnt(0)" ::: "memory");
        } else {
            XB_SPIN(xb_ld(&bar[XB_XGEN(b.x)]) == gen, bar);
            __builtin_amdgcn_fence(__ATOMIC_ACQUIRE, "agent");
            asm volatile("s_waitcnt vmcnt(0)" ::: "memory");
        }
    }
    __syncthreads();
}
#define GAS __attribute__((address_space(1)))
typedef float f32x4 __attribute__((ext_vector_type(4)));
typedef unsigned u32x2 __attribute__((ext_vector_type(2)));
typedef unsigned u32x4 __attribute__((ext_vector_type(4)));
typedef short bf16x8 __attribute__((ext_vector_type(8)));
constexpr int NTHR = 512, NWV = 8;
constexpr int RING_BYTES = 131072, MISC_OFF = RING_BYTES + 320, LDS_BYTES = 147456;
constexpr int CW_BAR = 1024;

struct KArgs { Inputs in; float* out; unsigned char* ws; int ph_lo, ph_hi, li, mask; };

__device__ __forceinline__ float wave_sum(float v) {
#pragma unroll
    for (int o = 1; o < 64; o <<= 1) v += __shfl_xor(v, o);
    return v;
}
__device__ __forceinline__ unsigned pk2(float lo, float hi) { return (unsigned)f2bf(lo) | ((unsigned)f2bf(hi) << 16); }
#define LDS_FENCE() asm volatile("s_waitcnt lgkmcnt(0)" ::: "memory")

constexpr int PH_PRO = 0;
constexpr int PH_L0 = 1, PH_PER_LAYER = 6;
constexpr int PH_FIN = PH_L0 + 2 * PH_PER_LAYER;
constexpr int PH_END = PH_FIN + 1;

__device__ __forceinline__ void transpose_item(const float* W, int K, int N, bf16_t* WT, LAS float* scr, int item, int lane) {
    const int nblk = N / 32, kb = item / nblk, nb = item % nblk, k0 = 64 * kb, n0 = 32 * nb;
#pragma unroll 8
    for (int i = 0; i < 32; ++i) { const int kk = 2 * i + (lane >> 5); scr[kk * 33 + (lane & 31)] = W[(size_t)(k0 + kk) * N + n0 + (lane & 31)]; }
    LDS_FENCE();
    const int c = lane & 7;
#pragma unroll
    for (int j = 0; j < 4; ++j) { const int n = (lane >> 3) + 8 * j; const LAS float* s = scr + (8 * c) * 33 + n;
        u32x4 o; o.x = pk2(s[0 * 33], s[1 * 33]); o.y = pk2(s[2 * 33], s[3 * 33]); o.z = pk2(s[4 * 33], s[5 * 33]); o.w = pk2(s[6 * 33], s[7 * 33]);
        *(u32x4*)(WT + (size_t)(n0 + n) * K + k0 + 8 * c) = o; }
    LDS_FENCE();
}

__device__ __forceinline__ void ph_prologue(const KArgs& a, LAS unsigned char* lds, int tid, int wave, int lane) {
    const Inputs& in = a.in;
    float* MOD = (float*)(a.ws + OFF_MOD);
    LAS float* sil = (LAS float*)lds;
    LAS float* part = (LAS float*)(lds + 5 * 1024 * 4);
    if ((int)blockIdx.x < 192) {
        for (int i = tid; i < 5 * 1024; i += NTHR) { const int j = i >> 10, k = i & 1023; const float cv = j < 4 ? in.c[j * DM + k] : in.c_ctx[k]; sil[i] = cv / (1.f + expf(-cv)); }
        __syncthreads();
        for (int it = blockIdx.x; it < 192; it += gridDim.x) {
            const int l = it / 96, nb = it % 96, n = nb * 32 + (lane & 31), k0 = wave * 128 + (lane >> 5) * 64;
            const float* w = in.w_mod + (size_t)l * DM * 3072 + n;
            float acc[5] = {0.f, 0.f, 0.f, 0.f, 0.f};
#pragma unroll 8
            for (int kk = 0; kk < 64; ++kk) { const float wv = w[(size_t)(k0 + kk) * 3072];
#pragma unroll
                for (int j = 0; j < 5; ++j) acc[j] += sil[j * 1024 + k0 + kk] * wv; }
#pragma unroll
            for (int j = 0; j < 5; ++j) { acc[j] += __shfl_xor(acc[j], 32); if (lane < 32) part[(wave * 5 + j) * 32 + lane] = acc[j]; }
            __syncthreads();
            if (tid < 160) { const int j = tid >> 5, c = tid & 31; float s = in.b_mod[l * 3072 + nb * 32 + c];
#pragma unroll
                for (int w8 = 0; w8 < 8; ++w8) s += part[(w8 * 5 + j) * 32 + c];
                MOD[((size_t)l * 5 + j) * 3072 + nb * 32 + c] = s; }
            __syncthreads();
        }
    }
    __syncthreads();
    LAS float* scr = (LAS float*)(lds + wave * 16384);
    const int gw = blockIdx.x * NWV + wave, NGW = gridDim.x * NWV;
    constexpr int I_IN = (DM / 64) * (NIN / 32), I_OUT = (DM / 64) * (DM / 32), I_PAD = NP - NIN;
    constexpr int I_L = I_IN + I_OUT + I_PAD;
    bf16_t* WIN = (bf16_t*)(a.ws + OFF_WIN); bf16_t* WOUT = (bf16_t*)(a.ws + OFF_WOUT);
    for (int it = gw; it < 2 * I_L; it += NGW) {
        const int l = it / I_L; int r = it % I_L;
        if (r < I_IN) { transpose_item(in.w_in + (size_t)l * DM * NIN, DM, NIN, WIN + (size_t)l * NP * DM, scr, r, lane); continue; } r -= I_IN;
        if (r < I_OUT) { transpose_item(in.w_out + (size_t)l * DM * DM, DM, DM, WOUT + (size_t)l * DM * DM, scr, r, lane); continue; } r -= I_OUT;
        u32x4* zp = (u32x4*)(WIN + ((size_t)l * NP + NIN + r) * DM);
        zp[lane] = (u32x4){0u, 0u, 0u, 0u}; zp[lane + 64] = (u32x4){0u, 0u, 0u, 0u};
    }
    const int gt = blockIdx.x * NTHR + tid, NGT = gridDim.x * NTHR;
    bf16_t* WPT = (bf16_t*)(a.ws + OFF_WPT);
    for (int i = gt; i < 2 * 4 * 64 * 64; i += NGT) { const int c = i & 63, e = (i >> 6) & 63, li = i >> 12; WPT[i] = f2bf(in.pool_w[(size_t)li * 4096 + c * 64 + e]); }
}

__device__ __forceinline__ void ph_post_pre(const KArgs& a, int lprev, int lnext, int wave, int lane) {
    const Inputs& in = a.in;
    const float* MOD = (const float*)(a.ws + OFF_MOD);
    const float* O = (const float*)(a.ws + OFF_P);
    float* XC = (float*)(a.ws + OFF_XC);
    bf16_t* H = (bf16_t*)(a.ws + OFF_H);
    const int gw = blockIdx.x * NWV + wave, NGW = gridDim.x * NWV;
    const int nrows = (lnext < 2) ? MTOT : NLAT;
    for (int row = gw; row < nrows; row += NGW) {
        const bool lat = row < NLAT; const int j = lat ? row / SEQ : 4;
        const float* xr; float* xw = nullptr;
        if (lprev <= 0) xr = lat ? in.x + (size_t)row * DM : in.ctx + (size_t)(row - NLAT) * DM;
        else xr = lat ? a.out + (size_t)row * DM : XC + (size_t)(row - NLAT) * DM;
        const bool post = (lprev >= 0) && (lat || lprev == 0);
        if (post) xw = lat ? a.out + (size_t)row * DM : XC + (size_t)(row - NLAT) * DM;
        f32x4 v[4];
#pragma unroll
        for (int q = 0; q < 4; ++q) v[q] = *(const f32x4*)(xr + 4 * lane + 256 * q);
        if (post) {
            f32x4 o[4]; float s = 0.f;
#pragma unroll
            for (int q = 0; q < 4; ++q) { o[q] = *(const f32x4*)(O + (size_t)row * DM + 4 * lane + 256 * q); s += (o[q].x * o[q].x + o[q].y * o[q].y) + (o[q].z * o[q].z + o[q].w * o[q].w); }
            const float rstd = rsqrtf(wave_sum(s) * (1.f / DM) + EPS);
            const float* gate = MOD + ((size_t)lprev * 5 + j) * 3072 + 2048; const float* gp = in.g_post + lprev * DM;
#pragma unroll
            for (int q = 0; q < 4; ++q) { const f32x4 gt = *(const f32x4*)(gate + 4 * lane + 256 * q), gg = *(const f32x4*)(gp + 4 * lane + 256 * q);
                v[q] = v[q] + gt * (o[q] * rstd * gg); *(f32x4*)(xw + 4 * lane + 256 * q) = v[q]; }
        }
        if (lnext < 2) {
            float s = 0.f;
#pragma unroll
            for (int q = 0; q < 4; ++q) s += (v[q].x * v[q].x + v[q].y * v[q].y) + (v[q].z * v[q].z + v[q].w * v[q].w);
            const float rstd = rsqrtf(wave_sum(s) * (1.f / DM) + EPS);
            const float* shift = MOD + ((size_t)lnext * 5 + j) * 3072; const float* scale = shift + 1024; const float* gp = in.g_pre + lnext * DM;
#pragma unroll
            for (int q = 0; q < 4; ++q) { const int k = 4 * lane + 256 * q; const f32x4 sh = *(const f32x4*)(shift + k), sc = *(const f32x4*)(scale + k), gg = *(const f32x4*)(gp + k);
                const f32x4 hv = (v[q] * rstd * gg) * (sc + 1.f) + sh;
                u32x2 w; w.x = pk2(hv.x, hv.y); w.y = pk2(hv.z, hv.w); *(u32x2*)(H + (size_t)row * DM + k) = w; }
        }
    }
}

typedef float f32x16 __attribute__((ext_vector_type(16)));
typedef float f32x2_t __attribute__((ext_vector_type(2)));
typedef __bf16 bf16x2_t __attribute__((ext_vector_type(2)));
#define MFMA16(a, b, c) __builtin_amdgcn_mfma_f32_16x16x32_bf16(a, b, c, 0, 0, 0)
#define MFMA32(a, b, c) __builtin_amdgcn_mfma_f32_32x32x16_bf16(a, b, c, 0, 0, 0)
__device__ __forceinline__ unsigned cvtpk(float lo, float hi) { f32x2_t v = {lo, hi}; bf16x2_t b = __builtin_convertvector(v, bf16x2_t); return __builtin_bit_cast(unsigned, b); }
__device__ __forceinline__ float fast_exp(float x) { return __builtin_amdgcn_exp2f(x * 1.4426950408889634f); }
__device__ __forceinline__ float fast_silu(float v) { return v * __builtin_amdgcn_rcpf(1.f + fast_exp(-v)); }
__device__ __forceinline__ float lo_bf(unsigned w) { return __uint_as_float(w << 16); }
__device__ __forceinline__ float hi_bf(unsigned w) { return __uint_as_float(w & 0xffff0000u); }


__device__ __forceinline__ void vt_item(const KArgs& a, LAS unsigned char* lds, int cid, int tid) {
    const bf16_t* P = (const bf16_t*)(a.ws + OFF_P);
    bf16_t* VTL = (bf16_t*)(a.ws + OFF_VTL); bf16_t* VTC = (bf16_t*)(a.ws + OFF_VTC);
    LAS bf16_t* tile = (LAS bf16_t*)lds;
    const int row0 = cid * 64;
    for (int i = tid; i < 2048; i += NTHR) { const int t = i >> 5, c8 = i & 31;
        *(LAS u32x4*)(tile + t * 264 + c8 * 8) = *(const u32x4*)(P + (size_t)(row0 + t) * NP + C_NV + c8 * 8); }
    __syncthreads();
    for (int i = tid; i < 2048; i += NTHR) { const int tg = i & 7, col = i >> 3;
        u32x4 w;
        w.x = (unsigned)tile[(8 * tg + 0) * 264 + col] | ((unsigned)tile[(8 * tg + 1) * 264 + col] << 16);
        w.y = (unsigned)tile[(8 * tg + 2) * 264 + col] | ((unsigned)tile[(8 * tg + 3) * 264 + col] << 16);
        w.z = (unsigned)tile[(8 * tg + 4) * 264 + col] | ((unsigned)tile[(8 * tg + 5) * 264 + col] << 16);
        w.w = (unsigned)tile[(8 * tg + 6) * 264 + col] | ((unsigned)tile[(8 * tg + 7) * 264 + col] << 16);
        bf16_t* dst;
        if (cid < 256) { const int b = cid >> 6; dst = VTL + ((size_t)(b * 256 + col)) * SEQ + (cid & 63) * 64 + 8 * tg; }
        else { const int cc = cid - 256, b = cc >> 2; dst = VTC + ((size_t)(b * 256 + col)) * NCTX + (cc & 3) * 64 + 8 * tg; }
        *(u32x4*)dst = w; }
    __syncthreads();
}

template <bool WIN>
__device__ __forceinline__ void na_unit(const KArgs& a, const LAS float* rpb  , int b, int h, int qrow0, int r, int cg, int lane) {
    const bf16_t* P = (const bf16_t*)(a.ws + OFF_P);
    const bf16_t* VTL = (const bf16_t*)(a.ws + OFF_VTL); const bf16_t* VTC = (const bf16_t*)(a.ws + OFF_VTC);
    bf16_t* Y = (bf16_t*)(a.ws + OFF_H);
    const int li = lane & 15, g = lane >> 4;
    const bf16_t* qp = P + (size_t)(qrow0 + li) * NP + C_NQ + h * 64 + 8 * g;
    const bf16x8 qf0 = *(const bf16x8*)qp, qf1 = *(const bf16x8*)(qp + 32);
    constexpr int NT = WIN ? 32 : 16, WOFF = WIN ? 16 : 0;
    f32x4 S[NT];
    const int c0 = cg * 16;
    const int CB = WIN ? min(max(c0 - 8, 0), 32) : 0, R0 = WIN ? min(max(r - 4, 0), 56) : 0;
    if (WIN) {
#pragma unroll
        for (int wt = 0; wt < 16; ++wt) {
            const int keyrow = b * SEQ + (R0 + (wt >> 1)) * 64 + CB + 16 * (wt & 1) + li;
            const bf16_t* kp = P + (size_t)keyrow * NP + C_NK + h * 64 + 8 * g;
            const bf16x8 k0 = *(const bf16x8*)kp, k1 = *(const bf16x8*)(kp + 32);
            f32x4 acc = {0.f, 0.f, 0.f, 0.f};
            acc = MFMA16(k0, qf0, acc); acc = MFMA16(k1, qf1, acc); S[wt] = acc;
        }
    }
#pragma unroll
    for (int ct = 0; ct < 16; ++ct) {
        const int keyrow = NLAT + b * NCTX + 16 * ct + li;
        const bf16_t* kp = P + (size_t)keyrow * NP + C_NK + h * 64 + 8 * g;
        const bf16x8 k0 = *(const bf16x8*)kp, k1 = *(const bf16x8*)(kp + 32);
        f32x4 acc = {0.f, 0.f, 0.f, 0.f};
        acc = MFMA16(k0, qf0, acc); acc = MFMA16(k1, qf1, acc); S[WOFF + ct] = acc;
    }
    float m = -INFINITY;
    if (WIN) {
        const int c = c0 + li, cs = min(max(c - 8, 0), 48);
        const LAS float* rp = rpb + h * 465;
#pragma unroll
        for (int wt = 0; wt < 16; ++wt) {
            const int krow = R0 + (wt >> 1); const LAS float* rr = rp + (krow - r + 7) * 31;
#pragma unroll
            for (int q = 0; q < 4; ++q) { const int kcol = CB + 16 * (wt & 1) + 4 * g + q; const bool valid = (kcol >= cs) && (kcol < cs + 16);
                const float bias = rr[min(max(kcol - c, -15), 15) + 15];
                const float s = valid ? S[wt][q] * 0.125f + bias : -INFINITY; S[wt][q] = s; m = fmaxf(m, s); }
        }
    }
#pragma unroll
    for (int ct = 0; ct < 16; ++ct)
#pragma unroll
        for (int q = 0; q < 4; ++q) { const float s = S[WOFF + ct][q] * 0.125f; S[WOFF + ct][q] = s; m = fmaxf(m, s); }
    m = fmaxf(m, __shfl_xor(m, 16)); m = fmaxf(m, __shfl_xor(m, 32));
    float lsum = 0.f;
    bf16x8 pf[NT / 2];
#pragma unroll
    for (int u = 0; u < NT / 2; ++u) {
        float p[8];
#pragma unroll
        for (int q = 0; q < 4; ++q) { p[q] = fast_exp(S[2 * u][q] - m); p[4 + q] = fast_exp(S[2 * u + 1][q] - m); }
#pragma unroll
        for (int q = 0; q < 8; ++q) lsum += p[q];
        u32x4 w; w.x = cvtpk(p[0], p[1]); w.y = cvtpk(p[2], p[3]); w.z = cvtpk(p[4], p[5]); w.w = cvtpk(p[6], p[7]);
        pf[u] = __builtin_bit_cast(bf16x8, w);
    }
    lsum += __shfl_xor(lsum, 16); lsum += __shfl_xor(lsum, 32);
    f32x4 acc[4];
#pragma unroll
    for (int mt = 0; mt < 4; ++mt) acc[mt] = (f32x4){0.f, 0.f, 0.f, 0.f};
#pragma unroll
    for (int u = 0; u < NT / 2; ++u) {
#pragma unroll
        for (int mt = 0; mt < 4; ++mt) {
            const int dh = 16 * mt + li;
            const bf16_t* vt;
            if (WIN && u < 8) vt = VTL + ((size_t)((b * 4 + h) * 64 + dh)) * SEQ + (R0 + u) * 64 + CB;
            else vt = VTC + ((size_t)((b * 4 + h) * 64 + dh)) * NCTX + 32 * (u - (WIN ? 8 : 0));
            const u32x2 lo = *(const u32x2*)(vt + 4 * g), hi = *(const u32x2*)(vt + 16 + 4 * g);
            u32x4 w; w.x = lo.x; w.y = lo.y; w.z = hi.x; w.w = hi.y;
            acc[mt] = MFMA16(__builtin_bit_cast(bf16x8, w), pf[u], acc[mt]);
        }
    }
    const float inv = 1.f / lsum;
    const size_t row = (size_t)(qrow0 + li);
#pragma unroll
    for (int mt = 0; mt < 4; ++mt) {
        const int col = 256 + h * 64 + 16 * mt + 4 * g;
        const u32x2 gt = *(const u32x2*)(P + row * NP + C_GATE + col);
        u32x2 w;
        w.x = cvtpk(acc[mt][0] * inv * fast_silu(lo_bf(gt.x)), acc[mt][1] * inv * fast_silu(hi_bf(gt.x)));
        w.y = cvtpk(acc[mt][2] * inv * fast_silu(lo_bf(gt.y)), acc[mt][3] * inv * fast_silu(hi_bf(gt.y)));
        *(u32x2*)(Y + row * DM + col) = w;
    }
}

__device__ __forceinline__ void pool_item(const KArgs& a, int l, LAS unsigned char* lds, int cid, int tid, int wave, int lane) {
    const bf16_t* P = (const bf16_t*)(a.ws + OFF_P); bf16_t* Y = (bf16_t*)(a.ws + OFF_H);
    const bf16_t* WPT = (const bf16_t*)(a.ws + OFF_WPT) + (size_t)l * 4 * 64 * 64;
    const float* pscale = a.in.pool_scale + l * 256;
    LAS bf16_t* U = (LAS bf16_t*)lds;
    LAS bf16_t* M = U + 80 * 264;
    const bool lat = cid < 256;
    const int seq_len = lat ? SEQ : NCTX;
    const int seq_base = lat ? (cid >> 6) * SEQ : NLAT + ((cid - 256) >> 2) * NCTX;
    const int t0 = lat ? (cid & 63) * 64 : ((cid - 256) & 3) * 64;
    for (int i = tid; i < 80 * 32; i += NTHR) { const int tr = i >> 5, c8 = i & 31, tt = t0 - 8 + tr;
        u32x4 v = {0u, 0u, 0u, 0u};
        if (tt >= 0 && tt < seq_len) v = *(const u32x4*)(P + (size_t)(seq_base + tt) * NP + C_PU + c8 * 8);
        *(LAS u32x4*)(U + tr * 264 + c8 * 8) = v; }
    __syncthreads();
    {
        const int col = tid & 255, th = tid >> 8, part = col >> 6, w = 2 << part;
        for (int t = 32 * th; t < 32 * th + 32; ++t) {
            const int tt = t0 + t; const int lo = min(max(tt - w / 2, 0), seq_len), hi = min(max(tt - w / 2 + w, 0), seq_len);
            float s = 0.f;
            for (int ss = lo; ss < hi; ++ss) s += bf2f(U[(ss - t0 + 8) * 264 + col]);
            const float mv = s / (float)(hi - lo) - bf2f(U[(t + 8) * 264 + col]);
            M[t * 264 + col] = f2bf(mv);
        }
    }
    __syncthreads();
    {
        const int part = wave >> 1, th = wave & 1, li = lane & 15, g = lane >> 4;
        f32x4 acc[4][2];
#pragma unroll
        for (int mt = 0; mt < 4; ++mt) { acc[mt][0] = (f32x4){0.f, 0.f, 0.f, 0.f}; acc[mt][1] = (f32x4){0.f, 0.f, 0.f, 0.f}; }
#pragma unroll
        for (int s = 0; s < 2; ++s) {
            bf16x8 bfr[2];
#pragma unroll
            for (int nt = 0; nt < 2; ++nt) bfr[nt] = *(const LAS bf16x8*)(M + (32 * th + 16 * nt + li) * 264 + part * 64 + 32 * s + 8 * g);
#pragma unroll
            for (int mt = 0; mt < 4; ++mt) {
                const bf16x8 af = *(const bf16x8*)(WPT + ((size_t)(part * 64 + 16 * mt + li)) * 64 + 32 * s + 8 * g);
#pragma unroll
                for (int nt = 0; nt < 2; ++nt) acc[mt][nt] = MFMA16(af, bfr[nt], acc[mt][nt]);
            }
        }
#pragma unroll
        for (int nt = 0; nt < 2; ++nt) {
            const size_t row = (size_t)(seq_base + t0 + 32 * th + 16 * nt + li);
#pragma unroll
            for (int mt = 0; mt < 4; ++mt) {
                const int cl = part * 64 + 16 * mt + 4 * g;
                const f32x4 sc = *(const f32x4*)(pscale + cl);
                const u32x2 gt = *(const u32x2*)(P + row * NP + C_GATE + 768 + cl);
                u32x2 w;
                w.x = cvtpk(acc[mt][nt][0] * sc.x * fast_silu(lo_bf(gt.x)), acc[mt][nt][1] * sc.y * fast_silu(hi_bf(gt.x)));
                w.y = cvtpk(acc[mt][nt][2] * sc.z * fast_silu(lo_bf(gt.y)), acc[mt][nt][3] * sc.w * fast_silu(hi_bf(gt.y)));
                *(u32x2*)(Y + row * DM + 768 + cl) = w;
            }
        }
    }
    __syncthreads();
}

__device__ __forceinline__ void phC_vt(const KArgs& a, LAS unsigned char* lds, int tid) {
    for (int cid = blockIdx.x; cid < 272; cid += gridDim.x) vt_item(a, lds, cid, tid);
}
__device__ __forceinline__ void phD_na_pool(const KArgs& a, int l, LAS unsigned char* lds, int tid, int wave, int lane) {
    const int ncid = (l == 1) ? 256 : 272;
    for (int cid = blockIdx.x; cid < ncid; cid += gridDim.x) pool_item(a, l, lds, cid, tid, wave, lane);
    LAS float* rpb = (LAS float*)lds;
    for (int i = tid; i < 4 * 465; i += NTHR) rpb[i] = a.in.na_rpb[l * 4 * 465 + i];
    __syncthreads();
    unsigned* ctr = (unsigned*)(a.ws + OFF_CTL) + 16 + l;
    const int nunits = (l == 1) ? 4096 : 4096 + 256;
    for (;;) {
        int u = 0;
        if (lane == 0) u = (int)atomicAdd(ctr, 1u);
        u = __builtin_amdgcn_readfirstlane(u);
        if (u >= nunits) break;
        if (u < 4096) { const int cg = u & 3, r = (u >> 2) & 63, h = (u >> 8) & 3, b = u >> 10;
            na_unit<true>(a, rpb, b, h, b * SEQ + r * 64 + cg * 16, r, cg, lane); }
        else { const int v = u - 4096, qt = v & 15, h = (v >> 4) & 3, b = v >> 6;
            na_unit<false>(a, rpb, b, h, NLAT + b * NCTX + qt * 16, 0, 0, lane); }
    }
    __syncthreads();
}
__global__ void __launch_bounds__(NTHR, 2) mega(KArgs a) {
    extern __shared__ __attribute__((aligned(16))) unsigned char lds_raw[];
    LAS unsigned char* lds = (LAS unsigned char*)lds_raw;
    const int tid = threadIdx.x, lane = tid & 63, wave = __builtin_amdgcn_readfirstlane(tid >> 6);
    volatile LAS unsigned* MISC = (volatile LAS unsigned*)(lds + MISC_OFF);
    for (int u = tid; u < (LDS_BYTES - RING_BYTES) / 4; u += NTHR) ((LAS unsigned*)(lds + RING_BYTES))[u] = 0u;
    __syncthreads();
    unsigned* ctl = (unsigned*)(a.ws + OFF_CTL);
    XcdBarrier bar = xcd_barrier_post(ctl + CW_BAR + a.li * XCD_BAR_WORDS, MISC + 8);
    const int lo = a.ph_lo, hi = a.ph_hi;
    bool first_seam = true;
#define IN(k) (lo <= (k) && (k) < hi)
#define SEAM(k) do { if (IN(k) && IN((k) + 1)) { if (first_seam) { cooperative_groups::this_grid().sync(); first_seam = false; } xcd_barrier(bar); } } while (0)
    if (IN(PH_PRO)) { ph_prologue(a, lds, tid, wave, lane); }
    SEAM(PH_PRO);
#define LAYER(l) do { \
        constexpr int pb = PH_L0 + (l) * PH_PER_LAYER; \
        constexpr int nrows_out = ((l) == 1) ? NLAT : MTOT; \
        if (IN(pb + 0)) { ph_post_pre(a, (l) - 1, (l), wave, lane); } \
        SEAM(pb + 0); \
        if (IN(pb + 1)) { \
            pg8::Gemm g{(const bf16_t*)(a.ws + OFF_H), (const bf16_t*)(a.ws + OFF_WIN) + (size_t)(l) * NP * DM, MTOT, NP, DM}; \
            pg8::StaticOrder S; S.init(MTOT, NP, gridDim.x, blockIdx.x); \
            pg8::EpiBf16<0> E{(bf16_t*)(a.ws + OFF_P), NP, nullptr, 0, 0, 1.f}; \
            pg8::gemm_phase<pg8::EpiBf16<0>, pg8::StaticOrder, true, true>(lds, g, S, E); \
        } \
        SEAM(pb + 1); \
        if (IN(pb + 2)) { if (a.mask & 1) phC_vt(a, lds, tid); } \
        SEAM(pb + 2); \
        if (IN(pb + 3)) { if (a.mask & 1) phD_na_pool(a, (l), lds, tid, wave, lane); } \
        SEAM(pb + 3); \
        SEAM(pb + 4); \
        if (IN(pb + 5)) { \
            pg8::Gemm g{(const bf16_t*)(a.ws + OFF_H), (const bf16_t*)(a.ws + OFF_WOUT) + (size_t)(l) * DM * DM, nrows_out, DM, DM}; \
            pg8::StaticOrder S; S.init(nrows_out, DM, gridDim.x, blockIdx.x); \
            pg8::EpiF32 E{(float*)(a.ws + OFF_P), DM, nullptr}; \
            pg8::gemm_phase<pg8::EpiF32, pg8::StaticOrder, true, true>(lds, g, S, E); \
        } \
        SEAM(pb + 5); \
    } while (0)
    LAYER(0);
    LAYER(1);
#undef LAYER
    if (IN(PH_FIN)) { ph_post_pre(a, 1, 2, wave, lane); }
#undef IN
#undef SEAM
}

static int g_grid = 0;
static void launch_mega(const KArgs& base, int lo, int hi, int li, hipStream_t stream) {
    KArgs a = base; a.ph_lo = lo; a.ph_hi = hi; a.li = li;
    void* args[] = {(void*)&a};
    hipError_t e = hipLaunchCooperativeKernel((const void*)mega, dim3(g_grid), dim3(NTHR), args, LDS_BYTES, stream);
    if (e != hipSuccess) fprintf(stderr, "cooperative launch failed: %s (grid %d)\n", hipGetErrorString(e), g_grid);
}

extern "C" void kernel_launch(void* const* d_in, const int* in_sizes, int n_in, void* d_out, int out_size, void* d_ws, size_t ws_size, hipStream_t stream) {
    if (g_grid == 0) {
        int dev = 0, cus = 0, per_cu = 0;
        hipGetDevice(&dev);
        hipDeviceGetAttribute(&cus, hipDeviceAttributeMultiprocessorCount, dev);
        hipFuncSetAttribute((const void*)mega, hipFuncAttributeMaxDynamicSharedMemorySize, LDS_BYTES);
        hipOccupancyMaxActiveBlocksPerMultiprocessor(&per_cu, (const void*)mega, NTHR, LDS_BYTES);
        if (per_cu < 1) per_cu = 1;
        g_grid = cus * per_cu;
        if (g_grid != 256) fprintf(stderr, "note: grid %d (cus %d x %d)\n", g_grid, cus, per_cu);
    }
    KArgs base;
    memset(&base, 0, sizeof(base));
    const float** ip = (const float**)&base.in;
    for (int i = 0; i < 26; ++i) ip[i] = (const float*)d_in[i];
    base.out = (float*)d_out; base.ws = (unsigned char*)d_ws; base.mask = 1;
    const Inputs& in = base.in;
    char* ws = (char*)d_ws;
    bf16_t* Y = (bf16_t*)(ws + OFF_H); bf16_t* P = (bf16_t*)(ws + OFF_P);
    float* LG = (float*)(ws + OFF_LG); float* OG = (float*)(ws + OFF_OG); float* SY = (float*)(ws + OFF_SY);
    hipMemsetAsync(ws + OFF_CTL, 0, CTL_BYTES, stream);
    int li = 0;
    launch_mega(base, PH_PRO, PH_L0 + 2, li++, stream);
    for (int l = 0; l < 2; ++l) {
        const int last = (l == 1); const int nrows = last ? NLAT : MTOT; const int pb = PH_L0 + l * PH_PER_LAYER;
        k_lg<<<dim3(MTOT, 2), 128, 0, stream>>>(P, in.gla_w_gate + l * 2 * 16 * 128, in.gla_b_gate + l * 2 * 128, LG);
        k_gla<<<16, 64, 0, stream>>>(P, LG, OG, 0, last);
        k_gla<<<16, 64, 0, stream>>>(P, LG, OG, 1, last);
        k_gla_fin<<<nrows, 256, 0, stream>>>(OG, P, in.gla_g_norm + l * 64, Y, 0);
        launch_mega(base, pb + 2, pb + 4, li++, stream);
        k_s5<<<64, 64, 0, stream>>>(P, in, l, SY, 0, last);
        k_s5<<<64, 64, 0, stream>>>(P, in, l, SY, 1, last);
        k_s5_glu<<<nrows, 256, 0, stream>>>(SY, P, in.s5_d + l * 256, in.s5_w_glu + l * 65536, in.s5_b_glu + l * 256, Y, 0);
        if (l == 0) launch_mega(base, pb + 5, pb + PH_PER_LAYER + 2, li++, stream);
        else launch_mega(base, pb + 5, PH_END, li++, stream);
    }
}
```

```cpp
#include <hip/hip_runtime.h>
#include <hip/hip_cooperative_groups.h>
#include <stdint.h>
#include <math.h>
#include <cstdio>
#include <cstring>

typedef unsigned short bf16_t;
__device__ __forceinline__ float bf2f(bf16_t v) { return __uint_as_float(((unsigned)v) << 16); }
__device__ __forceinline__ bf16_t f2bf(float f) { unsigned u = __float_as_uint(f); return (bf16_t)((u + 0x7fffu + ((u >> 16) & 1u)) >> 16); }

constexpr int DM = 1024, NB = 4, SEQ = 4096, NCTX = 256, GW = 64;
constexpr int NLAT = NB * SEQ;
constexpr int NCT = NB * NCTX;
constexpr int MTOT = NLAT + NCT;
constexpr int NIN = 2848, NP = 3072;
constexpr int C_GK = 0, C_GV = 128, C_GF = 384, C_GB = 400, C_NK = 416, C_NV = 672, C_SU = 928, C_GQ = 1184, C_NQ = 1312, C_PU = 1568, C_GATE = 1824;
constexpr float EPS = 1e-6f;

constexpr size_t OFF_CTL = 0, CTL_BYTES = 256 * 1024;
constexpr size_t OFF_WIN = OFF_CTL + CTL_BYTES;
constexpr size_t OFF_WOUT = OFF_WIN + (size_t)2 * NP * DM * 2;
constexpr size_t OFF_MOD = OFF_WOUT + (size_t)2 * DM * DM * 2;
constexpr size_t OFF_H = OFF_MOD + (size_t)2 * 5 * 3072 * 4 + 1024;
constexpr size_t OFF_P = OFF_H + (size_t)MTOT * DM * 2;
constexpr size_t OFF_XC = OFF_P + (size_t)MTOT * NP * 2;
constexpr size_t OFF_VTL = OFF_XC + (size_t)NCT * DM * 4;
constexpr size_t OFF_VTC = OFF_VTL + (size_t)1024 * SEQ * 2;
constexpr size_t OFF_WPT = OFF_VTC + (size_t)1024 * NCTX * 2;
constexpr size_t OFF_ROPE = OFF_WPT + (size_t)2 * 4 * 64 * 64 * 2;
constexpr size_t OFF_GLOC = OFF_ROPE + 4096;
constexpr size_t OFF_GDEC = OFF_GLOC + (size_t)32 * 68 * 2048 * 4;
constexpr size_t OFF_GSIN = OFF_GDEC + (size_t)32 * 68 * 32 * 4;
constexpr size_t OFF_BBT = OFF_GSIN + (size_t)32 * 68 * 2048 * 2;
constexpr size_t OFF_CMT = OFF_BBT + (size_t)64 * 128 * 16 * 2;
constexpr size_t OFF_SLB = OFF_CMT + (size_t)64 * 16 * 128 * 2;
constexpr size_t OFF_WGT = OFF_SLB + (size_t)64 * 64 * 16;
constexpr size_t OFF_SXL = OFF_WGT + (size_t)2 * 65536 * 2;
constexpr size_t OFF_SX0 = OFF_SXL + (size_t)128 * 68 * 128 * 4;
constexpr size_t OFF_END = OFF_SX0 + (size_t)128 * 68 * 128 * 4;
static_assert(OFF_END <= (size_t)256 * 1024 * 1024, "ws");

struct Inputs {
    const float *x, *c, *ctx, *c_ctx, *w_mod, *b_mod, *g_pre, *g_post, *w_in, *w_out, *gla_w_gate, *gla_b_gate, *gla_g_norm, *na_rpb,
        *s5_lam_re, *s5_lam_im, *s5_log_dt, *s5_b_re, *s5_b_im, *s5_c_re, *s5_c_im, *s5_d, *s5_w_glu, *s5_b_glu, *pool_w, *pool_scale;
};

__device__ __forceinline__ float silu_f(float v) { return v / (1.f + expf(-v)); }
__device__ __forceinline__ float sigmoid_f(float v) { return 1.f / (1.f + expf(-v)); }
__device__ __forceinline__ float gelu_tanh_f(float v) { const float k = 0.7978845608028654f; return 0.5f * v * (1.f + tanhf(k * (v + 0.044715f * v * v * v))); }
__device__ __forceinline__ float logsigmoid_f(float z) { return fminf(z, 0.f) - log1pf(expf(-fabsf(z))); }

#define LAS __attribute__((address_space(3)))
namespace pg8 {
#define PG8_LAS __attribute__((address_space(3)))
typedef unsigned short bf16_t;
typedef short bf16x8 __attribute__((ext_vector_type(8)));
typedef float f32x4 __attribute__((ext_vector_type(4)));
typedef unsigned u32x4 __attribute__((ext_vector_type(4)));
constexpr int BM = 256, BK = 64, HALF = 128, HTB = HALF * BK * 2  , STAGE_BYTES = 8 * HTB, NXCD = 8, WGM = 8;

__host__ __device__ __forceinline__ int lds_byte(int r, int c) { const int st = (r >> 4) * 2 + (c >> 5), rr = r & 15, cc = c & 31, ob = rr * 64 + cc * 2; return st * 1024 + (ob ^ (((ob >> 9) & 1) << 5)); }
__host__ __device__ __forceinline__ void stage_rc(int b, int& R, int& C) { const int st = b / 1024, sb = b % 1024, swz = sb ^ (((sb >> 9) & 1) << 5); R = (st >> 1) * 16 + swz / 64; C = (st & 1) * 32 + (swz % 64) / 2; }
__host__ __device__ __forceinline__ int perm32(int rho) { const int n = rho >> 4, i = rho & 15; return 8 * (i >> 2) + 4 * n + (i & 3); }

struct Unit { int pm, pn; };
struct Gemm { const bf16_t* A; const bf16_t* Bt; int M, N, K; };

struct StaticOrder {
    int nM, nN, nwg, G, c;
    __host__ __device__ void init(int M, int N, int G_, int c_) { nM = M / BM; nN = N / BM; nwg = nM * nN; G = G_; c = c_; }
    __host__ __device__ bool next(int i, Unit& u) const {
        const long L = (long)i * G + c; if (L >= nwg) return false;
        int wgid = (int)L; { const int q = nwg / NXCD, r = nwg % NXCD, xcd = wgid % NXCD, off = wgid / NXCD; wgid = (xcd < r ? xcd * (q + 1) : r * (q + 1) + (xcd - r) * q) + off; }
        const int nig = WGM * nN, gid = wgid / nig, fm = gid * WGM, gsz = (nM - fm) < WGM ? (nM - fm) : WGM;
        u.pm = fm + ((wgid % nig) % gsz); u.pn = (wgid % nig) / gsz; return true;
    }
    __device__ __forceinline__ void a_ready(const Unit&) const {}
    __device__ __forceinline__ void done(const Unit&) const {}
};

__device__ __forceinline__ unsigned cvt_pk_bf16(float lo, float hi) { unsigned r; asm volatile("v_cvt_pk_bf16_f32 %0, %1, %2" : "=v"(r) : "v"(lo), "v"(hi)); return r; }
typedef float f32x2 __attribute__((ext_vector_type(2)));
__device__ __forceinline__ f32x2 gelu_pk(f32x2 v) {
    const f32x2 av = __builtin_elementwise_abs(v), d = av * 0.2316418882f + 1.0f;
    f32x2 t; t.x = __builtin_amdgcn_rcpf(d.x); t.y = __builtin_amdgcn_rcpf(d.y);
    f32x2 q = t * 0.5307027145f + (-0.7265760135f); q = q * t + 0.7107068705f; q = q * t + (-0.142248368f); q = q * t + 0.127414796f; q = q * t;
    const f32x2 s = (v * v) * (-0.72134752044f);
    f32x2 e; e.x = __builtin_amdgcn_exp2f(s.x); e.y = __builtin_amdgcn_exp2f(s.y);
    const f32x2 m = v * (q * e), r = v - m;
    f32x2 o; o.x = v.x < 0.f ? m.x : r.x; o.y = v.y < 0.f ? m.y : r.y; return o;
}

template <int ACT  > struct EpiBf16 {
    static constexpr bool PERM = true, AFTER_DRAIN = false; static_assert(ACT == 0 || ACT == 1, "EpiBf16: ACT is 0 (none) or 1 (gelu_pk)");
    bf16_t* O; int ldc; const float* bias; int split_cols; size_t split_stride; float scale0;
    __device__ __forceinline__ void operator()(const f32x4 (&acc)[2][2][4][2], const Unit& u, int wr, int wc, int fr, int fq) const {
        const int row0 = u.pm * BM + wr * 64 + fr; int colt = u.pn * BM; bf16_t* base = O;
        float sc = 1.f; if (split_cols) { const int t = colt / split_cols; base += (size_t)t * split_stride; colt -= t * split_cols; if (t == 0) sc = scale0; }
        const int col0 = colt + wc * 32 + 8 * fq, bcol0 = u.pn * BM + wc * 32 + 8 * fq;
        f32x4 bv[2][2];
#pragma unroll
        for (int bj = 0; bj < 2; ++bj)
#pragma unroll
            for (int n = 0; n < 2; ++n) bv[bj][n] = bias ? *(const f32x4*)(bias + bcol0 + bj * HALF + 4 * n) : (f32x4){0.f, 0.f, 0.f, 0.f};
#pragma unroll
        for (int ai = 0; ai < 2; ++ai)
#pragma unroll
            for (int m = 0; m < 4; ++m) { bf16_t* rowp = base + (size_t)(row0 + ai * HALF + m * 16) * ldc + col0;
#pragma unroll
                for (int bj = 0; bj < 2; ++bj) { f32x4 v0 = acc[ai][bj][m][0] + bv[bj][0], v1 = acc[ai][bj][m][1] + bv[bj][1];
                    if (ACT == 1) { f32x2 a = gelu_pk((f32x2){v0[0], v0[1]}), b = gelu_pk((f32x2){v0[2], v0[3]}), c = gelu_pk((f32x2){v1[0], v1[1]}), d = gelu_pk((f32x2){v1[2], v1[3]});
                        v0 = (f32x4){a.x, a.y, b.x, b.y}; v1 = (f32x4){c.x, c.y, d.x, d.y}; }
                    v0 = v0 * sc; v1 = v1 * sc; u32x4 w; w.x = cvt_pk_bf16(v0[0], v0[1]); w.y = cvt_pk_bf16(v0[2], v0[3]); w.z = cvt_pk_bf16(v1[0], v1[1]); w.w = cvt_pk_bf16(v1[2], v1[3]);
                    *(u32x4*)(rowp + bj * HALF) = w; } }
    }
};
struct EpiF32 {
    static constexpr bool PERM = false, AFTER_DRAIN = false;
    float* C; int ldc; const float* bias;
    __device__ __forceinline__ void operator()(const f32x4 (&acc)[2][2][4][2], const Unit& u, int wr, int wc, int fr, int fq) const {
        const int row0 = u.pm * BM + wr * 64 + fr, col0 = u.pn * BM + wc * 32 + 4 * fq;
        f32x4 bv[2][2];
#pragma unroll
        for (int bj = 0; bj < 2; ++bj)
#pragma unroll
            for (int n = 0; n < 2; ++n) bv[bj][n] = bias ? *(const f32x4*)(bias + col0 + bj * HALF + n * 16) : (f32x4){0.f, 0.f, 0.f, 0.f};
#pragma unroll
        for (int ai = 0; ai < 2; ++ai)
#pragma unroll
            for (int m = 0; m < 4; ++m) { float* rowp = C + (size_t)(row0 + ai * HALF + m * 16) * ldc + col0;
#pragma unroll
                for (int bj = 0; bj < 2; ++bj)
#pragma unroll
                    for (int n = 0; n < 2; ++n) *(f32x4*)(rowp + bj * HALF + n * 16) = acc[ai][bj][m][n] + bv[bj][n]; }
    }
};
template <class Epi, class Sched, bool ALIGN_EPI = false, bool SP2 = false>
__device__ __forceinline__ void gemm_phase(PG8_LAS unsigned char* lds, const Gemm g, const Sched& S, const Epi& E) {
    const int tid = threadIdx.x, wid = __builtin_amdgcn_readfirstlane(tid >> 6), lane = tid & 63, wr = wid >> 2, wc = wid & 3, fr = lane & 15, fq = lane >> 4;
    const int K = g.K, nt = K / BK;
    unsigned voffA[2], voffB[2];
#pragma unroll
    for (int i = 0; i < 2; ++i) { int R, C; stage_rc(tid * 16 + i * 8192, R, C); const int Rb = Epi::PERM ? ((R & ~31) + perm32(R & 31)) : R;
        voffA[i] = (unsigned)(R * K + C) * 2u; voffB[i] = (unsigned)(Rb * K + C) * 2u; }
    const size_t kstep = (size_t)(BK * 2);
    const size_t hstep = (size_t)HALF * K * 2;
    const size_t tstep = 2 * hstep;
    const unsigned ldsw = (unsigned)wid * 1024u;
    const int aoff = lds_byte(wr * 64 + fr, fq * 8), boff = lds_byte(wc * 32 + fr, fq * 8);
#define PG8_SA(b, h) (((b) * 2 + (h)) * HTB)
#define PG8_SB(b, h) ((4 + (b) * 2 + (h)) * HTB)
#define PG8_STAGE(bufoff, gbase, voff) do { _Pragma("unroll") for (int _i = 0; _i < 2; ++_i) \
        __builtin_amdgcn_global_load_lds((const unsigned*)((const char*)(gbase) + (voff)[_i]), (PG8_LAS unsigned*)(lds + (bufoff) + ldsw + _i * 8192), 16, 0, 0); } while (0)
#define PG8_LDA(dst, b, h) do { _Pragma("unroll") for (int m = 0; m < 4; ++m) _Pragma("unroll") for (int k = 0; k < 2; ++k) dst[m][k] = *(const PG8_LAS bf16x8*)(lds + PG8_SA(b, h) + aoff + m * 2048 + k * 1024); } while (0)
#define PG8_LDB(dst, b, h) do { _Pragma("unroll") for (int n = 0; n < 2; ++n) _Pragma("unroll") for (int k = 0; k < 2; ++k) dst[n][k] = *(const PG8_LAS bf16x8*)(lds + PG8_SB(b, h) + boff + n * 2048 + k * 1024); } while (0)
#define PG8_MMA(ai, bj, At, Bt) do { __builtin_amdgcn_s_setprio(1); _Pragma("unroll") for (int m = 0; m < 4; ++m) _Pragma("unroll") for (int n = 0; n < 2; ++n) _Pragma("unroll") for (int k = 0; k < 2; ++k) \
        acc[ai][bj][m][n] = __builtin_amdgcn_mfma_f32_16x16x32_bf16(Bt[n][k], At[m][k], acc[ai][bj][m][n], 0, 0, 0); __builtin_amdgcn_s_setprio(0); } while (0)
#define PG8_WAIT_V(n) asm volatile("s_waitcnt vmcnt(" #n ")" ::: "memory")
#define PG8_WAIT_L(n) asm volatile("s_waitcnt lgkmcnt(" #n ")" ::: "memory")
#define PG8_BAR __builtin_amdgcn_s_barrier()
#define PG8_SCHED __builtin_amdgcn_sched_barrier(0)
    Unit cur, nxt; int ui = 0;
    if (!S.next(0, cur)) return;
    f32x4 acc[2][2][4][2];
#pragma unroll
    for (int a = 0; a < 2; ++a)
#pragma unroll
        for (int b = 0; b < 2; ++b)
#pragma unroll
            for (int m = 0; m < 4; ++m)
#pragma unroll
                for (int n = 0; n < 2; ++n) acc[a][b][m][n] = (f32x4){0.f, 0.f, 0.f, 0.f};
    bf16x8 At[4][2], B0[2][2], B1[2][2];
    const char* cA = (const char*)g.A + (size_t)cur.pm * tstep; const char* cB = (const char*)g.Bt + (size_t)cur.pn * tstep;
    S.a_ready(cur);
    if constexpr (SP2) {
        PG8_STAGE(PG8_SB(0, 0), cB, voffB); PG8_STAGE(PG8_SB(0, 1), cB + hstep, voffB); PG8_STAGE(PG8_SA(0, 0), cA, voffA); PG8_STAGE(PG8_SA(0, 1), cA + hstep, voffA);
        if (wr == 1) PG8_BAR;
        PG8_WAIT_V(2); PG8_BAR;
        PG8_STAGE(PG8_SB(1, 0), cB + kstep, voffB); PG8_STAGE(PG8_SA(1, 0), cA + kstep, voffA); PG8_STAGE(PG8_SB(1, 1), cB + hstep + kstep, voffB);
        PG8_WAIT_V(6); PG8_BAR;
    } else {
        PG8_STAGE(PG8_SB(0, 0), cB, voffB); PG8_STAGE(PG8_SA(0, 0), cA, voffA); PG8_STAGE(PG8_SB(0, 1), cB + hstep, voffB); PG8_STAGE(PG8_SA(0, 1), cA + hstep, voffA);
        if (wr == 1) PG8_BAR;
        PG8_WAIT_V(4); PG8_BAR;
        PG8_STAGE(PG8_SB(1, 0), cB + kstep, voffB); PG8_STAGE(PG8_SA(1, 0), cA + kstep, voffA); PG8_STAGE(PG8_SB(1, 1), cB + hstep + kstep, voffB);
        PG8_WAIT_V(6); PG8_BAR;
    }
    for (;;) {
        const bool has_next = S.next(ui + 1, nxt);
        const char* nA = has_next ? (const char*)g.A + (size_t)nxt.pm * tstep : cA; const char* nB = has_next ? (const char*)g.Bt + (size_t)nxt.pn * tstep : cB;
        for (int t = 0; t < nt; t += 2) {
            const bool last = (t == nt - 2);
            const char* a1 = cA + (size_t)(t + 1) * kstep;
            const char* a2 = last ? nA : cA + (size_t)(t + 2) * kstep; const char* b2 = last ? nB : cB + (size_t)(t + 2) * kstep;
            const char* a3 = a2 + kstep; const char* b3 = b2 + kstep;
            if (last && has_next) S.a_ready(nxt);
            if constexpr (SP2) {
            PG8_LDB(B0, 0, 0); PG8_LDB(B1, 0, 1); PG8_SCHED; PG8_LDA(At, 0, 0); PG8_STAGE(PG8_SA(1, 1), a1 + hstep, voffA);
            PG8_WAIT_V(8); PG8_WAIT_L(0); PG8_BAR; PG8_MMA(0, 0, At, B0); PG8_MMA(0, 1, At, B1); PG8_BAR; PG8_SCHED;
            PG8_LDA(At, 0, 1); PG8_STAGE(PG8_SB(0, 0), b2, voffB); PG8_STAGE(PG8_SB(0, 1), b2 + hstep, voffB); PG8_STAGE(PG8_SA(0, 0), a2, voffA);
            PG8_WAIT_V(8); PG8_WAIT_L(0); PG8_BAR; PG8_MMA(1, 0, At, B0); PG8_MMA(1, 1, At, B1); PG8_BAR; PG8_SCHED;
            PG8_LDB(B0, 1, 0); PG8_LDB(B1, 1, 1); PG8_SCHED; PG8_LDA(At, 1, 0); PG8_STAGE(PG8_SA(0, 1), a2 + hstep, voffA);
            PG8_WAIT_V(8); PG8_WAIT_L(0); PG8_BAR; PG8_MMA(0, 0, At, B0); PG8_MMA(0, 1, At, B1); PG8_BAR; PG8_SCHED;
            PG8_LDA(At, 1, 1); PG8_STAGE(PG8_SB(1, 0), b3, voffB); PG8_STAGE(PG8_SB(1, 1), b3 + hstep, voffB); PG8_STAGE(PG8_SA(1, 0), a3, voffA);
            PG8_WAIT_V(8); PG8_WAIT_L(0); PG8_BAR; PG8_MMA(1, 0, At, B0); PG8_MMA(1, 1, At, B1); PG8_BAR; PG8_SCHED;
            } else {
            PG8_LDB(B0, 0, 0); PG8_SCHED; PG8_LDA(At, 0, 0); PG8_STAGE(PG8_SA(1, 1), a1 + hstep, voffA);
            PG8_WAIT_L(8); PG8_BAR; PG8_WAIT_L(0); PG8_MMA(0, 0, At, B0); PG8_BAR; PG8_SCHED;
            PG8_LDB(B1, 0, 1); PG8_STAGE(PG8_SB(0, 0), b2, voffB);
            PG8_BAR; PG8_WAIT_L(0); PG8_MMA(0, 1, At, B1); PG8_BAR;
            PG8_LDA(At, 0, 1); PG8_STAGE(PG8_SA(0, 0), a2, voffA);
            PG8_BAR; PG8_WAIT_L(0); PG8_MMA(1, 0, At, B0); PG8_BAR; PG8_SCHED;
            PG8_STAGE(PG8_SB(0, 1), b2 + hstep, voffB);
            PG8_WAIT_V(6); PG8_BAR; PG8_MMA(1, 1, At, B1); PG8_BAR;
            PG8_LDB(B0, 1, 0); PG8_SCHED; PG8_LDA(At, 1, 0); PG8_STAGE(PG8_SA(0, 1), a2 + hstep, voffA);
            PG8_WAIT_L(8); PG8_BAR; PG8_WAIT_L(0); PG8_MMA(0, 0, At, B0); PG8_BAR; PG8_SCHED;
            PG8_LDB(B1, 1, 1); PG8_STAGE(PG8_SB(1, 0), b3, voffB);
            PG8_BAR; PG8_WAIT_L(0); PG8_MMA(0, 1, At, B1); PG8_BAR;
            PG8_LDA(At, 1, 1); PG8_STAGE(PG8_SA(1, 0), a3, voffA);
            PG8_BAR; PG8_WAIT_L(0); PG8_MMA(1, 0, At, B0); PG8_BAR; PG8_SCHED;
            PG8_STAGE(PG8_SB(1, 1), b3 + hstep, voffB);
            PG8_WAIT_V(6); PG8_BAR; PG8_MMA(1, 1, At, B1); PG8_BAR;
            }
        }
        if constexpr (ALIGN_EPI) { if (wr == 0) PG8_BAR; }
        if constexpr (!Epi::AFTER_DRAIN) { E(acc, cur, wr, wc, fr, fq); S.done(cur); }
        if (!has_next) break;
#pragma unroll
        for (int a = 0; a < 2; ++a)
#pragma unroll
            for (int b = 0; b < 2; ++b)
#pragma unroll
                for (int m = 0; m < 4; ++m)
#pragma unroll
                    for (int n = 0; n < 2; ++n) acc[a][b][m][n] = (f32x4){0.f, 0.f, 0.f, 0.f};
        cur = nxt; cA = nA; cB = nB; ++ui;
        if constexpr (ALIGN_EPI) { if (wr == 1) PG8_BAR; }
    }
    PG8_WAIT_V(0);
    if constexpr (!ALIGN_EPI) { if (wr == 0) PG8_BAR; }
    PG8_BAR;
    if constexpr (Epi::AFTER_DRAIN) { E.fused(acc, cur, wr, wc, fr, fq, lds, wid, lane); S.done(cur); }
#undef PG8_SA
#undef PG8_SB
#undef PG8_STAGE
#undef PG8_LDA
#undef PG8_LDB
#undef PG8_MMA
#undef PG8_WAIT_V
#undef PG8_WAIT_L
#undef PG8_BAR
#undef PG8_SCHED
}
}
#define XB_TMO      128
#define XB_XCNT(j)  (256  + 64 * (j))
#define XB_XSUB(j)  (1280 + 64 * (j))
#define XB_XGEN(j)  (2304 + 64 * (j))
#define XB_TOP      3328
#define XB_TOPGEN   3392
#define XCD_BAR_WORDS 3456
#define XB_SPIN_CAP (1u << 18)

__device__ __forceinline__ unsigned xb_ld(unsigned* p)              { return __hip_atomic_load(p, __ATOMIC_RELAXED, __HIP_MEMORY_SCOPE_AGENT); }
__device__ __forceinline__ unsigned xb_add(unsigned* p, unsigned v) { return __hip_atomic_fetch_add(p, v, __ATOMIC_RELAXED, __HIP_MEMORY_SCOPE_AGENT); }
__device__ __forceinline__ unsigned xb_xcc_id() { return (unsigned)__builtin_amdgcn_s_getreg((3 << 11) | 20) & 0xFu; }
#define XB_SPIN(cond, bar) do { unsigned _sp = 0; while (cond) { __builtin_amdgcn_s_sleep(1); \
    if ((++_sp & 255u) == 0u) { if (xb_ld(&(bar)[XB_TMO])) break; if (_sp > XB_SPIN_CAP) { atomicAdd(&(bar)[XB_TMO], 1u); break; } } } } while (0)

struct XcdBarrier {
    unsigned* bar; unsigned x;
    volatile LAS unsigned* st;
};

__device__ __forceinline__ XcdBarrier xcd_barrier_post(unsigned* bar, volatile LAS unsigned* st) {
    XcdBarrier b; b.bar = bar; b.x = xb_xcc_id(); b.st = st;
    if (threadIdx.x == 0) (void)xb_add(&bar[XB_XCNT(b.x)], 1u);
    return b;
}
__device__ __forceinline__ void xcd_barrier_complete(unsigned* bar, unsigned x, unsigned& nloc, unsigned& nx) {
    const unsigned G = gridDim.x * gridDim.y * gridDim.z;
    unsigned sum, cnt, mine, sp = 0u;
    for (;;) {
        sum = 0u; cnt = 0u; mine = 0u;
#pragma unroll
        for (unsigned j = 0; j < 16; ++j) { const unsigned c = xb_ld(&bar[XB_XCNT(j)]); sum += c; cnt += (c > 0u) ? 1u : 0u; mine = (j == x) ? c : mine; }
        if (sum == G) break;
        __builtin_amdgcn_s_sleep(1);
        if ((++sp & 255u) == 0u) { if (xb_ld(&bar[XB_TMO])) break; if (sp > XB_SPIN_CAP) { atomicAdd(&bar[XB_TMO], 1u); break; } }
    }
    nloc = mine > 0u ? mine : 1u; nx = cnt > 0u ? cnt : 1u;
}

__device__ __forceinline__ void xcd_barrier(const XcdBarrier& b) {
    asm volatile("s_waitcnt vmcnt(0)" ::: "memory");
    __syncthreads();
    if (threadIdx.x == 0) {
        unsigned* bar = b.bar;
        __builtin_amdgcn_s_waitcnt(0);
        unsigned nloc = b.st[0], nx = b.st[1];
        if (nloc == 0u) { xcd_barrier_complete(bar, b.x, nloc, nx); b.st[0] = nloc; b.st[1] = nx; }
        const unsigned old = xb_add(&bar[XB_XSUB(b.x)], 1u);
        const unsigned gen = old / nloc;
        if (old + 1u == (gen + 1u) * nloc) {
            __builtin_amdgcn_fence(__ATOMIC_RELEASE, "agent");
            asm volatile("s_waitcnt vmcnt(0)" ::: "memory");
            const unsigned og = xb_add(&bar[XB_TOP], 1u);
            const unsigned tg = og / nx;
            if (og + 1u == (tg + 1u) * nx) xb_add(&bar[XB_TOPGEN], 1u);
            else XB_SPIN(xb_ld(&bar[XB_TOPGEN]) == tg, bar);
            __builtin_amdgcn_fence(__ATOMIC_ACQUIRE, "agent");
            xb_add(&bar[XB_XGEN(b.x)], 1u);
            asm volatile("s_waitcnt vmcnt(0)" ::: "memory");
        } else {
            XB_SPIN(xb_ld(&bar[XB_XGEN(b.x)]) == gen, bar);
            __builtin_amdgcn_fence(__ATOMIC_ACQUIRE, "agent");
            asm volatile("s_waitcnt vmcnt(0)" ::: "memory");
        }
    }
    __syncthreads();
}
#define GAS __attribute__((address_space(1)))
typedef float f32x4 __attribute__((ext_vector_type(4)));
typedef unsigned u32x2 __attribute__((ext_vector_type(2)));
typedef unsigned u32x4 __attribute__((ext_vector_type(4)));
typedef short bf16x8 __attribute__((ext_vector_type(8)));
constexpr int NTHR = 512, NWV = 8;
constexpr int RING_BYTES = 139264, MISC_OFF = RING_BYTES + 320, LDS_BYTES = 147456;
constexpr int CW_BAR = 1024;

struct KArgs { Inputs in; float* out; unsigned char* ws; int ph_lo, ph_hi, li, mask; };

__device__ __forceinline__ float wave_sum(float v) {
#pragma unroll
    for (int o = 1; o < 64; o <<= 1) v += __shfl_xor(v, o);
    return v;
}
__device__ __forceinline__ unsigned pk2(float lo, float hi) { return (unsigned)f2bf(lo) | ((unsigned)f2bf(hi) << 16); }
#define LDS_FENCE() asm volatile("s_waitcnt lgkmcnt(0)" ::: "memory")

constexpr int PH_PRO = 0;
constexpr int PH_L0 = 1, PH_PER_LAYER = 6;
constexpr int PH_FIN = PH_L0 + 2 * PH_PER_LAYER;
constexpr int PH_END = PH_FIN + 1;

__device__ __forceinline__ void transpose_item(const float* W, int K, int N, bf16_t* WT, LAS float* scr, int item, int lane) {
    const int nblk = N / 32, kb = item / nblk, nb = item % nblk, k0 = 64 * kb, n0 = 32 * nb;
#pragma unroll 8
    for (int i = 0; i < 32; ++i) { const int kk = 2 * i + (lane >> 5); scr[kk * 33 + (lane & 31)] = W[(size_t)(k0 + kk) * N + n0 + (lane & 31)]; }
    LDS_FENCE();
    const int c = lane & 7;
#pragma unroll
    for (int j = 0; j < 4; ++j) { const int n = (lane >> 3) + 8 * j; const LAS float* s = scr + (8 * c) * 33 + n;
        u32x4 o; o.x = pk2(s[0 * 33], s[1 * 33]); o.y = pk2(s[2 * 33], s[3 * 33]); o.z = pk2(s[4 * 33], s[5 * 33]); o.w = pk2(s[6 * 33], s[7 * 33]);
        *(u32x4*)(WT + (size_t)(n0 + n) * K + k0 + 8 * c) = o; }
    LDS_FENCE();
}

__device__ __forceinline__ void ph_prologue(const KArgs& a, LAS unsigned char* lds, int tid, int wave, int lane) {
    const Inputs& in = a.in;
    float* MOD = (float*)(a.ws + OFF_MOD);
    LAS float* sil = (LAS float*)lds;
    LAS float* part = (LAS float*)(lds + 5 * 1024 * 4);
    if ((int)blockIdx.x < 192) {
        for (int i = tid; i < 5 * 1024; i += NTHR) { const int j = i >> 10, k = i & 1023; const float cv = j < 4 ? in.c[j * DM + k] : in.c_ctx[k]; sil[i] = cv / (1.f + expf(-cv)); }
        __syncthreads();
        for (int it = blockIdx.x; it < 192; it += gridDim.x) {
            const int l = it / 96, nb = it % 96, n = nb * 32 + (lane & 31), k0 = wave * 128 + (lane >> 5) * 64;
            const float* w = in.w_mod + (size_t)l * DM * 3072 + n;
            float acc[5] = {0.f, 0.f, 0.f, 0.f, 0.f};
#pragma unroll 8
            for (int kk = 0; kk < 64; ++kk) { const float wv = w[(size_t)(k0 + kk) * 3072];
#pragma unroll
                for (int j = 0; j < 5; ++j) acc[j] += sil[j * 1024 + k0 + kk] * wv; }
#pragma unroll
            for (int j = 0; j < 5; ++j) { acc[j] += __shfl_xor(acc[j], 32); if (lane < 32) part[(wave * 5 + j) * 32 + lane] = acc[j]; }
            __syncthreads();
            if (tid < 160) { const int j = tid >> 5, c = tid & 31; float s = in.b_mod[l * 3072 + nb * 32 + c];
#pragma unroll
                for (int w8 = 0; w8 < 8; ++w8) s += part[(w8 * 5 + j) * 32 + c];
                MOD[((size_t)l * 5 + j) * 3072 + nb * 32 + c] = s; }
            __syncthreads();
        }
    }
    __syncthreads();
    LAS float* scr = (LAS float*)(lds + wave * 16384);
    const int gw = blockIdx.x * NWV + wave, NGW = gridDim.x * NWV;
    constexpr int I_IN = (DM / 64) * (NIN / 32), I_OUT = (DM / 64) * (DM / 32), I_PAD = NP - NIN;
    constexpr int I_L = I_IN + I_OUT + I_PAD;
    bf16_t* WIN = (bf16_t*)(a.ws + OFF_WIN); bf16_t* WOUT = (bf16_t*)(a.ws + OFF_WOUT);
    for (int it = gw; it < 2 * I_L; it += NGW) {
        const int l = it / I_L; int r = it % I_L;
        if (r < I_IN) { transpose_item(in.w_in + (size_t)l * DM * NIN, DM, NIN, WIN + (size_t)l * NP * DM, scr, r, lane); continue; } r -= I_IN;
        if (r < I_OUT) { transpose_item(in.w_out + (size_t)l * DM * DM, DM, DM, WOUT + (size_t)l * DM * DM, scr, r, lane); continue; } r -= I_OUT;
        u32x4* zp = (u32x4*)(WIN + ((size_t)l * NP + NIN + r) * DM);
        zp[lane] = (u32x4){0u, 0u, 0u, 0u}; zp[lane + 64] = (u32x4){0u, 0u, 0u, 0u};
    }
    const int gt = blockIdx.x * NTHR + tid, NGT = gridDim.x * NTHR;
    bf16_t* WPT = (bf16_t*)(a.ws + OFF_WPT);
    if (gt < 512) { float* rt = (float*)(a.ws + OFF_ROPE); const int pos = gt >> 3, j = gt & 7; const float f = powf(10000.f, -(float)j / 8.f), ang = (float)pos * f; rt[gt] = cosf(ang); rt[512 + gt] = sinf(ang); }
    for (int i = gt; i < 2 * 4 * 64 * 64; i += NGT) { const int c = i & 63, e = (i >> 6) & 63, li = i >> 12; WPT[i] = f2bf(in.pool_w[(size_t)li * 4096 + c * 64 + e]); }
}

__device__ __forceinline__ void ph_post_pre(const KArgs& a, int lprev, int lnext, int wave, int lane) {
    const Inputs& in = a.in;
    const float* MOD = (const float*)(a.ws + OFF_MOD);
    const float* O = (const float*)(a.ws + OFF_P);
    float* XC = (float*)(a.ws + OFF_XC);
    bf16_t* H = (bf16_t*)(a.ws + OFF_H);
    const int gw = blockIdx.x * NWV + wave, NGW = gridDim.x * NWV;
    const int nrows = (lnext < 2) ? MTOT : NLAT;
    for (int row = gw; row < nrows; row += NGW) {
        const bool lat = row < NLAT; const int j = lat ? row / SEQ : 4;
        const float* xr; float* xw = nullptr;
        if (lprev <= 0) xr = lat ? in.x + (size_t)row * DM : in.ctx + (size_t)(row - NLAT) * DM;
        else xr = lat ? a.out + (size_t)row * DM : XC + (size_t)(row - NLAT) * DM;
        const bool post = (lprev >= 0) && (lat || lprev == 0);
        if (post) xw = lat ? a.out + (size_t)row * DM : XC + (size_t)(row - NLAT) * DM;
        f32x4 v[4];
#pragma unroll
        for (int q = 0; q < 4; ++q) v[q] = *(const f32x4*)(xr + 4 * lane + 256 * q);
        if (post) {
            f32x4 o[4]; float s = 0.f;
#pragma unroll
            for (int q = 0; q < 4; ++q) { o[q] = *(const f32x4*)(O + (size_t)row * DM + 4 * lane + 256 * q); s += (o[q].x * o[q].x + o[q].y * o[q].y) + (o[q].z * o[q].z + o[q].w * o[q].w); }
            const float rstd = rsqrtf(wave_sum(s) * (1.f / DM) + EPS);
            const float* gate = MOD + ((size_t)lprev * 5 + j) * 3072 + 2048; const float* gp = in.g_post + lprev * DM;
#pragma unroll
            for (int q = 0; q < 4; ++q) { const f32x4 gt = *(const f32x4*)(gate + 4 * lane + 256 * q), gg = *(const f32x4*)(gp + 4 * lane + 256 * q);
                v[q] = v[q] + gt * (o[q] * rstd * gg); *(f32x4*)(xw + 4 * lane + 256 * q) = v[q]; }
        }
        if (lnext < 2) {
            float s = 0.f;
#pragma unroll
            for (int q = 0; q < 4; ++q) s += (v[q].x * v[q].x + v[q].y * v[q].y) + (v[q].z * v[q].z + v[q].w * v[q].w);
            const float rstd = rsqrtf(wave_sum(s) * (1.f / DM) + EPS);
            const float* shift = MOD + ((size_t)lnext * 5 + j) * 3072; const float* scale = shift + 1024; const float* gp = in.g_pre + lnext * DM;
#pragma unroll
            for (int q = 0; q < 4; ++q) { const int k = 4 * lane + 256 * q; const f32x4 sh = *(const f32x4*)(shift + k), sc = *(const f32x4*)(scale + k), gg = *(const f32x4*)(gp + k);
                const f32x4 hv = (v[q] * rstd * gg) * (sc + 1.f) + sh;
                u32x2 w; w.x = pk2(hv.x, hv.y); w.y = pk2(hv.z, hv.w); *(u32x2*)(H + (size_t)row * DM + k) = w; }
        }
    }
}

typedef float f32x16 __attribute__((ext_vector_type(16)));
typedef float f32x2_t __attribute__((ext_vector_type(2)));
typedef __bf16 bf16x2_t __attribute__((ext_vector_type(2)));
#define MFMA16(a, b, c) __builtin_amdgcn_mfma_f32_16x16x32_bf16(a, b, c, 0, 0, 0)
#define MFMA32(a, b, c) __builtin_amdgcn_mfma_f32_32x32x16_bf16(a, b, c, 0, 0, 0)
__device__ __forceinline__ unsigned cvtpk(float lo, float hi) { f32x2_t v = {lo, hi}; bf16x2_t b = __builtin_convertvector(v, bf16x2_t); return __builtin_bit_cast(unsigned, b); }
__device__ __forceinline__ float fast_exp(float x) { return __builtin_amdgcn_exp2f(x * 1.4426950408889634f); }
__device__ __forceinline__ float fast_silu(float v) { return v * __builtin_amdgcn_rcpf(1.f + fast_exp(-v)); }
__device__ __forceinline__ float lo_bf(unsigned w) { return __uint_as_float(w << 16); }
__device__ __forceinline__ float hi_bf(unsigned w) { return __uint_as_float(w & 0xffff0000u); }


__device__ __forceinline__ void vt_item(const KArgs& a, LAS unsigned char* lds, int cid, int tid) {
    const bf16_t* P = (const bf16_t*)(a.ws + OFF_P);
    bf16_t* VTL = (bf16_t*)(a.ws + OFF_VTL); bf16_t* VTC = (bf16_t*)(a.ws + OFF_VTC);
    LAS bf16_t* tile = (LAS bf16_t*)lds;
    const int row0 = cid * 64;
    for (int i = tid; i < 2048; i += NTHR) { const int t = i >> 5, c8 = i & 31;
        *(LAS u32x4*)(tile + t * 264 + c8 * 8) = *(const u32x4*)(P + (size_t)(row0 + t) * NP + C_NV + c8 * 8); }
    __syncthreads();
    for (int i = tid; i < 2048; i += NTHR) { const int tg = i & 7, col = i >> 3;
        u32x4 w;
        w.x = (unsigned)tile[(8 * tg + 0) * 264 + col] | ((unsigned)tile[(8 * tg + 1) * 264 + col] << 16);
        w.y = (unsigned)tile[(8 * tg + 2) * 264 + col] | ((unsigned)tile[(8 * tg + 3) * 264 + col] << 16);
        w.z = (unsigned)tile[(8 * tg + 4) * 264 + col] | ((unsigned)tile[(8 * tg + 5) * 264 + col] << 16);
        w.w = (unsigned)tile[(8 * tg + 6) * 264 + col] | ((unsigned)tile[(8 * tg + 7) * 264 + col] << 16);
        bf16_t* dst;
        if (cid < 256) { const int b = cid >> 6; dst = VTL + ((size_t)(b * 256 + col)) * SEQ + (cid & 63) * 64 + 8 * tg; }
        else { const int cc = cid - 256, b = cc >> 2; dst = VTC + ((size_t)(b * 256 + col)) * NCTX + (cc & 3) * 64 + 8 * tg; }
        *(u32x4*)dst = w; }
    __syncthreads();
}

template <bool WIN>
__device__ __forceinline__ void na_unit(const KArgs& a, const LAS float* rpb  , int b, int h, int qrow0, int r, int cg, int lane) {
    const bf16_t* P = (const bf16_t*)(a.ws + OFF_P);
    const bf16_t* VTL = (const bf16_t*)(a.ws + OFF_VTL); const bf16_t* VTC = (const bf16_t*)(a.ws + OFF_VTC);
    bf16_t* Y = (bf16_t*)(a.ws + OFF_H);
    const int li = lane & 15, g = lane >> 4;
    const bf16_t* qp = P + (size_t)(qrow0 + li) * NP + C_NQ + h * 64 + 8 * g;
    const bf16x8 qf0 = *(const bf16x8*)qp, qf1 = *(const bf16x8*)(qp + 32);
    constexpr int NT = WIN ? 32 : 16, WOFF = WIN ? 16 : 0;
    f32x4 S[NT];
    const int c0 = cg * 16;
    const int CB = WIN ? min(max(c0 - 8, 0), 32) : 0, R0 = WIN ? min(max(r - 4, 0), 56) : 0;
    if (WIN) {
#pragma unroll
        for (int wt = 0; wt < 16; ++wt) {
            const int keyrow = b * SEQ + (R0 + (wt >> 1)) * 64 + CB + 16 * (wt & 1) + li;
            const bf16_t* kp = P + (size_t)keyrow * NP + C_NK + h * 64 + 8 * g;
            const bf16x8 k0 = *(const bf16x8*)kp, k1 = *(const bf16x8*)(kp + 32);
            f32x4 acc = {0.f, 0.f, 0.f, 0.f};
            acc = MFMA16(k0, qf0, acc); acc = MFMA16(k1, qf1, acc); S[wt] = acc;
        }
    }
#pragma unroll
    for (int ct = 0; ct < 16; ++ct) {
        const int keyrow = NLAT + b * NCTX + 16 * ct + li;
        const bf16_t* kp = P + (size_t)keyrow * NP + C_NK + h * 64 + 8 * g;
        const bf16x8 k0 = *(const bf16x8*)kp, k1 = *(const bf16x8*)(kp + 32);
        f32x4 acc = {0.f, 0.f, 0.f, 0.f};
        acc = MFMA16(k0, qf0, acc); acc = MFMA16(k1, qf1, acc); S[WOFF + ct] = acc;
    }
    float m = -INFINITY;
    if (WIN) {
        const int c = c0 + li, cs = min(max(c - 8, 0), 48);
        const LAS float* rp = rpb + h * 465;
#pragma unroll
        for (int wt = 0; wt < 16; ++wt) {
            const int krow = R0 + (wt >> 1); const LAS float* rr = rp + (krow - r + 7) * 31;
#pragma unroll
            for (int q = 0; q < 4; ++q) { const int kcol = CB + 16 * (wt & 1) + 4 * g + q; const bool valid = (kcol >= cs) && (kcol < cs + 16);
                const float bias = rr[min(max(kcol - c, -15), 15) + 15];
                const float s = valid ? S[wt][q] * 0.125f + bias : -INFINITY; S[wt][q] = s; m = fmaxf(m, s); }
        }
    }
#pragma unroll
    for (int ct = 0; ct < 16; ++ct)
#pragma unroll
        for (int q = 0; q < 4; ++q) { const float s = S[WOFF + ct][q] * 0.125f; S[WOFF + ct][q] = s; m = fmaxf(m, s); }
    m = fmaxf(m, __shfl_xor(m, 16)); m = fmaxf(m, __shfl_xor(m, 32));
    float lsum = 0.f;
    bf16x8 pf[NT / 2];
#pragma unroll
    for (int u = 0; u < NT / 2; ++u) {
        float p[8];
#pragma unroll
        for (int q = 0; q < 4; ++q) { p[q] = fast_exp(S[2 * u][q] - m); p[4 + q] = fast_exp(S[2 * u + 1][q] - m); }
#pragma unroll
        for (int q = 0; q < 8; ++q) lsum += p[q];
        u32x4 w; w.x = cvtpk(p[0], p[1]); w.y = cvtpk(p[2], p[3]); w.z = cvtpk(p[4], p[5]); w.w = cvtpk(p[6], p[7]);
        pf[u] = __builtin_bit_cast(bf16x8, w);
    }
    lsum += __shfl_xor(lsum, 16); lsum += __shfl_xor(lsum, 32);
    f32x4 acc[4];
#pragma unroll
    for (int mt = 0; mt < 4; ++mt) acc[mt] = (f32x4){0.f, 0.f, 0.f, 0.f};
#pragma unroll
    for (int u = 0; u < NT / 2; ++u) {
#pragma unroll
        for (int mt = 0; mt < 4; ++mt) {
            const int dh = 16 * mt + li;
            const bf16_t* vt;
            if (WIN && u < 8) vt = VTL + ((size_t)((b * 4 + h) * 64 + dh)) * SEQ + (R0 + u) * 64 + CB;
            else vt = VTC + ((size_t)((b * 4 + h) * 64 + dh)) * NCTX + 32 * (u - (WIN ? 8 : 0));
            const u32x2 lo = *(const u32x2*)(vt + 4 * g), hi = *(const u32x2*)(vt + 16 + 4 * g);
            u32x4 w; w.x = lo.x; w.y = lo.y; w.z = hi.x; w.w = hi.y;
            acc[mt] = MFMA16(__builtin_bit_cast(bf16x8, w), pf[u], acc[mt]);
        }
    }
    const float inv = 1.f / lsum;
    const size_t row = (size_t)(qrow0 + li);
#pragma unroll
    for (int mt = 0; mt < 4; ++mt) {
        const int col = 256 + h * 64 + 16 * mt + 4 * g;
        const u32x2 gt = *(const u32x2*)(P + row * NP + C_GATE + col);
        u32x2 w;
        w.x = cvtpk(acc[mt][0] * inv * fast_silu(lo_bf(gt.x)), acc[mt][1] * inv * fast_silu(hi_bf(gt.x)));
        w.y = cvtpk(acc[mt][2] * inv * fast_silu(lo_bf(gt.y)), acc[mt][3] * inv * fast_silu(hi_bf(gt.y)));
        *(u32x2*)(Y + row * DM + col) = w;
    }
}

__device__ __forceinline__ void pool_item(const KArgs& a, int l, LAS unsigned char* lds, int cid, int tid, int wave, int lane) {
    const bf16_t* P = (const bf16_t*)(a.ws + OFF_P); bf16_t* Y = (bf16_t*)(a.ws + OFF_H);
    const bf16_t* WPT = (const bf16_t*)(a.ws + OFF_WPT) + (size_t)l * 4 * 64 * 64;
    const float* pscale = a.in.pool_scale + l * 256;
    LAS bf16_t* U = (LAS bf16_t*)lds;
    LAS bf16_t* M = U + 80 * 264;
    const bool lat = cid < 256;
    const int seq_len = lat ? SEQ : NCTX;
    const int seq_base = lat ? (cid >> 6) * SEQ : NLAT + ((cid - 256) >> 2) * NCTX;
    const int t0 = lat ? (cid & 63) * 64 : ((cid - 256) & 3) * 64;
    for (int i = tid; i < 80 * 32; i += NTHR) { const int tr = i >> 5, c8 = i & 31, tt = t0 - 8 + tr;
        u32x4 v = {0u, 0u, 0u, 0u};
        if (tt >= 0 && tt < seq_len) v = *(const u32x4*)(P + (size_t)(seq_base + tt) * NP + C_PU + c8 * 8);
        *(LAS u32x4*)(U + tr * 264 + c8 * 8) = v; }
    __syncthreads();
    {
        const int col = tid & 255, th = tid >> 8, part = col >> 6, w = 2 << part;
        for (int t = 32 * th; t < 32 * th + 32; ++t) {
            const int tt = t0 + t; const int lo = min(max(tt - w / 2, 0), seq_len), hi = min(max(tt - w / 2 + w, 0), seq_len);
            float s = 0.f;
            for (int ss = lo; ss < hi; ++ss) s += bf2f(U[(ss - t0 + 8) * 264 + col]);
            const float mv = s / (float)(hi - lo) - bf2f(U[(t + 8) * 264 + col]);
            M[t * 264 + col] = f2bf(mv);
        }
    }
    __syncthreads();
    {
        const int part = wave >> 1, th = wave & 1, li = lane & 15, g = lane >> 4;
        f32x4 acc[4][2];
#pragma unroll
        for (int mt = 0; mt < 4; ++mt) { acc[mt][0] = (f32x4){0.f, 0.f, 0.f, 0.f}; acc[mt][1] = (f32x4){0.f, 0.f, 0.f, 0.f}; }
#pragma unroll
        for (int s = 0; s < 2; ++s) {
            bf16x8 bfr[2];
#pragma unroll
            for (int nt = 0; nt < 2; ++nt) bfr[nt] = *(const LAS bf16x8*)(M + (32 * th + 16 * nt + li) * 264 + part * 64 + 32 * s + 8 * g);
#pragma unroll
            for (int mt = 0; mt < 4; ++mt) {
                const bf16x8 af = *(const bf16x8*)(WPT + ((size_t)(part * 64 + 16 * mt + li)) * 64 + 32 * s + 8 * g);
#pragma unroll
                for (int nt = 0; nt < 2; ++nt) acc[mt][nt] = MFMA16(af, bfr[nt], acc[mt][nt]);
            }
        }
#pragma unroll
        for (int nt = 0; nt < 2; ++nt) {
            const size_t row = (size_t)(seq_base + t0 + 32 * th + 16 * nt + li);
#pragma unroll
            for (int mt = 0; mt < 4; ++mt) {
                const int cl = part * 64 + 16 * mt + 4 * g;
                const f32x4 sc = *(const f32x4*)(pscale + cl);
                const u32x2 gt = *(const u32x2*)(P + row * NP + C_GATE + 768 + cl);
                u32x2 w;
                w.x = cvtpk(acc[mt][nt][0] * sc.x * fast_silu(lo_bf(gt.x)), acc[mt][nt][1] * sc.y * fast_silu(hi_bf(gt.x)));
                w.y = cvtpk(acc[mt][nt][2] * sc.z * fast_silu(lo_bf(gt.y)), acc[mt][nt][3] * sc.w * fast_silu(hi_bf(gt.y)));
                *(u32x2*)(Y + row * DM + 768 + cl) = w;
            }
        }
    }
    __syncthreads();
}

__device__ __forceinline__ void phC_vt(const KArgs& a, LAS unsigned char* lds, int tid) {
    for (int cid = blockIdx.x; cid < 272; cid += gridDim.x) vt_item(a, lds, cid, tid);
}
__device__ __forceinline__ void phD_na_pool(const KArgs& a, int l, LAS unsigned char* lds, int tid, int wave, int lane) {
    const int ncid = (l == 1) ? 256 : 272;
    for (int cid = blockIdx.x; cid < ncid; cid += gridDim.x) pool_item(a, l, lds, cid, tid, wave, lane);
    LAS float* rpb = (LAS float*)lds;
    for (int i = tid; i < 4 * 465; i += NTHR) rpb[i] = a.in.na_rpb[l * 4 * 465 + i];
    __syncthreads();
    unsigned* ctr = (unsigned*)(a.ws + OFF_CTL) + 16 + l;
    const int nunits = (l == 1) ? 4096 : 4096 + 256;
    for (;;) {
        int u = 0;
        if (lane == 0) u = (int)atomicAdd(ctr, 1u);
        u = __builtin_amdgcn_readfirstlane(u);
        if (u >= nunits) break;
        if (u < 4096) { const int cg = u & 3, r = (u >> 2) & 63, h = (u >> 8) & 3, b = u >> 10;
            na_unit<true>(a, rpb, b, h, b * SEQ + r * 64 + cg * 16, r, cg, lane); }
        else { const int v = u - 4096, qt = v & 15, h = (v >> 4) & 3, b = v >> 6;
            na_unit<false>(a, rpb, b, h, NLAT + b * NCTX + qt * 16, 0, 0, lane); }
    }
    __syncthreads();
}
constexpr int GL_QR = 0, GL_KR = 8192, GL_GFB = 16384, GL_ROPE = 24576, GL_TOT = 28672, GL_QC = 30720, GL_KF = 49152, GL_KB = 59392,
              GL_VT = 69632, GL_KFT = 88064, GL_KBT = 97280, GL_ATT = 106496;

__device__ __forceinline__ float logsigmoid_fast(float z) { return fminf(z, 0.f) - __logf(1.f + __expf(-fabsf(z))); }

template <bool LOCAL>
__device__ __forceinline__ void gla_prep(const KArgs& a, int l, LAS unsigned char* lds, int cid, int hp, int tid) {
    const bf16_t* P = (const bf16_t*)(a.ws + OFF_P);
    const size_t row0 = (size_t)cid * 64;
    const bool lat = cid < 256;
    LAS bf16_t* QR = (LAS bf16_t*)(lds + GL_QR); LAS bf16_t* KR = (LAS bf16_t*)(lds + GL_KR);
    LAS float* GFB = (LAS float*)(lds + GL_GFB); LAS float* ROPE = (LAS float*)(lds + GL_ROPE); LAS float* TOT = (LAS float*)(lds + GL_TOT);
    LAS bf16_t* QC = (LAS bf16_t*)(lds + GL_QC); LAS bf16_t* KF = (LAS bf16_t*)(lds + GL_KF); LAS bf16_t* KB = (LAS bf16_t*)(lds + GL_KB);
    LAS bf16_t* VT = (LAS bf16_t*)(lds + GL_VT); LAS bf16_t* KFT = (LAS bf16_t*)(lds + GL_KFT); LAS bf16_t* KBT = (LAS bf16_t*)(lds + GL_KBT);
    { const int t = tid >> 3, c8 = tid & 7;
      *(LAS u32x4*)(QR + t * 64 + c8 * 8) = *(const u32x4*)(P + (row0 + t) * NP + C_GQ + hp * 64 + c8 * 8);
      *(LAS u32x4*)(KR + t * 64 + c8 * 8) = *(const u32x4*)(P + (row0 + t) * NP + C_GK + hp * 64 + c8 * 8); }
    if (tid < 256) { const int t = tid >> 2, c8 = tid & 3; const u32x4 v = *(const u32x4*)(P + (row0 + t) * NP + C_GF + c8 * 8);
        LAS float* gp = GFB + t * 32 + c8 * 8;
        gp[0] = lo_bf(v.x); gp[1] = hi_bf(v.x); gp[2] = lo_bf(v.y); gp[3] = hi_bf(v.y); gp[4] = lo_bf(v.z); gp[5] = hi_bf(v.z); gp[6] = lo_bf(v.w); gp[7] = hi_bf(v.w); }
    { const float* rt = (const float*)(a.ws + OFF_ROPE); ROPE[tid] = rt[tid]; ROPE[tid + 512] = rt[tid + 512]; }
#pragma unroll
    for (int rep = 0; rep < 2; ++rep) { const int i = tid + rep * NTHR, t = i & 63, c16 = i >> 6;
        const u32x4 v = *(const u32x4*)(P + (row0 + t) * NP + C_GV + hp * 128 + c16 * 8);
        const int h2 = c16 >> 3, e0 = (c16 & 7) * 8; LAS bf16_t* vp = VT + (h2 * 64 + e0) * 72 + t;
        vp[0 * 72] = (bf16_t)(v.x & 0xffff); vp[1 * 72] = (bf16_t)(v.x >> 16); vp[2 * 72] = (bf16_t)(v.y & 0xffff); vp[3 * 72] = (bf16_t)(v.y >> 16);
        vp[4 * 72] = (bf16_t)(v.z & 0xffff); vp[5 * 72] = (bf16_t)(v.z >> 16); vp[6 * 72] = (bf16_t)(v.w & 0xffff); vp[7 * 72] = (bf16_t)(v.w >> 16); }
    __syncthreads();
    const int col = tid & 127, dir = col >> 6, h2 = (col >> 5) & 1, d = col & 31, tq = tid >> 7;
    const int h = 2 * hp + h2;
    float wg[16];
    { const float* wp = a.in.gla_w_gate + ((size_t)(l * 2 + dir) * 16) * 128 + h * 32 + d;
#pragma unroll
      for (int r = 0; r < 16; ++r) wg[r] = wp[r * 128]; }
    const float bg = a.in.gla_b_gate[(l * 2 + dir) * 128 + h * 32 + d];
    float lgv[16], pf[16]; float run = 0.f;
#pragma unroll
    for (int tt = 0; tt < 16; ++tt) { const LAS float* gp = GFB + (16 * tq + tt) * 32 + dir * 16;
        float z = bg;
#pragma unroll
        for (int r = 0; r < 16; ++r) z += gp[r] * wg[r];
        lgv[tt] = logsigmoid_fast(z) * (1.f / 16.f); run += lgv[tt]; pf[tt] = run; }
    TOT[tq * 128 + col] = run;
    __syncthreads();
    float off = 0.f, total = 0.f;
#pragma unroll
    for (int q = 0; q < 4; ++q) { const float v = TOT[q * 128 + col]; total += v; if (dir ? (q > tq) : (q < tq)) off += v; }
    const float qs = 0.17677669529663687f;
    const int i16 = d & 15, j8 = d & 7, dp = (i16 < 8) ? d + 8 : d - 8; const float sg = (i16 < 8) ? -1.f : 1.f;
#pragma unroll
    for (int tl = 0; tl < 16; ++tl) { const int t = 16 * tq + tl; const float cv = (dir ? run - pf[tl] + lgv[tl] : pf[tl]) + off;
        float k = bf2f(KR[t * 64 + h2 * 32 + d]), q = bf2f(QR[t * 64 + h2 * 32 + d]);
        if (lat) { const int tokpos = (cid & 63) * 64 + t; const int pos = (d & 16) ? (tokpos & 63) : (tokpos >> 6);
            const float cs = ROPE[pos * 8 + j8], sn = ROPE[512 + pos * 8 + j8];
            k = k * cs + sg * bf2f(KR[t * 64 + h2 * 32 + dp]) * sn; q = q * cs + sg * bf2f(QR[t * 64 + h2 * 32 + dp]) * sn; }
        if (LOCAL) { (dir ? KBT : KFT)[(h2 * 32 + d) * 72 + t] = f2bf(k * __expf(total - cv)); }
        else { QC[(h2 * 64 + t) * 72 + dir * 32 + d] = f2bf(q * qs * __expf(cv)); (dir ? KB : KF)[(h2 * 64 + t) * 40 + d] = f2bf(k * __expf(-cv)); }
    }
    if (LOCAL && tq == 0) { const int b = lat ? cid >> 6 : (cid - 256) >> 2; const int slot = lat ? 4 + (cid & 63) : (cid - 256) & 3;
        float* DEC = (float*)(a.ws + OFF_GDEC); DEC[((size_t)((b * 4 + h) * 2 + dir) * 68 + slot) * 32 + d] = __expf(total); }
    __syncthreads();
}

__device__ __forceinline__ void gla_local_unit(const KArgs& a, int l, LAS unsigned char* lds, int cid, int hp, int tid, int wave, int lane) {
    gla_prep<true>(a, l, lds, cid, hp, tid);
    if (wave < 4) {
        const int h2 = wave >> 1, dir = wave & 1, h = 2 * hp + h2, lr = lane & 31, hi = lane >> 5;
        const LAS bf16_t* VT = (const LAS bf16_t*)(lds + GL_VT) + h2 * 64 * 72;
        const LAS bf16_t* KT = (const LAS bf16_t*)(lds + (dir ? GL_KBT : GL_KFT)) + h2 * 32 * 72;
        f32x16 acc[2];
#pragma unroll
        for (int mt = 0; mt < 2; ++mt)
#pragma unroll
            for (int r = 0; r < 16; ++r) acc[mt][r] = 0.f;
#pragma unroll
        for (int s = 0; s < 4; ++s) {
            const bf16x8 bfr = *(const LAS bf16x8*)(KT + lr * 72 + 16 * s + 8 * hi);
#pragma unroll
            for (int mt = 0; mt < 2; ++mt) { const bf16x8 afr = *(const LAS bf16x8*)(VT + (32 * mt + lr) * 72 + 16 * s + 8 * hi); acc[mt] = MFMA32(afr, bfr, acc[mt]); }
        }
        const bool lat = cid < 256; const int b = lat ? cid >> 6 : (cid - 256) >> 2; const int slot = lat ? 4 + (cid & 63) : (cid - 256) & 3;
        float* LOC = (float*)(a.ws + OFF_GLOC) + ((size_t)((b * 4 + h) * 2 + dir) * 68 + slot) * 2048;
#pragma unroll
        for (int mt = 0; mt < 2; ++mt)
#pragma unroll
            for (int r = 0; r < 16; ++r) { const int e = 32 * mt + (r & 3) + 8 * (r >> 2) + 4 * hi; LOC[e * 32 + lr] = acc[mt][r]; }
    }
    __syncthreads();
}

__device__ __forceinline__ void gla_scan_item(const KArgs& a, int item, int tid) {
    const int chain = item >> 2, elem = (item & 3) * 512 + tid, d = elem & 31, dir = chain & 1;
    const float* LOC = (const float*)(a.ws + OFF_GLOC) + (size_t)chain * 68 * 2048 + elem;
    const float* DEC = (const float*)(a.ws + OFF_GDEC) + (size_t)chain * 68 * 32 + d;
    bf16_t* SIN = (bf16_t*)(a.ws + OFF_GSIN) + (size_t)chain * 68 * 2048 + elem;
    float S = 0.f;
    for (int st = 0; st < 68; st += 4) {
        float lv[4], dv[4]; int sl[4];
#pragma unroll
        for (int k = 0; k < 4; ++k) { sl[k] = dir ? 71 - (st + k) : st + k; if (dir && st + k < 4) sl[k] = 3 - (st + k); lv[k] = LOC[(size_t)sl[k] * 2048]; dv[k] = DEC[sl[k] * 32]; }
#pragma unroll
        for (int k = 0; k < 4; ++k) { SIN[(size_t)sl[k] * 2048] = f2bf(S); S = dv[k] * S + lv[k]; }
    }
}

__device__ __forceinline__ void gla_out_unit(const KArgs& a, int l, LAS unsigned char* lds, int cid, int hp, int tid, int wave, int lane) {
    gla_prep<false>(a, l, lds, cid, hp, tid);
    if (wave < 4) {
        const int h2 = wave >> 1, ih = wave & 1, h = 2 * hp + h2, lr = lane & 31, hi = lane >> 5;
        const LAS bf16_t* QC = (const LAS bf16_t*)(lds + GL_QC) + h2 * 64 * 72;
        const LAS bf16_t* KF = (const LAS bf16_t*)(lds + GL_KF) + h2 * 64 * 40;
        const LAS bf16_t* KB = (const LAS bf16_t*)(lds + GL_KB) + h2 * 64 * 40;
        const LAS bf16_t* VT = (const LAS bf16_t*)(lds + GL_VT) + h2 * 64 * 72;
        LAS bf16_t* ATT = (LAS bf16_t*)(lds + GL_ATT) + wave * 32 * 72;
        const int icol = 32 * ih + lr;
#pragma unroll
        for (int jt = 0; jt < 2; ++jt) {
            f32x16 df, db;
#pragma unroll
            for (int r = 0; r < 16; ++r) { df[r] = 0.f; db[r] = 0.f; }
#pragma unroll
            for (int s = 0; s < 2; ++s) {
                const bf16x8 af = *(const LAS bf16x8*)(KF + (32 * jt + lr) * 40 + 16 * s + 8 * hi), ab = *(const LAS bf16x8*)(KB + (32 * jt + lr) * 40 + 16 * s + 8 * hi);
                const bf16x8 bf_ = *(const LAS bf16x8*)(QC + icol * 72 + 16 * s + 8 * hi), bb_ = *(const LAS bf16x8*)(QC + icol * 72 + 32 + 16 * s + 8 * hi);
                df = MFMA32(af, bf_, df); db = MFMA32(ab, bb_, db);
            }
#pragma unroll
            for (int qd = 0; qd < 4; ++qd) { float v[4];
#pragma unroll
                for (int k = 0; k < 4; ++k) { const int j = 32 * jt + 8 * qd + 4 * hi + k; v[k] = (j <= icol ? df[4 * qd + k] : 0.f) + (j >= icol ? db[4 * qd + k] : 0.f); }
                u32x2 w; w.x = cvtpk(v[0], v[1]); w.y = cvtpk(v[2], v[3]);
                *(LAS u32x2*)(ATT + lr * 72 + 32 * jt + 8 * qd + 4 * hi) = w; }
        }
        LDS_FENCE();
        const bool lat = cid < 256; const int b = lat ? cid >> 6 : (cid - 256) >> 2; const int slot = lat ? 4 + (cid & 63) : (cid - 256) & 3;
        const bf16_t* SF = (const bf16_t*)(a.ws + OFF_GSIN) + ((size_t)((b * 4 + h) * 2 + 0) * 68 + slot) * 2048;
        const bf16_t* SB = SF + (size_t)68 * 2048;
        f32x16 acc[2];
#pragma unroll
        for (int mt = 0; mt < 2; ++mt)
#pragma unroll
            for (int r = 0; r < 16; ++r) acc[mt][r] = 0.f;
#pragma unroll
        for (int s = 0; s < 4; ++s) {
            const bf16x8 b1 = *(const LAS bf16x8*)(ATT + lr * 72 + 16 * s + 8 * hi);
            const bf16x8 b2 = *(const LAS bf16x8*)(QC + icol * 72 + 16 * s + 8 * hi);
#pragma unroll
            for (int mt = 0; mt < 2; ++mt) {
                const bf16x8 a1 = *(const LAS bf16x8*)(VT + (32 * mt + lr) * 72 + 16 * s + 8 * hi);
                const bf16_t* sp = (s < 2 ? SF : SB) + (32 * mt + lr) * 32 + 16 * (s & 1) + 8 * hi;
                const bf16x8 a2 = *(const bf16x8*)sp;
                acc[mt] = MFMA32(a1, b1, acc[mt]); acc[mt] = MFMA32(a2, b2, acc[mt]);
            }
        }
        float ss = 0.f;
#pragma unroll
        for (int mt = 0; mt < 2; ++mt)
#pragma unroll
            for (int r = 0; r < 16; ++r) ss += acc[mt][r] * acc[mt][r];
        ss += __shfl_xor(ss, 32);
        const float rstd = rsqrtf(ss * (1.f / 64.f) + EPS);
        const bf16_t* P = (const bf16_t*)(a.ws + OFF_P); bf16_t* Y = (bf16_t*)(a.ws + OFF_H);
        const float* gn = a.in.gla_g_norm + l * 64;
        const size_t row = (size_t)cid * 64 + icol;
#pragma unroll
        for (int mt = 0; mt < 2; ++mt)
#pragma unroll
            for (int qd = 0; qd < 4; ++qd) { const int e0 = 32 * mt + 8 * qd + 4 * hi;
                const f32x4 g4 = *(const f32x4*)(gn + e0);
                const u32x2 gt = *(const u32x2*)(P + row * NP + C_GATE + h * 64 + e0);
                u32x2 w;
                w.x = cvtpk(acc[mt][4 * qd + 0] * rstd * g4.x * fast_silu(lo_bf(gt.x)), acc[mt][4 * qd + 1] * rstd * g4.y * fast_silu(hi_bf(gt.x)));
                w.y = cvtpk(acc[mt][4 * qd + 2] * rstd * g4.z * fast_silu(lo_bf(gt.y)), acc[mt][4 * qd + 3] * rstd * g4.w * fast_silu(hi_bf(gt.y)));
                *(u32x2*)(Y + row * DM + h * 64 + e0) = w; }
    }
    __syncthreads();
}

__device__ __forceinline__ void phC_gla(const KArgs& a, int l, LAS unsigned char* lds, int tid, int wave, int lane) {
    for (int u = blockIdx.x; u < 544; u += gridDim.x) gla_local_unit(a, l, lds, u >> 1, u & 1, tid, wave, lane);
}
__device__ __forceinline__ void phD_gla(const KArgs& a, int tid) {
    for (int it = blockIdx.x; it < 128; it += gridDim.x) gla_scan_item(a, it, tid);
}
__device__ __forceinline__ void phE_gla(const KArgs& a, int l, LAS unsigned char* lds, int tid, int wave, int lane) {
    const int nu = (l == 1) ? 512 : 544;
    for (int u = blockIdx.x; u < nu; u += gridDim.x) gla_out_unit(a, l, lds, u >> 1, u & 1, tid, wave, lane);
}
constexpr int S5_WAVE_BYTES = 12544;
constexpr int S5_GT = 8 * S5_WAVE_BYTES;

__device__ __forceinline__ float gelu_tanh_fast(float v) { const float u = 0.7978845608028654f * (v + 0.044715f * v * v * v); return v * __builtin_amdgcn_rcpf(1.f + fast_exp(-2.f * u)); }

template <int DIR, bool READOUT>
__device__ __forceinline__ void s5_dir(const KArgs& a, int l, LAS unsigned char* wl, size_t row0, int g, int lane, float& xr, float& xi, f32x4 (&D2)[4]) {
    const bf16_t* P = (const bf16_t*)(a.ws + OFF_P);
    const int dgl = (l * 2 + DIR) * 16 + g;
    const bf16_t* BBT = (const bf16_t*)(a.ws + OFF_BBT) + (size_t)dgl * 128 * 16;
    const bf16_t* CMT = (const bf16_t*)(a.ws + OFF_CMT) + (size_t)dgl * 16 * 128;
    const f32x4 lb = *(const f32x4*)((const float*)(a.ws + OFF_SLB) + ((size_t)dgl * 64 + lane) * 4);
    const float lbr = lb.x, lbi = lb.y;
    LAS float* SCAN = (LAS float*)wl; LAS bf16_t* XB = (LAS bf16_t*)(wl + 8192);
    const int li = lane & 15, g4 = lane >> 4;
    const bf16x8 zero8 = {0, 0, 0, 0, 0, 0, 0, 0};
    bf16x8 bfr[8];
#pragma unroll
    for (int nt = 0; nt < 8; ++nt) bfr[nt] = (g4 < 2) ? *(const bf16x8*)(BBT + (16 * nt + li) * 16 + 8 * g4) : zero8;
#pragma unroll
    for (int step = 0; step < 4; ++step) {
        const int sb = DIR ? 3 - step : step;
        const bf16x8 afr = (g4 < 2) ? *(const bf16x8*)(P + (row0 + 16 * sb + li) * NP + C_SU + 16 * g + 8 * g4) : zero8;
#pragma unroll
        for (int nt = 0; nt < 8; ++nt) { f32x4 d = {0.f, 0.f, 0.f, 0.f}; d = MFMA16(afr, bfr[nt], d);
#pragma unroll
            for (int r = 0; r < 4; ++r) SCAN[(4 * g4 + r) * 128 + 16 * nt + li] = d[r]; }
        LDS_FENCE();
#pragma unroll
        for (int tt = 0; tt < 16; ++tt) { const int t = DIR ? 15 - tt : tt;
            const float bur = SCAN[t * 128 + lane], bui = SCAN[t * 128 + 64 + lane];
            const float nxr = lbr * xr - lbi * xi + bur, nxi = lbr * xi + lbi * xr + bui; xr = nxr; xi = nxi;
            if (READOUT) { XB[t * 136 + lane] = f2bf(xr); XB[t * 136 + 64 + lane] = f2bf(xi); } }
        LDS_FENCE();
        if (READOUT) {
#pragma unroll
            for (int s = 0; s < 4; ++s) { const bf16x8 xa = *(const LAS bf16x8*)(XB + li * 136 + 32 * s + 8 * g4);
                const bf16x8 cb = *(const bf16x8*)(CMT + li * 128 + 32 * s + 8 * g4);
                D2[sb] = MFMA16(xa, cb, D2[sb]); }
            LDS_FENCE();
        }
    }
}

__device__ __forceinline__ void s5_local_unit(const KArgs& a, int l, LAS unsigned char* lds, int cid, int wave, int lane) {
    const bool lat = cid < 256; const int b = lat ? cid >> 6 : (cid - 256) >> 2; const int slot = lat ? 4 + (cid & 63) : (cid - 256) & 3;
    LAS unsigned char* wl = lds + wave * S5_WAVE_BYTES;
    float* SXL = (float*)(a.ws + OFF_SXL);
    f32x4 dummy[4];
#pragma unroll
    for (int gi = 0; gi < 2; ++gi) { const int g = 2 * wave + gi;
        { float xr = 0.f, xi = 0.f; s5_dir<0, false>(a, l, wl, (size_t)cid * 64, g, lane, xr, xi, dummy);
          float* o = SXL + ((size_t)((b * 16 + g) * 2 + 0) * 68 + slot) * 128; o[lane] = xr; o[64 + lane] = xi; }
        { float xr = 0.f, xi = 0.f; s5_dir<1, false>(a, l, wl, (size_t)cid * 64, g, lane, xr, xi, dummy);
          float* o = SXL + ((size_t)((b * 16 + g) * 2 + 1) * 68 + slot) * 128; o[lane] = xr; o[64 + lane] = xi; }
    }
}

__device__ __forceinline__ void s5_scan_item(const KArgs& a, int l, int item, int tid) {
    const int chain = item * 8 + (tid >> 6), p = tid & 63, dir = chain & 1, g = (chain >> 1) & 15;
    const int dgl = (l * 2 + dir) * 16 + g;
    const f32x4 lb = *(const f32x4*)((const float*)(a.ws + OFF_SLB) + ((size_t)dgl * 64 + p) * 4);
    const float* SXL = (const float*)(a.ws + OFF_SXL) + (size_t)chain * 68 * 128 + p;
    float* SX0 = (float*)(a.ws + OFF_SX0) + (size_t)chain * 68 * 128 + p;
    float xr = 0.f, xi = 0.f;
    for (int st = 0; st < 68; st += 4) {
        float vr[4], vi[4]; int sl[4];
#pragma unroll
        for (int k = 0; k < 4; ++k) { sl[k] = dir ? 71 - (st + k) : st + k; if (dir && st + k < 4) sl[k] = 3 - (st + k); vr[k] = SXL[sl[k] * 128]; vi[k] = SXL[sl[k] * 128 + 64]; }
#pragma unroll
        for (int k = 0; k < 4; ++k) { SX0[sl[k] * 128] = xr; SX0[sl[k] * 128 + 64] = xi;
            const float nr = lb.z * xr - lb.w * xi + vr[k], ni = lb.z * xi + lb.w * xr + vi[k]; xr = nr; xi = ni; }
    }
}

__device__ __forceinline__ void s5_out_unit(const KArgs& a, int l, LAS unsigned char* lds, int cid, int tid, int wave, int lane) {
    const bf16_t* P = (const bf16_t*)(a.ws + OFF_P); bf16_t* Y = (bf16_t*)(a.ws + OFF_H);
    const bool lat = cid < 256; const int b = lat ? cid >> 6 : (cid - 256) >> 2; const int slot = lat ? 4 + (cid & 63) : (cid - 256) & 3;
    const size_t row0 = (size_t)cid * 64;
    LAS unsigned char* wl = lds + wave * S5_WAVE_BYTES;
    LAS bf16_t* GT = (LAS bf16_t*)(lds + S5_GT);
    const float* SX0 = (const float*)(a.ws + OFF_SX0);
    const float* dsk = a.in.s5_d + l * 256;
    const int li = lane & 15, g4 = lane >> 4;
#pragma unroll
    for (int gi = 0; gi < 2; ++gi) { const int g = 2 * wave + gi;
        f32x4 D2[4];
#pragma unroll
        for (int k = 0; k < 4; ++k) D2[k] = (f32x4){0.f, 0.f, 0.f, 0.f};
        { const float* x0 = SX0 + ((size_t)((b * 16 + g) * 2 + 0) * 68 + slot) * 128; float xr = x0[lane], xi = x0[64 + lane];
          s5_dir<0, true>(a, l, wl, row0, g, lane, xr, xi, D2); }
        { const float* x0 = SX0 + ((size_t)((b * 16 + g) * 2 + 1) * 68 + slot) * 128; float xr = x0[lane], xi = x0[64 + lane];
          s5_dir<1, true>(a, l, wl, row0, g, lane, xr, xi, D2); }
        const float dk = dsk[16 * g + li];
#pragma unroll
        for (int sb = 0; sb < 4; ++sb)
#pragma unroll
            for (int r = 0; r < 4; ++r) { const int t = 16 * sb + 4 * g4 + r;
                const float u = bf2f(P[(row0 + t) * NP + C_SU + 16 * g + li]);
                GT[t * 264 + 16 * g + li] = f2bf(gelu_tanh_fast(D2[sb][r] + u * dk)); }
    }
    __syncthreads();
    {
        const bf16_t* WGT = (const bf16_t*)(a.ws + OFF_WGT) + (size_t)l * 65536;
        f32x4 acc[2][4];
#pragma unroll
        for (int mi = 0; mi < 2; ++mi)
#pragma unroll
            for (int nt = 0; nt < 4; ++nt) acc[mi][nt] = (f32x4){0.f, 0.f, 0.f, 0.f};
#pragma unroll
        for (int s = 0; s < 8; ++s) {
            bf16x8 af[2], bfr[4];
#pragma unroll
            for (int mi = 0; mi < 2; ++mi) af[mi] = *(const bf16x8*)(WGT + (size_t)(16 * (2 * wave + mi) + li) * 256 + 32 * s + 8 * g4);
#pragma unroll
            for (int nt = 0; nt < 4; ++nt) bfr[nt] = *(const LAS bf16x8*)(GT + (16 * nt + li) * 264 + 32 * s + 8 * g4);
#pragma unroll
            for (int mi = 0; mi < 2; ++mi)
#pragma unroll
                for (int nt = 0; nt < 4; ++nt) acc[mi][nt] = MFMA16(af[mi], bfr[nt], acc[mi][nt]);
        }
        const float* bgl = a.in.s5_b_glu + l * 256;
#pragma unroll
        for (int mi = 0; mi < 2; ++mi) { const int m0 = 16 * (2 * wave + mi) + 4 * g4; const f32x4 bv = *(const f32x4*)(bgl + m0);
#pragma unroll
            for (int nt = 0; nt < 4; ++nt) { const int t = 16 * nt + li; const size_t row = row0 + t;
                const u32x2 gv = *(const LAS u32x2*)(GT + t * 264 + m0);
                const u32x2 gt = *(const u32x2*)(P + row * NP + C_GATE + 512 + m0);
                const float o0 = lo_bf(gv.x) * __builtin_amdgcn_rcpf(1.f + fast_exp(-(acc[mi][nt][0] + bv.x))) * fast_silu(lo_bf(gt.x));
                const float o1 = hi_bf(gv.x) * __builtin_amdgcn_rcpf(1.f + fast_exp(-(acc[mi][nt][1] + bv.y))) * fast_silu(hi_bf(gt.x));
                const float o2 = lo_bf(gv.y) * __builtin_amdgcn_rcpf(1.f + fast_exp(-(acc[mi][nt][2] + bv.z))) * fast_silu(lo_bf(gt.y));
                const float o3 = hi_bf(gv.y) * __builtin_amdgcn_rcpf(1.f + fast_exp(-(acc[mi][nt][3] + bv.w))) * fast_silu(hi_bf(gt.y));
                u32x2 w; w.x = cvtpk(o0, o1); w.y = cvtpk(o2, o3);
                *(u32x2*)(Y + row * DM + 512 + m0) = w; }
        }
    }
    __syncthreads();
}

__device__ __forceinline__ void phC_s5(const KArgs& a, int l, LAS unsigned char* lds, int wave, int lane) {
    for (int cid = blockIdx.x; cid < 272; cid += gridDim.x) s5_local_unit(a, l, lds, cid, wave, lane);
    __syncthreads();
}
__device__ __forceinline__ void phD_s5(const KArgs& a, int l, int tid) {
    const int vb = gridDim.x - 1 - blockIdx.x;
    for (int it = vb; it < 16; it += gridDim.x) s5_scan_item(a, l, it, tid);
}
__device__ __forceinline__ void phE_s5(const KArgs& a, int l, LAS unsigned char* lds, int tid, int wave, int lane) {
    const int nc = (l == 1) ? 256 : 272;
    for (int cid = blockIdx.x; cid < nc; cid += gridDim.x) s5_out_unit(a, l, lds, cid, tid, wave, lane);
}

__device__ __forceinline__ void pro_s5_tables(const KArgs& a, int tid) {
    const Inputs& in = a.in;
    const int gt = blockIdx.x * NTHR + tid, NGT = gridDim.x * NTHR;
    bf16_t* BBT = (bf16_t*)(a.ws + OFF_BBT); bf16_t* CMT = (bf16_t*)(a.ws + OFF_CMT); float* SLB = (float*)(a.ws + OFF_SLB); bf16_t* WGT = (bf16_t*)(a.ws + OFF_WGT);
    if (gt < 2 * 2 * 16 * 64) {
        const int p = gt & 63, dgl = gt >> 6;
        const float dt = expf(in.s5_log_dt[dgl]);
        const float lre = in.s5_lam_re[dgl * 64 + p], lim = in.s5_lam_im[dgl * 64 + p];
        const float mag = expf(lre * dt), ang = lim * dt;
        const float lbr = mag * cosf(ang), lbi = mag * sinf(ang);
        const float nr = lbr - 1.f, ni = lbi, den = lre * lre + lim * lim;
        const float cr = (nr * lre + ni * lim) / den, ci = (ni * lre - nr * lim) / den;
        for (int h = 0; h < 16; ++h) { const float br = in.s5_b_re[((size_t)dgl * 64 + p) * 16 + h], bi = in.s5_b_im[((size_t)dgl * 64 + p) * 16 + h];
            BBT[((size_t)dgl * 128 + p) * 16 + h] = f2bf(cr * br - ci * bi); BBT[((size_t)dgl * 128 + 64 + p) * 16 + h] = f2bf(cr * bi + ci * br); }
        float pr = lbr, pi = lbi;
        for (int k = 0; k < 6; ++k) { const float tr = pr * pr - pi * pi, ti = 2.f * pr * pi; pr = tr; pi = ti; }
        *(f32x4*)(SLB + ((size_t)dgl * 64 + p) * 4) = (f32x4){lbr, lbi, pr, pi};
    }
    for (int i = gt; i < 2 * 2 * 16 * 16 * 128; i += NGT) { const int pri = i & 127, h = (i >> 7) & 15, dgl = i >> 11;
        const float v = pri < 64 ? in.s5_c_re[((size_t)dgl * 16 + h) * 64 + pri] : -in.s5_c_im[((size_t)dgl * 16 + h) * 64 + pri - 64];
        CMT[i] = f2bf(v); }
    for (int i = gt; i < 2 * 65536; i += NGT) { const int n = i & 255, m = (i >> 8) & 255, li = i >> 16; WGT[i] = f2bf(in.s5_w_glu[(size_t)li * 65536 + n * 256 + m]); }
}
__global__ void __launch_bounds__(NTHR, 2) mega(KArgs a) {
    extern __shared__ __attribute__((aligned(16))) unsigned char lds_raw[];
    LAS unsigned char* lds = (LAS unsigned char*)lds_raw;
    const int tid = threadIdx.x, lane = tid & 63, wave = __builtin_amdgcn_readfirstlane(tid >> 6);
    volatile LAS unsigned* MISC = (volatile LAS unsigned*)(lds + MISC_OFF);
    for (int u = tid; u < (LDS_BYTES - RING_BYTES) / 4; u += NTHR) ((LAS unsigned*)(lds + RING_BYTES))[u] = 0u;
    __syncthreads();
    unsigned* ctl = (unsigned*)(a.ws + OFF_CTL);
    XcdBarrier bar = xcd_barrier_post(ctl + CW_BAR + a.li * XCD_BAR_WORDS, MISC + 8);
    const int lo = a.ph_lo, hi = a.ph_hi;
    bool first_seam = true;
#define IN(k) (lo <= (k) && (k) < hi)
#define SEAM(k) do { if (IN(k) && IN((k) + 1)) { if (first_seam) { cooperative_groups::this_grid().sync(); first_seam = false; } xcd_barrier(bar); } } while (0)
    if (IN(PH_PRO)) { ph_prologue(a, lds, tid, wave, lane); pro_s5_tables(a, tid); }
    SEAM(PH_PRO);
#define LAYER(l) do { \
        constexpr int pb = PH_L0 + (l) * PH_PER_LAYER; \
        constexpr int nrows_out = ((l) == 1) ? NLAT : MTOT; \
        if (IN(pb + 0)) { ph_post_pre(a, (l) - 1, (l), wave, lane); } \
        SEAM(pb + 0); \
        if (IN(pb + 1)) { \
            pg8::Gemm g{(const bf16_t*)(a.ws + OFF_H), (const bf16_t*)(a.ws + OFF_WIN) + (size_t)(l) * NP * DM, MTOT, NP, DM}; \
            pg8::StaticOrder S; S.init(MTOT, NP, gridDim.x, blockIdx.x); \
            pg8::EpiBf16<0> E{(bf16_t*)(a.ws + OFF_P), NP, nullptr, 0, 0, 1.f}; \
            pg8::gemm_phase<pg8::EpiBf16<0>, pg8::StaticOrder, true, true>(lds, g, S, E); \
        } \
        SEAM(pb + 1); \
        if (IN(pb + 2)) { if (a.mask & 1) phC_vt(a, lds, tid); if (a.mask & 2) phC_gla(a, (l), lds, tid, wave, lane); if (a.mask & 4) phC_s5(a, (l), lds, wave, lane); } \
        SEAM(pb + 2); \
        if (IN(pb + 3)) { if (a.mask & 2) phD_gla(a, tid); if (a.mask & 4) phD_s5(a, (l), tid); if (a.mask & 1) phD_na_pool(a, (l), lds, tid, wave, lane); } \
        SEAM(pb + 3); \
        if (IN(pb + 4)) { if (a.mask & 2) phE_gla(a, (l), lds, tid, wave, lane); if (a.mask & 4) phE_s5(a, (l), lds, tid, wave, lane); } \
        SEAM(pb + 4); \
        if (IN(pb + 5)) { \
            pg8::Gemm g{(const bf16_t*)(a.ws + OFF_H), (const bf16_t*)(a.ws + OFF_WOUT) + (size_t)(l) * DM * DM, nrows_out, DM, DM}; \
            pg8::StaticOrder S; S.init(nrows_out, DM, gridDim.x, blockIdx.x); \
            pg8::EpiF32 E{(float*)(a.ws + OFF_P), DM, nullptr}; \
            pg8::gemm_phase<pg8::EpiF32, pg8::StaticOrder, true, true>(lds, g, S, E); \
        } \
        SEAM(pb + 5); \
    } while (0)
    LAYER(0);
    LAYER(1);
#undef LAYER
    if (IN(PH_FIN)) { ph_post_pre(a, 1, 2, wave, lane); }
#undef IN
#undef SEAM
}

static int g_grid = 0;
static void launch_mega(const KArgs& base, int lo, int hi, int li, hipStream_t stream) {
    KArgs a = base; a.ph_lo = lo; a.ph_hi = hi; a.li = li;
    void* args[] = {(void*)&a};
    hipError_t e = hipLaunchCooperativeKernel((const void*)mega, dim3(g_grid), dim3(NTHR), args, LDS_BYTES, stream);
    if (e != hipSuccess) fprintf(stderr, "cooperative launch failed: %s (grid %d)\n", hipGetErrorString(e), g_grid);
}

extern "C" void kernel_launch(void* const* d_in, const int* in_sizes, int n_in, void* d_out, int out_size, void* d_ws, size_t ws_size, hipStream_t stream) {
    if (g_grid == 0) {
        int dev = 0, cus = 0, per_cu = 0;
        hipGetDevice(&dev);
        hipDeviceGetAttribute(&cus, hipDeviceAttributeMultiprocessorCount, dev);
        hipFuncSetAttribute((const void*)mega, hipFuncAttributeMaxDynamicSharedMemorySize, LDS_BYTES);
        hipOccupancyMaxActiveBlocksPerMultiprocessor(&per_cu, (const void*)mega, NTHR, LDS_BYTES);
        if (per_cu < 1) per_cu = 1;
        g_grid = cus * per_cu;
        if (g_grid != 256) fprintf(stderr, "note: grid %d (cus %d x %d)\n", g_grid, cus, per_cu);
    }
    KArgs base;
    memset(&base, 0, sizeof(base));
    const float** ip = (const float**)&base.in;
    for (int i = 0; i < 26; ++i) ip[i] = (const float*)d_in[i];
    base.out = (float*)d_out; base.ws = (unsigned char*)d_ws; base.mask = 7;
    hipMemsetAsync((char*)d_ws + OFF_CTL, 0, CTL_BYTES, stream);
    launch_mega(base, PH_PRO, PH_END, 0, stream);
}
```

```cpp
#include <hip/hip_runtime.h>
#include <hip/hip_cooperative_groups.h>
#include <stdint.h>
#include <math.h>
#include <cstdio>
#include <cstring>

typedef unsigned short bf16_t;
__device__ __forceinline__ float bf2f(bf16_t v) { return __uint_as_float(((unsigned)v) << 16); }
__device__ __forceinline__ bf16_t f2bf(float f) { unsigned u = __float_as_uint(f); return (bf16_t)((u + 0x7fffu + ((u >> 16) & 1u)) >> 16); }

constexpr int DM = 1024, NB = 4, SEQ = 4096, NCTX = 256, GW = 64;
constexpr int NLAT = NB * SEQ;
constexpr int NCT = NB * NCTX;
constexpr int MTOT = NLAT + NCT;
constexpr int NIN = 2848, NP = 3072;
constexpr int C_GK = 0, C_GV = 128, C_GF = 384, C_GB = 400, C_NK = 416, C_NV = 672, C_SU = 928, C_GQ = 1184, C_NQ = 1312, C_PU = 1568, C_GATE = 1824;
constexpr float EPS = 1e-6f;

constexpr size_t OFF_CTL = 0, CTL_BYTES = 256 * 1024;
constexpr size_t OFF_WIN = OFF_CTL + CTL_BYTES;
constexpr size_t OFF_WOUT = OFF_WIN + (size_t)2 * NP * DM * 2;
constexpr size_t OFF_MOD = OFF_WOUT + (size_t)2 * DM * DM * 2;
constexpr size_t OFF_H = OFF_MOD + (size_t)2 * 5 * 3072 * 4 + 1024;
constexpr size_t OFF_P = OFF_H + (size_t)MTOT * DM * 2;
constexpr size_t OFF_XC = OFF_P + (size_t)MTOT * NP * 2;
constexpr size_t OFF_VTL = OFF_XC + (size_t)NCT * DM * 4;
constexpr size_t OFF_VTC = OFF_VTL + (size_t)1024 * SEQ * 2;
constexpr size_t OFF_WPT = OFF_VTC + (size_t)1024 * NCTX * 2;
constexpr size_t OFF_ROPE = OFF_WPT + (size_t)2 * 4 * 64 * 64 * 2;
constexpr size_t OFF_GLOC = OFF_ROPE + 4096;
constexpr size_t OFF_GDEC = OFF_GLOC + (size_t)32 * 68 * 2048 * 4;
constexpr size_t OFF_GSIN = OFF_GDEC + (size_t)32 * 68 * 32 * 4;
constexpr size_t OFF_BBT = OFF_GSIN + (size_t)32 * 68 * 2048 * 2;
constexpr size_t OFF_CMT = OFF_BBT + (size_t)64 * 128 * 16 * 2;
constexpr size_t OFF_SLB = OFF_CMT + (size_t)64 * 16 * 128 * 2;
constexpr size_t OFF_WGT = OFF_SLB + (size_t)64 * 64 * 16;
constexpr size_t OFF_SXL = OFF_WGT + (size_t)2 * 65536 * 2;
constexpr size_t OFF_SX0 = OFF_SXL + (size_t)128 * 68 * 128 * 4;
constexpr size_t OFF_END = OFF_SX0 + (size_t)128 * 68 * 128 * 4;
static_assert(OFF_END <= (size_t)256 * 1024 * 1024, "ws");

struct Inputs {
    const float *x, *c, *ctx, *c_ctx, *w_mod, *b_mod, *g_pre, *g_post, *w_in, *w_out, *gla_w_gate, *gla_b_gate, *gla_g_norm, *na_rpb,
        *s5_lam_re, *s5_lam_im, *s5_log_dt, *s5_b_re, *s5_b_im, *s5_c_re, *s5_c_im, *s5_d, *s5_w_glu, *s5_b_glu, *pool_w, *pool_scale;
};

__device__ __forceinline__ float silu_f(float v) { return v / (1.f + expf(-v)); }
__device__ __forceinline__ float sigmoid_f(float v) { return 1.f / (1.f + expf(-v)); }
__device__ __forceinline__ float gelu_tanh_f(float v) { const float k = 0.7978845608028654f; return 0.5f * v * (1.f + tanhf(k * (v + 0.044715f * v * v * v))); }
__device__ __forceinline__ float logsigmoid_f(float z) { return fminf(z, 0.f) - log1pf(expf(-fabsf(z))); }

#define LAS __attribute__((address_space(3)))
__device__ __forceinline__ int fresh_lane();
namespace pg8 {
#define PG8_LAS __attribute__((address_space(3)))
typedef unsigned short bf16_t;
typedef short bf16x8 __attribute__((ext_vector_type(8)));
typedef float f32x4 __attribute__((ext_vector_type(4)));
typedef unsigned u32x4 __attribute__((ext_vector_type(4)));
constexpr int BM = 256, BK = 64, HALF = 128, HTB = HALF * BK * 2  , STAGE_BYTES = 8 * HTB, NXCD = 8, WGM = 8;

__host__ __device__ __forceinline__ int lds_byte(int r, int c) { const int st = (r >> 4) * 2 + (c >> 5), rr = r & 15, cc = c & 31, ob = rr * 64 + cc * 2; return st * 1024 + (ob ^ (((ob >> 9) & 1) << 5)); }
__host__ __device__ __forceinline__ void stage_rc(int b, int& R, int& C) { const int st = b / 1024, sb = b % 1024, swz = sb ^ (((sb >> 9) & 1) << 5); R = (st >> 1) * 16 + swz / 64; C = (st & 1) * 32 + (swz % 64) / 2; }
__host__ __device__ __forceinline__ int perm32(int rho) { const int n = rho >> 4, i = rho & 15; return 8 * (i >> 2) + 4 * n + (i & 3); }

struct Unit { int pm, pn; };
struct Gemm { const bf16_t* A; const bf16_t* Bt; int M, N, K; };

struct StaticOrder {
    int nM, nN, nwg, G, c;
    __host__ __device__ void init(int M, int N, int G_, int c_) { nM = M / BM; nN = N / BM; nwg = nM * nN; G = G_; c = c_; }
    __host__ __device__ bool next(int i, Unit& u) const {
        const long L = (long)i * G + c; if (L >= nwg) return false;
        int wgid = (int)L; { const int q = nwg / NXCD, r = nwg % NXCD, xcd = wgid % NXCD, off = wgid / NXCD; wgid = (xcd < r ? xcd * (q + 1) : r * (q + 1) + (xcd - r) * q) + off; }
        const int nig = WGM * nN, gid = wgid / nig, fm = gid * WGM, gsz = (nM - fm) < WGM ? (nM - fm) : WGM;
        u.pm = fm + ((wgid % nig) % gsz); u.pn = (wgid % nig) / gsz; return true;
    }
    __device__ __forceinline__ void a_ready(const Unit&) const {}
    __device__ __forceinline__ void done(const Unit&) const {}
};

__device__ __forceinline__ unsigned cvt_pk_bf16(float lo, float hi) { unsigned r; asm volatile("v_cvt_pk_bf16_f32 %0, %1, %2" : "=v"(r) : "v"(lo), "v"(hi)); return r; }
typedef float f32x2 __attribute__((ext_vector_type(2)));
__device__ __forceinline__ f32x2 gelu_pk(f32x2 v) {
    const f32x2 av = __builtin_elementwise_abs(v), d = av * 0.2316418882f + 1.0f;
    f32x2 t; t.x = __builtin_amdgcn_rcpf(d.x); t.y = __builtin_amdgcn_rcpf(d.y);
    f32x2 q = t * 0.5307027145f + (-0.7265760135f); q = q * t + 0.7107068705f; q = q * t + (-0.142248368f); q = q * t + 0.127414796f; q = q * t;
    const f32x2 s = (v * v) * (-0.72134752044f);
    f32x2 e; e.x = __builtin_amdgcn_exp2f(s.x); e.y = __builtin_amdgcn_exp2f(s.y);
    const f32x2 m = v * (q * e), r = v - m;
    f32x2 o; o.x = v.x < 0.f ? m.x : r.x; o.y = v.y < 0.f ? m.y : r.y; return o;
}

template <int ACT  > struct EpiBf16 {
    static constexpr bool PERM = true, AFTER_DRAIN = false; static_assert(ACT == 0 || ACT == 1, "EpiBf16: ACT is 0 (none) or 1 (gelu_pk)");
    bf16_t* O; int ldc; const float* bias; int split_cols; size_t split_stride; float scale0;
    __device__ __forceinline__ void operator()(const f32x4 (&acc)[2][2][4][2], const Unit& u, int wr, int wc, int fr, int fq) const {
        const int row0 = u.pm * BM + wr * 64 + fr; int colt = u.pn * BM; bf16_t* base = O;
        float sc = 1.f; if (split_cols) { const int t = colt / split_cols; base += (size_t)t * split_stride; colt -= t * split_cols; if (t == 0) sc = scale0; }
        const int col0 = colt + wc * 32 + 8 * fq, bcol0 = u.pn * BM + wc * 32 + 8 * fq;
        f32x4 bv[2][2];
#pragma unroll
        for (int bj = 0; bj < 2; ++bj)
#pragma unroll
            for (int n = 0; n < 2; ++n) bv[bj][n] = bias ? *(const f32x4*)(bias + bcol0 + bj * HALF + 4 * n) : (f32x4){0.f, 0.f, 0.f, 0.f};
#pragma unroll
        for (int ai = 0; ai < 2; ++ai)
#pragma unroll
            for (int m = 0; m < 4; ++m) { bf16_t* rowp = base + (size_t)(row0 + ai * HALF + m * 16) * ldc + col0;
#pragma unroll
                for (int bj = 0; bj < 2; ++bj) { f32x4 v0 = acc[ai][bj][m][0] + bv[bj][0], v1 = acc[ai][bj][m][1] + bv[bj][1];
                    if (ACT == 1) { f32x2 a = gelu_pk((f32x2){v0[0], v0[1]}), b = gelu_pk((f32x2){v0[2], v0[3]}), c = gelu_pk((f32x2){v1[0], v1[1]}), d = gelu_pk((f32x2){v1[2], v1[3]});
                        v0 = (f32x4){a.x, a.y, b.x, b.y}; v1 = (f32x4){c.x, c.y, d.x, d.y}; }
                    v0 = v0 * sc; v1 = v1 * sc; u32x4 w; w.x = cvt_pk_bf16(v0[0], v0[1]); w.y = cvt_pk_bf16(v0[2], v0[3]); w.z = cvt_pk_bf16(v1[0], v1[1]); w.w = cvt_pk_bf16(v1[2], v1[3]);
                    *(u32x4*)(rowp + bj * HALF) = w; } }
    }
};
struct EpiF32 {
    static constexpr bool PERM = false, AFTER_DRAIN = false;
    float* C; int ldc; const float* bias;
    __device__ __forceinline__ void operator()(const f32x4 (&acc)[2][2][4][2], const Unit& u, int wr, int wc, int fr, int fq) const {
        const int row0 = u.pm * BM + wr * 64 + fr, col0 = u.pn * BM + wc * 32 + 4 * fq;
        f32x4 bv[2][2];
#pragma unroll
        for (int bj = 0; bj < 2; ++bj)
#pragma unroll
            for (int n = 0; n < 2; ++n) bv[bj][n] = bias ? *(const f32x4*)(bias + col0 + bj * HALF + n * 16) : (f32x4){0.f, 0.f, 0.f, 0.f};
#pragma unroll
        for (int ai = 0; ai < 2; ++ai)
#pragma unroll
            for (int m = 0; m < 4; ++m) { float* rowp = C + (size_t)(row0 + ai * HALF + m * 16) * ldc + col0;
#pragma unroll
                for (int bj = 0; bj < 2; ++bj)
#pragma unroll
                    for (int n = 0; n < 2; ++n) *(f32x4*)(rowp + bj * HALF + n * 16) = acc[ai][bj][m][n] + bv[bj][n]; }
    }
};
template <class Epi, class Sched, bool ALIGN_EPI = false, bool SP2 = false>
__device__ __forceinline__ void gemm_phase(PG8_LAS unsigned char* lds, const Gemm g, const Sched& S, const Epi& E, const int wave_in) {
    const int lane = fresh_lane(), wid = wave_in, tid = wid * 64 + lane, wr = wid >> 2, wc = wid & 3, fr = lane & 15, fq = lane >> 4;
    const int K = g.K, nt = K / BK;
    unsigned voffA[2], voffB[2];
#pragma unroll
    for (int i = 0; i < 2; ++i) { int R, C; stage_rc(tid * 16 + i * 8192, R, C); const int Rb = Epi::PERM ? ((R & ~31) + perm32(R & 31)) : R;
        voffA[i] = (unsigned)(R * K + C) * 2u; voffB[i] = (unsigned)(Rb * K + C) * 2u; }
    const size_t kstep = (size_t)(BK * 2);
    const size_t hstep = (size_t)HALF * K * 2;
    const size_t tstep = 2 * hstep;
    const unsigned ldsw = (unsigned)wid * 1024u;
    const int aoff = lds_byte(wr * 64 + fr, fq * 8), boff = lds_byte(wc * 32 + fr, fq * 8);
#define PG8_SA(b, h) (((b) * 2 + (h)) * HTB)
#define PG8_SB(b, h) ((4 + (b) * 2 + (h)) * HTB)
#define PG8_STAGE(bufoff, gbase, voff) do { _Pragma("unroll") for (int _i = 0; _i < 2; ++_i) \
        __builtin_amdgcn_global_load_lds((const unsigned*)((const char*)(gbase) + (voff)[_i]), (PG8_LAS unsigned*)(lds + (bufoff) + ldsw + _i * 8192), 16, 0, 0); } while (0)
#define PG8_LDA(dst, b, h) do { _Pragma("unroll") for (int m = 0; m < 4; ++m) _Pragma("unroll") for (int k = 0; k < 2; ++k) dst[m][k] = *(const PG8_LAS bf16x8*)(lds + PG8_SA(b, h) + aoff + m * 2048 + k * 1024); } while (0)
#define PG8_LDB(dst, b, h) do { _Pragma("unroll") for (int n = 0; n < 2; ++n) _Pragma("unroll") for (int k = 0; k < 2; ++k) dst[n][k] = *(const PG8_LAS bf16x8*)(lds + PG8_SB(b, h) + boff + n * 2048 + k * 1024); } while (0)
#define PG8_MMA(ai, bj, At, Bt) do { __builtin_amdgcn_s_setprio(1); _Pragma("unroll") for (int m = 0; m < 4; ++m) _Pragma("unroll") for (int n = 0; n < 2; ++n) _Pragma("unroll") for (int k = 0; k < 2; ++k) \
        acc[ai][bj][m][n] = __builtin_amdgcn_mfma_f32_16x16x32_bf16(Bt[n][k], At[m][k], acc[ai][bj][m][n], 0, 0, 0); __builtin_amdgcn_s_setprio(0); } while (0)
#define PG8_WAIT_V(n) asm volatile("s_waitcnt vmcnt(" #n ")" ::: "memory")
#define PG8_WAIT_L(n) asm volatile("s_waitcnt lgkmcnt(" #n ")" ::: "memory")
#define PG8_BAR __builtin_amdgcn_s_barrier()
#define PG8_SCHED __builtin_amdgcn_sched_barrier(0)
    Unit cur, nxt; int ui = 0;
    if (!S.next(0, cur)) return;
    f32x4 acc[2][2][4][2];
#pragma unroll
    for (int a = 0; a < 2; ++a)
#pragma unroll
        for (int b = 0; b < 2; ++b)
#pragma unroll
            for (int m = 0; m < 4; ++m)
#pragma unroll
                for (int n = 0; n < 2; ++n) acc[a][b][m][n] = (f32x4){0.f, 0.f, 0.f, 0.f};
    bf16x8 At[4][2], B0[2][2], B1[2][2];
    const char* cA = (const char*)g.A + (size_t)cur.pm * tstep; const char* cB = (const char*)g.Bt + (size_t)cur.pn * tstep;
    S.a_ready(cur);
    if constexpr (SP2) {
        PG8_STAGE(PG8_SB(0, 0), cB, voffB); PG8_STAGE(PG8_SB(0, 1), cB + hstep, voffB); PG8_STAGE(PG8_SA(0, 0), cA, voffA); PG8_STAGE(PG8_SA(0, 1), cA + hstep, voffA);
        if (wr == 1) PG8_BAR;
        PG8_WAIT_V(2); PG8_BAR;
        PG8_STAGE(PG8_SB(1, 0), cB + kstep, voffB); PG8_STAGE(PG8_SA(1, 0), cA + kstep, voffA); PG8_STAGE(PG8_SB(1, 1), cB + hstep + kstep, voffB);
        PG8_WAIT_V(6); PG8_BAR;
    } else {
        PG8_STAGE(PG8_SB(0, 0), cB, voffB); PG8_STAGE(PG8_SA(0, 0), cA, voffA); PG8_STAGE(PG8_SB(0, 1), cB + hstep, voffB); PG8_STAGE(PG8_SA(0, 1), cA + hstep, voffA);
        if (wr == 1) PG8_BAR;
        PG8_WAIT_V(4); PG8_BAR;
        PG8_STAGE(PG8_SB(1, 0), cB + kstep, voffB); PG8_STAGE(PG8_SA(1, 0), cA + kstep, voffA); PG8_STAGE(PG8_SB(1, 1), cB + hstep + kstep, voffB);
        PG8_WAIT_V(6); PG8_BAR;
    }
    for (;;) {
        const bool has_next = S.next(ui + 1, nxt);
        const char* nA = has_next ? (const char*)g.A + (size_t)nxt.pm * tstep : cA; const char* nB = has_next ? (const char*)g.Bt + (size_t)nxt.pn * tstep : cB;
        for (int t = 0; t < nt; t += 2) {
            const bool last = (t == nt - 2);
            const char* a1 = cA + (size_t)(t + 1) * kstep;
            const char* a2 = last ? nA : cA + (size_t)(t + 2) * kstep; const char* b2 = last ? nB : cB + (size_t)(t + 2) * kstep;
            const char* a3 = a2 + kstep; const char* b3 = b2 + kstep;
            if (last && has_next) S.a_ready(nxt);
            if constexpr (SP2) {
            PG8_LDB(B0, 0, 0); PG8_LDB(B1, 0, 1); PG8_SCHED; PG8_LDA(At, 0, 0); PG8_STAGE(PG8_SA(1, 1), a1 + hstep, voffA);
            PG8_WAIT_V(8); PG8_WAIT_L(0); PG8_BAR; PG8_MMA(0, 0, At, B0); PG8_MMA(0, 1, At, B1); PG8_BAR; PG8_SCHED;
            PG8_LDA(At, 0, 1); PG8_STAGE(PG8_SB(0, 0), b2, voffB); PG8_STAGE(PG8_SB(0, 1), b2 + hstep, voffB); PG8_STAGE(PG8_SA(0, 0), a2, voffA);
            PG8_WAIT_V(8); PG8_WAIT_L(0); PG8_BAR; PG8_MMA(1, 0, At, B0); PG8_MMA(1, 1, At, B1); PG8_BAR; PG8_SCHED;
            PG8_LDB(B0, 1, 0); PG8_LDB(B1, 1, 1); PG8_SCHED; PG8_LDA(At, 1, 0); PG8_STAGE(PG8_SA(0, 1), a2 + hstep, voffA);
            PG8_WAIT_V(8); PG8_WAIT_L(0); PG8_BAR; PG8_MMA(0, 0, At, B0); PG8_MMA(0, 1, At, B1); PG8_BAR; PG8_SCHED;
            PG8_LDA(At, 1, 1); PG8_STAGE(PG8_SB(1, 0), b3, voffB); PG8_STAGE(PG8_SB(1, 1), b3 + hstep, voffB); PG8_STAGE(PG8_SA(1, 0), a3, voffA);
            PG8_WAIT_V(8); PG8_WAIT_L(0); PG8_BAR; PG8_MMA(1, 0, At, B0); PG8_MMA(1, 1, At, B1); PG8_BAR; PG8_SCHED;
            } else {
            PG8_LDB(B0, 0, 0); PG8_SCHED; PG8_LDA(At, 0, 0); PG8_STAGE(PG8_SA(1, 1), a1 + hstep, voffA);
            PG8_WAIT_L(8); PG8_BAR; PG8_WAIT_L(0); PG8_MMA(0, 0, At, B0); PG8_BAR; PG8_SCHED;
            PG8_LDB(B1, 0, 1); PG8_STAGE(PG8_SB(0, 0), b2, voffB);
            PG8_BAR; PG8_WAIT_L(0); PG8_MMA(0, 1, At, B1); PG8_BAR;
            PG8_LDA(At, 0, 1); PG8_STAGE(PG8_SA(0, 0), a2, voffA);
            PG8_BAR; PG8_WAIT_L(0); PG8_MMA(1, 0, At, B0); PG8_BAR; PG8_SCHED;
            PG8_STAGE(PG8_SB(0, 1), b2 + hstep, voffB);
            PG8_WAIT_V(6); PG8_BAR; PG8_MMA(1, 1, At, B1); PG8_BAR;
            PG8_LDB(B0, 1, 0); PG8_SCHED; PG8_LDA(At, 1, 0); PG8_STAGE(PG8_SA(0, 1), a2 + hstep, voffA);
            PG8_WAIT_L(8); PG8_BAR; PG8_WAIT_L(0); PG8_MMA(0, 0, At, B0); PG8_BAR; PG8_SCHED;
            PG8_LDB(B1, 1, 1); PG8_STAGE(PG8_SB(1, 0), b3, voffB);
            PG8_BAR; PG8_WAIT_L(0); PG8_MMA(0, 1, At, B1); PG8_BAR;
            PG8_LDA(At, 1, 1); PG8_STAGE(PG8_SA(1, 0), a3, voffA);
            PG8_BAR; PG8_WAIT_L(0); PG8_MMA(1, 0, At, B0); PG8_BAR; PG8_SCHED;
            PG8_STAGE(PG8_SB(1, 1), b3 + hstep, voffB);
            PG8_WAIT_V(6); PG8_BAR; PG8_MMA(1, 1, At, B1); PG8_BAR;
            }
        }
        if constexpr (ALIGN_EPI) { if (wr == 0) PG8_BAR; }
        if constexpr (!Epi::AFTER_DRAIN) { E(acc, cur, wr, wc, fr, fq); S.done(cur); }
        if (!has_next) break;
#pragma unroll
        for (int a = 0; a < 2; ++a)
#pragma unroll
            for (int b = 0; b < 2; ++b)
#pragma unroll
                for (int m = 0; m < 4; ++m)
#pragma unroll
                    for (int n = 0; n < 2; ++n) acc[a][b][m][n] = (f32x4){0.f, 0.f, 0.f, 0.f};
        cur = nxt; cA = nA; cB = nB; ++ui;
        if constexpr (ALIGN_EPI) { if (wr == 1) PG8_BAR; }
    }
    PG8_WAIT_V(0);
    if constexpr (!ALIGN_EPI) { if (wr == 0) PG8_BAR; }
    PG8_BAR;
    if constexpr (Epi::AFTER_DRAIN) { E.fused(acc, cur, wr, wc, fr, fq, lds, wid, lane); S.done(cur); }
#undef PG8_SA
#undef PG8_SB
#undef PG8_STAGE
#undef PG8_LDA
#undef PG8_LDB
#undef PG8_MMA
#undef PG8_WAIT_V
#undef PG8_WAIT_L
#undef PG8_BAR
#undef PG8_SCHED
}
}
#define XB_TMO      128
#define XB_XCNT(j)  (256  + 64 * (j))
#define XB_XSUB(j)  (1280 + 64 * (j))
#define XB_XGEN(j)  (2304 + 64 * (j))
#define XB_TOP      3328
#define XB_TOPGEN   3392
#define XCD_BAR_WORDS 3456
#define XB_SPIN_CAP (1u << 18)

__device__ __forceinline__ unsigned xb_ld(unsigned* p)              { return __hip_atomic_load(p, __ATOMIC_RELAXED, __HIP_MEMORY_SCOPE_AGENT); }
__device__ __forceinline__ unsigned xb_add(unsigned* p, unsigned v) { return __hip_atomic_fetch_add(p, v, __ATOMIC_RELAXED, __HIP_MEMORY_SCOPE_AGENT); }
__device__ __forceinline__ unsigned xb_xcc_id() { return (unsigned)__builtin_amdgcn_s_getreg((3 << 11) | 20) & 0xFu; }
#define XB_SPIN(cond, bar) do { unsigned _sp = 0; while (cond) { __builtin_amdgcn_s_sleep(1); \
    if ((++_sp & 255u) == 0u) { if (xb_ld(&(bar)[XB_TMO])) break; if (_sp > XB_SPIN_CAP) { atomicAdd(&(bar)[XB_TMO], 1u); break; } } } } while (0)

struct XcdBarrier {
    unsigned* bar; unsigned x;
    volatile LAS unsigned* st;
};

__device__ __forceinline__ XcdBarrier xcd_barrier_post(unsigned* bar, volatile LAS unsigned* st, const bool t0) {
    XcdBarrier b; b.bar = bar; b.x = xb_xcc_id(); b.st = st;
    if (t0) (void)xb_add(&bar[XB_XCNT(b.x)], 1u);
    return b;
}
__device__ __forceinline__ void xcd_barrier_complete(unsigned* bar, unsigned x, unsigned& nloc, unsigned& nx) {
    const unsigned G = gridDim.x * gridDim.y * gridDim.z;
    unsigned sum, cnt, mine, sp = 0u;
    for (;;) {
        sum = 0u; cnt = 0u; mine = 0u;
#pragma unroll
        for (unsigned j = 0; j < 16; ++j) { const unsigned c = xb_ld(&bar[XB_XCNT(j)]); sum += c; cnt += (c > 0u) ? 1u : 0u; mine = (j == x) ? c : mine; }
        if (sum == G) break;
        __builtin_amdgcn_s_sleep(1);
        if ((++sp & 255u) == 0u) { if (xb_ld(&bar[XB_TMO])) break; if (sp > XB_SPIN_CAP) { atomicAdd(&bar[XB_TMO], 1u); break; } }
    }
    nloc = mine > 0u ? mine : 1u; nx = cnt > 0u ? cnt : 1u;
}

__device__ __forceinline__ void xcd_barrier(const XcdBarrier& b, const bool t0) {
    asm volatile("s_waitcnt vmcnt(0)" ::: "memory");
    __syncthreads();
    if (t0) {
        unsigned* bar = b.bar;
        __builtin_amdgcn_s_waitcnt(0);
        unsigned nloc = b.st[0], nx = b.st[1];
        if (nloc == 0u) { xcd_barrier_complete(bar, b.x, nloc, nx); b.st[0] = nloc; b.st[1] = nx; }
        const unsigned old = xb_add(&bar[XB_XSUB(b.x)], 1u);
        const unsigned gen = old / nloc;
        if (old + 1u == (gen + 1u) * nloc) {
            __builtin_amdgcn_fence(__ATOMIC_RELEASE, "agent");
            asm volatile("s_waitcnt vmcnt(0)" ::: "memory");
            const unsigned og = xb_add(&bar[XB_TOP], 1u);
            const unsigned tg = og / nx;
            if (og + 1u == (tg + 1u) * nx) xb_add(&bar[XB_TOPGEN], 1u);
            else XB_SPIN(xb_ld(&bar[XB_TOPGEN]) == tg, bar);
            __builtin_amdgcn_fence(__ATOMIC_ACQUIRE, "agent");
            xb_add(&bar[XB_XGEN(b.x)], 1u);
            asm volatile("s_waitcnt vmcnt(0)" ::: "memory");
        } else {
            XB_SPIN(xb_ld(&bar[XB_XGEN(b.x)]) == gen, bar);
            __builtin_amdgcn_fence(__ATOMIC_ACQUIRE, "agent");
            asm volatile("s_waitcnt vmcnt(0)" ::: "memory");
        }
    }
    __syncthreads();
}
#define GAS __attribute__((address_space(1)))
typedef float f32x4 __attribute__((ext_vector_type(4)));
typedef unsigned u32x2 __attribute__((ext_vector_type(2)));
typedef unsigned u32x4 __attribute__((ext_vector_type(4)));
typedef short bf16x8 __attribute__((ext_vector_type(8)));
constexpr int NTHR = 512, NWV = 8;
constexpr int RING_BYTES = 139264, MISC_OFF = RING_BYTES + 320, LDS_BYTES = 147456;
constexpr int CW_BAR = 1024;

struct KArgs { Inputs in; float* out; unsigned char* ws; int ph_lo, ph_hi, li, mask; };
#ifndef PROBE_REP
#define PROBE_REP {0, 0, 0, 0, 0, 0, 0, 0}
#endif
constexpr int kRep[8] = PROBE_REP;

__device__ __forceinline__ float wave_sum(float v) {
#pragma unroll
    for (int o = 1; o < 64; o <<= 1) v += __shfl_xor(v, o);
    return v;
}
__device__ __forceinline__ unsigned pk2(float lo, float hi) { return (unsigned)f2bf(lo) | ((unsigned)f2bf(hi) << 16); }
__device__ __forceinline__ int fresh_lane() { int l; asm volatile("v_mbcnt_lo_u32_b32 %0, -1, 0\n\tv_mbcnt_hi_u32_b32 %0, -1, %0" : "=v"(l)); return l; }
#define LDS_FENCE() asm volatile("s_waitcnt lgkmcnt(0)" ::: "memory")

constexpr int PH_PRO = 0;
constexpr int PH_L0 = 1, PH_PER_LAYER = 6;
constexpr int PH_FIN = PH_L0 + 2 * PH_PER_LAYER;
constexpr int PH_END = PH_FIN + 1;

__device__ __forceinline__ void transpose_item(const float* W, int K, int N, bf16_t* WT, LAS float* scr, int item, int lane) {
    const int nblk = N / 32, kb = item / nblk, nb = item % nblk, k0 = 64 * kb, n0 = 32 * nb;
#pragma unroll 8
    for (int i = 0; i < 32; ++i) { const int kk = 2 * i + (lane >> 5); scr[kk * 33 + (lane & 31)] = W[(size_t)(k0 + kk) * N + n0 + (lane & 31)]; }
    LDS_FENCE();
    const int c = lane & 7;
#pragma unroll
    for (int j = 0; j < 4; ++j) { const int n = (lane >> 3) + 8 * j; const LAS float* s = scr + (8 * c) * 33 + n;
        u32x4 o; o.x = pk2(s[0 * 33], s[1 * 33]); o.y = pk2(s[2 * 33], s[3 * 33]); o.z = pk2(s[4 * 33], s[5 * 33]); o.w = pk2(s[6 * 33], s[7 * 33]);
        *(u32x4*)(WT + (size_t)(n0 + n) * K + k0 + 8 * c) = o; }
    LDS_FENCE();
}

__device__ __forceinline__ void ph_prologue(const KArgs& a, LAS unsigned char* lds, int tid, int wave, int lane) {
    const Inputs& in = a.in;
    float* MOD = (float*)(a.ws + OFF_MOD);
    LAS float* sil = (LAS float*)lds;
    LAS float* part = (LAS float*)(lds + 5 * 1024 * 4);
    if ((int)blockIdx.x < 192) {
        for (int i = tid; i < 5 * 1024; i += NTHR) { const int j = i >> 10, k = i & 1023; const float cv = j < 4 ? in.c[j * DM + k] : in.c_ctx[k]; sil[i] = cv / (1.f + expf(-cv)); }
        __syncthreads();
        for (int it = blockIdx.x; it < 192; it += gridDim.x) {
            const int l = it / 96, nb = it % 96, n = nb * 32 + (lane & 31), k0 = wave * 128 + (lane >> 5) * 64;
            const float* w = in.w_mod + (size_t)l * DM * 3072 + n;
            float acc[5] = {0.f, 0.f, 0.f, 0.f, 0.f};
#pragma unroll 8
            for (int kk = 0; kk < 64; ++kk) { const float wv = w[(size_t)(k0 + kk) * 3072];
#pragma unroll
                for (int j = 0; j < 5; ++j) acc[j] += sil[j * 1024 + k0 + kk] * wv; }
#pragma unroll
            for (int j = 0; j < 5; ++j) { acc[j] += __shfl_xor(acc[j], 32); if (lane < 32) part[(wave * 5 + j) * 32 + lane] = acc[j]; }
            __syncthreads();
            if (tid < 160) { const int j = tid >> 5, c = tid & 31; float s = in.b_mod[l * 3072 + nb * 32 + c];
#pragma unroll
                for (int w8 = 0; w8 < 8; ++w8) s += part[(w8 * 5 + j) * 32 + c];
                MOD[((size_t)l * 5 + j) * 3072 + nb * 32 + c] = s; }
            __syncthreads();
        }
    }
    __syncthreads();
    LAS float* scr = (LAS float*)(lds + wave * 16384);
    const int gw = blockIdx.x * NWV + wave, NGW = gridDim.x * NWV;
    constexpr int I_IN = (DM / 64) * (NIN / 32), I_OUT = (DM / 64) * (DM / 32), I_PAD = NP - NIN;
    constexpr int I_L = I_IN + I_OUT + I_PAD;
    bf16_t* WIN = (bf16_t*)(a.ws + OFF_WIN); bf16_t* WOUT = (bf16_t*)(a.ws + OFF_WOUT);
    for (int it = gw; it < 2 * I_L; it += NGW) {
        const int l = it / I_L; int r = it % I_L;
        if (r < I_IN) { transpose_item(in.w_in + (size_t)l * DM * NIN, DM, NIN, WIN + (size_t)l * NP * DM, scr, r, lane); continue; } r -= I_IN;
        if (r < I_OUT) { transpose_item(in.w_out + (size_t)l * DM * DM, DM, DM, WOUT + (size_t)l * DM * DM, scr, r, lane); continue; } r -= I_OUT;
        u32x4* zp = (u32x4*)(WIN + ((size_t)l * NP + NIN + r) * DM);
        zp[lane] = (u32x4){0u, 0u, 0u, 0u}; zp[lane + 64] = (u32x4){0u, 0u, 0u, 0u};
    }
    const int gt = blockIdx.x * NTHR + tid, NGT = gridDim.x * NTHR;
    bf16_t* WPT = (bf16_t*)(a.ws + OFF_WPT);
    if (gt < 512) { float* rt = (float*)(a.ws + OFF_ROPE); const int pos = gt >> 3, j = gt & 7; const float f = powf(10000.f, -(float)j / 8.f), ang = (float)pos * f; rt[gt] = cosf(ang); rt[512 + gt] = sinf(ang); }
    for (int i = gt; i < 2 * 4 * 64 * 64; i += NGT) { const int c = i & 63, e = (i >> 6) & 63, li = i >> 12; WPT[i] = f2bf(in.pool_w[(size_t)li * 4096 + c * 64 + e]); }
}

__device__ __forceinline__ void ph_post_pre(const KArgs& a, int lprev, int lnext, int wave, int lane) {
    const Inputs& in = a.in;
    const float* MOD = (const float*)(a.ws + OFF_MOD);
    const float* O = (const float*)(a.ws + OFF_P);
    float* XC = (float*)(a.ws + OFF_XC);
    bf16_t* H = (bf16_t*)(a.ws + OFF_H);
    const int gw = blockIdx.x * NWV + wave, NGW = gridDim.x * NWV;
    const int nrows = (lnext < 2) ? MTOT : NLAT;
    for (int row = gw; row < nrows; row += NGW) {
        const bool lat = row < NLAT; const int j = lat ? row / SEQ : 4;
        const float* xr; float* xw = nullptr;
        if (lprev <= 0) xr = lat ? in.x + (size_t)row * DM : in.ctx + (size_t)(row - NLAT) * DM;
        else xr = lat ? a.out + (size_t)row * DM : XC + (size_t)(row - NLAT) * DM;
        const bool post = (lprev >= 0) && (lat || lprev == 0);
        if (post) xw = lat ? a.out + (size_t)row * DM : XC + (size_t)(row - NLAT) * DM;
        f32x4 v[4];
#pragma unroll
        for (int q = 0; q < 4; ++q) v[q] = *(const f32x4*)(xr + 4 * lane + 256 * q);
        if (post) {
            f32x4 o[4]; float s = 0.f;
#pragma unroll
            for (int q = 0; q < 4; ++q) { o[q] = *(const f32x4*)(O + (size_t)row * DM + 4 * lane + 256 * q); s += (o[q].x * o[q].x + o[q].y * o[q].y) + (o[q].z * o[q].z + o[q].w * o[q].w); }
            const float rstd = rsqrtf(wave_sum(s) * (1.f / DM) + EPS);
            const float* gate = MOD + ((size_t)lprev * 5 + j) * 3072 + 2048; const float* gp = in.g_post + lprev * DM;
#pragma unroll
            for (int q = 0; q < 4; ++q) { const f32x4 gt = *(const f32x4*)(gate + 4 * lane + 256 * q), gg = *(const f32x4*)(gp + 4 * lane + 256 * q);
                v[q] = v[q] + gt * (o[q] * rstd * gg); *(f32x4*)(xw + 4 * lane + 256 * q) = v[q]; }
        }
        if (lnext < 2) {
            float s = 0.f;
#pragma unroll
            for (int q = 0; q < 4; ++q) s += (v[q].x * v[q].x + v[q].y * v[q].y) + (v[q].z * v[q].z + v[q].w * v[q].w);
            const float rstd = rsqrtf(wave_sum(s) * (1.f / DM) + EPS);
            const float* shift = MOD + ((size_t)lnext * 5 + j) * 3072; const float* scale = shift + 1024; const float* gp = in.g_pre + lnext * DM;
#pragma unroll
            for (int q = 0; q < 4; ++q) { const int k = 4 * lane + 256 * q; const f32x4 sh = *(const f32x4*)(shift + k), sc = *(const f32x4*)(scale + k), gg = *(const f32x4*)(gp + k);
                const f32x4 hv = (v[q] * rstd * gg) * (sc + 1.f) + sh;
                u32x2 w; w.x = pk2(hv.x, hv.y); w.y = pk2(hv.z, hv.w); *(u32x2*)(H + (size_t)row * DM + k) = w; }
        }
    }
}

typedef float f32x16 __attribute__((ext_vector_type(16)));
typedef float f32x2_t __attribute__((ext_vector_type(2)));
typedef __bf16 bf16x2_t __attribute__((ext_vector_type(2)));
#define MFMA16(a, b, c) __builtin_amdgcn_mfma_f32_16x16x32_bf16(a, b, c, 0, 0, 0)
#define MFMA32(a, b, c) __builtin_amdgcn_mfma_f32_32x32x16_bf16(a, b, c, 0, 0, 0)
__device__ __forceinline__ unsigned cvtpk(float lo, float hi) { f32x2_t v = {lo, hi}; bf16x2_t b = __builtin_convertvector(v, bf16x2_t); return __builtin_bit_cast(unsigned, b); }
__device__ __forceinline__ float fast_exp(float x) { return __builtin_amdgcn_exp2f(x * 1.4426950408889634f); }
__device__ __forceinline__ float fast_silu(float v) { return v * __builtin_amdgcn_rcpf(1.f + fast_exp(-v)); }
__device__ __forceinline__ float lo_bf(unsigned w) { return __uint_as_float(w << 16); }
__device__ __forceinline__ float hi_bf(unsigned w) { return __uint_as_float(w & 0xffff0000u); }


typedef short v4i16_t __attribute__((ext_vector_type(4)));
constexpr int NA_KV_BYTES = 832 * 128, NA_RPB_OFF = NA_KV_BYTES;

__device__ __forceinline__ void na_stage(const bf16_t* P, LAS unsigned char* kv, int colbase, int b, int U0, int nwin, int tid) {
    const int kr0 = tid >> 3, c = tid & 7;
    const unsigned toff = (unsigned)kr0 * NP + 8u * c;
    const bf16_t* gctx = P + (size_t)(NLAT + b * NCTX) * NP + colbase;
    const bf16_t* gwin = P + (size_t)(b * SEQ + U0 * 64) * NP + colbase;
    LAS unsigned char* lb = kv + kr0 * 128 + ((c ^ (kr0 & 7)) << 4);
    u32x4 v[7];
#pragma unroll
    for (int it = 0; it < 4; ++it) v[it] = *(const u32x4*)(gctx + (size_t)it * 64 * NP + toff);
#pragma unroll
    for (int it = 4; it < 7; ++it) if (it - 4 < nwin) v[it] = *(const u32x4*)(gwin + (size_t)(it - 4) * 64 * NP + toff);
#pragma unroll
    for (int it = 0; it < 4; ++it) *(LAS u32x4*)(lb + it * 8192) = v[it];
#pragma unroll
    for (int it = 4; it < 7; ++it) if (it - 4 < nwin) *(LAS u32x4*)(lb + it * 8192) = v[it];
#pragma unroll
    for (int it = 7; it < 13; ++it) if (it - 4 < nwin) v[it - 7] = *(const u32x4*)(gwin + (size_t)(it - 4) * 64 * NP + toff);
#pragma unroll
    for (int it = 7; it < 13; ++it) if (it - 4 < nwin) *(LAS u32x4*)(lb + it * 8192) = v[it - 7];
}

template <bool HW>
__device__ __forceinline__ void na_half(const LAS unsigned char* kbase, int sw0, int sw1, bf16x8 qf0, bf16x8 qf1, const LAS float* rp, int R0, int r, int CB, int cg, int li, int g,
                                        bf16x8 (&pf)[8], float& mo, float& lo_) {
    f32x4 S[16];
#pragma unroll
    for (int t = 0; t < 16; ++t) {
        const LAS unsigned char* kb = HW ? kbase + (t >> 1) * 8192 + (t & 1) * 2048 : kbase + t * 2048;
        const bf16x8 k0 = *(const LAS bf16x8*)(kb + sw0), k1 = *(const LAS bf16x8*)(kb + sw1);
        f32x4 acc = {0.f, 0.f, 0.f, 0.f};
        acc = MFMA16(k0, qf0, acc); acc = MFMA16(k1, qf1, acc); S[t] = acc;
    }
    float m = -INFINITY;
    if (HW) {
        const int c = cg * 16 + li, cs = min(max(c - 8, 0), 48);
        const LAS float* rb = rp + (R0 - r + 7) * 31 + (CB - c + 4 * g + 15);
        bool vld[8];
#pragma unroll
        for (int k = 0; k < 8; ++k) { const int kcol = CB + 16 * (k >> 2) + 4 * g + (k & 3); vld[k] = (kcol >= cs) && (kcol < cs + 16); }
#pragma unroll
        for (int wt = 0; wt < 16; ++wt) {
#pragma unroll
            for (int q = 0; q < 4; ++q) { const float bias = rb[(wt >> 1) * 31 + 16 * (wt & 1) + q];
                const float s = vld[4 * (wt & 1) + q] ? S[wt][q] * 0.125f + bias : -INFINITY; S[wt][q] = s; m = fmaxf(m, s); }
        }
    } else {
#pragma unroll
        for (int ct = 0; ct < 16; ++ct)
#pragma unroll
            for (int q = 0; q < 4; ++q) { const float s = S[ct][q] * 0.125f; S[ct][q] = s; m = fmaxf(m, s); }
    }
    m = fmaxf(m, __shfl_xor(m, 16)); m = fmaxf(m, __shfl_xor(m, 32));
    float lsum = 0.f;
#pragma unroll
    for (int u = 0; u < 8; ++u) {
        float p[8];
#pragma unroll
        for (int q = 0; q < 4; ++q) { p[q] = fast_exp(S[2 * u][q] - m); p[4 + q] = fast_exp(S[2 * u + 1][q] - m); }
#pragma unroll
        for (int q = 0; q < 8; ++q) lsum += p[q];
        u32x4 w; w.x = cvtpk(p[0], p[1]); w.y = cvtpk(p[2], p[3]); w.z = cvtpk(p[4], p[5]); w.w = cvtpk(p[6], p[7]);
        pf[u] = __builtin_bit_cast(bf16x8, w);
    }
    lsum += __shfl_xor(lsum, 16); lsum += __shfl_xor(lsum, 32);
    mo = m; lo_ = lsum;
}

template <bool WIN>
__device__ __forceinline__ void na_block(const KArgs& a, LAS unsigned char* lds, int b, int h, int R, int tid, int wave, int lane) {
    const bf16_t* P = (const bf16_t*)(a.ws + OFF_P); bf16_t* Y = (bf16_t*)(a.ws + OFF_H);
    LAS unsigned char* kv = lds; const LAS float* rpb = (const LAS float*)(lds + NA_RPB_OFF);
    const int li = lane & 15, g = lane >> 4;
    int r = 0, cg = 0, U0 = 0, nwin = 0, wo = 0, CB = 0, R0 = 0, qrow0;
    if (WIN) { r = 2 * R + (wave >> 2); cg = wave & 3; U0 = min(max(2 * R - 4, 0), 56); nwin = min(9, 64 - U0); R0 = min(max(r - 4, 0), 56); wo = R0 - U0;
        CB = min(max(cg * 16 - 8, 0), 32); qrow0 = b * SEQ + r * 64 + cg * 16; }
    else qrow0 = NLAT + b * NCTX + R * 128 + wave * 16;
    __syncthreads();
    na_stage(P, kv, C_NK + h * 64, b, U0, nwin, tid);
    const bf16_t* qp = P + (size_t)(qrow0 + li) * NP + C_NQ + h * 64 + 8 * g;
    const bf16x8 qf0 = *(const bf16x8*)qp, qf1 = *(const bf16x8*)(qp + 32);
    __syncthreads();
    const LAS unsigned char* kwin = kv + (256 + wo * 64 + CB + li) * 128; const LAS unsigned char* kctx = kv + li * 128;
    const int sw0 = (g ^ (li & 7)) << 4, sw1 = ((4 + g) ^ (li & 7)) << 4;
    bf16x8 pfw[8], pfc[8];
    float mw = -INFINITY, lw = 0.f, mc, lc;
    if (WIN) na_half<true>(kwin, sw0, sw1, qf0, qf1, rpb + h * 465, R0, r, CB, cg, li, g, pfw, mw, lw);
    na_half<false>(kctx, sw0, sw1, qf0, qf1, rpb, 0, 0, 0, 0, li, g, pfc, mc, lc);
    __syncthreads();
    na_stage(P, kv, C_NV + h * 64, b, U0, nwin, tid);
    __syncthreads();
    const int trow = 4 * g + (li >> 2), rl = trow & 7;
    LAS unsigned char* twin = kv + (256 + wo * 64 + CB + trow) * 128 + (li & 1) * 8; LAS unsigned char* tctx = kv + trow * 128 + (li & 1) * 8;
    int trs[4];
#pragma unroll
    for (int mt = 0; mt < 4; ++mt) trs[mt] = ((2 * mt + ((li & 3) >> 1)) ^ rl) << 4;
    f32x4 accw[4], acc[4];
#pragma unroll
    for (int mt = 0; mt < 4; ++mt) { accw[mt] = (f32x4){0.f, 0.f, 0.f, 0.f}; acc[mt] = (f32x4){0.f, 0.f, 0.f, 0.f}; }
    if (WIN) {
#pragma unroll
        for (int u = 0; u < 8; ++u)
#pragma unroll
            for (int mt = 0; mt < 4; ++mt) { const LAS unsigned char* tp = twin + trs[mt] + u * 8192;
                const v4i16_t lo = __builtin_amdgcn_ds_read_tr16_b64_v4i16((LAS v4i16_t*)tp), hi = __builtin_amdgcn_ds_read_tr16_b64_v4i16((LAS v4i16_t*)(tp + 2048));
                const bf16x8 af = {lo[0], lo[1], lo[2], lo[3], hi[0], hi[1], hi[2], hi[3]};
                accw[mt] = MFMA16(af, pfw[u], accw[mt]); }
    }
#pragma unroll
    for (int u = 0; u < 8; ++u)
#pragma unroll
        for (int mt = 0; mt < 4; ++mt) { const LAS unsigned char* tp = tctx + trs[mt] + u * 4096;
            const v4i16_t lo = __builtin_amdgcn_ds_read_tr16_b64_v4i16((LAS v4i16_t*)tp), hi = __builtin_amdgcn_ds_read_tr16_b64_v4i16((LAS v4i16_t*)(tp + 2048));
            const bf16x8 af = {lo[0], lo[1], lo[2], lo[3], hi[0], hi[1], hi[2], hi[3]};
            acc[mt] = MFMA16(af, pfc[u], acc[mt]); }
    float lsum = lc;
    if (WIN) { const float mm = fmaxf(mw, mc); const float f0 = fast_exp(mw - mm), f1 = fast_exp(mc - mm);
#pragma unroll
        for (int mt = 0; mt < 4; ++mt) acc[mt] = accw[mt] * f0 + acc[mt] * f1;
        lsum = lw * f0 + lc * f1; }
    const float inv = 1.f / lsum;
    const size_t row = (size_t)(qrow0 + li);
#pragma unroll
    for (int mt = 0; mt < 4; ++mt) {
        const int col = 256 + h * 64 + 16 * mt + 4 * g;
        const u32x2 gt = *(const u32x2*)(P + row * NP + C_GATE + col);
        u32x2 w;
        w.x = cvtpk(acc[mt][0] * inv * fast_silu(lo_bf(gt.x)), acc[mt][1] * inv * fast_silu(hi_bf(gt.x)));
        w.y = cvtpk(acc[mt][2] * inv * fast_silu(lo_bf(gt.y)), acc[mt][3] * inv * fast_silu(hi_bf(gt.y)));
        *(u32x2*)(Y + row * DM + col) = w;
    }
}

__device__ __forceinline__ void pool_item(const KArgs& a, int l, LAS unsigned char* lds, int cid, int tid, int wave, int lane) {
    const bf16_t* P = (const bf16_t*)(a.ws + OFF_P); bf16_t* Y = (bf16_t*)(a.ws + OFF_H);
    const bf16_t* WPT = (const bf16_t*)(a.ws + OFF_WPT) + (size_t)l * 4 * 64 * 64;
    const float* pscale = a.in.pool_scale + l * 256;
    LAS bf16_t* U = (LAS bf16_t*)lds;
    LAS bf16_t* M = U + 80 * 264;
    const bool lat = cid < 256;
    const int seq_len = lat ? SEQ : NCTX;
    const int seq_base = lat ? (cid >> 6) * SEQ : NLAT + ((cid - 256) >> 2) * NCTX;
    const int t0 = lat ? (cid & 63) * 64 : ((cid - 256) & 3) * 64;
    for (int i = tid; i < 80 * 32; i += NTHR) { const int tr = i >> 5, c8 = i & 31, tt = t0 - 8 + tr;
        u32x4 v = {0u, 0u, 0u, 0u};
        if (tt >= 0 && tt < seq_len) v = *(const u32x4*)(P + (size_t)(seq_base + tt) * NP + C_PU + c8 * 8);
        *(LAS u32x4*)(U + tr * 264 + c8 * 8) = v; }
    __syncthreads();
    {
        const int col = tid & 255, th = tid >> 8, part = col >> 6, w = 2 << part;
        for (int t = 32 * th; t < 32 * th + 32; ++t) {
            const int tt = t0 + t; const int lo = min(max(tt - w / 2, 0), seq_len), hi = min(max(tt - w / 2 + w, 0), seq_len);
            float s = 0.f;
            for (int ss = lo; ss < hi; ++ss) s += bf2f(U[(ss - t0 + 8) * 264 + col]);
            const float mv = s / (float)(hi - lo) - bf2f(U[(t + 8) * 264 + col]);
            M[t * 264 + col] = f2bf(mv);
        }
    }
    __syncthreads();
    {
        const int part = wave >> 1, th = wave & 1, li = lane & 15, g = lane >> 4;
        f32x4 acc[4][2];
#pragma unroll
        for (int mt = 0; mt < 4; ++mt) { acc[mt][0] = (f32x4){0.f, 0.f, 0.f, 0.f}; acc[mt][1] = (f32x4){0.f, 0.f, 0.f, 0.f}; }
#pragma unroll
        for (int s = 0; s < 2; ++s) {
            bf16x8 bfr[2];
#pragma unroll
            for (int nt = 0; nt < 2; ++nt) bfr[nt] = *(const LAS bf16x8*)(M + (32 * th + 16 * nt + li) * 264 + part * 64 + 32 * s + 8 * g);
#pragma unroll
            for (int mt = 0; mt < 4; ++mt) {
                const bf16x8 af = *(const bf16x8*)(WPT + ((size_t)(part * 64 + 16 * mt + li)) * 64 + 32 * s + 8 * g);
#pragma unroll
                for (int nt = 0; nt < 2; ++nt) acc[mt][nt] = MFMA16(af, bfr[nt], acc[mt][nt]);
            }
        }
#pragma unroll
        for (int nt = 0; nt < 2; ++nt) {
            const size_t row = (size_t)(seq_base + t0 + 32 * th + 16 * nt + li);
#pragma unroll
            for (int mt = 0; mt < 4; ++mt) {
                const int cl = part * 64 + 16 * mt + 4 * g;
                const f32x4 sc = *(const f32x4*)(pscale + cl);
                const u32x2 gt = *(const u32x2*)(P + row * NP + C_GATE + 768 + cl);
                u32x2 w;
                w.x = cvtpk(acc[mt][nt][0] * sc.x * fast_silu(lo_bf(gt.x)), acc[mt][nt][1] * sc.y * fast_silu(hi_bf(gt.x)));
                w.y = cvtpk(acc[mt][nt][2] * sc.z * fast_silu(lo_bf(gt.y)), acc[mt][nt][3] * sc.w * fast_silu(hi_bf(gt.y)));
                *(u32x2*)(Y + row * DM + 768 + cl) = w;
            }
        }
    }
    __syncthreads();
}

__device__ __forceinline__ void phC_na_ctx(const KArgs& a, int l, LAS unsigned char* lds, int tid, int wave, int lane) {
    if (l != 0) return;
    for (int u = blockIdx.x; u < 32; u += gridDim.x) na_block<false>(a, lds, u >> 3, (u >> 1) & 3, u & 1, tid, wave, lane);
    __syncthreads();
}
__device__ __forceinline__ void phD_na_pool(const KArgs& a, int l, LAS unsigned char* lds, int tid, int wave, int lane) {
    const int ncid = (l == 1) ? 256 : 272;
    for (int cid = gridDim.x - 1 - blockIdx.x; cid < ncid; cid += gridDim.x) pool_item(a, l, lds, cid, tid, wave, lane);
    LAS float* rpb = (LAS float*)(lds + NA_RPB_OFF);
    for (int i = tid; i < 4 * 465; i += NTHR) rpb[i] = a.in.na_rpb[l * 4 * 465 + i];
    for (int u = blockIdx.x; u < 512; u += gridDim.x) { const int ln = fresh_lane(); na_block<true>(a, lds, u >> 7, (u >> 5) & 3, u & 31, wave * 64 + ln, wave, ln); }
    __syncthreads();
}
constexpr int GL_QR = 0, GL_KR = 8192, GL_GFB = 16384, GL_ROPE = 24576, GL_TOT = 28672, GL_QC = 30720, GL_KF = 49152, GL_KB = 59392,
              GL_VT = 69632, GL_KFT = 88064, GL_KBT = 97280, GL_ATT = 106496;

__device__ __forceinline__ float logsigmoid_fast(float z) { return fminf(z, 0.f) - __logf(1.f + __expf(-fabsf(z))); }

template <bool LOCAL>
__device__ __forceinline__ void gla_prep(const KArgs& a, int l, LAS unsigned char* lds, int cid, int hp, int tid) {
    const bf16_t* P = (const bf16_t*)(a.ws + OFF_P);
    const size_t row0 = (size_t)cid * 64;
    const bool lat = cid < 256;
    LAS bf16_t* QR = (LAS bf16_t*)(lds + GL_QR); LAS bf16_t* KR = (LAS bf16_t*)(lds + GL_KR);
    LAS float* GFB = (LAS float*)(lds + GL_GFB); LAS float* ROPE = (LAS float*)(lds + GL_ROPE); LAS float* TOT = (LAS float*)(lds + GL_TOT);
    LAS bf16_t* QC = (LAS bf16_t*)(lds + GL_QC); LAS bf16_t* KF = (LAS bf16_t*)(lds + GL_KF); LAS bf16_t* KB = (LAS bf16_t*)(lds + GL_KB);
    LAS bf16_t* VT = (LAS bf16_t*)(lds + GL_VT); LAS bf16_t* KFT = (LAS bf16_t*)(lds + GL_KFT); LAS bf16_t* KBT = (LAS bf16_t*)(lds + GL_KBT);
    { const int t = tid >> 3, c8 = tid & 7;
      *(LAS u32x4*)(QR + t * 64 + c8 * 8) = *(const u32x4*)(P + (row0 + t) * NP + C_GQ + hp * 64 + c8 * 8);
      *(LAS u32x4*)(KR + t * 64 + c8 * 8) = *(const u32x4*)(P + (row0 + t) * NP + C_GK + hp * 64 + c8 * 8); }
    if (tid < 256) { const int t = tid >> 2, c8 = tid & 3; const u32x4 v = *(const u32x4*)(P + (row0 + t) * NP + C_GF + c8 * 8);
        LAS float* gp = GFB + t * 32 + c8 * 8;
        gp[0] = lo_bf(v.x); gp[1] = hi_bf(v.x); gp[2] = lo_bf(v.y); gp[3] = hi_bf(v.y); gp[4] = lo_bf(v.z); gp[5] = hi_bf(v.z); gp[6] = lo_bf(v.w); gp[7] = hi_bf(v.w); }
    { const float* rt = (const float*)(a.ws + OFF_ROPE); ROPE[tid] = rt[tid]; ROPE[tid + 512] = rt[tid + 512]; }
#pragma unroll
    for (int rep = 0; rep < 2; ++rep) { const int i = tid + rep * NTHR, t = i & 63, c16 = i >> 6;
        const u32x4 v = *(const u32x4*)(P + (row0 + t) * NP + C_GV + hp * 128 + c16 * 8);
        const int h2 = c16 >> 3, e0 = (c16 & 7) * 8; LAS bf16_t* vp = VT + (h2 * 64 + e0) * 72 + t;
        vp[0 * 72] = (bf16_t)(v.x & 0xffff); vp[1 * 72] = (bf16_t)(v.x >> 16); vp[2 * 72] = (bf16_t)(v.y & 0xffff); vp[3 * 72] = (bf16_t)(v.y >> 16);
        vp[4 * 72] = (bf16_t)(v.z & 0xffff); vp[5 * 72] = (bf16_t)(v.z >> 16); vp[6 * 72] = (bf16_t)(v.w & 0xffff); vp[7 * 72] = (bf16_t)(v.w >> 16); }
    __syncthreads();
    const int col = tid & 127, dir = col >> 6, h2 = (col >> 5) & 1, d = col & 31, tq = tid >> 7;
    const int h = 2 * hp + h2;
    float wg[16];
    { const float* wp = a.in.gla_w_gate + ((size_t)(l * 2 + dir) * 16) * 128 + h * 32 + d;
#pragma unroll
      for (int r = 0; r < 16; ++r) wg[r] = wp[r * 128]; }
    const float bg = a.in.gla_b_gate[(l * 2 + dir) * 128 + h * 32 + d];
    float lgv[16], pf[16]; float run = 0.f;
#pragma unroll
    for (int tt = 0; tt < 16; ++tt) { const LAS float* gp = GFB + (16 * tq + tt) * 32 + dir * 16;
        float z = bg;
#pragma unroll
        for (int r = 0; r < 16; ++r) z += gp[r] * wg[r];
        lgv[tt] = logsigmoid_fast(z) * (1.f / 16.f); run += lgv[tt]; pf[tt] = run; }
    TOT[tq * 128 + col] = run;
    __syncthreads();
    float off = 0.f, total = 0.f;
#pragma unroll
    for (int q = 0; q < 4; ++q) { const float v = TOT[q * 128 + col]; total += v; if (dir ? (q > tq) : (q < tq)) off += v; }
    const float qs = 0.17677669529663687f;
    const int i16 = d & 15, j8 = d & 7, dp = (i16 < 8) ? d + 8 : d - 8; const float sg = (i16 < 8) ? -1.f : 1.f;
#pragma unroll
    for (int tl = 0; tl < 16; ++tl) { const int t = 16 * tq + tl; const float cv = (dir ? run - pf[tl] + lgv[tl] : pf[tl]) + off;
        float k = bf2f(KR[t * 64 + h2 * 32 + d]), q = bf2f(QR[t * 64 + h2 * 32 + d]);
        if (lat) { const int tokpos = (cid & 63) * 64 + t; const int pos = (d & 16) ? (tokpos & 63) : (tokpos >> 6);
            const float cs = ROPE[pos * 8 + j8], sn = ROPE[512 + pos * 8 + j8];
            k = k * cs + sg * bf2f(KR[t * 64 + h2 * 32 + dp]) * sn; q = q * cs + sg * bf2f(QR[t * 64 + h2 * 32 + dp]) * sn; }
        if (LOCAL) { (dir ? KBT : KFT)[(h2 * 32 + d) * 72 + t] = f2bf(k * __expf(total - cv)); }
        else { QC[(h2 * 64 + t) * 72 + dir * 32 + d] = f2bf(q * qs * __expf(cv)); (dir ? KB : KF)[(h2 * 64 + t) * 40 + d] = f2bf(k * __expf(-cv)); }
    }
    if (LOCAL && tq == 0) { const int b = lat ? cid >> 6 : (cid - 256) >> 2; const int slot = lat ? 4 + (cid & 63) : (cid - 256) & 3;
        float* DEC = (float*)(a.ws + OFF_GDEC); DEC[((size_t)((b * 4 + h) * 2 + dir) * 68 + slot) * 32 + d] = __expf(total); }
    __syncthreads();
}

__device__ __forceinline__ void gla_local_unit(const KArgs& a, int l, LAS unsigned char* lds, int cid, int hp, int tid, int wave, int lane) {
    gla_prep<true>(a, l, lds, cid, hp, tid);
    if (wave < 4) {
        const int h2 = wave >> 1, dir = wave & 1, h = 2 * hp + h2, lr = lane & 31, hi = lane >> 5;
        const LAS bf16_t* VT = (const LAS bf16_t*)(lds + GL_VT) + h2 * 64 * 72;
        const LAS bf16_t* KT = (const LAS bf16_t*)(lds + (dir ? GL_KBT : GL_KFT)) + h2 * 32 * 72;
        f32x16 acc[2];
#pragma unroll
        for (int mt = 0; mt < 2; ++mt)
#pragma unroll
            for (int r = 0; r < 16; ++r) acc[mt][r] = 0.f;
#pragma unroll
        for (int s = 0; s < 4; ++s) {
            const bf16x8 bfr = *(const LAS bf16x8*)(KT + lr * 72 + 16 * s + 8 * hi);
#pragma unroll
            for (int mt = 0; mt < 2; ++mt) { const bf16x8 afr = *(const LAS bf16x8*)(VT + (32 * mt + lr) * 72 + 16 * s + 8 * hi); acc[mt] = MFMA32(afr, bfr, acc[mt]); }
        }
        const bool lat = cid < 256; const int b = lat ? cid >> 6 : (cid - 256) >> 2; const int slot = lat ? 4 + (cid & 63) : (cid - 256) & 3;
        float* LOC = (float*)(a.ws + OFF_GLOC) + ((size_t)((b * 4 + h) * 2 + dir) * 68 + slot) * 2048;
#pragma unroll
        for (int mt = 0; mt < 2; ++mt)
#pragma unroll
            for (int r = 0; r < 16; ++r) { const int e = 32 * mt + (r & 3) + 8 * (r >> 2) + 4 * hi; LOC[e * 32 + lr] = acc[mt][r]; }
    }
    __syncthreads();
}

__device__ __forceinline__ void gla_scan_item(const KArgs& a, int item, int tid) {
    const int chain = item >> 2, elem = (item & 3) * 512 + tid, d = elem & 31, dir = chain & 1;
    const float* LOC = (const float*)(a.ws + OFF_GLOC) + (size_t)chain * 68 * 2048 + elem;
    const float* DEC = (const float*)(a.ws + OFF_GDEC) + (size_t)chain * 68 * 32 + d;
    bf16_t* SIN = (bf16_t*)(a.ws + OFF_GSIN) + (size_t)chain * 68 * 2048 + elem;
    float S = 0.f;
    for (int st = 0; st < 68; st += 4) {
        float lv[4], dv[4]; int sl[4];
#pragma unroll
        for (int k = 0; k < 4; ++k) { sl[k] = dir ? 71 - (st + k) : st + k; if (dir && st + k < 4) sl[k] = 3 - (st + k); lv[k] = LOC[(size_t)sl[k] * 2048]; dv[k] = DEC[sl[k] * 32]; }
#pragma unroll
        for (int k = 0; k < 4; ++k) { SIN[(size_t)sl[k] * 2048] = f2bf(S); S = dv[k] * S + lv[k]; }
    }
}

__device__ __forceinline__ void gla_out_unit(const KArgs& a, int l, LAS unsigned char* lds, int cid, int hp, int tid, int wave, int lane) {
    gla_prep<false>(a, l, lds, cid, hp, tid);
    if (wave < 4) {
        const int h2 = wave >> 1, ih = wave & 1, h = 2 * hp + h2, lr = lane & 31, hi = lane >> 5;
        const LAS bf16_t* QC = (const LAS bf16_t*)(lds + GL_QC) + h2 * 64 * 72;
        const LAS bf16_t* KF = (const LAS bf16_t*)(lds + GL_KF) + h2 * 64 * 40;
        const LAS bf16_t* KB = (const LAS bf16_t*)(lds + GL_KB) + h2 * 64 * 40;
        const LAS bf16_t* VT = (const LAS bf16_t*)(lds + GL_VT) + h2 * 64 * 72;
        LAS bf16_t* ATT = (LAS bf16_t*)(lds + GL_ATT) + wave * 32 * 72;
        const int icol = 32 * ih + lr;
#pragma unroll
        for (int jt = 0; jt < 2; ++jt) {
            f32x16 df, db;
#pragma unroll
            for (int r = 0; r < 16; ++r) { df[r] = 0.f; db[r] = 0.f; }
#pragma unroll
            for (int s = 0; s < 2; ++s) {
                const bf16x8 af = *(const LAS bf16x8*)(KF + (32 * jt + lr) * 40 + 16 * s + 8 * hi), ab = *(const LAS bf16x8*)(KB + (32 * jt + lr) * 40 + 16 * s + 8 * hi);
                const bf16x8 bf_ = *(const LAS bf16x8*)(QC + icol * 72 + 16 * s + 8 * hi), bb_ = *(const LAS bf16x8*)(QC + icol * 72 + 32 + 16 * s + 8 * hi);
                df = MFMA32(af, bf_, df); db = MFMA32(ab, bb_, db);
            }
#pragma unroll
            for (int qd = 0; qd < 4; ++qd) { float v[4];
#pragma unroll
                for (int k = 0; k < 4; ++k) { const int j = 32 * jt + 8 * qd + 4 * hi + k; v[k] = (j <= icol ? df[4 * qd + k] : 0.f) + (j >= icol ? db[4 * qd + k] : 0.f); }
                u32x2 w; w.x = cvtpk(v[0], v[1]); w.y = cvtpk(v[2], v[3]);
                *(LAS u32x2*)(ATT + lr * 72 + 32 * jt + 8 * qd + 4 * hi) = w; }
        }
        LDS_FENCE();
        const bool lat = cid < 256; const int b = lat ? cid >> 6 : (cid - 256) >> 2; const int slot = lat ? 4 + (cid & 63) : (cid - 256) & 3;
        const bf16_t* SF = (const bf16_t*)(a.ws + OFF_GSIN) + ((size_t)((b * 4 + h) * 2 + 0) * 68 + slot) * 2048;
        const bf16_t* SB = SF + (size_t)68 * 2048;
        f32x16 acc[2];
#pragma unroll
        for (int mt = 0; mt < 2; ++mt)
#pragma unroll
            for (int r = 0; r < 16; ++r) acc[mt][r] = 0.f;
#pragma unroll
        for (int s = 0; s < 4; ++s) {
            const bf16x8 b1 = *(const LAS bf16x8*)(ATT + lr * 72 + 16 * s + 8 * hi);
            const bf16x8 b2 = *(const LAS bf16x8*)(QC + icol * 72 + 16 * s + 8 * hi);
#pragma unroll
            for (int mt = 0; mt < 2; ++mt) {
                const bf16x8 a1 = *(const LAS bf16x8*)(VT + (32 * mt + lr) * 72 + 16 * s + 8 * hi);
                const bf16_t* sp = (s < 2 ? SF : SB) + (32 * mt + lr) * 32 + 16 * (s & 1) + 8 * hi;
                const bf16x8 a2 = *(const bf16x8*)sp;
                acc[mt] = MFMA32(a1, b1, acc[mt]); acc[mt] = MFMA32(a2, b2, acc[mt]);
            }
        }
        float ss = 0.f;
#pragma unroll
        for (int mt = 0; mt < 2; ++mt)
#pragma unroll
            for (int r = 0; r < 16; ++r) ss += acc[mt][r] * acc[mt][r];
        ss += __shfl_xor(ss, 32);
        const float rstd = rsqrtf(ss * (1.f / 64.f) + EPS);
        const bf16_t* P = (const bf16_t*)(a.ws + OFF_P); bf16_t* Y = (bf16_t*)(a.ws + OFF_H);
        const float* gn = a.in.gla_g_norm + l * 64;
        const size_t row = (size_t)cid * 64 + icol;
#pragma unroll
        for (int mt = 0; mt < 2; ++mt)
#pragma unroll
            for (int qd = 0; qd < 4; ++qd) { const int e0 = 32 * mt + 8 * qd + 4 * hi;
                const f32x4 g4 = *(const f32x4*)(gn + e0);
                const u32x2 gt = *(const u32x2*)(P + row * NP + C_GATE + h * 64 + e0);
                u32x2 w;
                w.x = cvtpk(acc[mt][4 * qd + 0] * rstd * g4.x * fast_silu(lo_bf(gt.x)), acc[mt][4 * qd + 1] * rstd * g4.y * fast_silu(hi_bf(gt.x)));
                w.y = cvtpk(acc[mt][4 * qd + 2] * rstd * g4.z * fast_silu(lo_bf(gt.y)), acc[mt][4 * qd + 3] * rstd * g4.w * fast_silu(hi_bf(gt.y)));
                *(u32x2*)(Y + row * DM + h * 64 + e0) = w; }
    }
    __syncthreads();
}

__device__ __forceinline__ void phC_gla(const KArgs& a, int l, LAS unsigned char* lds, int tid, int wave, int lane) {
    for (int u = blockIdx.x; u < 544; u += gridDim.x) gla_local_unit(a, l, lds, u >> 1, u & 1, tid, wave, lane);
}
__device__ __forceinline__ void phD_gla(const KArgs& a, int tid) {
    for (int it = blockIdx.x; it < 128; it += gridDim.x) gla_scan_item(a, it, tid);
}
__device__ __forceinline__ void phE_gla(const KArgs& a, int l, LAS unsigned char* lds, int tid, int wave, int lane) {
    const int nu = (l == 1) ? 512 : 544;
    for (int u = blockIdx.x; u < nu; u += gridDim.x) gla_out_unit(a, l, lds, u >> 1, u & 1, tid, wave, lane);
}
constexpr int S5_WAVE_BYTES = 12544;
constexpr int S5_GT = 8 * S5_WAVE_BYTES;

__device__ __forceinline__ float gelu_tanh_fast(float v) { const float u = 0.7978845608028654f * (v + 0.044715f * v * v * v); return v * __builtin_amdgcn_rcpf(1.f + fast_exp(-2.f * u)); }

template <int DIR, bool READOUT>
__device__ __forceinline__ void s5_dir(const KArgs& a, int l, LAS unsigned char* wl, size_t row0, int g, int lane, float& xr, float& xi, f32x4 (&D2)[4]) {
    const bf16_t* P = (const bf16_t*)(a.ws + OFF_P);
    const int dgl = (l * 2 + DIR) * 16 + g;
    const bf16_t* BBT = (const bf16_t*)(a.ws + OFF_BBT) + (size_t)dgl * 128 * 16;
    const bf16_t* CMT = (const bf16_t*)(a.ws + OFF_CMT) + (size_t)dgl * 16 * 128;
    const f32x4 lb = *(const f32x4*)((const float*)(a.ws + OFF_SLB) + ((size_t)dgl * 64 + lane) * 4);
    const float lbr = lb.x, lbi = lb.y;
    LAS float* SCAN = (LAS float*)wl; LAS bf16_t* XB = (LAS bf16_t*)(wl + 8192);
    const int li = lane & 15, g4 = lane >> 4;
    const bf16x8 zero8 = {0, 0, 0, 0, 0, 0, 0, 0};
    bf16x8 bfr[8];
#pragma unroll
    for (int nt = 0; nt < 8; ++nt) bfr[nt] = (g4 < 2) ? *(const bf16x8*)(BBT + (16 * nt + li) * 16 + 8 * g4) : zero8;
#pragma unroll
    for (int step = 0; step < 4; ++step) {
        const int sb = DIR ? 3 - step : step;
        const bf16x8 afr = (g4 < 2) ? *(const bf16x8*)(P + (row0 + 16 * sb + li) * NP + C_SU + 16 * g + 8 * g4) : zero8;
#pragma unroll
        for (int nt = 0; nt < 8; ++nt) { f32x4 d = {0.f, 0.f, 0.f, 0.f}; d = MFMA16(afr, bfr[nt], d);
#pragma unroll
            for (int r = 0; r < 4; ++r) SCAN[(4 * g4 + r) * 128 + 16 * nt + li] = d[r]; }
        LDS_FENCE();
#pragma unroll
        for (int tt = 0; tt < 16; ++tt) { const int t = DIR ? 15 - tt : tt;
            const float bur = SCAN[t * 128 + lane], bui = SCAN[t * 128 + 64 + lane];
            const float nxr = lbr * xr - lbi * xi + bur, nxi = lbr * xi + lbi * xr + bui; xr = nxr; xi = nxi;
            if (READOUT) { XB[t * 136 + lane] = f2bf(xr); XB[t * 136 + 64 + lane] = f2bf(xi); } }
        LDS_FENCE();
        if (READOUT) {
#pragma unroll
            for (int s = 0; s < 4; ++s) { const bf16x8 xa = *(const LAS bf16x8*)(XB + li * 136 + 32 * s + 8 * g4);
                const bf16x8 cb = *(const bf16x8*)(CMT + li * 128 + 32 * s + 8 * g4);
                D2[sb] = MFMA16(xa, cb, D2[sb]); }
            LDS_FENCE();
        }
    }
}

__device__ __forceinline__ void s5_local_unit(const KArgs& a, int l, LAS unsigned char* lds, int cid, int wave, int lane) {
    const bool lat = cid < 256; const int b = lat ? cid >> 6 : (cid - 256) >> 2; const int slot = lat ? 4 + (cid & 63) : (cid - 256) & 3;
    LAS unsigned char* wl = lds + wave * S5_WAVE_BYTES;
    float* SXL = (float*)(a.ws + OFF_SXL);
    f32x4 dummy[4];
#pragma unroll
    for (int gi = 0; gi < 2; ++gi) { const int g = 2 * wave + gi;
        { float xr = 0.f, xi = 0.f; s5_dir<0, false>(a, l, wl, (size_t)cid * 64, g, lane, xr, xi, dummy);
          float* o = SXL + ((size_t)((b * 16 + g) * 2 + 0) * 68 + slot) * 128; o[lane] = xr; o[64 + lane] = xi; }
        { float xr = 0.f, xi = 0.f; s5_dir<1, false>(a, l, wl, (size_t)cid * 64, g, lane, xr, xi, dummy);
          float* o = SXL + ((size_t)((b * 16 + g) * 2 + 1) * 68 + slot) * 128; o[lane] = xr; o[64 + lane] = xi; }
    }
}

__device__ __forceinline__ void s5_scan_item(const KArgs& a, int l, int item, int tid) {
    const int chain = item * 8 + (tid >> 6), p = tid & 63, dir = chain & 1, g = (chain >> 1) & 15;
    const int dgl = (l * 2 + dir) * 16 + g;
    const f32x4 lb = *(const f32x4*)((const float*)(a.ws + OFF_SLB) + ((size_t)dgl * 64 + p) * 4);
    const float* SXL = (const float*)(a.ws + OFF_SXL) + (size_t)chain * 68 * 128 + p;
    float* SX0 = (float*)(a.ws + OFF_SX0) + (size_t)chain * 68 * 128 + p;
    float xr = 0.f, xi = 0.f;
    for (int st = 0; st < 68; st += 4) {
        float vr[4], vi[4]; int sl[4];
#pragma unroll
        for (int k = 0; k < 4; ++k) { sl[k] = dir ? 71 - (st + k) : st + k; if (dir && st + k < 4) sl[k] = 3 - (st + k); vr[k] = SXL[sl[k] * 128]; vi[k] = SXL[sl[k] * 128 + 64]; }
#pragma unroll
        for (int k = 0; k < 4; ++k) { SX0[sl[k] * 128] = xr; SX0[sl[k] * 128 + 64] = xi;
            const float nr = lb.z * xr - lb.w * xi + vr[k], ni = lb.z * xi + lb.w * xr + vi[k]; xr = nr; xi = ni; }
    }
}

__device__ __forceinline__ void s5_out_unit(const KArgs& a, int l, LAS unsigned char* lds, int cid, int tid, int wave, int lane) {
    const bf16_t* P = (const bf16_t*)(a.ws + OFF_P); bf16_t* Y = (bf16_t*)(a.ws + OFF_H);
    const bool lat = cid < 256; const int b = lat ? cid >> 6 : (cid - 256) >> 2; const int slot = lat ? 4 + (cid & 63) : (cid - 256) & 3;
    const size_t row0 = (size_t)cid * 64;
    LAS unsigned char* wl = lds + wave * S5_WAVE_BYTES;
    LAS bf16_t* GT = (LAS bf16_t*)(lds + S5_GT);
    const float* SX0 = (const float*)(a.ws + OFF_SX0);
    const float* dsk = a.in.s5_d + l * 256;
    const int li = lane & 15, g4 = lane >> 4;
#pragma unroll
    for (int gi = 0; gi < 2; ++gi) { const int g = 2 * wave + gi;
        f32x4 D2[4];
#pragma unroll
        for (int k = 0; k < 4; ++k) D2[k] = (f32x4){0.f, 0.f, 0.f, 0.f};
        { const float* x0 = SX0 + ((size_t)((b * 16 + g) * 2 + 0) * 68 + slot) * 128; float xr = x0[lane], xi = x0[64 + lane];
          s5_dir<0, true>(a, l, wl, row0, g, lane, xr, xi, D2); }
        { const float* x0 = SX0 + ((size_t)((b * 16 + g) * 2 + 1) * 68 + slot) * 128; float xr = x0[lane], xi = x0[64 + lane];
          s5_dir<1, true>(a, l, wl, row0, g, lane, xr, xi, D2); }
        const float dk = dsk[16 * g + li];
#pragma unroll
        for (int sb = 0; sb < 4; ++sb)
#pragma unroll
            for (int r = 0; r < 4; ++r) { const int t = 16 * sb + 4 * g4 + r;
                const float u = bf2f(P[(row0 + t) * NP + C_SU + 16 * g + li]);
                GT[t * 264 + 16 * g + li] = f2bf(gelu_tanh_fast(D2[sb][r] + u * dk)); }
    }
    __syncthreads();
    {
        const bf16_t* WGT = (const bf16_t*)(a.ws + OFF_WGT) + (size_t)l * 65536;
        f32x4 acc[2][4];
#pragma unroll
        for (int mi = 0; mi < 2; ++mi)
#pragma unroll
            for (int nt = 0; nt < 4; ++nt) acc[mi][nt] = (f32x4){0.f, 0.f, 0.f, 0.f};
#pragma unroll
        for (int s = 0; s < 8; ++s) {
            bf16x8 af[2], bfr[4];
#pragma unroll
            for (int mi = 0; mi < 2; ++mi) af[mi] = *(const bf16x8*)(WGT + (size_t)(16 * (2 * wave + mi) + li) * 256 + 32 * s + 8 * g4);
#pragma unroll
            for (int nt = 0; nt < 4; ++nt) bfr[nt] = *(const LAS bf16x8*)(GT + (16 * nt + li) * 264 + 32 * s + 8 * g4);
#pragma unroll
            for (int mi = 0; mi < 2; ++mi)
#pragma unroll
                for (int nt = 0; nt < 4; ++nt) acc[mi][nt] = MFMA16(af[mi], bfr[nt], acc[mi][nt]);
        }
        const float* bgl = a.in.s5_b_glu + l * 256;
#pragma unroll
        for (int mi = 0; mi < 2; ++mi) { const int m0 = 16 * (2 * wave + mi) + 4 * g4; const f32x4 bv = *(const f32x4*)(bgl + m0);
#pragma unroll
            for (int nt = 0; nt < 4; ++nt) { const int t = 16 * nt + li; const size_t row = row0 + t;
                const u32x2 gv = *(const LAS u32x2*)(GT + t * 264 + m0);
                const u32x2 gt = *(const u32x2*)(P + row * NP + C_GATE + 512 + m0);
                const float o0 = lo_bf(gv.x) * __builtin_amdgcn_rcpf(1.f + fast_exp(-(acc[mi][nt][0] + bv.x))) * fast_silu(lo_bf(gt.x));
                const float o1 = hi_bf(gv.x) * __builtin_amdgcn_rcpf(1.f + fast_exp(-(acc[mi][nt][1] + bv.y))) * fast_silu(hi_bf(gt.x));
                const float o2 = lo_bf(gv.y) * __builtin_amdgcn_rcpf(1.f + fast_exp(-(acc[mi][nt][2] + bv.z))) * fast_silu(lo_bf(gt.y));
                const float o3 = hi_bf(gv.y) * __builtin_amdgcn_rcpf(1.f + fast_exp(-(acc[mi][nt][3] + bv.w))) * fast_silu(hi_bf(gt.y));
                u32x2 w; w.x = cvtpk(o0, o1); w.y = cvtpk(o2, o3);
                *(u32x2*)(Y + row * DM + 512 + m0) = w; }
        }
    }
    __syncthreads();
}

__device__ __forceinline__ void phC_s5(const KArgs& a, int l, LAS unsigned char* lds, int wave, int lane) {
    for (int cid = blockIdx.x; cid < 272; cid += gridDim.x) s5_local_unit(a, l, lds, cid, wave, lane);
    __syncthreads();
}
__device__ __forceinline__ void phD_s5(const KArgs& a, int l, int tid) {
    const int vb = gridDim.x - 1 - blockIdx.x;
    for (int it = vb; it < 16; it += gridDim.x) s5_scan_item(a, l, it, tid);
}
__device__ __forceinline__ void phE_s5(const KArgs& a, int l, LAS unsigned char* lds, int tid, int wave, int lane) {
    const int nc = (l == 1) ? 256 : 272;
    for (int cid = blockIdx.x; cid < nc; cid += gridDim.x) s5_out_unit(a, l, lds, cid, tid, wave, lane);
}

__device__ __forceinline__ void pro_s5_tables(const KArgs& a, int tid) {
    const Inputs& in = a.in;
    const int gt = blockIdx.x * NTHR + tid, NGT = gridDim.x * NTHR;
    bf16_t* BBT = (bf16_t*)(a.ws + OFF_BBT); bf16_t* CMT = (bf16_t*)(a.ws + OFF_CMT); float* SLB = (float*)(a.ws + OFF_SLB); bf16_t* WGT = (bf16_t*)(a.ws + OFF_WGT);
    if (gt < 2 * 2 * 16 * 64) {
        const int p = gt & 63, dgl = gt >> 6;
        const float dt = expf(in.s5_log_dt[dgl]);
        const float lre = in.s5_lam_re[dgl * 64 + p], lim = in.s5_lam_im[dgl * 64 + p];
        const float mag = expf(lre * dt), ang = lim * dt;
        const float lbr = mag * cosf(ang), lbi = mag * sinf(ang);
        const float nr = lbr - 1.f, ni = lbi, den = lre * lre + lim * lim;
        const float cr = (nr * lre + ni * lim) / den, ci = (ni * lre - nr * lim) / den;
        for (int h = 0; h < 16; ++h) { const float br = in.s5_b_re[((size_t)dgl * 64 + p) * 16 + h], bi = in.s5_b_im[((size_t)dgl * 64 + p) * 16 + h];
            BBT[((size_t)dgl * 128 + p) * 16 + h] = f2bf(cr * br - ci * bi); BBT[((size_t)dgl * 128 + 64 + p) * 16 + h] = f2bf(cr * bi + ci * br); }
        float pr = lbr, pi = lbi;
        for (int k = 0; k < 6; ++k) { const float tr = pr * pr - pi * pi, ti = 2.f * pr * pi; pr = tr; pi = ti; }
        *(f32x4*)(SLB + ((size_t)dgl * 64 + p) * 4) = (f32x4){lbr, lbi, pr, pi};
    }
    for (int i = gt; i < 2 * 2 * 16 * 16 * 128; i += NGT) { const int pri = i & 127, h = (i >> 7) & 15, dgl = i >> 11;
        const float v = pri < 64 ? in.s5_c_re[((size_t)dgl * 16 + h) * 64 + pri] : -in.s5_c_im[((size_t)dgl * 16 + h) * 64 + pri - 64];
        CMT[i] = f2bf(v); }
    for (int i = gt; i < 2 * 65536; i += NGT) { const int n = i & 255, m = (i >> 8) & 255, li = i >> 16; WGT[i] = f2bf(in.s5_w_glu[(size_t)li * 65536 + n * 256 + m]); }
}
__global__ void __launch_bounds__(NTHR, 2) mega(KArgs a_by_value) {
    unsigned long long kp_ = (unsigned long long)__builtin_amdgcn_kernarg_segment_ptr();
    asm volatile("" : "+s"(kp_));
    const KArgs& a = *(const KArgs*)(const GAS KArgs*)kp_;
    extern __shared__ __attribute__((aligned(16))) unsigned char lds_raw[];
    LAS unsigned char* lds = (LAS unsigned char*)lds_raw;
    const int wave = __builtin_amdgcn_readfirstlane((int)threadIdx.x >> 6);
#define MY_LANE() fresh_lane()
#define T0() (wave == 0 && MY_LANE() == 0)
    const int tid = wave * 64 + MY_LANE();
    volatile LAS unsigned* MISC = (volatile LAS unsigned*)(lds + MISC_OFF);
    for (int u = tid; u < (LDS_BYTES - RING_BYTES) / 4; u += NTHR) ((LAS unsigned*)(lds + RING_BYTES))[u] = 0u;
    __syncthreads();
    unsigned* ctl = (unsigned*)(a.ws + OFF_CTL);
    XcdBarrier bar = xcd_barrier_post(ctl + CW_BAR + a.li * XCD_BAR_WORDS, MISC + 8, T0());
    const int lo = a.ph_lo, hi = a.ph_hi;
    cooperative_groups::this_grid().sync();
#define IN(k) (lo <= (k) && (k) < hi)
#define REP(i, ...) do { _Pragma("unroll") for (int rr = 0; rr <= kRep[i]; ++rr) { __VA_ARGS__; if (rr < kRep[i]) xcd_barrier(bar, T0()); } } while (0)
#define PHV const int lane_ = MY_LANE(); const int tid_ = wave * 64 + lane_
#define SEAM(k) do { if (IN(k) && IN((k) + 1)) { xcd_barrier(bar, T0()); } } while (0)
    if (IN(PH_PRO)) { PHV; REP(0, { ph_prologue(a, lds, tid_, wave, lane_); pro_s5_tables(a, tid_); }); for (int rr = 0; rr < kRep[7]; ++rr) xcd_barrier(bar, T0()); }
    SEAM(PH_PRO);
#define LAYER(l) do { \
        constexpr int pb = PH_L0 + (l) * PH_PER_LAYER; \
        constexpr int nrows_out = ((l) == 1) ? NLAT : MTOT; \
        if (IN(pb + 0)) { PHV; REP(1, ph_post_pre(a, (l) - 1, (l), wave, lane_)); } \
        SEAM(pb + 0); \
        if (IN(pb + 1)) { PHV; REP(2, { \
            pg8::Gemm g{(const bf16_t*)(a.ws + OFF_H), (const bf16_t*)(a.ws + OFF_WIN) + (size_t)(l) * NP * DM, MTOT, NP, DM}; \
            pg8::StaticOrder S; S.init(MTOT, NP, gridDim.x, blockIdx.x); \
            pg8::EpiBf16<0> E{(bf16_t*)(a.ws + OFF_P), NP, nullptr, 0, 0, 1.f}; \
            pg8::gemm_phase<pg8::EpiBf16<0>, pg8::StaticOrder, true, true>(lds, g, S, E, wave); }); \
        } \
        SEAM(pb + 1); \
        if (IN(pb + 2)) { PHV; REP(3, { if (a.mask & 1) phC_na_ctx(a, (l), lds, tid_, wave, lane_); if (a.mask & 2) phC_gla(a, (l), lds, tid_, wave, lane_); if (a.mask & 4) phC_s5(a, (l), lds, wave, lane_); }); } \
        SEAM(pb + 2); \
        if (IN(pb + 3)) { PHV; REP(4, { if (a.mask & 2) phD_gla(a, tid_); if (a.mask & 4) phD_s5(a, (l), tid_); if (a.mask & 1) phD_na_pool(a, (l), lds, tid_, wave, lane_); }); } \
        SEAM(pb + 3); \
        if (IN(pb + 4)) { PHV; REP(5, { if (a.mask & 2) phE_gla(a, (l), lds, tid_, wave, lane_); if (a.mask & 4) phE_s5(a, (l), lds, tid_, wave, lane_); }); } \
        SEAM(pb + 4); \
        if (IN(pb + 5)) { PHV; REP(6, { \
            pg8::Gemm g{(const bf16_t*)(a.ws + OFF_H), (const bf16_t*)(a.ws + OFF_WOUT) + (size_t)(l) * DM * DM, nrows_out, DM, DM}; \
            pg8::StaticOrder S; S.init(nrows_out, DM, gridDim.x, blockIdx.x); \
            pg8::EpiF32 E{(float*)(a.ws + OFF_P), DM, nullptr}; \
            pg8::gemm_phase<pg8::EpiF32, pg8::StaticOrder, true, true>(lds, g, S, E, wave); }); \
        } \
        SEAM(pb + 5); \
    } while (0)
    LAYER(0);
    LAYER(1);
#undef LAYER
    if (IN(PH_FIN)) { PHV; ph_post_pre(a, 1, 2, wave, lane_); }
#undef IN
#undef SEAM
}

static int g_grid = 0;
static void launch_mega(const KArgs& base, int lo, int hi, int li, hipStream_t stream) {
    KArgs a = base; a.ph_lo = lo; a.ph_hi = hi; a.li = li;
    void* args[] = {(void*)&a};
    hipError_t e = hipLaunchCooperativeKernel((const void*)mega, dim3(g_grid), dim3(NTHR), args, LDS_BYTES, stream);
    if (e != hipSuccess) fprintf(stderr, "cooperative launch failed: %s (grid %d)\n", hipGetErrorString(e), g_grid);
}

extern "C" void kernel_launch(void* const* d_in, const int* in_sizes, int n_in, void* d_out, int out_size, void* d_ws, size_t ws_size, hipStream_t stream) {
    if (g_grid == 0) {
        int dev = 0, cus = 0, per_cu = 0;
        hipGetDevice(&dev);
        hipDeviceGetAttribute(&cus, hipDeviceAttributeMultiprocessorCount, dev);
        hipFuncSetAttribute((const void*)mega, hipFuncAttributeMaxDynamicSharedMemorySize, LDS_BYTES);
        hipOccupancyMaxActiveBlocksPerMultiprocessor(&per_cu, (const void*)mega, NTHR, LDS_BYTES);
        if (per_cu < 1) per_cu = 1;
        g_grid = cus * per_cu;
        if (g_grid != 256) fprintf(stderr, "note: grid %d (cus %d x %d)\n", g_grid, cus, per_cu);
    }
    KArgs base;
    memset(&base, 0, sizeof(base));
    const float** ip = (const float**)&base.in;
    for (int i = 0; i < 26; ++i) ip[i] = (const float*)d_in[i];
    base.out = (float*)d_out; base.ws = (unsigned char*)d_ws; base.mask = 7;
    hipMemsetAsync((char*)d_ws + OFF_CTL, 0, CTL_BYTES, stream);
    launch_mega(base, PH_PRO, PH_END, 0, stream);
}
```

```cpp
#include <hip/hip_runtime.h>
#include <hip/hip_cooperative_groups.h>
#include <stdint.h>
#include <math.h>
#include <cstdio>
#include <cstring>

typedef unsigned short bf16_t;
__device__ __forceinline__ float bf2f(bf16_t v) { return __uint_as_float(((unsigned)v) << 16); }
__device__ __forceinline__ bf16_t f2bf(float f) { unsigned u = __float_as_uint(f); return (bf16_t)((u + 0x7fffu + ((u >> 16) & 1u)) >> 16); }

constexpr int DM = 1024, NB = 4, SEQ = 4096, NCTX = 256, GW = 64;
constexpr int NLAT = NB * SEQ;
constexpr int NCT = NB * NCTX;
constexpr int MTOT = NLAT + NCT;
constexpr int NIN = 2848, NP = 3072;
constexpr int C_GK = 0, C_GV = 128, C_GF = 384, C_GB = 400, C_NK = 416, C_NV = 672, C_SU = 928, C_GQ = 1184, C_NQ = 1312, C_PU = 1568, C_GATE = 1824;
constexpr float EPS = 1e-6f;

constexpr size_t OFF_CTL = 0, CTL_BYTES = 256 * 1024;
constexpr size_t OFF_WIN = OFF_CTL + CTL_BYTES;
constexpr size_t OFF_WOUT = OFF_WIN + (size_t)2 * NP * DM * 2;
constexpr size_t OFF_MOD = OFF_WOUT + (size_t)2 * DM * DM * 2;
constexpr size_t OFF_H = OFF_MOD + (size_t)2 * 5 * 3072 * 4 + 1024;
constexpr size_t OFF_P = OFF_H + (size_t)MTOT * DM * 2;
constexpr size_t OFF_XC = OFF_P + (size_t)MTOT * NP * 2;
constexpr size_t OFF_VTL = OFF_XC + (size_t)NCT * DM * 4;
constexpr size_t OFF_VTC = OFF_VTL + (size_t)1024 * SEQ * 2;
constexpr size_t OFF_WPT = OFF_VTC + (size_t)1024 * NCTX * 2;
constexpr size_t OFF_ROPE = OFF_WPT + (size_t)2 * 4 * 64 * 64 * 2;
constexpr size_t OFF_GLOC = OFF_ROPE + 4096;
constexpr size_t OFF_GDEC = OFF_GLOC + (size_t)32 * 68 * 2048 * 4;
constexpr size_t OFF_GSIN = OFF_GDEC + (size_t)32 * 68 * 32 * 4;
constexpr size_t OFF_BBT = OFF_GSIN + (size_t)32 * 68 * 2048 * 2;
constexpr size_t OFF_CMT = OFF_BBT + (size_t)64 * 128 * 16 * 2;
constexpr size_t OFF_SLB = OFF_CMT + (size_t)64 * 16 * 128 * 2;
constexpr size_t OFF_WGT = OFF_SLB + (size_t)64 * 64 * 16;
constexpr size_t OFF_SXL = OFF_WGT + (size_t)2 * 65536 * 2;
constexpr size_t OFF_SX0 = OFF_SXL + (size_t)128 * 68 * 128 * 4;
constexpr size_t OFF_END = OFF_SX0 + (size_t)128 * 68 * 128 * 4;
static_assert(OFF_END <= (size_t)256 * 1024 * 1024, "ws");

struct Inputs {
    const float *x, *c, *ctx, *c_ctx, *w_mod, *b_mod, *g_pre, *g_post, *w_in, *w_out, *gla_w_gate, *gla_b_gate, *gla_g_norm, *na_rpb,
        *s5_lam_re, *s5_lam_im, *s5_log_dt, *s5_b_re, *s5_b_im, *s5_c_re, *s5_c_im, *s5_d, *s5_w_glu, *s5_b_glu, *pool_w, *pool_scale;
};

__device__ __forceinline__ float silu_f(float v) { return v / (1.f + expf(-v)); }
__device__ __forceinline__ float sigmoid_f(float v) { return 1.f / (1.f + expf(-v)); }
__device__ __forceinline__ float gelu_tanh_f(float v) { const float k = 0.7978845608028654f; return 0.5f * v * (1.f + tanhf(k * (v + 0.044715f * v * v * v))); }
__device__ __forceinline__ float logsigmoid_f(float z) { return fminf(z, 0.f) - log1pf(expf(-fabsf(z))); }

#define LAS __attribute__((address_space(3)))
__device__ __forceinline__ int fresh_lane();
namespace pg8 {
#define PG8_LAS __attribute__((address_space(3)))
typedef unsigned short bf16_t;
typedef short bf16x8 __attribute__((ext_vector_type(8)));
typedef float f32x4 __attribute__((ext_vector_type(4)));
typedef unsigned u32x4 __attribute__((ext_vector_type(4)));
constexpr int BM = 256, BK = 64, HALF = 128, HTB = HALF * BK * 2  , STAGE_BYTES = 8 * HTB, NXCD = 8, WGM = 8;

__host__ __device__ __forceinline__ int lds_byte(int r, int c) { const int st = (r >> 4) * 2 + (c >> 5), rr = r & 15, cc = c & 31, ob = rr * 64 + cc * 2; return st * 1024 + (ob ^ (((ob >> 9) & 1) << 5)); }
__host__ __device__ __forceinline__ void stage_rc(int b, int& R, int& C) { const int st = b / 1024, sb = b % 1024, swz = sb ^ (((sb >> 9) & 1) << 5); R = (st >> 1) * 16 + swz / 64; C = (st & 1) * 32 + (swz % 64) / 2; }
__host__ __device__ __forceinline__ int perm32(int rho) { const int n = rho >> 4, i = rho & 15; return 8 * (i >> 2) + 4 * n + (i & 3); }

struct Unit { int pm, pn; };
struct Gemm { const bf16_t* A; const bf16_t* Bt; int M, N, K; };

struct StaticOrder {
    int nM, nN, nwg, G, c;
    __host__ __device__ void init(int M, int N, int G_, int c_) { nM = M / BM; nN = N / BM; nwg = nM * nN; G = G_; c = c_; }
    __host__ __device__ bool next(int i, Unit& u) const {
        const long L = (long)i * G + c; if (L >= nwg) return false;
        int wgid = (int)L; { const int q = nwg / NXCD, r = nwg % NXCD, xcd = wgid % NXCD, off = wgid / NXCD; wgid = (xcd < r ? xcd * (q + 1) : r * (q + 1) + (xcd - r) * q) + off; }
        const int nig = WGM * nN, gid = wgid / nig, fm = gid * WGM, gsz = (nM - fm) < WGM ? (nM - fm) : WGM;
        u.pm = fm + ((wgid % nig) % gsz); u.pn = (wgid % nig) / gsz; return true;
    }
    __device__ __forceinline__ void a_ready(const Unit&) const {}
    __device__ __forceinline__ void done(const Unit&) const {}
};

__device__ __forceinline__ unsigned cvt_pk_bf16(float lo, float hi) { unsigned r; asm volatile("v_cvt_pk_bf16_f32 %0, %1, %2" : "=v"(r) : "v"(lo), "v"(hi)); return r; }
typedef float f32x2 __attribute__((ext_vector_type(2)));
__device__ __forceinline__ f32x2 gelu_pk(f32x2 v) {
    const f32x2 av = __builtin_elementwise_abs(v), d = av * 0.2316418882f + 1.0f;
    f32x2 t; t.x = __builtin_amdgcn_rcpf(d.x); t.y = __builtin_amdgcn_rcpf(d.y);
    f32x2 q = t * 0.5307027145f + (-0.7265760135f); q = q * t + 0.7107068705f; q = q * t + (-0.142248368f); q = q * t + 0.127414796f; q = q * t;
    const f32x2 s = (v * v) * (-0.72134752044f);
    f32x2 e; e.x = __builtin_amdgcn_exp2f(s.x); e.y = __builtin_amdgcn_exp2f(s.y);
    const f32x2 m = v * (q * e), r = v - m;
    f32x2 o; o.x = v.x < 0.f ? m.x : r.x; o.y = v.y < 0.f ? m.y : r.y; return o;
}

template <int ACT  > struct EpiBf16 {
    static constexpr bool PERM = true, AFTER_DRAIN = false; static_assert(ACT == 0 || ACT == 1, "EpiBf16: ACT is 0 (none) or 1 (gelu_pk)");
    bf16_t* O; int ldc; const float* bias; int split_cols; size_t split_stride; float scale0;
    __device__ __forceinline__ void operator()(const f32x4 (&acc)[2][2][4][2], const Unit& u, int wr, int wc, int fr, int fq) const {
        const int row0 = u.pm * BM + wr * 64 + fr; int colt = u.pn * BM; bf16_t* base = O;
        float sc = 1.f; if (split_cols) { const int t = colt / split_cols; base += (size_t)t * split_stride; colt -= t * split_cols; if (t == 0) sc = scale0; }
        const int col0 = colt + wc * 32 + 8 * fq, bcol0 = u.pn * BM + wc * 32 + 8 * fq;
        f32x4 bv[2][2];
#pragma unroll
        for (int bj = 0; bj < 2; ++bj)
#pragma unroll
            for (int n = 0; n < 2; ++n) bv[bj][n] = bias ? *(const f32x4*)(bias + bcol0 + bj * HALF + 4 * n) : (f32x4){0.f, 0.f, 0.f, 0.f};
#pragma unroll
        for (int ai = 0; ai < 2; ++ai)
#pragma unroll
            for (int m = 0; m < 4; ++m) { bf16_t* rowp = base + (size_t)(row0 + ai * HALF + m * 16) * ldc + col0;
#pragma unroll
                for (int bj = 0; bj < 2; ++bj) { f32x4 v0 = acc[ai][bj][m][0] + bv[bj][0], v1 = acc[ai][bj][m][1] + bv[bj][1];
                    if (ACT == 1) { f32x2 a = gelu_pk((f32x2){v0[0], v0[1]}), b = gelu_pk((f32x2){v0[2], v0[3]}), c = gelu_pk((f32x2){v1[0], v1[1]}), d = gelu_pk((f32x2){v1[2], v1[3]});
                        v0 = (f32x4){a.x, a.y, b.x, b.y}; v1 = (f32x4){c.x, c.y, d.x, d.y}; }
                    v0 = v0 * sc; v1 = v1 * sc; u32x4 w; w.x = cvt_pk_bf16(v0[0], v0[1]); w.y = cvt_pk_bf16(v0[2], v0[3]); w.z = cvt_pk_bf16(v1[0], v1[1]); w.w = cvt_pk_bf16(v1[2], v1[3]);
                    *(u32x4*)(rowp + bj * HALF) = w; } }
    }
};
struct EpiF32 {
    static constexpr bool PERM = false, AFTER_DRAIN = false;
    float* C; int ldc; const float* bias;
    __device__ __forceinline__ void operator()(const f32x4 (&acc)[2][2][4][2], const Unit& u, int wr, int wc, int fr, int fq) const {
        const int row0 = u.pm * BM + wr * 64 + fr, col0 = u.pn * BM + wc * 32 + 4 * fq;
        f32x4 bv[2][2];
#pragma unroll
        for (int bj = 0; bj < 2; ++bj)
#pragma unroll
            for (int n = 0; n < 2; ++n) bv[bj][n] = bias ? *(const f32x4*)(bias + col0 + bj * HALF + n * 16) : (f32x4){0.f, 0.f, 0.f, 0.f};
#pragma unroll
        for (int ai = 0; ai < 2; ++ai)
#pragma unroll
            for (int m = 0; m < 4; ++m) { float* rowp = C + (size_t)(row0 + ai * HALF + m * 16) * ldc + col0;
#pragma unroll
                for (int bj = 0; bj < 2; ++bj)
#pragma unroll
                    for (int n = 0; n < 2; ++n) *(f32x4*)(rowp + bj * HALF + n * 16) = acc[ai][bj][m][n] + bv[bj][n]; }
    }
};
template <class Epi, class Sched, bool ALIGN_EPI = false, bool SP2 = false>
__device__ __forceinline__ void gemm_phase(PG8_LAS unsigned char* lds, const Gemm g, const Sched& S, const Epi& E, const int wave_in) {
    const int lane = fresh_lane(), wid = wave_in, tid = wid * 64 + lane, wr = wid >> 2, wc = wid & 3, fr = lane & 15, fq = lane >> 4;
    const int K = g.K, nt = K / BK;
    unsigned voffA[2], voffB[2];
#pragma unroll
    for (int i = 0; i < 2; ++i) { int R, C; stage_rc(tid * 16 + i * 8192, R, C); const int Rb = Epi::PERM ? ((R & ~31) + perm32(R & 31)) : R;
        voffA[i] = (unsigned)(R * K + C) * 2u; voffB[i] = (unsigned)(Rb * K + C) * 2u; }
    const size_t kstep = (size_t)(BK * 2);
    const size_t hstep = (size_t)HALF * K * 2;
    const size_t tstep = 2 * hstep;
    const unsigned ldsw = (unsigned)wid * 1024u;
    const int aoff = lds_byte(wr * 64 + fr, fq * 8), boff = lds_byte(wc * 32 + fr, fq * 8);
#define PG8_SA(b, h) (((b) * 2 + (h)) * HTB)
#define PG8_SB(b, h) ((4 + (b) * 2 + (h)) * HTB)
#define PG8_STAGE(bufoff, gbase, voff) do { _Pragma("unroll") for (int _i = 0; _i < 2; ++_i) \
        __builtin_amdgcn_global_load_lds((const unsigned*)((const char*)(gbase) + (voff)[_i]), (PG8_LAS unsigned*)(lds + (bufoff) + ldsw + _i * 8192), 16, 0, 0); } while (0)
#define PG8_LDA(dst, b, h) do { _Pragma("unroll") for (int m = 0; m < 4; ++m) _Pragma("unroll") for (int k = 0; k < 2; ++k) dst[m][k] = *(const PG8_LAS bf16x8*)(lds + PG8_SA(b, h) + aoff + m * 2048 + k * 1024); } while (0)
#define PG8_LDB(dst, b, h) do { _Pragma("unroll") for (int n = 0; n < 2; ++n) _Pragma("unroll") for (int k = 0; k < 2; ++k) dst[n][k] = *(const PG8_LAS bf16x8*)(lds + PG8_SB(b, h) + boff + n * 2048 + k * 1024); } while (0)
#define PG8_MMA(ai, bj, At, Bt) do { __builtin_amdgcn_s_setprio(1); _Pragma("unroll") for (int m = 0; m < 4; ++m) _Pragma("unroll") for (int n = 0; n < 2; ++n) _Pragma("unroll") for (int k = 0; k < 2; ++k) \
        acc[ai][bj][m][n] = __builtin_amdgcn_mfma_f32_16x16x32_bf16(Bt[n][k], At[m][k], acc[ai][bj][m][n], 0, 0, 0); __builtin_amdgcn_s_setprio(0); } while (0)
#define PG8_WAIT_V(n) asm volatile("s_waitcnt vmcnt(" #n ")" ::: "memory")
#define PG8_WAIT_L(n) asm volatile("s_waitcnt lgkmcnt(" #n ")" ::: "memory")
#define PG8_BAR __builtin_amdgcn_s_barrier()
#define PG8_SCHED __builtin_amdgcn_sched_barrier(0)
    Unit cur, nxt; int ui = 0;
    if (!S.next(0, cur)) return;
    f32x4 acc[2][2][4][2];
#pragma unroll
    for (int a = 0; a < 2; ++a)
#pragma unroll
        for (int b = 0; b < 2; ++b)
#pragma unroll
            for (int m = 0; m < 4; ++m)
#pragma unroll
                for (int n = 0; n < 2; ++n) acc[a][b][m][n] = (f32x4){0.f, 0.f, 0.f, 0.f};
    bf16x8 At[4][2], B0[2][2], B1[2][2];
    const char* cA = (const char*)g.A + (size_t)cur.pm * tstep; const char* cB = (const char*)g.Bt + (size_t)cur.pn * tstep;
    S.a_ready(cur);
    if constexpr (SP2) {
        PG8_STAGE(PG8_SB(0, 0), cB, voffB); PG8_STAGE(PG8_SB(0, 1), cB + hstep, voffB); PG8_STAGE(PG8_SA(0, 0), cA, voffA); PG8_STAGE(PG8_SA(0, 1), cA + hstep, voffA);
        if (wr == 1) PG8_BAR;
        PG8_WAIT_V(2); PG8_BAR;
        PG8_STAGE(PG8_SB(1, 0), cB + kstep, voffB); PG8_STAGE(PG8_SA(1, 0), cA + kstep, voffA); PG8_STAGE(PG8_SB(1, 1), cB + hstep + kstep, voffB);
        PG8_WAIT_V(6); PG8_BAR;
    } else {
        PG8_STAGE(PG8_SB(0, 0), cB, voffB); PG8_STAGE(PG8_SA(0, 0), cA, voffA); PG8_STAGE(PG8_SB(0, 1), cB + hstep, voffB); PG8_STAGE(PG8_SA(0, 1), cA + hstep, voffA);
        if (wr == 1) PG8_BAR;
        PG8_WAIT_V(4); PG8_BAR;
        PG8_STAGE(PG8_SB(1, 0), cB + kstep, voffB); PG8_STAGE(PG8_SA(1, 0), cA + kstep, voffA); PG8_STAGE(PG8_SB(1, 1), cB + hstep + kstep, voffB);
        PG8_WAIT_V(6); PG8_BAR;
    }
    for (;;) {
        const bool has_next = S.next(ui + 1, nxt);
        const char* nA = has_next ? (const char*)g.A + (size_t)nxt.pm * tstep : cA; const char* nB = has_next ? (const char*)g.Bt + (size_t)nxt.pn * tstep : cB;
        for (int t = 0; t < nt; t += 2) {
            const bool last = (t == nt - 2);
            const char* a1 = cA + (size_t)(t + 1) * kstep;
            const char* a2 = last ? nA : cA + (size_t)(t + 2) * kstep; const char* b2 = last ? nB : cB + (size_t)(t + 2) * kstep;
            const char* a3 = a2 + kstep; const char* b3 = b2 + kstep;
            if (last && has_next) S.a_ready(nxt);
            if constexpr (SP2) {
            PG8_LDB(B0, 0, 0); PG8_LDB(B1, 0, 1); PG8_SCHED; PG8_LDA(At, 0, 0); PG8_STAGE(PG8_SA(1, 1), a1 + hstep, voffA);
            PG8_WAIT_V(8); PG8_WAIT_L(0); PG8_BAR; PG8_MMA(0, 0, At, B0); PG8_MMA(0, 1, At, B1); PG8_BAR; PG8_SCHED;
            PG8_LDA(At, 0, 1); PG8_STAGE(PG8_SB(0, 0), b2, voffB); PG8_STAGE(PG8_SB(0, 1), b2 + hstep, voffB); PG8_STAGE(PG8_SA(0, 0), a2, voffA);
            PG8_WAIT_V(8); PG8_WAIT_L(0); PG8_BAR; PG8_MMA(1, 0, At, B0); PG8_MMA(1, 1, At, B1); PG8_BAR; PG8_SCHED;
            PG8_LDB(B0, 1, 0); PG8_LDB(B1, 1, 1); PG8_SCHED; PG8_LDA(At, 1, 0); PG8_STAGE(PG8_SA(0, 1), a2 + hstep, voffA);
            PG8_WAIT_V(8); PG8_WAIT_L(0); PG8_BAR; PG8_MMA(0, 0, At, B0); PG8_MMA(0, 1, At, B1); PG8_BAR; PG8_SCHED;
            PG8_LDA(At, 1, 1); PG8_STAGE(PG8_SB(1, 0), b3, voffB); PG8_STAGE(PG8_SB(1, 1), b3 + hstep, voffB); PG8_STAGE(PG8_SA(1, 0), a3, voffA);
            PG8_WAIT_V(8); PG8_WAIT_L(0); PG8_BAR; PG8_MMA(1, 0, At, B0); PG8_MMA(1, 1, At, B1); PG8_BAR; PG8_SCHED;
            } else {
            PG8_LDB(B0, 0, 0); PG8_SCHED; PG8_LDA(At, 0, 0); PG8_STAGE(PG8_SA(1, 1), a1 + hstep, voffA);
            PG8_WAIT_L(8); PG8_BAR; PG8_WAIT_L(0); PG8_MMA(0, 0, At, B0); PG8_BAR; PG8_SCHED;
            PG8_LDB(B1, 0, 1); PG8_STAGE(PG8_SB(0, 0), b2, voffB);
            PG8_BAR; PG8_WAIT_L(0); PG8_MMA(0, 1, At, B1); PG8_BAR;
            PG8_LDA(At, 0, 1); PG8_STAGE(PG8_SA(0, 0), a2, voffA);
            PG8_BAR; PG8_WAIT_L(0); PG8_MMA(1, 0, At, B0); PG8_BAR; PG8_SCHED;
            PG8_STAGE(PG8_SB(0, 1), b2 + hstep, voffB);
            PG8_WAIT_V(6); PG8_BAR; PG8_MMA(1, 1, At, B1); PG8_BAR;
            PG8_LDB(B0, 1, 0); PG8_SCHED; PG8_LDA(At, 1, 0); PG8_STAGE(PG8_SA(0, 1), a2 + hstep, voffA);
            PG8_WAIT_L(8); PG8_BAR; PG8_WAIT_L(0); PG8_MMA(0, 0, At, B0); PG8_BAR; PG8_SCHED;
            PG8_LDB(B1, 1, 1); PG8_STAGE(PG8_SB(1, 0), b3, voffB);
            PG8_BAR; PG8_WAIT_L(0); PG8_MMA(0, 1, At, B1); PG8_BAR;
            PG8_LDA(At, 1, 1); PG8_STAGE(PG8_SA(1, 0), a3, voffA);
            PG8_BAR; PG8_WAIT_L(0); PG8_MMA(1, 0, At, B0); PG8_BAR; PG8_SCHED;
            PG8_STAGE(PG8_SB(1, 1), b3 + hstep, voffB);
            PG8_WAIT_V(6); PG8_BAR; PG8_MMA(1, 1, At, B1); PG8_BAR;
            }
        }
        if constexpr (ALIGN_EPI) { if (wr == 0) PG8_BAR; }
        if constexpr (!Epi::AFTER_DRAIN) { E(acc, cur, wr, wc, fr, fq); S.done(cur); }
        if (!has_next) break;
#pragma unroll
        for (int a = 0; a < 2; ++a)
#pragma unroll
            for (int b = 0; b < 2; ++b)
#pragma unroll
                for (int m = 0; m < 4; ++m)
#pragma unroll
                    for (int n = 0; n < 2; ++n) acc[a][b][m][n] = (f32x4){0.f, 0.f, 0.f, 0.f};
        cur = nxt; cA = nA; cB = nB; ++ui;
        if constexpr (ALIGN_EPI) { if (wr == 1) PG8_BAR; }
    }
    PG8_WAIT_V(0);
    if constexpr (!ALIGN_EPI) { if (wr == 0) PG8_BAR; }
    PG8_BAR;
    if constexpr (Epi::AFTER_DRAIN) { E.fused(acc, cur, wr, wc, fr, fq, lds, wid, lane); S.done(cur); }
#undef PG8_SA
#undef PG8_SB
#undef PG8_STAGE
#undef PG8_LDA
#undef PG8_LDB
#undef PG8_MMA
#undef PG8_WAIT_V
#undef PG8_WAIT_L
#undef PG8_BAR
#undef PG8_SCHED
}
}
#define XB_TMO      128
#define XB_XCNT(j)  (256  + 64 * (j))
#define XB_XSUB(j)  (1280 + 64 * (j))
#define XB_XGEN(j)  (2304 + 64 * (j))
#define XB_TOP      3328
#define XB_TOPGEN   3392
#define XCD_BAR_WORDS 3456
#define XB_SPIN_CAP (1u << 18)

__device__ __forceinline__ unsigned xb_ld(unsigned* p)              { return __hip_atomic_load(p, __ATOMIC_RELAXED, __HIP_MEMORY_SCOPE_AGENT); }
__device__ __forceinline__ unsigned xb_add(unsigned* p, unsigned v) { return __hip_atomic_fetch_add(p, v, __ATOMIC_RELAXED, __HIP_MEMORY_SCOPE_AGENT); }
__device__ __forceinline__ unsigned xb_xcc_id() { return (unsigned)__builtin_amdgcn_s_getreg((3 << 11) | 20) & 0xFu; }
#define XB_SPIN(cond, bar) do { unsigned _sp = 0; while (cond) { __builtin_amdgcn_s_sleep(1); \
    if ((++_sp & 255u) == 0u) { if (xb_ld(&(bar)[XB_TMO])) break; if (_sp > XB_SPIN_CAP) { atomicAdd(&(bar)[XB_TMO], 1u); break; } } } } while (0)

struct XcdBarrier {
    unsigned* bar; unsigned x;
    volatile LAS unsigned* st;
};

__device__ __forceinline__ XcdBarrier xcd_barrier_post(unsigned* bar, volatile LAS unsigned* st, const bool t0) {
    XcdBarrier b; b.bar = bar; b.x = xb_xcc_id(); b.st = st;
    if (t0) (void)xb_add(&bar[XB_XCNT(b.x)], 1u);
    return b;
}
__device__ __forceinline__ void xcd_barrier_complete(unsigned* bar, unsigned x, unsigned& nloc, unsigned& nx) {
    const unsigned G = gridDim.x * gridDim.y * gridDim.z;
    unsigned sum, cnt, mine, sp = 0u;
    for (;;) {
        sum = 0u; cnt = 0u; mine = 0u;
#pragma unroll
        for (unsigned j = 0; j < 16; ++j) { const unsigned c = xb_ld(&bar[XB_XCNT(j)]); sum += c; cnt += (c > 0u) ? 1u : 0u; mine = (j == x) ? c : mine; }
        if (sum == G) break;
        __builtin_amdgcn_s_sleep(1);
        if ((++sp & 255u) == 0u) { if (xb_ld(&bar[XB_TMO])) break; if (sp > XB_SPIN_CAP) { atomicAdd(&bar[XB_TMO], 1u); break; } }
    }
    nloc = mine > 0u ? mine : 1u; nx = cnt > 0u ? cnt : 1u;
}

__device__ __forceinline__ void xcd_barrier(const XcdBarrier& b, const bool t0) {
    asm volatile("s_waitcnt vmcnt(0)" ::: "memory");
    __syncthreads();
    if (t0) {
        unsigned* bar = b.bar;
        __builtin_amdgcn_s_waitcnt(0);
        unsigned nloc = b.st[0], nx = b.st[1];
        if (nloc == 0u) { xcd_barrier_complete(bar, b.x, nloc, nx); b.st[0] = nloc; b.st[1] = nx; }
        const unsigned old = xb_add(&bar[XB_XSUB(b.x)], 1u);
        const unsigned gen = old / nloc;
        if (old + 1u == (gen + 1u) * nloc) {
            __builtin_amdgcn_fence(__ATOMIC_RELEASE, "agent");
            asm volatile("s_waitcnt vmcnt(0)" ::: "memory");
            const unsigned og = xb_add(&bar[XB_TOP], 1u);
            const unsigned tg = og / nx;
            if (og + 1u == (tg + 1u) * nx) xb_add(&bar[XB_TOPGEN], 1u);
            else XB_SPIN(xb_ld(&bar[XB_TOPGEN]) == tg, bar);
            __builtin_amdgcn_fence(__ATOMIC_ACQUIRE, "agent");
            xb_add(&bar[XB_XGEN(b.x)], 1u);
            asm volatile("s_waitcnt vmcnt(0)" ::: "memory");
        } else {
            XB_SPIN(xb_ld(&bar[XB_XGEN(b.x)]) == gen, bar);
            __builtin_amdgcn_fence(__ATOMIC_ACQUIRE, "agent");
            asm volatile("s_waitcnt vmcnt(0)" ::: "memory");
        }
    }
    __syncthreads();
}
#define GAS __attribute__((address_space(1)))
typedef float f32x4 __attribute__((ext_vector_type(4)));
typedef unsigned u32x2 __attribute__((ext_vector_type(2)));
typedef unsigned u32x4 __attribute__((ext_vector_type(4)));
typedef short bf16x8 __attribute__((ext_vector_type(8)));
constexpr int NTHR = 512, NWV = 8;
constexpr int RING_BYTES = 139264, MISC_OFF = RING_BYTES + 320, LDS_BYTES = 147456;
constexpr int CW_BAR = 1024;

struct KArgs { Inputs in; float* out; unsigned char* ws; int ph_lo, ph_hi, li, mask; };
#ifndef PROBE_REP
#define PROBE_REP {0, 0, 0, 0, 0, 0, 0, 0, 0, 0, 0, 0, 0, 0, 0, 0, 0}
#endif
constexpr int kRep[17] = PROBE_REP;

__device__ __forceinline__ float wave_sum(float v) {
#pragma unroll
    for (int o = 1; o < 64; o <<= 1) v += __shfl_xor(v, o);
    return v;
}
typedef float f32x2_t __attribute__((ext_vector_type(2)));
typedef __bf16 bf16x2_t __attribute__((ext_vector_type(2)));
__device__ __forceinline__ unsigned cvtpk(float lo, float hi) { f32x2_t v = {lo, hi}; bf16x2_t b = __builtin_convertvector(v, bf16x2_t); return __builtin_bit_cast(unsigned, b); }
__device__ __forceinline__ unsigned pk2(float lo, float hi) { return cvtpk(lo, hi); }
__device__ __forceinline__ int fresh_lane() { int l; asm volatile("v_mbcnt_lo_u32_b32 %0, -1, 0\n\tv_mbcnt_hi_u32_b32 %0, -1, %0" : "=v"(l)); return l; }
#ifdef PROBE_SEC
#define SEC_B(k) unsigned long long sec_t0_##k = 0; if ((k) == PROBE_SEC && blockIdx.x == 0 && tid == 0) sec_t0_##k = __builtin_amdgcn_s_memrealtime()
#define SEC_E(k) do { if ((k) == PROBE_SEC && blockIdx.x == 0 && tid == 0) { volatile LAS unsigned* sw_ = (volatile LAS unsigned*)(lds + MISC_OFF + 96); sw_[0] = sw_[0] + (unsigned)(__builtin_amdgcn_s_memrealtime() - sec_t0_##k); } } while (0)
#else
#define SEC_B(k)
#define SEC_E(k) do { } while (0)
#endif
#define LDS_FENCE() asm volatile("s_waitcnt lgkmcnt(0)" ::: "memory")

constexpr int PH_PRO = 0;
constexpr int PH_L0 = 1, PH_PER_LAYER = 6;
constexpr int PH_FIN = PH_L0 + 2 * PH_PER_LAYER;
constexpr int PH_END = PH_FIN + 1;

__device__ __forceinline__ void transpose_item(const float* W, int K, int N, bf16_t* WT, LAS float* scr, int item, int lane) {
    const int nblk = N / 32, kb = item / nblk, nb = item % nblk, k0 = 64 * kb, n0 = 32 * nb;
    float wv[32];
#pragma unroll
    for (int i = 0; i < 32; ++i) wv[i] = W[(size_t)(k0 + 2 * i + (lane >> 5)) * N + n0 + (lane & 31)];
#pragma unroll
    for (int i = 0; i < 32; ++i) scr[(2 * i + (lane >> 5)) * 33 + (lane & 31)] = wv[i];
    LDS_FENCE();
    const int c = lane & 7;
#pragma unroll
    for (int j = 0; j < 4; ++j) { const int n = (lane >> 3) + 8 * j; const LAS float* s = scr + (8 * c) * 33 + n;
        u32x4 o; o.x = pk2(s[0 * 33], s[1 * 33]); o.y = pk2(s[2 * 33], s[3 * 33]); o.z = pk2(s[4 * 33], s[5 * 33]); o.w = pk2(s[6 * 33], s[7 * 33]);
        *(u32x4*)(WT + (size_t)(n0 + n) * K + k0 + 8 * c) = o; }
    LDS_FENCE();
}

__device__ __forceinline__ void ph_prologue(const KArgs& a, LAS unsigned char* lds, int tid, int wave, int lane) {
    const Inputs& in = a.in;
    float* MOD = (float*)(a.ws + OFF_MOD);
    LAS float* sil = (LAS float*)lds;
    LAS float* part = (LAS float*)(lds + 5 * 1024 * 4);
    if ((int)blockIdx.x < 192) {
        for (int i = tid; i < 5 * 1024; i += NTHR) { const int j = i >> 10, k = i & 1023; const float cv = j < 4 ? in.c[j * DM + k] : in.c_ctx[k]; sil[i] = cv / (1.f + expf(-cv)); }
        __syncthreads();
        for (int it = blockIdx.x; it < 192; it += gridDim.x) {
            const int l = it / 96, nb = it % 96, n = nb * 32 + (lane & 31), k0 = wave * 128 + (lane >> 5) * 64;
            const float* w = in.w_mod + (size_t)l * DM * 3072 + n;
            float acc[5] = {0.f, 0.f, 0.f, 0.f, 0.f};
#pragma unroll 32
            for (int kk = 0; kk < 64; ++kk) { const float wv = w[(size_t)(k0 + kk) * 3072];
#pragma unroll
                for (int j = 0; j < 5; ++j) acc[j] += sil[j * 1024 + k0 + kk] * wv; }
#pragma unroll
            for (int j = 0; j < 5; ++j) { acc[j] += __shfl_xor(acc[j], 32); if (lane < 32) part[(wave * 5 + j) * 32 + lane] = acc[j]; }
            __syncthreads();
            if (tid < 160) { const int j = tid >> 5, c = tid & 31; float s = in.b_mod[l * 3072 + nb * 32 + c];
#pragma unroll
                for (int w8 = 0; w8 < 8; ++w8) s += part[(w8 * 5 + j) * 32 + c];
                MOD[((size_t)l * 5 + j) * 3072 + nb * 32 + c] = s; }
            __syncthreads();
        }
    }
    __syncthreads();
    LAS float* scr = (LAS float*)(lds + wave * 16384);
    const int gw = blockIdx.x * NWV + wave, NGW = gridDim.x * NWV;
    constexpr int I_IN = (DM / 64) * (NIN / 32), I_OUT = (DM / 64) * (DM / 32), I_PAD = NP - NIN;
    constexpr int I_L = I_IN + I_OUT + I_PAD;
    bf16_t* WIN = (bf16_t*)(a.ws + OFF_WIN); bf16_t* WOUT = (bf16_t*)(a.ws + OFF_WOUT);
    unsigned* tctr = (unsigned*)(a.ws + OFF_CTL) + 24;
    unsigned nxt = 0u; if (lane == 0) nxt = atomicAdd(tctr, 1u);
    (void)gw; (void)NGW;
    for (;;) {
        const int it = __builtin_amdgcn_readfirstlane((int)nxt);
        if (it >= 2 * I_L) break;
        if (lane == 0) nxt = atomicAdd(tctr, 1u);
        const int l = it / I_L; int r = it % I_L;
        if (r < I_IN) { transpose_item(in.w_in + (size_t)l * DM * NIN, DM, NIN, WIN + (size_t)l * NP * DM, scr, r, lane); continue; } r -= I_IN;
        if (r < I_OUT) { transpose_item(in.w_out + (size_t)l * DM * DM, DM, DM, WOUT + (size_t)l * DM * DM, scr, r, lane); continue; } r -= I_OUT;
        u32x4* zp = (u32x4*)(WIN + ((size_t)l * NP + NIN + r) * DM);
        zp[lane] = (u32x4){0u, 0u, 0u, 0u}; zp[lane + 64] = (u32x4){0u, 0u, 0u, 0u};
    }
    const int gt = blockIdx.x * NTHR + tid, NGT = gridDim.x * NTHR;
    bf16_t* WPT = (bf16_t*)(a.ws + OFF_WPT);
    if (gt < 512) { float* rt = (float*)(a.ws + OFF_ROPE); const int pos = gt >> 3, j = gt & 7; const float f = powf(10000.f, -(float)j / 8.f), ang = (float)pos * f; rt[gt] = cosf(ang); rt[512 + gt] = sinf(ang); }
    for (int i = gt; i < 2 * 4 * 64 * 64; i += NGT) { const int c = i & 63, e = (i >> 6) & 63, li = i >> 12; WPT[i] = f2bf(in.pool_w[(size_t)li * 4096 + c * 64 + e]); }
}

__device__ __forceinline__ void ph_post_pre(const KArgs& a, int lprev, int lnext, int wave, int lane) {
    const Inputs& in = a.in;
    const float* MOD = (const float*)(a.ws + OFF_MOD);
    const float* O = (const float*)(a.ws + OFF_P);
    float* XC = (float*)(a.ws + OFF_XC);
    bf16_t* H = (bf16_t*)(a.ws + OFF_H);
    const int gw = blockIdx.x * NWV + wave, NGW = gridDim.x * NWV;
    const int nrows = (lnext < 2) ? MTOT : NLAT;
    for (int row = gw; row < nrows; row += NGW) {
        const bool lat = row < NLAT; const int j = lat ? row / SEQ : 4;
        const float* xr; float* xw = nullptr;
        if (lprev <= 0) xr = lat ? in.x + (size_t)row * DM : in.ctx + (size_t)(row - NLAT) * DM;
        else xr = lat ? a.out + (size_t)row * DM : XC + (size_t)(row - NLAT) * DM;
        const bool post = (lprev >= 0) && (lat || lprev == 0);
        if (post) xw = lat ? a.out + (size_t)row * DM : XC + (size_t)(row - NLAT) * DM;
        f32x4 v[4];
#pragma unroll
        for (int q = 0; q < 4; ++q) v[q] = *(const f32x4*)(xr + 4 * lane + 256 * q);
        if (post) {
            f32x4 o[4]; float s = 0.f;
#pragma unroll
            for (int q = 0; q < 4; ++q) { o[q] = *(const f32x4*)(O + (size_t)row * DM + 4 * lane + 256 * q); s += (o[q].x * o[q].x + o[q].y * o[q].y) + (o[q].z * o[q].z + o[q].w * o[q].w); }
            const float rstd = rsqrtf(wave_sum(s) * (1.f / DM) + EPS);
            const float* gate = MOD + ((size_t)lprev * 5 + j) * 3072 + 2048; const float* gp = in.g_post + lprev * DM;
#pragma unroll
            for (int q = 0; q < 4; ++q) { const f32x4 gt = *(const f32x4*)(gate + 4 * lane + 256 * q), gg = *(const f32x4*)(gp + 4 * lane + 256 * q);
                v[q] = v[q] + gt * (o[q] * rstd * gg); *(f32x4*)(xw + 4 * lane + 256 * q) = v[q]; }
        }
        if (lnext < 2) {
            float s = 0.f;
#pragma unroll
            for (int q = 0; q < 4; ++q) s += (v[q].x * v[q].x + v[q].y * v[q].y) + (v[q].z * v[q].z + v[q].w * v[q].w);
            const float rstd = rsqrtf(wave_sum(s) * (1.f / DM) + EPS);
            const float* shift = MOD + ((size_t)lnext * 5 + j) * 3072; const float* scale = shift + 1024; const float* gp = in.g_pre + lnext * DM;
#pragma unroll
            for (int q = 0; q < 4; ++q) { const int k = 4 * lane + 256 * q; const f32x4 sh = *(const f32x4*)(shift + k), sc = *(const f32x4*)(scale + k), gg = *(const f32x4*)(gp + k);
                const f32x4 hv = (v[q] * rstd * gg) * (sc + 1.f) + sh;
                u32x2 w; w.x = pk2(hv.x, hv.y); w.y = pk2(hv.z, hv.w); *(u32x2*)(H + (size_t)row * DM + k) = w; }
        }
    }
}

typedef float f32x16 __attribute__((ext_vector_type(16)));
#define MFMA16(a, b, c) __builtin_amdgcn_mfma_f32_16x16x32_bf16(a, b, c, 0, 0, 0)
#define MFMA32(a, b, c) __builtin_amdgcn_mfma_f32_32x32x16_bf16(a, b, c, 0, 0, 0)
__device__ __forceinline__ float fast_exp(float x) { return __builtin_amdgcn_exp2f(x * 1.4426950408889634f); }
__device__ __forceinline__ float fast_silu(float v) { return v * __builtin_amdgcn_rcpf(1.f + fast_exp(-v)); }
__device__ __forceinline__ float lo_bf(unsigned w) { return __uint_as_float(w << 16); }
__device__ __forceinline__ float hi_bf(unsigned w) { return __uint_as_float(w & 0xffff0000u); }


typedef short v4i16_t __attribute__((ext_vector_type(4)));
constexpr int NA_KV_BYTES = 832 * 128, NA_RPB_OFF = NA_KV_BYTES;

__device__ __forceinline__ void na_stage(const bf16_t* P, LAS unsigned char* kv, int colbase, int b, int U0, int nwin, int tid) {
    const int kr0 = tid >> 3, c = tid & 7;
    const unsigned toff = (unsigned)kr0 * NP + 8u * c;
    const bf16_t* gctx = P + (size_t)(NLAT + b * NCTX) * NP + colbase;
    const bf16_t* gwin = P + (size_t)(b * SEQ + U0 * 64) * NP + colbase;
    LAS unsigned char* lb = kv + kr0 * 128 + ((c ^ (kr0 & 7)) << 4);
    u32x4 v[7];
#pragma unroll
    for (int it = 0; it < 4; ++it) v[it] = *(const u32x4*)(gctx + (size_t)it * 64 * NP + toff);
#pragma unroll
    for (int it = 4; it < 7; ++it) if (it - 4 < nwin) v[it] = *(const u32x4*)(gwin + (size_t)(it - 4) * 64 * NP + toff);
#pragma unroll
    for (int it = 0; it < 4; ++it) *(LAS u32x4*)(lb + it * 8192) = v[it];
#pragma unroll
    for (int it = 4; it < 7; ++it) if (it - 4 < nwin) *(LAS u32x4*)(lb + it * 8192) = v[it];
#pragma unroll
    for (int it = 7; it < 13; ++it) if (it - 4 < nwin) v[it - 7] = *(const u32x4*)(gwin + (size_t)(it - 4) * 64 * NP + toff);
#pragma unroll
    for (int it = 7; it < 13; ++it) if (it - 4 < nwin) *(LAS u32x4*)(lb + it * 8192) = v[it - 7];
}

template <bool HW>
__device__ __forceinline__ void na_half(const LAS unsigned char* kbase, int sw0, int sw1, bf16x8 qf0, bf16x8 qf1, const LAS float* rp, int R0, int r, int CB, int cg, int li, int g,
                                        bf16x8 (&pf)[8], float& mo, float& lo_) {
    f32x4 S[16];
#pragma unroll
    for (int t = 0; t < 16; ++t) {
        const LAS unsigned char* kb = HW ? kbase + (t >> 1) * 8192 + (t & 1) * 2048 : kbase + t * 2048;
        const bf16x8 k0 = *(const LAS bf16x8*)(kb + sw0), k1 = *(const LAS bf16x8*)(kb + sw1);
        f32x4 acc = {0.f, 0.f, 0.f, 0.f};
        acc = MFMA16(k0, qf0, acc); acc = MFMA16(k1, qf1, acc); S[t] = acc;
    }
    float m = -INFINITY;
    if (HW) {
        const int c = cg * 16 + li, cs = min(max(c - 8, 0), 48);
        const LAS float* rb = rp + (R0 - r + 7) * 31 + (CB - c + 4 * g + 15);
        bool vld[8];
#pragma unroll
        for (int k = 0; k < 8; ++k) { const int kcol = CB + 16 * (k >> 2) + 4 * g + (k & 3); vld[k] = (kcol >= cs) && (kcol < cs + 16); }
#pragma unroll
        for (int wt = 0; wt < 16; ++wt) {
#pragma unroll
            for (int q = 0; q < 4; ++q) { const float bias = rb[(wt >> 1) * 31 + 16 * (wt & 1) + q];
                const float s = vld[4 * (wt & 1) + q] ? S[wt][q] * 0.125f + bias : -INFINITY; S[wt][q] = s; m = fmaxf(m, s); }
        }
    } else {
#pragma unroll
        for (int ct = 0; ct < 16; ++ct)
#pragma unroll
            for (int q = 0; q < 4; ++q) { const float s = S[ct][q] * 0.125f; S[ct][q] = s; m = fmaxf(m, s); }
    }
    m = fmaxf(m, __shfl_xor(m, 16)); m = fmaxf(m, __shfl_xor(m, 32));
    float lsum = 0.f;
#pragma unroll
    for (int u = 0; u < 8; ++u) {
        float p[8];
#pragma unroll
        for (int q = 0; q < 4; ++q) { p[q] = fast_exp(S[2 * u][q] - m); p[4 + q] = fast_exp(S[2 * u + 1][q] - m); }
#pragma unroll
        for (int q = 0; q < 8; ++q) lsum += p[q];
        u32x4 w; w.x = cvtpk(p[0], p[1]); w.y = cvtpk(p[2], p[3]); w.z = cvtpk(p[4], p[5]); w.w = cvtpk(p[6], p[7]);
        pf[u] = __builtin_bit_cast(bf16x8, w);
    }
    lsum += __shfl_xor(lsum, 16); lsum += __shfl_xor(lsum, 32);
    mo = m; lo_ = lsum;
}

template <bool WIN>
__device__ __forceinline__ void na_block(const KArgs& a, LAS unsigned char* lds, int b, int h, int R, int tid, int wave, int lane) {
    const bf16_t* P = (const bf16_t*)(a.ws + OFF_P); bf16_t* Y = (bf16_t*)(a.ws + OFF_H);
    LAS unsigned char* kv = lds; const LAS float* rpb = (const LAS float*)(lds + NA_RPB_OFF);
    const int li = lane & 15, g = lane >> 4;
    int r = 0, cg = 0, U0 = 0, nwin = 0, wo = 0, CB = 0, R0 = 0, qrow0;
    if (WIN) { r = 2 * R + (wave >> 2); cg = wave & 3; U0 = min(max(2 * R - 4, 0), 56); nwin = min(9, 64 - U0); R0 = min(max(r - 4, 0), 56); wo = R0 - U0;
        CB = min(max(cg * 16 - 8, 0), 32); qrow0 = b * SEQ + r * 64 + cg * 16; }
    else qrow0 = NLAT + b * NCTX + R * 128 + wave * 16;
    SEC_B(7);
    __syncthreads();
    na_stage(P, kv, C_NK + h * 64, b, U0, nwin, tid);
    const bf16_t* qp = P + (size_t)(qrow0 + li) * NP + C_NQ + h * 64 + 8 * g;
    const bf16x8 qf0 = *(const bf16x8*)qp, qf1 = *(const bf16x8*)(qp + 32);
    __syncthreads();
    const LAS unsigned char* kwin = kv + (256 + wo * 64 + CB + li) * 128; const LAS unsigned char* kctx = kv + li * 128;
    const int sw0 = (g ^ (li & 7)) << 4, sw1 = ((4 + g) ^ (li & 7)) << 4;
    bf16x8 pfw[8], pfc[8];
    float mw = -INFINITY, lw = 0.f, mc, lc;
    if (WIN) na_half<true>(kwin, sw0, sw1, qf0, qf1, rpb + h * 465, R0, r, CB, cg, li, g, pfw, mw, lw);
    na_half<false>(kctx, sw0, sw1, qf0, qf1, rpb, 0, 0, 0, 0, li, g, pfc, mc, lc);
    __syncthreads();
    SEC_E(7);
    SEC_B(8);
    na_stage(P, kv, C_NV + h * 64, b, U0, nwin, tid);
    __syncthreads();
    const int trow = 4 * g + (li >> 2), rl = trow & 7;
    LAS unsigned char* twin = kv + (256 + wo * 64 + CB + trow) * 128 + (li & 1) * 8; LAS unsigned char* tctx = kv + trow * 128 + (li & 1) * 8;
    int trs[4];
#pragma unroll
    for (int mt = 0; mt < 4; ++mt) trs[mt] = ((2 * mt + ((li & 3) >> 1)) ^ rl) << 4;
    f32x4 accw[4], acc[4];
#pragma unroll
    for (int mt = 0; mt < 4; ++mt) { accw[mt] = (f32x4){0.f, 0.f, 0.f, 0.f}; acc[mt] = (f32x4){0.f, 0.f, 0.f, 0.f}; }
    if (WIN) {
#pragma unroll
        for (int u = 0; u < 8; ++u)
#pragma unroll
            for (int mt = 0; mt < 4; ++mt) { const LAS unsigned char* tp = twin + trs[mt] + u * 8192;
                const v4i16_t lo = __builtin_amdgcn_ds_read_tr16_b64_v4i16((LAS v4i16_t*)tp), hi = __builtin_amdgcn_ds_read_tr16_b64_v4i16((LAS v4i16_t*)(tp + 2048));
                const bf16x8 af = {lo[0], lo[1], lo[2], lo[3], hi[0], hi[1], hi[2], hi[3]};
                accw[mt] = MFMA16(af, pfw[u], accw[mt]); }
    }
#pragma unroll
    for (int u = 0; u < 8; ++u)
#pragma unroll
        for (int mt = 0; mt < 4; ++mt) { const LAS unsigned char* tp = tctx + trs[mt] + u * 4096;
            const v4i16_t lo = __builtin_amdgcn_ds_read_tr16_b64_v4i16((LAS v4i16_t*)tp), hi = __builtin_amdgcn_ds_read_tr16_b64_v4i16((LAS v4i16_t*)(tp + 2048));
            const bf16x8 af = {lo[0], lo[1], lo[2], lo[3], hi[0], hi[1], hi[2], hi[3]};
            acc[mt] = MFMA16(af, pfc[u], acc[mt]); }
    float lsum = lc;
    if (WIN) { const float mm = fmaxf(mw, mc); const float f0 = fast_exp(mw - mm), f1 = fast_exp(mc - mm);
#pragma unroll
        for (int mt = 0; mt < 4; ++mt) acc[mt] = accw[mt] * f0 + acc[mt] * f1;
        lsum = lw * f0 + lc * f1; }
    const float inv = 1.f / lsum;
    const size_t row = (size_t)(qrow0 + li);
#pragma unroll
    for (int mt = 0; mt < 4; ++mt) {
        const int col = 256 + h * 64 + 16 * mt + 4 * g;
        const u32x2 gt = *(const u32x2*)(P + row * NP + C_GATE + col);
        u32x2 w;
        w.x = cvtpk(acc[mt][0] * inv * fast_silu(lo_bf(gt.x)), acc[mt][1] * inv * fast_silu(hi_bf(gt.x)));
        w.y = cvtpk(acc[mt][2] * inv * fast_silu(lo_bf(gt.y)), acc[mt][3] * inv * fast_silu(hi_bf(gt.y)));
        *(u32x2*)(Y + row * DM + col) = w;
    }
    SEC_E(8);
}

__device__ __forceinline__ void pool_item(const KArgs& a, int l, LAS unsigned char* lds, int cid, int tid, int wave, int lane) {
    const bf16_t* P = (const bf16_t*)(a.ws + OFF_P); bf16_t* Y = (bf16_t*)(a.ws + OFF_H);
    const bf16_t* WPT = (const bf16_t*)(a.ws + OFF_WPT) + (size_t)l * 4 * 64 * 64;
    const float* pscale = a.in.pool_scale + l * 256;
    LAS bf16_t* U = (LAS bf16_t*)lds;
    LAS bf16_t* M = U + 80 * 264;
    const bool lat = cid < 256;
    const int seq_len = lat ? SEQ : NCTX;
    const int seq_base = lat ? (cid >> 6) * SEQ : NLAT + ((cid - 256) >> 2) * NCTX;
    const int t0 = lat ? (cid & 63) * 64 : ((cid - 256) & 3) * 64;
    SEC_B(9);
    for (int i = tid; i < 80 * 32; i += NTHR) { const int tr = i >> 5, c8 = i & 31, tt = t0 - 8 + tr;
        u32x4 v = {0u, 0u, 0u, 0u};
        if (tt >= 0 && tt < seq_len) v = *(const u32x4*)(P + (size_t)(seq_base + tt) * NP + C_PU + c8 * 8);
        *(LAS u32x4*)(U + tr * 264 + c8 * 8) = v; }
    __syncthreads();
    {
        const int col = tid & 255, th = tid >> 8, part = col >> 6, w = 2 << part;
        for (int t = 32 * th; t < 32 * th + 32; ++t) {
            const int tt = t0 + t; const int lo = min(max(tt - w / 2, 0), seq_len), hi = min(max(tt - w / 2 + w, 0), seq_len);
            float s = 0.f;
            for (int ss = lo; ss < hi; ++ss) s += bf2f(U[(ss - t0 + 8) * 264 + col]);
            const float mv = s / (float)(hi - lo) - bf2f(U[(t + 8) * 264 + col]);
            M[t * 264 + col] = (bf16_t)cvtpk(mv, 0.f);
        }
    }
    __syncthreads();
    {
        const int part = wave >> 1, th = wave & 1, li = lane & 15, g = lane >> 4;
        f32x4 acc[4][2];
#pragma unroll
        for (int mt = 0; mt < 4; ++mt) { acc[mt][0] = (f32x4){0.f, 0.f, 0.f, 0.f}; acc[mt][1] = (f32x4){0.f, 0.f, 0.f, 0.f}; }
#pragma unroll
        for (int s = 0; s < 2; ++s) {
            bf16x8 bfr[2];
#pragma unroll
            for (int nt = 0; nt < 2; ++nt) bfr[nt] = *(const LAS bf16x8*)(M + (32 * th + 16 * nt + li) * 264 + part * 64 + 32 * s + 8 * g);
#pragma unroll
            for (int mt = 0; mt < 4; ++mt) {
                const bf16x8 af = *(const bf16x8*)(WPT + ((size_t)(part * 64 + 16 * mt + li)) * 64 + 32 * s + 8 * g);
#pragma unroll
                for (int nt = 0; nt < 2; ++nt) acc[mt][nt] = MFMA16(af, bfr[nt], acc[mt][nt]);
            }
        }
#pragma unroll
        for (int nt = 0; nt < 2; ++nt) {
            const size_t row = (size_t)(seq_base + t0 + 32 * th + 16 * nt + li);
#pragma unroll
            for (int mt = 0; mt < 4; ++mt) {
                const int cl = part * 64 + 16 * mt + 4 * g;
                const f32x4 sc = *(const f32x4*)(pscale + cl);
                const u32x2 gt = *(const u32x2*)(P + row * NP + C_GATE + 768 + cl);
                u32x2 w;
                w.x = cvtpk(acc[mt][nt][0] * sc.x * fast_silu(lo_bf(gt.x)), acc[mt][nt][1] * sc.y * fast_silu(hi_bf(gt.x)));
                w.y = cvtpk(acc[mt][nt][2] * sc.z * fast_silu(lo_bf(gt.y)), acc[mt][nt][3] * sc.w * fast_silu(hi_bf(gt.y)));
                *(u32x2*)(Y + row * DM + 768 + cl) = w;
            }
        }
    }
    __syncthreads();
    SEC_E(9);
}

__device__ __forceinline__ void phC_na_ctx(const KArgs& a, int l, LAS unsigned char* lds, int tid, int wave, int lane) {
    if (l != 0) return;
    for (int u = blockIdx.x; u < 32; u += gridDim.x) na_block<false>(a, lds, u >> 3, (u >> 1) & 3, u & 1, tid, wave, lane);
    __syncthreads();
}
__device__ __forceinline__ void phD_na_pool(const KArgs& a, int l, LAS unsigned char* lds, int tid, int wave, int lane) {
    const int ncid = (l == 1) ? 256 : 272;
    for (int q = 0; q <= kRep[13]; ++q) for (int cid = gridDim.x - 1 - blockIdx.x; cid < ncid; cid += gridDim.x) pool_item(a, l, lds, cid, tid, wave, lane);
    LAS float* rpb = (LAS float*)(lds + NA_RPB_OFF);
    for (int i = tid; i < 4 * 465; i += NTHR) rpb[i] = a.in.na_rpb[l * 4 * 465 + i];
    for (int q = 0; q <= kRep[14]; ++q) for (int u = blockIdx.x; u < 512; u += gridDim.x) { const int ln = fresh_lane(); na_block<true>(a, lds, u >> 7, (u >> 5) & 3, u & 31, wave * 64 + ln, wave, ln); }
    __syncthreads();
}
constexpr int GL_QR = 0, GL_KR = 8192, GL_GFB = 16384, GL_ROPE = 24576, GL_TOT = 28672, GL_QC = 30720, GL_KF = 49152, GL_KB = 59392,
              GL_VT = 69632, GL_KFT = 88064, GL_KBT = 97280, GL_ATT = 106496;

__device__ __forceinline__ float logsigmoid_fast(float z) { return fminf(z, 0.f) - __logf(1.f + __expf(-fabsf(z))); }

template <bool LOCAL>
__device__ __forceinline__ void gla_prep(const KArgs& a, int l, LAS unsigned char* lds, int cid, int hp, int tid) {
    const bf16_t* P = (const bf16_t*)(a.ws + OFF_P);
    const size_t row0 = (size_t)cid * 64;
    const bool lat = cid < 256;
    LAS bf16_t* QR = (LAS bf16_t*)(lds + GL_QR); LAS bf16_t* KR = (LAS bf16_t*)(lds + GL_KR);
    LAS float* GFB = (LAS float*)(lds + GL_GFB); LAS float* ROPE = (LAS float*)(lds + GL_ROPE); LAS float* TOT = (LAS float*)(lds + GL_TOT);
    LAS bf16_t* QC = (LAS bf16_t*)(lds + GL_QC); LAS bf16_t* KF = (LAS bf16_t*)(lds + GL_KF); LAS bf16_t* KB = (LAS bf16_t*)(lds + GL_KB);
    LAS bf16_t* VT = (LAS bf16_t*)(lds + GL_VT); LAS bf16_t* KFT = (LAS bf16_t*)(lds + GL_KFT); LAS bf16_t* KBT = (LAS bf16_t*)(lds + GL_KBT);
    { const int t = tid >> 3, c8 = tid & 7;
      *(LAS u32x4*)(QR + t * 64 + c8 * 8) = *(const u32x4*)(P + (row0 + t) * NP + C_GQ + hp * 64 + c8 * 8);
      *(LAS u32x4*)(KR + t * 64 + c8 * 8) = *(const u32x4*)(P + (row0 + t) * NP + C_GK + hp * 64 + c8 * 8); }
    if (tid < 256) { const int t = tid >> 2, c8 = tid & 3; const u32x4 v = *(const u32x4*)(P + (row0 + t) * NP + C_GF + c8 * 8);
        LAS float* gp = GFB + t * 32 + c8 * 8;
        gp[0] = lo_bf(v.x); gp[1] = hi_bf(v.x); gp[2] = lo_bf(v.y); gp[3] = hi_bf(v.y); gp[4] = lo_bf(v.z); gp[5] = hi_bf(v.z); gp[6] = lo_bf(v.w); gp[7] = hi_bf(v.w); }
    { const float* rt = (const float*)(a.ws + OFF_ROPE); ROPE[tid] = rt[tid]; ROPE[tid + 512] = rt[tid + 512]; }
#pragma unroll
    for (int rep = 0; rep < 2; ++rep) { const int i = tid + rep * NTHR, t = i & 63, c16 = i >> 6;
        const u32x4 v = *(const u32x4*)(P + (row0 + t) * NP + C_GV + hp * 128 + c16 * 8);
        const int h2 = c16 >> 3, e0 = (c16 & 7) * 8; LAS bf16_t* vp = VT + (h2 * 64 + e0) * 72 + t;
        vp[0 * 72] = (bf16_t)(v.x & 0xffff); vp[1 * 72] = (bf16_t)(v.x >> 16); vp[2 * 72] = (bf16_t)(v.y & 0xffff); vp[3 * 72] = (bf16_t)(v.y >> 16);
        vp[4 * 72] = (bf16_t)(v.z & 0xffff); vp[5 * 72] = (bf16_t)(v.z >> 16); vp[6 * 72] = (bf16_t)(v.w & 0xffff); vp[7 * 72] = (bf16_t)(v.w >> 16); }
    __syncthreads();
    const int col = tid & 127, dir = col >> 6, h2 = (col >> 5) & 1, d = col & 31, tq = tid >> 7;
    const int h = 2 * hp + h2;
    float wg[16];
    { const float* wp = a.in.gla_w_gate + ((size_t)(l * 2 + dir) * 16) * 128 + h * 32 + d;
#pragma unroll
      for (int r = 0; r < 16; ++r) wg[r] = wp[r * 128]; }
    const float bg = a.in.gla_b_gate[(l * 2 + dir) * 128 + h * 32 + d];
    float lgv[16], pf[16]; float run = 0.f;
#pragma unroll
    for (int tt = 0; tt < 16; ++tt) { const LAS float* gp = GFB + (16 * tq + tt) * 32 + dir * 16;
        float z = bg;
#pragma unroll
        for (int r = 0; r < 16; ++r) z += gp[r] * wg[r];
        lgv[tt] = logsigmoid_fast(z) * (1.f / 16.f); run += lgv[tt]; pf[tt] = run; }
    TOT[tq * 128 + col] = run;
    __syncthreads();
    float off = 0.f, total = 0.f;
#pragma unroll
    for (int q = 0; q < 4; ++q) { const float v = TOT[q * 128 + col]; total += v; if (dir ? (q > tq) : (q < tq)) off += v; }
    const float qs = 0.17677669529663687f;
    const int i16 = d & 15, j8 = d & 7, dp = (i16 < 8) ? d + 8 : d - 8; const float sg = (i16 < 8) ? -1.f : 1.f;
#pragma unroll
    for (int tl = 0; tl < 16; ++tl) { const int t = 16 * tq + tl; const float cv = (dir ? run - pf[tl] + lgv[tl] : pf[tl]) + off;
        float k = bf2f(KR[t * 64 + h2 * 32 + d]), q = bf2f(QR[t * 64 + h2 * 32 + d]);
        if (lat) { const int tokpos = (cid & 63) * 64 + t; const int pos = (d & 16) ? (tokpos & 63) : (tokpos >> 6);
            const float cs = ROPE[pos * 8 + j8], sn = ROPE[512 + pos * 8 + j8];
            k = k * cs + sg * bf2f(KR[t * 64 + h2 * 32 + dp]) * sn; q = q * cs + sg * bf2f(QR[t * 64 + h2 * 32 + dp]) * sn; }
        if (LOCAL) { (dir ? KBT : KFT)[(h2 * 32 + d) * 72 + t] = (bf16_t)cvtpk(k * __expf(total - cv), 0.f); }
        else { { const unsigned w_ = cvtpk(q * qs * __expf(cv), k * __expf(-cv)); QC[(h2 * 64 + t) * 72 + dir * 32 + d] = (bf16_t)w_; (dir ? KB : KF)[(h2 * 64 + t) * 40 + d] = (bf16_t)(w_ >> 16); } }
    }
    if (LOCAL && tq == 0) { const int b = lat ? cid >> 6 : (cid - 256) >> 2; const int slot = lat ? 4 + (cid & 63) : (cid - 256) & 3;
        float* DEC = (float*)(a.ws + OFF_GDEC); DEC[((size_t)((b * 4 + h) * 2 + dir) * 68 + slot) * 32 + d] = __expf(total); }
    __syncthreads();
}

__device__ __forceinline__ void gla_local_unit(const KArgs& a, int l, LAS unsigned char* lds, int cid, int hp, int tid, int wave, int lane) {
    SEC_B(6);
    gla_prep<true>(a, l, lds, cid, hp, tid);
    if (wave < 4) {
        const int h2 = wave >> 1, dir = wave & 1, h = 2 * hp + h2, lr = lane & 31, hi = lane >> 5;
        const LAS bf16_t* VT = (const LAS bf16_t*)(lds + GL_VT) + h2 * 64 * 72;
        const LAS bf16_t* KT = (const LAS bf16_t*)(lds + (dir ? GL_KBT : GL_KFT)) + h2 * 32 * 72;
        f32x16 acc[2];
#pragma unroll
        for (int mt = 0; mt < 2; ++mt)
#pragma unroll
            for (int r = 0; r < 16; ++r) acc[mt][r] = 0.f;
#pragma unroll
        for (int s = 0; s < 4; ++s) {
            const bf16x8 bfr = *(const LAS bf16x8*)(KT + lr * 72 + 16 * s + 8 * hi);
#pragma unroll
            for (int mt = 0; mt < 2; ++mt) { const bf16x8 afr = *(const LAS bf16x8*)(VT + (32 * mt + lr) * 72 + 16 * s + 8 * hi); acc[mt] = MFMA32(afr, bfr, acc[mt]); }
        }
        const bool lat = cid < 256; const int b = lat ? cid >> 6 : (cid - 256) >> 2; const int slot = lat ? 4 + (cid & 63) : (cid - 256) & 3;
        float* LOC = (float*)(a.ws + OFF_GLOC) + ((size_t)((b * 4 + h) * 2 + dir) * 68 + slot) * 2048;
#pragma unroll
        for (int mt = 0; mt < 2; ++mt)
#pragma unroll
            for (int r = 0; r < 16; ++r) { const int e = 32 * mt + (r & 3) + 8 * (r >> 2) + 4 * hi; LOC[e * 32 + lr] = acc[mt][r]; }
    }
    __syncthreads();
    SEC_E(6);
}

__device__ __forceinline__ void gla_scan_item(const KArgs& a, int item, int tid) {
    const int chain = item >> 2, elem = (item & 3) * 512 + tid, d = elem & 31, dir = chain & 1;
    const float* LOC = (const float*)(a.ws + OFF_GLOC) + (size_t)chain * 68 * 2048 + elem;
    const float* DEC = (const float*)(a.ws + OFF_GDEC) + (size_t)chain * 68 * 32 + d;
    bf16_t* SIN = (bf16_t*)(a.ws + OFF_GSIN) + (size_t)chain * 68 * 2048 + elem;
    float S = 0.f;
    for (int st = 0; st < 68; st += 4) {
        float lv[4], dv[4]; int sl[4];
#pragma unroll
        for (int k = 0; k < 4; ++k) { sl[k] = dir ? 71 - (st + k) : st + k; if (dir && st + k < 4) sl[k] = 3 - (st + k); lv[k] = LOC[(size_t)sl[k] * 2048]; dv[k] = DEC[sl[k] * 32]; }
#pragma unroll
        for (int k = 0; k < 4; ++k) { SIN[(size_t)sl[k] * 2048] = f2bf(S); S = dv[k] * S + lv[k]; }
    }
}

__device__ __forceinline__ void gla_out_unit(const KArgs& a, int l, LAS unsigned char* lds, int cid, int hp, int tid, int wave, int lane) {
    SEC_B(3);
    gla_prep<false>(a, l, lds, cid, hp, tid);
    SEC_E(3);
    SEC_B(4);
    if (wave < 4) {
        const int h2 = wave >> 1, ih = wave & 1, h = 2 * hp + h2, lr = lane & 31, hi = lane >> 5;
        const LAS bf16_t* QC = (const LAS bf16_t*)(lds + GL_QC) + h2 * 64 * 72;
        const LAS bf16_t* KF = (const LAS bf16_t*)(lds + GL_KF) + h2 * 64 * 40;
        const LAS bf16_t* KB = (const LAS bf16_t*)(lds + GL_KB) + h2 * 64 * 40;
        const LAS bf16_t* VT = (const LAS bf16_t*)(lds + GL_VT) + h2 * 64 * 72;
        LAS bf16_t* ATT = (LAS bf16_t*)(lds + GL_ATT) + wave * 32 * 72;
        const int icol = 32 * ih + lr;
#pragma unroll
        for (int jt = 0; jt < 2; ++jt) {
            f32x16 df, db;
#pragma unroll
            for (int r = 0; r < 16; ++r) { df[r] = 0.f; db[r] = 0.f; }
#pragma unroll
            for (int s = 0; s < 2; ++s) {
                const bf16x8 af = *(const LAS bf16x8*)(KF + (32 * jt + lr) * 40 + 16 * s + 8 * hi), ab = *(const LAS bf16x8*)(KB + (32 * jt + lr) * 40 + 16 * s + 8 * hi);
                const bf16x8 bf_ = *(const LAS bf16x8*)(QC + icol * 72 + 16 * s + 8 * hi), bb_ = *(const LAS bf16x8*)(QC + icol * 72 + 32 + 16 * s + 8 * hi);
                df = MFMA32(af, bf_, df); db = MFMA32(ab, bb_, db);
            }
#pragma unroll
            for (int qd = 0; qd < 4; ++qd) { float v[4];
#pragma unroll
                for (int k = 0; k < 4; ++k) { const int j = 32 * jt + 8 * qd + 4 * hi + k; v[k] = (j <= icol ? df[4 * qd + k] : 0.f) + (j >= icol ? db[4 * qd + k] : 0.f); }
                u32x2 w; w.x = cvtpk(v[0], v[1]); w.y = cvtpk(v[2], v[3]);
                *(LAS u32x2*)(ATT + lr * 72 + 32 * jt + 8 * qd + 4 * hi) = w; }
        }
        LDS_FENCE();
        const bool lat = cid < 256; const int b = lat ? cid >> 6 : (cid - 256) >> 2; const int slot = lat ? 4 + (cid & 63) : (cid - 256) & 3;
        const bf16_t* SF = (const bf16_t*)(a.ws + OFF_GSIN) + ((size_t)((b * 4 + h) * 2 + 0) * 68 + slot) * 2048;
        const bf16_t* SB = SF + (size_t)68 * 2048;
        f32x16 acc[2];
#pragma unroll
        for (int mt = 0; mt < 2; ++mt)
#pragma unroll
            for (int r = 0; r < 16; ++r) acc[mt][r] = 0.f;
#pragma unroll
        for (int s = 0; s < 4; ++s) {
            const bf16x8 b1 = *(const LAS bf16x8*)(ATT + lr * 72 + 16 * s + 8 * hi);
            const bf16x8 b2 = *(const LAS bf16x8*)(QC + icol * 72 + 16 * s + 8 * hi);
#pragma unroll
            for (int mt = 0; mt < 2; ++mt) {
                const bf16x8 a1 = *(const LAS bf16x8*)(VT + (32 * mt + lr) * 72 + 16 * s + 8 * hi);
                const bf16_t* sp = (s < 2 ? SF : SB) + (32 * mt + lr) * 32 + 16 * (s & 1) + 8 * hi;
                const bf16x8 a2 = *(const bf16x8*)sp;
                acc[mt] = MFMA32(a1, b1, acc[mt]); acc[mt] = MFMA32(a2, b2, acc[mt]);
            }
        }
        float ss = 0.f;
#pragma unroll
        for (int mt = 0; mt < 2; ++mt)
#pragma unroll
            for (int r = 0; r < 16; ++r) ss += acc[mt][r] * acc[mt][r];
        ss += __shfl_xor(ss, 32);
        const float rstd = rsqrtf(ss * (1.f / 64.f) + EPS);
        const bf16_t* P = (const bf16_t*)(a.ws + OFF_P); bf16_t* Y = (bf16_t*)(a.ws + OFF_H);
        const float* gn = a.in.gla_g_norm + l * 64;
        const size_t row = (size_t)cid * 64 + icol;
#pragma unroll
        for (int mt = 0; mt < 2; ++mt)
#pragma unroll
            for (int qd = 0; qd < 4; ++qd) { const int e0 = 32 * mt + 8 * qd + 4 * hi;
                const f32x4 g4 = *(const f32x4*)(gn + e0);
                const u32x2 gt = *(const u32x2*)(P + row * NP + C_GATE + h * 64 + e0);
                u32x2 w;
                w.x = cvtpk(acc[mt][4 * qd + 0] * rstd * g4.x * fast_silu(lo_bf(gt.x)), acc[mt][4 * qd + 1] * rstd * g4.y * fast_silu(hi_bf(gt.x)));
                w.y = cvtpk(acc[mt][4 * qd + 2] * rstd * g4.z * fast_silu(lo_bf(gt.y)), acc[mt][4 * qd + 3] * rstd * g4.w * fast_silu(hi_bf(gt.y)));
                *(u32x2*)(Y + row * DM + h * 64 + e0) = w; }
    }
    __syncthreads();
    SEC_E(4);
}

__device__ __forceinline__ void phC_gla(const KArgs& a, int l, LAS unsigned char* lds, int tid, int wave, int lane) {
    for (int u = blockIdx.x; u < 544; u += gridDim.x) gla_local_unit(a, l, lds, u >> 1, u & 1, tid, wave, lane);
}
__device__ __forceinline__ void phD_gla(const KArgs& a, int tid) {
    for (int it = blockIdx.x; it < 128; it += gridDim.x) gla_scan_item(a, it, tid);
}
__device__ __forceinline__ void phE_gla(const KArgs& a, int l, LAS unsigned char* lds, int tid, int wave, int lane) {
    const int nu = (l == 1) ? 512 : 544;
    for (int u = blockIdx.x; u < nu; u += gridDim.x) gla_out_unit(a, l, lds, u >> 1, u & 1, tid, wave, lane);
}
constexpr int S5_WAVE_BYTES = 12544;
constexpr int S5_GT = 8 * S5_WAVE_BYTES;

__device__ __forceinline__ float gelu_tanh_fast(float v) { const float u = 0.7978845608028654f * (v + 0.044715f * v * v * v); return v * __builtin_amdgcn_rcpf(1.f + fast_exp(-2.f * u)); }

template <int DIR, bool READOUT>
__device__ __forceinline__ void s5_dir(const KArgs& a, int l, LAS unsigned char* wl, size_t row0, int g, int lane, float& xr, float& xi, f32x4 (&D2)[4]) {
    const bf16_t* P = (const bf16_t*)(a.ws + OFF_P);
    const int dgl = (l * 2 + DIR) * 16 + g;
    const bf16_t* BBT = (const bf16_t*)(a.ws + OFF_BBT) + (size_t)dgl * 128 * 16;
    const bf16_t* CMT = (const bf16_t*)(a.ws + OFF_CMT) + (size_t)dgl * 16 * 128;
    const f32x4 lb = *(const f32x4*)((const float*)(a.ws + OFF_SLB) + ((size_t)dgl * 64 + lane) * 4);
    const float lbr = lb.x, lbi = lb.y;
    LAS float* SCAN = (LAS float*)wl; LAS bf16_t* XB = (LAS bf16_t*)(wl + 8192);
    const int li = lane & 15, g4 = lane >> 4;
    const bf16x8 zero8 = {0, 0, 0, 0, 0, 0, 0, 0};
    bf16x8 bfr[8];
#pragma unroll
    for (int nt = 0; nt < 8; ++nt) bfr[nt] = (g4 < 2) ? *(const bf16x8*)(BBT + (16 * nt + li) * 16 + 8 * g4) : zero8;
    bf16x8 afr[4], cbf[4];
#pragma unroll
    for (int sb = 0; sb < 4; ++sb) afr[sb] = (g4 < 2) ? *(const bf16x8*)(P + (row0 + 16 * sb + li) * NP + C_SU + 16 * g + 8 * g4) : zero8;
    if (READOUT) {
#pragma unroll
        for (int s = 0; s < 4; ++s) cbf[s] = *(const bf16x8*)(CMT + li * 128 + 32 * s + 8 * g4);
    }
#pragma unroll
    for (int step = 0; step < 4; ++step) {
        const int sb = DIR ? 3 - step : step;
#pragma unroll
        for (int nt = 0; nt < 8; ++nt) { f32x4 d = {0.f, 0.f, 0.f, 0.f}; d = MFMA16(afr[sb], bfr[nt], d);
#pragma unroll
            for (int r = 0; r < 4; ++r) SCAN[(4 * g4 + r) * 128 + 16 * nt + li] = d[r]; }
        LDS_FENCE();
#pragma unroll
        for (int hh = 0; hh < 2; ++hh) {
            const int tb = (DIR ? 1 - hh : hh) * 8;
            float br[8], bi[8];
#pragma unroll
            for (int t = 0; t < 8; ++t) { const f32x2_t v2 = *(const LAS f32x2_t*)(SCAN + (tb + t) * 128 + 2 * lane); br[t] = v2.x; bi[t] = v2.y; }
#pragma unroll
            for (int tt = 0; tt < 8; ++tt) { const int t = DIR ? 7 - tt : tt;
                const float nxr = lbr * xr - lbi * xi + br[t], nxi = lbr * xi + lbi * xr + bi[t]; xr = nxr; xi = nxi;
                if (READOUT) { br[t] = xr; bi[t] = xi; } }
            if (READOUT) {
#pragma unroll
                for (int t = 0; t < 8; ++t) *(LAS unsigned*)(XB + (tb + t) * 136 + 2 * lane) = cvtpk(br[t], bi[t]);
            }
        }
        LDS_FENCE();
        if (READOUT) {
#pragma unroll
            for (int s = 0; s < 4; ++s) { const bf16x8 xa = *(const LAS bf16x8*)(XB + li * 136 + 32 * s + 8 * g4);
                D2[sb] = MFMA16(xa, cbf[s], D2[sb]); }
            LDS_FENCE();
        }
    }
}

__device__ __forceinline__ void s5_local_unit(const KArgs& a, int l, LAS unsigned char* lds, int cid, int wave, int lane) {
    const int tid = wave * 64 + lane; SEC_B(5);
    const bool lat = cid < 256; const int b = lat ? cid >> 6 : (cid - 256) >> 2; const int slot = lat ? 4 + (cid & 63) : (cid - 256) & 3;
    LAS unsigned char* wl = lds + wave * S5_WAVE_BYTES;
    float* SXL = (float*)(a.ws + OFF_SXL);
    f32x4 dummy[4];
#pragma unroll
    for (int gi = 0; gi < 2; ++gi) { const int g = 2 * wave + gi;
        { float xr = 0.f, xi = 0.f; s5_dir<0, false>(a, l, wl, (size_t)cid * 64, g, lane, xr, xi, dummy);
          float* o = SXL + ((size_t)((b * 16 + g) * 2 + 0) * 68 + slot) * 128; o[lane] = xr; o[64 + lane] = xi; }
        { float xr = 0.f, xi = 0.f; s5_dir<1, false>(a, l, wl, (size_t)cid * 64, g, lane, xr, xi, dummy);
          float* o = SXL + ((size_t)((b * 16 + g) * 2 + 1) * 68 + slot) * 128; o[lane] = xr; o[64 + lane] = xi; }
    }
    SEC_E(5);
}

__device__ __forceinline__ void s5_scan_item(const KArgs& a, int l, int item, int tid) {
    const int chain = item * 8 + (tid >> 6), p = tid & 63, dir = chain & 1, g = (chain >> 1) & 15;
    const int dgl = (l * 2 + dir) * 16 + g;
    const f32x4 lb = *(const f32x4*)((const float*)(a.ws + OFF_SLB) + ((size_t)dgl * 64 + p) * 4);
    const float* SXL = (const float*)(a.ws + OFF_SXL) + (size_t)chain * 68 * 128 + p;
    float* SX0 = (float*)(a.ws + OFF_SX0) + (size_t)chain * 68 * 128 + p;
    float xr = 0.f, xi = 0.f;
    for (int st = 0; st < 68; st += 4) {
        float vr[4], vi[4]; int sl[4];
#pragma unroll
        for (int k = 0; k < 4; ++k) { sl[k] = dir ? 71 - (st + k) : st + k; if (dir && st + k < 4) sl[k] = 3 - (st + k); vr[k] = SXL[sl[k] * 128]; vi[k] = SXL[sl[k] * 128 + 64]; }
#pragma unroll
        for (int k = 0; k < 4; ++k) { SX0[sl[k] * 128] = xr; SX0[sl[k] * 128 + 64] = xi;
            const float nr = lb.z * xr - lb.w * xi + vr[k], ni = lb.z * xi + lb.w * xr + vi[k]; xr = nr; xi = ni; }
    }
}

__device__ __forceinline__ void s5_out_unit(const KArgs& a, int l, LAS unsigned char* lds, int cid, int tid, int wave, int lane) {
    const bf16_t* P = (const bf16_t*)(a.ws + OFF_P); bf16_t* Y = (bf16_t*)(a.ws + OFF_H);
    const bool lat = cid < 256; const int b = lat ? cid >> 6 : (cid - 256) >> 2; const int slot = lat ? 4 + (cid & 63) : (cid - 256) & 3;
    const size_t row0 = (size_t)cid * 64;
    LAS unsigned char* wl = lds + wave * S5_WAVE_BYTES;
    LAS bf16_t* GT = (LAS bf16_t*)(lds + S5_GT);
    const float* SX0 = (const float*)(a.ws + OFF_SX0);
    const float* dsk = a.in.s5_d + l * 256;
    const int li = lane & 15, g4 = lane >> 4;
    SEC_B(1);
#pragma unroll 1
    for (int gi = 0; gi < 2; ++gi) { const int g = 2 * wave + gi;
        f32x4 D2[4];
#pragma unroll
        for (int k = 0; k < 4; ++k) D2[k] = (f32x4){0.f, 0.f, 0.f, 0.f};
        { const float* x0 = SX0 + ((size_t)((b * 16 + g) * 2 + 0) * 68 + slot) * 128; float xr = x0[lane], xi = x0[64 + lane];
          s5_dir<0, true>(a, l, wl, row0, g, lane, xr, xi, D2); }
        { const float* x0 = SX0 + ((size_t)((b * 16 + g) * 2 + 1) * 68 + slot) * 128; float xr = x0[lane], xi = x0[64 + lane];
          s5_dir<1, true>(a, l, wl, row0, g, lane, xr, xi, D2); }
        const float dk = dsk[16 * g + li];
        const unsigned uoff = (unsigned)(4 * g4) * NP + li;
#pragma unroll
        for (int sb = 0; sb < 4; ++sb)
#pragma unroll
            for (int r = 0; r < 4; ++r) { const int t = 16 * sb + 4 * g4 + r;
                const bf16_t* urow = P + (row0 + 16 * sb + r) * NP + C_SU + 16 * g;
                const float u = bf2f(urow[uoff]);
                GT[t * 264 + 16 * g + li] = (bf16_t)cvtpk(gelu_tanh_fast(D2[sb][r] + u * dk), 0.f); }
    }
    __syncthreads();
    SEC_E(1);
    SEC_B(2);
    {
        const bf16_t* WGT = (const bf16_t*)(a.ws + OFF_WGT) + (size_t)l * 65536;
        f32x4 acc[2][4];
#pragma unroll
        for (int mi = 0; mi < 2; ++mi)
#pragma unroll
            for (int nt = 0; nt < 4; ++nt) acc[mi][nt] = (f32x4){0.f, 0.f, 0.f, 0.f};
#pragma unroll
        for (int s = 0; s < 8; ++s) {
            bf16x8 af[2], bfr[4];
#pragma unroll
            for (int mi = 0; mi < 2; ++mi) af[mi] = *(const bf16x8*)(WGT + (size_t)(16 * (2 * wave + mi) + li) * 256 + 32 * s + 8 * g4);
#pragma unroll
            for (int nt = 0; nt < 4; ++nt) bfr[nt] = *(const LAS bf16x8*)(GT + (16 * nt + li) * 264 + 32 * s + 8 * g4);
#pragma unroll
            for (int mi = 0; mi < 2; ++mi)
#pragma unroll
                for (int nt = 0; nt < 4; ++nt) acc[mi][nt] = MFMA16(af[mi], bfr[nt], acc[mi][nt]);
        }
        const float* bgl = a.in.s5_b_glu + l * 256;
#pragma unroll
        for (int mi = 0; mi < 2; ++mi) { const int m0 = 16 * (2 * wave + mi) + 4 * g4; const f32x4 bv = *(const f32x4*)(bgl + m0);
#pragma unroll
            for (int nt = 0; nt < 4; ++nt) { const int t = 16 * nt + li; const size_t row = row0 + t;
                const u32x2 gv = *(const LAS u32x2*)(GT + t * 264 + m0);
                const u32x2 gt = *(const u32x2*)(P + row * NP + C_GATE + 512 + m0);
                const float o0 = lo_bf(gv.x) * __builtin_amdgcn_rcpf(1.f + fast_exp(-(acc[mi][nt][0] + bv.x))) * fast_silu(lo_bf(gt.x));
                const float o1 = hi_bf(gv.x) * __builtin_amdgcn_rcpf(1.f + fast_exp(-(acc[mi][nt][1] + bv.y))) * fast_silu(hi_bf(gt.x));
                const float o2 = lo_bf(gv.y) * __builtin_amdgcn_rcpf(1.f + fast_exp(-(acc[mi][nt][2] + bv.z))) * fast_silu(lo_bf(gt.y));
                const float o3 = hi_bf(gv.y) * __builtin_amdgcn_rcpf(1.f + fast_exp(-(acc[mi][nt][3] + bv.w))) * fast_silu(hi_bf(gt.y));
                u32x2 w; w.x = cvtpk(o0, o1); w.y = cvtpk(o2, o3);
                *(u32x2*)(Y + row * DM + 512 + m0) = w; }
        }
    }
    __syncthreads();
    SEC_E(2);
}

__device__ __forceinline__ void phC_s5(const KArgs& a, int l, LAS unsigned char* lds, int wave, int lane) {
    for (int cid = blockIdx.x; cid < 272; cid += gridDim.x) s5_local_unit(a, l, lds, cid, wave, lane);
    __syncthreads();
}
__device__ __forceinline__ void phD_s5(const KArgs& a, int l, int tid) {
    const int vb = gridDim.x - 1 - blockIdx.x;
    for (int it = vb; it < 16; it += gridDim.x) s5_scan_item(a, l, it, tid);
}
__device__ __forceinline__ void phE_s5(const KArgs& a, int l, LAS unsigned char* lds, int tid, int wave, int lane) {
    const int nc = (l == 1) ? 256 : 272;
    for (int cid = blockIdx.x; cid < nc; cid += gridDim.x) s5_out_unit(a, l, lds, cid, tid, wave, lane);
}

__device__ __forceinline__ void pro_s5_tables(const KArgs& a, int tid) {
    const Inputs& in = a.in;
    const int gt = blockIdx.x * NTHR + tid, NGT = gridDim.x * NTHR;
    bf16_t* BBT = (bf16_t*)(a.ws + OFF_BBT); bf16_t* CMT = (bf16_t*)(a.ws + OFF_CMT); float* SLB = (float*)(a.ws + OFF_SLB); bf16_t* WGT = (bf16_t*)(a.ws + OFF_WGT);
    if (gt < 2 * 2 * 16 * 64) {
        const int p = gt & 63, dgl = gt >> 6;
        const float dt = expf(in.s5_log_dt[dgl]);
        const float lre = in.s5_lam_re[dgl * 64 + p], lim = in.s5_lam_im[dgl * 64 + p];
        const float mag = expf(lre * dt), ang = lim * dt;
        const float lbr = mag * cosf(ang), lbi = mag * sinf(ang);
        const float nr = lbr - 1.f, ni = lbi, den = lre * lre + lim * lim;
        const float cr = (nr * lre + ni * lim) / den, ci = (ni * lre - nr * lim) / den;
        for (int h = 0; h < 16; ++h) { const float br = in.s5_b_re[((size_t)dgl * 64 + p) * 16 + h], bi = in.s5_b_im[((size_t)dgl * 64 + p) * 16 + h];
            BBT[((size_t)dgl * 128 + 2 * p) * 16 + h] = f2bf(cr * br - ci * bi); BBT[((size_t)dgl * 128 + 2 * p + 1) * 16 + h] = f2bf(cr * bi + ci * br); }
        float pr = lbr, pi = lbi;
        for (int k = 0; k < 6; ++k) { const float tr = pr * pr - pi * pi, ti = 2.f * pr * pi; pr = tr; pi = ti; }
        *(f32x4*)(SLB + ((size_t)dgl * 64 + p) * 4) = (f32x4){lbr, lbi, pr, pi};
    }
    for (int i = gt; i < 2 * 2 * 16 * 16 * 128; i += NGT) { const int pri = i & 127, h = (i >> 7) & 15, dgl = i >> 11;
        const float v = (pri & 1) ? -in.s5_c_im[((size_t)dgl * 16 + h) * 64 + (pri >> 1)] : in.s5_c_re[((size_t)dgl * 16 + h) * 64 + (pri >> 1)];
        CMT[i] = f2bf(v); }
    for (int i = gt; i < 2 * 65536; i += NGT) { const int n = i & 255, m = (i >> 8) & 255, li = i >> 16; WGT[i] = f2bf(in.s5_w_glu[(size_t)li * 65536 + n * 256 + m]); }
}
#define WQ_LOOP(ctr_, nitems_, ...) do { unsigned nxt_ = 0u; if (tid == 0) nxt_ = atomicAdd((ctr_), 1u); \
    for (;;) { __syncthreads(); if (tid == 0) wq[0] = nxt_; __syncthreads(); const int item = (int)wq[0]; if (item >= (nitems_)) break; \
        if (tid == 0) nxt_ = atomicAdd((ctr_), 1u); __VA_ARGS__ } __syncthreads(); } while (0)
#define WQ_CTR(l, idx) ((unsigned*)(a.ws + OFF_CTL) + 32 + 16 * ((l) * 16 + (idx)))

__device__ __forceinline__ void phC_dyn(const KArgs& a, int l, LAS unsigned char* lds, volatile LAS unsigned* wq, int tid, int wave, int lane) {
    WQ_LOOP(WQ_CTR(l, 0), 272, { s5_local_unit(a, l, lds, item, wave, lane); });
    if (l == 0) WQ_LOOP(WQ_CTR(l, 1), 32, { na_block<false>(a, lds, item >> 3, (item >> 1) & 3, item & 1, tid, wave, lane); });
    WQ_LOOP(WQ_CTR(l, 2), 544, { gla_local_unit(a, l, lds, item >> 1, item & 1, tid, wave, lane); });
}
__device__ __forceinline__ void phD_dyn(const KArgs& a, int l, LAS unsigned char* lds, volatile LAS unsigned* wq, int tid, int wave, int lane) {
    LAS float* rpb = (LAS float*)(lds + NA_RPB_OFF);
    for (int i = tid; i < 4 * 465; i += NTHR) rpb[i] = a.in.na_rpb[l * 4 * 465 + i];
    WQ_LOOP(WQ_CTR(l, 3), 512, { const int ln = fresh_lane(); na_block<true>(a, lds, item >> 7, (item >> 5) & 3, item & 31, wave * 64 + ln, wave, ln); });
    WQ_LOOP(WQ_CTR(l, 4), (l == 1) ? 256 : 272, { pool_item(a, l, lds, item, tid, wave, lane); });
    WQ_LOOP(WQ_CTR(l, 5), 128, { gla_scan_item(a, item, tid); });
    WQ_LOOP(WQ_CTR(l, 6), 16, { s5_scan_item(a, l, item, tid); });
}
__device__ __forceinline__ void phE_dyn(const KArgs& a, int l, LAS unsigned char* lds, volatile LAS unsigned* wq, int tid, int wave, int lane) {
    WQ_LOOP(WQ_CTR(l, 7), (l == 1) ? 256 : 272, { s5_out_unit(a, l, lds, item, tid, wave, lane); });
    WQ_LOOP(WQ_CTR(l, 8), (l == 1) ? 512 : 544, { gla_out_unit(a, l, lds, item >> 1, item & 1, tid, wave, lane); });
}
__global__ void __launch_bounds__(NTHR, 2) mega(KArgs a_by_value) {
    unsigned long long kp_ = (unsigned long long)__builtin_amdgcn_kernarg_segment_ptr();
    asm volatile("" : "+s"(kp_));
    const KArgs& a = *(const KArgs*)(const GAS KArgs*)kp_;
    extern __shared__ __attribute__((aligned(16))) unsigned char lds_raw[];
    LAS unsigned char* lds = (LAS unsigned char*)lds_raw;
    const int wave = __builtin_amdgcn_readfirstlane((int)threadIdx.x >> 6);
#define MY_LANE() fresh_lane()
#define T0() (wave == 0 && MY_LANE() == 0)
    const int tid = wave * 64 + MY_LANE();
    volatile LAS unsigned* MISC = (volatile LAS unsigned*)(lds + MISC_OFF);
    for (int u = tid; u < (LDS_BYTES - RING_BYTES) / 4; u += NTHR) ((LAS unsigned*)(lds + RING_BYTES))[u] = 0u;
    __syncthreads();
    unsigned* ctl = (unsigned*)(a.ws + OFF_CTL);
    XcdBarrier bar = xcd_barrier_post(ctl + CW_BAR + a.li * XCD_BAR_WORDS, MISC + 8, T0());
    const int lo = a.ph_lo, hi = a.ph_hi;
    cooperative_groups::this_grid().sync();
#define IN(k) (lo <= (k) && (k) < hi)
#define REP(i, ...) do { _Pragma("unroll") for (int rr = 0; rr <= kRep[i]; ++rr) { __VA_ARGS__; if (rr < kRep[i]) xcd_barrier(bar, T0()); } } while (0)
#define PHV const int lane_ = MY_LANE(); const int tid_ = wave * 64 + lane_
#ifdef PROBE_TSEL
    unsigned long long tp_prev = __builtin_amdgcn_s_memrealtime(), tp_acc = 0ull;
#define TSTAMP(k) do { const unsigned long long tn_ = __builtin_amdgcn_s_memrealtime(); if ((PROBE_TSEL >> (k)) & 1) tp_acc += tn_ - tp_prev; tp_prev = tn_; } while (0)
#else
#define TSTAMP(k) do { } while (0)
#endif
#define SEAM(k) do { if (IN(k) && IN((k) + 1)) { xcd_barrier(bar, T0()); } TSTAMP(k); } while (0)
    if (IN(PH_PRO)) { PHV; REP(0, { ph_prologue(a, lds, tid_, wave, lane_); pro_s5_tables(a, tid_); }); for (int rr = 0; rr < kRep[7]; ++rr) xcd_barrier(bar, T0()); }
    SEAM(PH_PRO);
#define LAYER(l) do { \
        constexpr int pb = PH_L0 + (l) * PH_PER_LAYER; \
        constexpr int nrows_out = ((l) == 1) ? NLAT : MTOT; \
        if (IN(pb + 0)) { PHV; REP(1, ph_post_pre(a, (l) - 1, (l), wave, lane_)); } \
        SEAM(pb + 0); \
        if (IN(pb + 1)) { PHV; REP(2, { \
            pg8::Gemm g{(const bf16_t*)(a.ws + OFF_H), (const bf16_t*)(a.ws + OFF_WIN) + (size_t)(l) * NP * DM, MTOT, NP, DM}; \
            pg8::StaticOrder S; S.init(MTOT, NP, gridDim.x, blockIdx.x); \
            pg8::EpiBf16<0> E{(bf16_t*)(a.ws + OFF_P), NP, nullptr, 0, 0, 1.f}; \
            pg8::gemm_phase<pg8::EpiBf16<0>, pg8::StaticOrder, true, true>(lds, g, S, E, wave); }); \
        } \
        SEAM(pb + 1); \
        if (IN(pb + 2)) { PHV; REP(3, phC_dyn(a, (l), lds, MISC + 16, tid_, wave, lane_)); } \
        SEAM(pb + 2); \
        if (IN(pb + 3)) { PHV; REP(4, phD_dyn(a, (l), lds, MISC + 16, tid_, wave, lane_)); } \
        SEAM(pb + 3); \
        if (IN(pb + 4)) { PHV; REP(5, phE_dyn(a, (l), lds, MISC + 16, tid_, wave, lane_)); } \
        SEAM(pb + 4); \
        if (IN(pb + 5)) { PHV; REP(6, { \
            pg8::Gemm g{(const bf16_t*)(a.ws + OFF_H), (const bf16_t*)(a.ws + OFF_WOUT) + (size_t)(l) * DM * DM, nrows_out, DM, DM}; \
            pg8::StaticOrder S; S.init(nrows_out, DM, gridDim.x, blockIdx.x); \
            pg8::EpiF32 E{(float*)(a.ws + OFF_P), DM, nullptr}; \
            pg8::gemm_phase<pg8::EpiF32, pg8::StaticOrder, true, true>(lds, g, S, E, wave); }); \
        } \
        SEAM(pb + 5); \
    } while (0)
    LAYER(0);
    LAYER(1);
#undef LAYER
    if (IN(PH_FIN)) { PHV; ph_post_pre(a, 1, 2, wave, lane_); }
#ifdef PROBE_SEC
    if (blockIdx.x == 0 && wave == 0) { const unsigned long long acc_ = ((volatile LAS unsigned*)(lds + MISC_OFF + 96))[0]; const unsigned long long t0_ = __builtin_amdgcn_s_memrealtime(); while (__builtin_amdgcn_s_memrealtime() - t0_ < 4ull * acc_) __builtin_amdgcn_s_sleep(8); }
#endif
#ifdef PROBE_TSEL
    TSTAMP(PH_FIN);
    if (blockIdx.x == 0 && wave == 0) { const unsigned long long t0_ = __builtin_amdgcn_s_memrealtime(); while (__builtin_amdgcn_s_memrealtime() - t0_ < 4ull * tp_acc) __builtin_amdgcn_s_sleep(8); }
#endif
#undef IN
#undef SEAM
}

static int g_grid = 0;
static void launch_mega(const KArgs& base, int lo, int hi, int li, hipStream_t stream) {
    KArgs a = base; a.ph_lo = lo; a.ph_hi = hi; a.li = li;
    void* args[] = {(void*)&a};
    hipError_t e = hipLaunchCooperativeKernel((const void*)mega, dim3(g_grid), dim3(NTHR), args, LDS_BYTES, stream);
    if (e != hipSuccess) fprintf(stderr, "cooperative launch failed: %s (grid %d)\n", hipGetErrorString(e), g_grid);
}

extern "C" void kernel_launch(void* const* d_in, const int* in_sizes, int n_in, void* d_out, int out_size, void* d_ws, size_t ws_size, hipStream_t stream) {
    if (g_grid == 0) {
        int dev = 0, cus = 0, per_cu = 0;
        hipGetDevice(&dev);
        hipDeviceGetAttribute(&cus, hipDeviceAttributeMultiprocessorCount, dev);
        hipFuncSetAttribute((const void*)mega, hipFuncAttributeMaxDynamicSharedMemorySize, LDS_BYTES);
        hipOccupancyMaxActiveBlocksPerMultiprocessor(&per_cu, (const void*)mega, NTHR, LDS_BYTES);
        if (per_cu < 1) per_cu = 1;
        g_grid = cus * per_cu;
        if (g_grid != 256) fprintf(stderr, "note: grid %d (cus %d x %d)\n", g_grid, cus, per_cu);
    }
    KArgs base;
    memset(&base, 0, sizeof(base));
    const float** ip = (const float**)&base.in;
    for (int i = 0; i < 26; ++i) ip[i] = (const float*)d_in[i];
    base.out = (float*)d_out; base.ws = (unsigned char*)d_ws; base.mask = 7;
    hipMemsetAsync((char*)d_ws + OFF_CTL, 0, CTL_BYTES, stream);
    launch_mega(base, PH_PRO, PH_END, 0, stream);
}
```

```cpp
#include <hip/hip_runtime.h>
#include <hip/hip_cooperative_groups.h>
#include <stdint.h>
#include <math.h>
#include <cstdio>
#include <cstring>

typedef unsigned short bf16_t;
__device__ __forceinline__ float bf2f(bf16_t v) { return __uint_as_float(((unsigned)v) << 16); }
__device__ __forceinline__ bf16_t f2bf(float f) { unsigned u = __float_as_uint(f); return (bf16_t)((u + 0x7fffu + ((u >> 16) & 1u)) >> 16); }

constexpr int DM = 1024, NB = 4, SEQ = 4096, NCTX = 256, GW = 64;
constexpr int NLAT = NB * SEQ;
constexpr int NCT = NB * NCTX;
constexpr int MTOT = NLAT + NCT;
constexpr int NIN = 2848, NP = 3072;
constexpr int C_GK = 0, C_GV = 128, C_GF = 384, C_GB = 400, C_NK = 416, C_NV = 672, C_SU = 928, C_GQ = 1184, C_NQ = 1312, C_PU = 1568, C_GATE = 1824;
constexpr float EPS = 1e-6f;

constexpr size_t OFF_CTL = 0, CTL_BYTES = 256 * 1024;
constexpr size_t OFF_WIN = OFF_CTL + CTL_BYTES;
constexpr size_t OFF_WOUT = OFF_WIN + (size_t)2 * NP * DM * 2;
constexpr size_t OFF_MOD = OFF_WOUT + (size_t)2 * DM * DM * 2;
constexpr size_t OFF_H = OFF_MOD + (size_t)2 * 5 * 3072 * 4 + 1024;
constexpr size_t OFF_P = OFF_H + (size_t)MTOT * DM * 2;
constexpr size_t OFF_XC = OFF_P + (size_t)MTOT * NP * 2;
constexpr size_t OFF_VTL = OFF_XC + (size_t)NCT * DM * 4;
constexpr size_t OFF_VTC = OFF_VTL + (size_t)1024 * SEQ * 2;
constexpr size_t OFF_WPT = OFF_VTC + (size_t)1024 * NCTX * 2;
constexpr size_t OFF_ROPE = OFF_WPT + (size_t)2 * 4 * 64 * 64 * 2;
constexpr size_t OFF_GLOC = OFF_ROPE + 4096;
constexpr size_t OFF_GDEC = OFF_GLOC + (size_t)32 * 68 * 2048 * 4;
constexpr size_t OFF_GSIN = OFF_GDEC + (size_t)32 * 68 * 32 * 4;
constexpr size_t OFF_BBT = OFF_GSIN + (size_t)32 * 68 * 2048 * 2;
constexpr size_t OFF_CMT = OFF_BBT + (size_t)64 * 128 * 16 * 2;
constexpr size_t OFF_SLB = OFF_CMT + (size_t)64 * 16 * 128 * 2;
constexpr size_t OFF_WGT = OFF_SLB + (size_t)64 * 64 * 16;
constexpr size_t OFF_SXL = OFF_WGT + (size_t)2 * 65536 * 2;
constexpr size_t OFF_SX0 = OFF_SXL + (size_t)128 * 68 * 128 * 4;
constexpr size_t OFF_END = OFF_SX0 + (size_t)128 * 68 * 128 * 4;
static_assert(OFF_END <= (size_t)256 * 1024 * 1024, "ws");

struct Inputs {
    const float *x, *c, *ctx, *c_ctx, *w_mod, *b_mod, *g_pre, *g_post, *w_in, *w_out, *gla_w_gate, *gla_b_gate, *gla_g_norm, *na_rpb,
        *s5_lam_re, *s5_lam_im, *s5_log_dt, *s5_b_re, *s5_b_im, *s5_c_re, *s5_c_im, *s5_d, *s5_w_glu, *s5_b_glu, *pool_w, *pool_scale;
};

__device__ __forceinline__ float silu_f(float v) { return v / (1.f + expf(-v)); }
__device__ __forceinline__ float sigmoid_f(float v) { return 1.f / (1.f + expf(-v)); }
__device__ __forceinline__ float gelu_tanh_f(float v) { const float k = 0.7978845608028654f; return 0.5f * v * (1.f + tanhf(k * (v + 0.044715f * v * v * v))); }
__device__ __forceinline__ float logsigmoid_f(float z) { return fminf(z, 0.f) - log1pf(expf(-fabsf(z))); }

#define LAS __attribute__((address_space(3)))
__device__ __forceinline__ int fresh_lane();
namespace pg8 {
#define PG8_LAS __attribute__((address_space(3)))
typedef unsigned short bf16_t;
typedef short bf16x8 __attribute__((ext_vector_type(8)));
typedef float f32x4 __attribute__((ext_vector_type(4)));
typedef unsigned u32x4 __attribute__((ext_vector_type(4)));
constexpr int BM = 256, BK = 64, HALF = 128, HTB = HALF * BK * 2  , STAGE_BYTES = 8 * HTB, NXCD = 8, WGM = 8;

__host__ __device__ __forceinline__ int lds_byte(int r, int c) { const int st = (r >> 4) * 2 + (c >> 5), rr = r & 15, cc = c & 31, ob = rr * 64 + cc * 2; return st * 1024 + (ob ^ (((ob >> 9) & 1) << 5)); }
__host__ __device__ __forceinline__ void stage_rc(int b, int& R, int& C) { const int st = b / 1024, sb = b % 1024, swz = sb ^ (((sb >> 9) & 1) << 5); R = (st >> 1) * 16 + swz / 64; C = (st & 1) * 32 + (swz % 64) / 2; }
__host__ __device__ __forceinline__ int perm32(int rho) { const int n = rho >> 4, i = rho & 15; return 8 * (i >> 2) + 4 * n + (i & 3); }

struct Unit { int pm, pn; };
struct Gemm { const bf16_t* A; const bf16_t* Bt; int M, N, K; };

struct StaticOrder {
    int nM, nN, nwg, G, c;
    __host__ __device__ void init(int M, int N, int G_, int c_) { nM = M / BM; nN = N / BM; nwg = nM * nN; G = G_; c = c_; }
    __host__ __device__ bool next(int i, Unit& u) const {
        const long L = (long)i * G + c; if (L >= nwg) return false;
        int wgid = (int)L; { const int q = nwg / NXCD, r = nwg % NXCD, xcd = wgid % NXCD, off = wgid / NXCD; wgid = (xcd < r ? xcd * (q + 1) : r * (q + 1) + (xcd - r) * q) + off; }
        const int nig = WGM * nN, gid = wgid / nig, fm = gid * WGM, gsz = (nM - fm) < WGM ? (nM - fm) : WGM;
        u.pm = fm + ((wgid % nig) % gsz); u.pn = (wgid % nig) / gsz; return true;
    }
    __device__ __forceinline__ void a_ready(const Unit&) const {}
    __device__ __forceinline__ void done(const Unit&) const {}
};

__device__ __forceinline__ unsigned cvt_pk_bf16(float lo, float hi) { unsigned r; asm volatile("v_cvt_pk_bf16_f32 %0, %1, %2" : "=v"(r) : "v"(lo), "v"(hi)); return r; }
typedef float f32x2 __attribute__((ext_vector_type(2)));
__device__ __forceinline__ f32x2 gelu_pk(f32x2 v) {
    const f32x2 av = __builtin_elementwise_abs(v), d = av * 0.2316418882f + 1.0f;
    f32x2 t; t.x = __builtin_amdgcn_rcpf(d.x); t.y = __builtin_amdgcn_rcpf(d.y);
    f32x2 q = t * 0.5307027145f + (-0.7265760135f); q = q * t + 0.7107068705f; q = q * t + (-0.142248368f); q = q * t + 0.127414796f; q = q * t;
    const f32x2 s = (v * v) * (-0.72134752044f);
    f32x2 e; e.x = __builtin_amdgcn_exp2f(s.x); e.y = __builtin_amdgcn_exp2f(s.y);
    const f32x2 m = v * (q * e), r = v - m;
    f32x2 o; o.x = v.x < 0.f ? m.x : r.x; o.y = v.y < 0.f ? m.y : r.y; return o;
}

template <int ACT  > struct EpiBf16 {
    static constexpr bool PERM = true, AFTER_DRAIN = false; static_assert(ACT == 0 || ACT == 1, "EpiBf16: ACT is 0 (none) or 1 (gelu_pk)");
    bf16_t* O; int ldc; const float* bias; int split_cols; size_t split_stride; float scale0;
    __device__ __forceinline__ void operator()(const f32x4 (&acc)[2][2][4][2], const Unit& u, int wr, int wc, int fr, int fq) const {
        const int row0 = u.pm * BM + wr * 64 + fr; int colt = u.pn * BM; bf16_t* base = O;
        float sc = 1.f; if (split_cols) { const int t = colt / split_cols; base += (size_t)t * split_stride; colt -= t * split_cols; if (t == 0) sc = scale0; }
        const int col0 = colt + wc * 32 + 8 * fq, bcol0 = u.pn * BM + wc * 32 + 8 * fq;
        f32x4 bv[2][2];
#pragma unroll
        for (int bj = 0; bj < 2; ++bj)
#pragma unroll
            for (int n = 0; n < 2; ++n) bv[bj][n] = bias ? *(const f32x4*)(bias + bcol0 + bj * HALF + 4 * n) : (f32x4){0.f, 0.f, 0.f, 0.f};
#pragma unroll
        for (int ai = 0; ai < 2; ++ai)
#pragma unroll
            for (int m = 0; m < 4; ++m) { bf16_t* rowp = base + (size_t)(row0 + ai * HALF + m * 16) * ldc + col0;
#pragma unroll
                for (int bj = 0; bj < 2; ++bj) { f32x4 v0 = acc[ai][bj][m][0] + bv[bj][0], v1 = acc[ai][bj][m][1] + bv[bj][1];
                    if (ACT == 1) { f32x2 a = gelu_pk((f32x2){v0[0], v0[1]}), b = gelu_pk((f32x2){v0[2], v0[3]}), c = gelu_pk((f32x2){v1[0], v1[1]}), d = gelu_pk((f32x2){v1[2], v1[3]});
                        v0 = (f32x4){a.x, a.y, b.x, b.y}; v1 = (f32x4){c.x, c.y, d.x, d.y}; }
                    v0 = v0 * sc; v1 = v1 * sc; u32x4 w; w.x = cvt_pk_bf16(v0[0], v0[1]); w.y = cvt_pk_bf16(v0[2], v0[3]); w.z = cvt_pk_bf16(v1[0], v1[1]); w.w = cvt_pk_bf16(v1[2], v1[3]);
                    *(u32x4*)(rowp + bj * HALF) = w; } }
    }
};
struct EpiF32 {
    static constexpr bool PERM = false, AFTER_DRAIN = false;
    float* C; int ldc; const float* bias;
    __device__ __forceinline__ void operator()(const f32x4 (&acc)[2][2][4][2], const Unit& u, int wr, int wc, int fr, int fq) const {
        const int row0 = u.pm * BM + wr * 64 + fr, col0 = u.pn * BM + wc * 32 + 4 * fq;
        f32x4 bv[2][2];
#pragma unroll
        for (int bj = 0; bj < 2; ++bj)
#pragma unroll
            for (int n = 0; n < 2; ++n) bv[bj][n] = bias ? *(const f32x4*)(bias + col0 + bj * HALF + n * 16) : (f32x4){0.f, 0.f, 0.f, 0.f};
#pragma unroll
        for (int ai = 0; ai < 2; ++ai)
#pragma unroll
            for (int m = 0; m < 4; ++m) { float* rowp = C + (size_t)(row0 + ai * HALF + m * 16) * ldc + col0;
#pragma unroll
                for (int bj = 0; bj < 2; ++bj)
#pragma unroll
                    for (int n = 0; n < 2; ++n) *(f32x4*)(rowp + bj * HALF + n * 16) = acc[ai][bj][m][n] + bv[bj][n]; }
    }
};
template <class Epi, class Sched, bool ALIGN_EPI = false, bool SP2 = false>
__device__ __forceinline__ void gemm_phase(PG8_LAS unsigned char* lds, const Gemm g, const Sched& S, const Epi& E, const int wave_in) {
    const int lane = fresh_lane(), wid = wave_in, tid = wid * 64 + lane, wr = wid >> 2, wc = wid & 3, fr = lane & 15, fq = lane >> 4;
    const int K = g.K, nt = K / BK;
    unsigned voffA[2], voffB[2];
#pragma unroll
    for (int i = 0; i < 2; ++i) { int R, C; stage_rc(tid * 16 + i * 8192, R, C); const int Rb = Epi::PERM ? ((R & ~31) + perm32(R & 31)) : R;
        voffA[i] = (unsigned)(R * K + C) * 2u; voffB[i] = (unsigned)(Rb * K + C) * 2u; }
    const size_t kstep = (size_t)(BK * 2);
    const size_t hstep = (size_t)HALF * K * 2;
    const size_t tstep = 2 * hstep;
    const unsigned ldsw = (unsigned)wid * 1024u;
    const int aoff = lds_byte(wr * 64 + fr, fq * 8), boff = lds_byte(wc * 32 + fr, fq * 8);
#define PG8_SA(b, h) (((b) * 2 + (h)) * HTB)
#define PG8_SB(b, h) ((4 + (b) * 2 + (h)) * HTB)
#define PG8_STAGE(bufoff, gbase, voff) do { _Pragma("unroll") for (int _i = 0; _i < 2; ++_i) \
        __builtin_amdgcn_global_load_lds((const unsigned*)((const char*)(gbase) + (voff)[_i]), (PG8_LAS unsigned*)(lds + (bufoff) + ldsw + _i * 8192), 16, 0, 0); } while (0)
#define PG8_LDA(dst, b, h) do { _Pragma("unroll") for (int m = 0; m < 4; ++m) _Pragma("unroll") for (int k = 0; k < 2; ++k) dst[m][k] = *(const PG8_LAS bf16x8*)(lds + PG8_SA(b, h) + aoff + m * 2048 + k * 1024); } while (0)
#define PG8_LDB(dst, b, h) do { _Pragma("unroll") for (int n = 0; n < 2; ++n) _Pragma("unroll") for (int k = 0; k < 2; ++k) dst[n][k] = *(const PG8_LAS bf16x8*)(lds + PG8_SB(b, h) + boff + n * 2048 + k * 1024); } while (0)
#define PG8_MMA(ai, bj, At, Bt) do { __builtin_amdgcn_s_setprio(1); _Pragma("unroll") for (int m = 0; m < 4; ++m) _Pragma("unroll") for (int n = 0; n < 2; ++n) _Pragma("unroll") for (int k = 0; k < 2; ++k) \
        acc[ai][bj][m][n] = __builtin_amdgcn_mfma_f32_16x16x32_bf16(Bt[n][k], At[m][k], acc[ai][bj][m][n], 0, 0, 0); __builtin_amdgcn_s_setprio(0); } while (0)
#define PG8_WAIT_V(n) asm volatile("s_waitcnt vmcnt(" #n ")" ::: "memory")
#define PG8_WAIT_L(n) asm volatile("s_waitcnt lgkmcnt(" #n ")" ::: "memory")
#define PG8_BAR __builtin_amdgcn_s_barrier()
#define PG8_SCHED __builtin_amdgcn_sched_barrier(0)
    Unit cur, nxt; int ui = 0;
    if (!S.next(0, cur)) return;
    f32x4 acc[2][2][4][2];
#pragma unroll
    for (int a = 0; a < 2; ++a)
#pragma unroll
        for (int b = 0; b < 2; ++b)
#pragma unroll
            for (int m = 0; m < 4; ++m)
#pragma unroll
                for (int n = 0; n < 2; ++n) acc[a][b][m][n] = (f32x4){0.f, 0.f, 0.f, 0.f};
    bf16x8 At[4][2], B0[2][2], B1[2][2];
    const char* cA = (const char*)g.A + (size_t)cur.pm * tstep; const char* cB = (const char*)g.Bt + (size_t)cur.pn * tstep;
    S.a_ready(cur);
    if constexpr (SP2) {
        PG8_STAGE(PG8_SB(0, 0), cB, voffB); PG8_STAGE(PG8_SB(0, 1), cB + hstep, voffB); PG8_STAGE(PG8_SA(0, 0), cA, voffA); PG8_STAGE(PG8_SA(0, 1), cA + hstep, voffA);
        if (wr == 1) PG8_BAR;
        PG8_WAIT_V(2); PG8_BAR;
        PG8_STAGE(PG8_SB(1, 0), cB + kstep, voffB); PG8_STAGE(PG8_SA(1, 0), cA + kstep, voffA); PG8_STAGE(PG8_SB(1, 1), cB + hstep + kstep, voffB);
        PG8_WAIT_V(6); PG8_BAR;
    } else {
        PG8_STAGE(PG8_SB(0, 0), cB, voffB); PG8_STAGE(PG8_SA(0, 0), cA, voffA); PG8_STAGE(PG8_SB(0, 1), cB + hstep, voffB); PG8_STAGE(PG8_SA(0, 1), cA + hstep, voffA);
        if (wr == 1) PG8_BAR;
        PG8_WAIT_V(4); PG8_BAR;
        PG8_STAGE(PG8_SB(1, 0), cB + kstep, voffB); PG8_STAGE(PG8_SA(1, 0), cA + kstep, voffA); PG8_STAGE(PG8_SB(1, 1), cB + hstep + kstep, voffB);
        PG8_WAIT_V(6); PG8_BAR;
    }
    for (;;) {
        const bool has_next = S.next(ui + 1, nxt);
        const char* nA = has_next ? (const char*)g.A + (size_t)nxt.pm * tstep : cA; const char* nB = has_next ? (const char*)g.Bt + (size_t)nxt.pn * tstep : cB;
        for (int t = 0; t < nt; t += 2) {
            const bool last = (t == nt - 2);
            const char* a1 = cA + (size_t)(t + 1) * kstep;
            const char* a2 = last ? nA : cA + (size_t)(t + 2) * kstep; const char* b2 = last ? nB : cB + (size_t)(t + 2) * kstep;
            const char* a3 = a2 + kstep; const char* b3 = b2 + kstep;
            if (last && has_next) S.a_ready(nxt);
            if constexpr (SP2) {
            PG8_LDB(B0, 0, 0); PG8_LDB(B1, 0, 1); PG8_SCHED; PG8_LDA(At, 0, 0); PG8_STAGE(PG8_SA(1, 1), a1 + hstep, voffA);
            PG8_WAIT_V(8); PG8_WAIT_L(0); PG8_BAR; PG8_MMA(0, 0, At, B0); PG8_MMA(0, 1, At, B1); PG8_BAR; PG8_SCHED;
            PG8_LDA(At, 0, 1); PG8_STAGE(PG8_SB(0, 0), b2, voffB); PG8_STAGE(PG8_SB(0, 1), b2 + hstep, voffB); PG8_STAGE(PG8_SA(0, 0), a2, voffA);
            PG8_WAIT_V(8); PG8_WAIT_L(0); PG8_BAR; PG8_MMA(1, 0, At, B0); PG8_MMA(1, 1, At, B1); PG8_BAR; PG8_SCHED;
            PG8_LDB(B0, 1, 0); PG8_LDB(B1, 1, 1); PG8_SCHED; PG8_LDA(At, 1, 0); PG8_STAGE(PG8_SA(0, 1), a2 + hstep, voffA);
            PG8_WAIT_V(8); PG8_WAIT_L(0); PG8_BAR; PG8_MMA(0, 0, At, B0); PG8_MMA(0, 1, At, B1); PG8_BAR; PG8_SCHED;
            PG8_LDA(At, 1, 1); PG8_STAGE(PG8_SB(1, 0), b3, voffB); PG8_STAGE(PG8_SB(1, 1), b3 + hstep, voffB); PG8_STAGE(PG8_SA(1, 0), a3, voffA);
            PG8_WAIT_V(8); PG8_WAIT_L(0); PG8_BAR; PG8_MMA(1, 0, At, B0); PG8_MMA(1, 1, At, B1); PG8_BAR; PG8_SCHED;
            } else {
            PG8_LDB(B0, 0, 0); PG8_SCHED; PG8_LDA(At, 0, 0); PG8_STAGE(PG8_SA(1, 1), a1 + hstep, voffA);
            PG8_WAIT_L(8); PG8_BAR; PG8_WAIT_L(0); PG8_MMA(0, 0, At, B0); PG8_BAR; PG8_SCHED;
            PG8_LDB(B1, 0, 1); PG8_STAGE(PG8_SB(0, 0), b2, voffB);
            PG8_BAR; PG8_WAIT_L(0); PG8_MMA(0, 1, At, B1); PG8_BAR;
            PG8_LDA(At, 0, 1); PG8_STAGE(PG8_SA(0, 0), a2, voffA);
            PG8_BAR; PG8_WAIT_L(0); PG8_MMA(1, 0, At, B0); PG8_BAR; PG8_SCHED;
            PG8_STAGE(PG8_SB(0, 1), b2 + hstep, voffB);
            PG8_WAIT_V(6); PG8_BAR; PG8_MMA(1, 1, At, B1); PG8_BAR;
            PG8_LDB(B0, 1, 0); PG8_SCHED; PG8_LDA(At, 1, 0); PG8_STAGE(PG8_SA(0, 1), a2 + hstep, voffA);
            PG8_WAIT_L(8); PG8_BAR; PG8_WAIT_L(0); PG8_MMA(0, 0, At, B0); PG8_BAR; PG8_SCHED;
            PG8_LDB(B1, 1, 1); PG8_STAGE(PG8_SB(1, 0), b3, voffB);
            PG8_BAR; PG8_WAIT_L(0); PG8_MMA(0, 1, At, B1); PG8_BAR;
            PG8_LDA(At, 1, 1); PG8_STAGE(PG8_SA(1, 0), a3, voffA);
            PG8_BAR; PG8_WAIT_L(0); PG8_MMA(1, 0, At, B0); PG8_BAR; PG8_SCHED;
            PG8_STAGE(PG8_SB(1, 1), b3 + hstep, voffB);
            PG8_WAIT_V(6); PG8_BAR; PG8_MMA(1, 1, At, B1); PG8_BAR;
            }
        }
        if constexpr (ALIGN_EPI) { if (wr == 0) PG8_BAR; }
        if constexpr (!Epi::AFTER_DRAIN) { E(acc, cur, wr, wc, fr, fq); S.done(cur); }
        if (!has_next) break;
#pragma unroll
        for (int a = 0; a < 2; ++a)
#pragma unroll
            for (int b = 0; b < 2; ++b)
#pragma unroll
                for (int m = 0; m < 4; ++m)
#pragma unroll
                    for (int n = 0; n < 2; ++n) acc[a][b][m][n] = (f32x4){0.f, 0.f, 0.f, 0.f};
        cur = nxt; cA = nA; cB = nB; ++ui;
        if constexpr (ALIGN_EPI) { if (wr == 1) PG8_BAR; }
    }
    PG8_WAIT_V(0);
    if constexpr (!ALIGN_EPI) { if (wr == 0) PG8_BAR; }
    PG8_BAR;
    if constexpr (Epi::AFTER_DRAIN) { E.fused(acc, cur, wr, wc, fr, fq, lds, wid, lane); S.done(cur); }
#undef PG8_SA
#undef PG8_SB
#undef PG8_STAGE
#undef PG8_LDA
#undef PG8_LDB
#undef PG8_MMA
#undef PG8_WAIT_V
#undef PG8_WAIT_L
#undef PG8_BAR
#undef PG8_SCHED
}
}
#define XB_TMO      128
#define XB_XCNT(j)  (256  + 64 * (j))
#define XB_XSUB(j)  (1280 + 64 * (j))
#define XB_XGEN(j)  (2304 + 64 * (j))
#define XB_TOP      3328
#define XB_TOPGEN   3392
#define XCD_BAR_WORDS 3456
#define XB_SPIN_CAP (1u << 18)

__device__ __forceinline__ unsigned xb_ld(unsigned* p)              { return __hip_atomic_load(p, __ATOMIC_RELAXED, __HIP_MEMORY_SCOPE_AGENT); }
__device__ __forceinline__ unsigned xb_add(unsigned* p, unsigned v) { return __hip_atomic_fetch_add(p, v, __ATOMIC_RELAXED, __HIP_MEMORY_SCOPE_AGENT); }
__device__ __forceinline__ unsigned xb_xcc_id() { return (unsigned)__builtin_amdgcn_s_getreg((3 << 11) | 20) & 0xFu; }
#define XB_SPIN(cond, bar) do { unsigned _sp = 0; while (cond) { __builtin_amdgcn_s_sleep(1); \
    if ((++_sp & 255u) == 0u) { if (xb_ld(&(bar)[XB_TMO])) break; if (_sp > XB_SPIN_CAP) { atomicAdd(&(bar)[XB_TMO], 1u); break; } } } } while (0)

struct XcdBarrier {
    unsigned* bar; unsigned x;
    volatile LAS unsigned* st;
};

__device__ __forceinline__ XcdBarrier xcd_barrier_post(unsigned* bar, volatile LAS unsigned* st, const bool t0) {
    XcdBarrier b; b.bar = bar; b.x = xb_xcc_id(); b.st = st;
    if (t0) (void)xb_add(&bar[XB_XCNT(b.x)], 1u);
    return b;
}
__device__ __forceinline__ void xcd_barrier_complete(unsigned* bar, unsigned x, unsigned& nloc, unsigned& nx) {
    const unsigned G = gridDim.x * gridDim.y * gridDim.z;
    unsigned sum, cnt, mine, sp = 0u;
    for (;;) {
        sum = 0u; cnt = 0u; mine = 0u;
#pragma unroll
        for (unsigned j = 0; j < 16; ++j) { const unsigned c = xb_ld(&bar[XB_XCNT(j)]); sum += c; cnt += (c > 0u) ? 1u : 0u; mine = (j == x) ? c : mine; }
        if (sum == G) break;
        __builtin_amdgcn_s_sleep(1);
        if ((++sp & 255u) == 0u) { if (xb_ld(&bar[XB_TMO])) break; if (sp > XB_SPIN_CAP) { atomicAdd(&bar[XB_TMO], 1u); break; } }
    }
    nloc = mine > 0u ? mine : 1u; nx = cnt > 0u ? cnt : 1u;
}

__device__ __forceinline__ void xcd_barrier(const XcdBarrier& b, const bool t0) {
    asm volatile("s_waitcnt vmcnt(0)" ::: "memory");
    __syncthreads();
    if (t0) {
        unsigned* bar = b.bar;
        __builtin_amdgcn_s_waitcnt(0);
        unsigned nloc = b.st[0], nx = b.st[1];
        if (nloc == 0u) { xcd_barrier_complete(bar, b.x, nloc, nx); b.st[0] = nloc; b.st[1] = nx; }
        const unsigned old = xb_add(&bar[XB_XSUB(b.x)], 1u);
        const unsigned gen = old / nloc;
        if (old + 1u == (gen + 1u) * nloc) {
            __builtin_amdgcn_fence(__ATOMIC_RELEASE, "agent");
            asm volatile("s_waitcnt vmcnt(0)" ::: "memory");
            const unsigned og = xb_add(&bar[XB_TOP], 1u);
            const unsigned tg = og / nx;
            if (og + 1u == (tg + 1u) * nx) xb_add(&bar[XB_TOPGEN], 1u);
            else XB_SPIN(xb_ld(&bar[XB_TOPGEN]) == tg, bar);
            __builtin_amdgcn_fence(__ATOMIC_ACQUIRE, "agent");
            xb_add(&bar[XB_XGEN(b.x)], 1u);
            asm volatile("s_waitcnt vmcnt(0)" ::: "memory");
        } else {
            XB_SPIN(xb_ld(&bar[XB_XGEN(b.x)]) == gen, bar);
            __builtin_amdgcn_fence(__ATOMIC_ACQUIRE, "agent");
            asm volatile("s_waitcnt vmcnt(0)" ::: "memory");
        }
    }
    __syncthreads();
}
#define GAS __attribute__((address_space(1)))
typedef float f32x4 __attribute__((ext_vector_type(4)));
typedef unsigned u32x2 __attribute__((ext_vector_type(2)));
typedef unsigned u32x4 __attribute__((ext_vector_type(4)));
typedef short bf16x8 __attribute__((ext_vector_type(8)));
constexpr int NTHR = 512, NWV = 8;
constexpr int RING_BYTES = 139264, MISC_OFF = RING_BYTES + 320, LDS_BYTES = 147456;
constexpr int CW_BAR = 1024;

struct KArgs { Inputs in; float* out; unsigned char* ws; int ph_lo, ph_hi, li, mask; };
#ifndef PROBE_REP
#define PROBE_REP {0, 0, 0, 0, 0, 0, 0, 0, 0, 0, 0, 0, 0, 0, 0, 0, 0}
#endif
constexpr int kRep[17] = PROBE_REP;

__device__ __forceinline__ float wave_sum(float v) {
#pragma unroll
    for (int o = 1; o < 64; o <<= 1) v += __shfl_xor(v, o);
    return v;
}
typedef float f32x2_t __attribute__((ext_vector_type(2)));
typedef __bf16 bf16x2_t __attribute__((ext_vector_type(2)));
__device__ __forceinline__ unsigned cvtpk(float lo, float hi) { f32x2_t v = {lo, hi}; bf16x2_t b = __builtin_convertvector(v, bf16x2_t); return __builtin_bit_cast(unsigned, b); }
__device__ __forceinline__ unsigned pk2(float lo, float hi) { return cvtpk(lo, hi); }
__device__ __forceinline__ int fresh_lane() { int l; asm volatile("v_mbcnt_lo_u32_b32 %0, -1, 0\n\tv_mbcnt_hi_u32_b32 %0, -1, %0" : "=v"(l)); return l; }
#ifdef PROBE_SEC
#define SEC_B(k) unsigned long long sec_t0_##k = 0; if ((k) == PROBE_SEC && blockIdx.x == 0 && tid == 0) sec_t0_##k = __builtin_amdgcn_s_memrealtime()
#define SEC_E(k) do { if ((k) == PROBE_SEC && blockIdx.x == 0 && tid == 0) { volatile LAS unsigned* sw_ = (volatile LAS unsigned*)(lds + MISC_OFF + 96); sw_[0] = sw_[0] + (unsigned)(__builtin_amdgcn_s_memrealtime() - sec_t0_##k); } } while (0)
#else
#define SEC_B(k)
#define SEC_E(k) do { } while (0)
#endif
#define LDS_FENCE() asm volatile("s_waitcnt lgkmcnt(0)" ::: "memory")

constexpr int PH_PRO = 0;
constexpr int PH_L0 = 1, PH_PER_LAYER = 6;
constexpr int PH_FIN = PH_L0 + 2 * PH_PER_LAYER;
constexpr int PH_END = PH_FIN + 1;

__device__ __forceinline__ void transpose_item(const float* W, int K, int N, bf16_t* WT, LAS float* scr, int item, int lane) {
    const int nblk = N / 32, kb = item / nblk, nb = item % nblk, k0 = 64 * kb, n0 = 32 * nb;
    float wv[32];
#pragma unroll
    for (int i = 0; i < 32; ++i) wv[i] = W[(size_t)(k0 + 2 * i + (lane >> 5)) * N + n0 + (lane & 31)];
#pragma unroll
    for (int i = 0; i < 32; ++i) scr[(2 * i + (lane >> 5)) * 33 + (lane & 31)] = wv[i];
    LDS_FENCE();
    const int c = lane & 7;
#pragma unroll
    for (int j = 0; j < 4; ++j) { const int n = (lane >> 3) + 8 * j; const LAS float* s = scr + (8 * c) * 33 + n;
        u32x4 o; o.x = pk2(s[0 * 33], s[1 * 33]); o.y = pk2(s[2 * 33], s[3 * 33]); o.z = pk2(s[4 * 33], s[5 * 33]); o.w = pk2(s[6 * 33], s[7 * 33]);
        *(u32x4*)(WT + (size_t)(n0 + n) * K + k0 + 8 * c) = o; }
    LDS_FENCE();
}

__device__ __forceinline__ void ph_prologue(const KArgs& a, LAS unsigned char* lds, int tid, int wave, int lane) {
    const Inputs& in = a.in;
    float* MOD = (float*)(a.ws + OFF_MOD);
    LAS float* sil = (LAS float*)lds;
    LAS float* part = (LAS float*)(lds + 5 * 1024 * 4);
    if ((int)blockIdx.x < 192) {
        for (int i = tid; i < 5 * 1024; i += NTHR) { const int j = i >> 10, k = i & 1023; const float cv = j < 4 ? in.c[j * DM + k] : in.c_ctx[k]; sil[i] = cv / (1.f + expf(-cv)); }
        __syncthreads();
        for (int it = blockIdx.x; it < 192; it += gridDim.x) {
            const int l = it / 96, nb = it % 96, n = nb * 32 + (lane & 31), k0 = wave * 128 + (lane >> 5) * 64;
            const float* w = in.w_mod + (size_t)l * DM * 3072 + n;
            float acc[5] = {0.f, 0.f, 0.f, 0.f, 0.f};
#pragma unroll 32
            for (int kk = 0; kk < 64; ++kk) { const float wv = w[(size_t)(k0 + kk) * 3072];
#pragma unroll
                for (int j = 0; j < 5; ++j) acc[j] += sil[j * 1024 + k0 + kk] * wv; }
#pragma unroll
            for (int j = 0; j < 5; ++j) { acc[j] += __shfl_xor(acc[j], 32); if (lane < 32) part[(wave * 5 + j) * 32 + lane] = acc[j]; }
            __syncthreads();
            if (tid < 160) { const int j = tid >> 5, c = tid & 31; float s = in.b_mod[l * 3072 + nb * 32 + c];
#pragma unroll
                for (int w8 = 0; w8 < 8; ++w8) s += part[(w8 * 5 + j) * 32 + c];
                MOD[((size_t)l * 5 + j) * 3072 + nb * 32 + c] = s; }
            __syncthreads();
        }
    }
    __syncthreads();
    LAS float* scr = (LAS float*)(lds + wave * 16384);
    const int gw = blockIdx.x * NWV + wave, NGW = gridDim.x * NWV;
    constexpr int I_IN = (DM / 64) * (NIN / 32), I_OUT = (DM / 64) * (DM / 32), I_PAD = NP - NIN;
    constexpr int I_L = I_IN + I_OUT + I_PAD;
    bf16_t* WIN = (bf16_t*)(a.ws + OFF_WIN); bf16_t* WOUT = (bf16_t*)(a.ws + OFF_WOUT);
    for (int it = gw; it < 2 * I_L; it += NGW) {
        const int l = it / I_L; int r = it % I_L;
        if (r < I_IN) { transpose_item(in.w_in + (size_t)l * DM * NIN, DM, NIN, WIN + (size_t)l * NP * DM, scr, r, lane); continue; } r -= I_IN;
        if (r < I_OUT) { transpose_item(in.w_out + (size_t)l * DM * DM, DM, DM, WOUT + (size_t)l * DM * DM, scr, r, lane); continue; } r -= I_OUT;
        u32x4* zp = (u32x4*)(WIN + ((size_t)l * NP + NIN + r) * DM);
        zp[lane] = (u32x4){0u, 0u, 0u, 0u}; zp[lane + 64] = (u32x4){0u, 0u, 0u, 0u};
    }
    const int gt = blockIdx.x * NTHR + tid, NGT = gridDim.x * NTHR;
    bf16_t* WPT = (bf16_t*)(a.ws + OFF_WPT);
    if (gt < 512) { float* rt = (float*)(a.ws + OFF_ROPE); const int pos = gt >> 3, j = gt & 7; const float f = powf(10000.f, -(float)j / 8.f), ang = (float)pos * f; rt[gt] = cosf(ang); rt[512 + gt] = sinf(ang); }
    for (int i = gt; i < 2 * 4 * 64 * 64; i += NGT) { const int c = i & 63, e = (i >> 6) & 63, li = i >> 12; WPT[i] = f2bf(in.pool_w[(size_t)li * 4096 + c * 64 + e]); }
}

__device__ __forceinline__ void ph_post_pre(const KArgs& a, int lprev, int lnext, int wave, int lane) {
    const Inputs& in = a.in;
    const float* MOD = (const float*)(a.ws + OFF_MOD);
    const float* O = (const float*)(a.ws + OFF_P);
    float* XC = (float*)(a.ws + OFF_XC);
    bf16_t* H = (bf16_t*)(a.ws + OFF_H);
    const int gw = blockIdx.x * NWV + wave, NGW = gridDim.x * NWV;
    const int nrows = (lnext < 2) ? MTOT : NLAT;
    for (int row = gw; row < nrows; row += NGW) {
        const bool lat = row < NLAT; const int j = lat ? row / SEQ : 4;
        const float* xr; float* xw = nullptr;
        if (lprev <= 0) xr = lat ? in.x + (size_t)row * DM : in.ctx + (size_t)(row - NLAT) * DM;
        else xr = lat ? a.out + (size_t)row * DM : XC + (size_t)(row - NLAT) * DM;
        const bool post = (lprev >= 0) && (lat || lprev == 0);
        if (post) xw = lat ? a.out + (size_t)row * DM : XC + (size_t)(row - NLAT) * DM;
        f32x4 v[4];
#pragma unroll
        for (int q = 0; q < 4; ++q) v[q] = *(const f32x4*)(xr + 4 * lane + 256 * q);
        if (post) {
            f32x4 o[4]; float s = 0.f;
#pragma unroll
            for (int q = 0; q < 4; ++q) { o[q] = *(const f32x4*)(O + (size_t)row * DM + 4 * lane + 256 * q); s += (o[q].x * o[q].x + o[q].y * o[q].y) + (o[q].z * o[q].z + o[q].w * o[q].w); }
            const float rstd = rsqrtf(wave_sum(s) * (1.f / DM) + EPS);
            const float* gate = MOD + ((size_t)lprev * 5 + j) * 3072 + 2048; const float* gp = in.g_post + lprev * DM;
#pragma unroll
            for (int q = 0; q < 4; ++q) { const f32x4 gt = *(const f32x4*)(gate + 4 * lane + 256 * q), gg = *(const f32x4*)(gp + 4 * lane + 256 * q);
                v[q] = v[q] + gt * (o[q] * rstd * gg); *(f32x4*)(xw + 4 * lane + 256 * q) = v[q]; }
        }
        if (lnext < 2) {
            float s = 0.f;
#pragma unroll
            for (int q = 0; q < 4; ++q) s += (v[q].x * v[q].x + v[q].y * v[q].y) + (v[q].z * v[q].z + v[q].w * v[q].w);
            const float rstd = rsqrtf(wave_sum(s) * (1.f / DM) + EPS);
            const float* shift = MOD + ((size_t)lnext * 5 + j) * 3072; const float* scale = shift + 1024; const float* gp = in.g_pre + lnext * DM;
#pragma unroll
            for (int q = 0; q < 4; ++q) { const int k = 4 * lane + 256 * q; const f32x4 sh = *(const f32x4*)(shift + k), sc = *(const f32x4*)(scale + k), gg = *(const f32x4*)(gp + k);
                const f32x4 hv = (v[q] * rstd * gg) * (sc + 1.f) + sh;
                u32x2 w; w.x = pk2(hv.x, hv.y); w.y = pk2(hv.z, hv.w); *(u32x2*)(H + (size_t)row * DM + k) = w; }
        }
    }
}

typedef float f32x16 __attribute__((ext_vector_type(16)));
#define MFMA16(a, b, c) __builtin_amdgcn_mfma_f32_16x16x32_bf16(a, b, c, 0, 0, 0)
#define MFMA32(a, b, c) __builtin_amdgcn_mfma_f32_32x32x16_bf16(a, b, c, 0, 0, 0)
__device__ __forceinline__ float fast_exp(float x) { return __builtin_amdgcn_exp2f(x * 1.4426950408889634f); }
__device__ __forceinline__ float fast_silu(float v) { return v * __builtin_amdgcn_rcpf(1.f + fast_exp(-v)); }
__device__ __forceinline__ float lo_bf(unsigned w) { return __uint_as_float(w << 16); }
__device__ __forceinline__ float hi_bf(unsigned w) { return __uint_as_float(w & 0xffff0000u); }


typedef short v4i16_t __attribute__((ext_vector_type(4)));
constexpr int NA_KV_BYTES = 832 * 128, NA_RPB_OFF = NA_KV_BYTES;

__device__ __forceinline__ void na_stage(const bf16_t* P, LAS unsigned char* kv, int colbase, int b, int U0, int nwin, int tid) {
    const int kr0 = tid >> 3, c = tid & 7;
    const unsigned toff = (unsigned)kr0 * NP + 8u * c;
    const bf16_t* gctx = P + (size_t)(NLAT + b * NCTX) * NP + colbase;
    const bf16_t* gwin = P + (size_t)(b * SEQ + U0 * 64) * NP + colbase;
    LAS unsigned char* lb = kv + kr0 * 128 + ((c ^ (kr0 & 7)) << 4);
    u32x4 v[7];
#pragma unroll
    for (int it = 0; it < 4; ++it) v[it] = *(const u32x4*)(gctx + (size_t)it * 64 * NP + toff);
#pragma unroll
    for (int it = 4; it < 7; ++it) if (it - 4 < nwin) v[it] = *(const u32x4*)(gwin + (size_t)(it - 4) * 64 * NP + toff);
#pragma unroll
    for (int it = 0; it < 4; ++it) *(LAS u32x4*)(lb + it * 8192) = v[it];
#pragma unroll
    for (int it = 4; it < 7; ++it) if (it - 4 < nwin) *(LAS u32x4*)(lb + it * 8192) = v[it];
#pragma unroll
    for (int it = 7; it < 13; ++it) if (it - 4 < nwin) v[it - 7] = *(const u32x4*)(gwin + (size_t)(it - 4) * 64 * NP + toff);
#pragma unroll
    for (int it = 7; it < 13; ++it) if (it - 4 < nwin) *(LAS u32x4*)(lb + it * 8192) = v[it - 7];
}

template <bool HW>
__device__ __forceinline__ void na_half(const LAS unsigned char* kbase, int sw0, int sw1, bf16x8 qf0, bf16x8 qf1, const LAS float* rp, int R0, int r, int CB, int cg, int li, int g,
                                        bf16x8 (&pf)[8], float& mo, float& lo_) {
    f32x4 S[16];
#pragma unroll
    for (int t = 0; t < 16; ++t) {
        const LAS unsigned char* kb = HW ? kbase + (t >> 1) * 8192 + (t & 1) * 2048 : kbase + t * 2048;
        const bf16x8 k0 = *(const LAS bf16x8*)(kb + sw0), k1 = *(const LAS bf16x8*)(kb + sw1);
        f32x4 acc = {0.f, 0.f, 0.f, 0.f};
        acc = MFMA16(k0, qf0, acc); acc = MFMA16(k1, qf1, acc); S[t] = acc;
    }
    float m = -INFINITY;
    if (HW) {
        const int c = cg * 16 + li, cs = min(max(c - 8, 0), 48);
        const LAS float* rb = rp + (R0 - r + 7) * 31 + (CB - c + 4 * g + 15);
        bool vld[8];
#pragma unroll
        for (int k = 0; k < 8; ++k) { const int kcol = CB + 16 * (k >> 2) + 4 * g + (k & 3); vld[k] = (kcol >= cs) && (kcol < cs + 16); }
#pragma unroll
        for (int wt = 0; wt < 16; ++wt) {
#pragma unroll
            for (int q = 0; q < 4; ++q) { const float bias = rb[(wt >> 1) * 31 + 16 * (wt & 1) + q];
                const float s = vld[4 * (wt & 1) + q] ? S[wt][q] * 0.125f + bias : -INFINITY; S[wt][q] = s; m = fmaxf(m, s); }
        }
    } else {
#pragma unroll
        for (int ct = 0; ct < 16; ++ct)
#pragma unroll
            for (int q = 0; q < 4; ++q) { const float s = S[ct][q] * 0.125f; S[ct][q] = s; m = fmaxf(m, s); }
    }
    m = fmaxf(m, __shfl_xor(m, 16)); m = fmaxf(m, __shfl_xor(m, 32));
    float lsum = 0.f;
#pragma unroll
    for (int u = 0; u < 8; ++u) {
        float p[8];
#pragma unroll
        for (int q = 0; q < 4; ++q) { p[q] = fast_exp(S[2 * u][q] - m); p[4 + q] = fast_exp(S[2 * u + 1][q] - m); }
#pragma unroll
        for (int q = 0; q < 8; ++q) lsum += p[q];
        u32x4 w; w.x = cvtpk(p[0], p[1]); w.y = cvtpk(p[2], p[3]); w.z = cvtpk(p[4], p[5]); w.w = cvtpk(p[6], p[7]);
        pf[u] = __builtin_bit_cast(bf16x8, w);
    }
    lsum += __shfl_xor(lsum, 16); lsum += __shfl_xor(lsum, 32);
    mo = m; lo_ = lsum;
}

template <bool WIN>
__device__ __forceinline__ void na_block(const KArgs& a, LAS unsigned char* lds, int b, int h, int R, int tid, int wave, int lane) {
    const bf16_t* P = (const bf16_t*)(a.ws + OFF_P); bf16_t* Y = (bf16_t*)(a.ws + OFF_H);
    LAS unsigned char* kv = lds; const LAS float* rpb = (const LAS float*)(lds + NA_RPB_OFF);
    const int li = lane & 15, g = lane >> 4;
    int r = 0, cg = 0, U0 = 0, nwin = 0, wo = 0, CB = 0, R0 = 0, qrow0;
    if (WIN) { r = 2 * R + (wave >> 2); cg = wave & 3; U0 = min(max(2 * R - 4, 0), 56); nwin = min(9, 64 - U0); R0 = min(max(r - 4, 0), 56); wo = R0 - U0;
        CB = min(max(cg * 16 - 8, 0), 32); qrow0 = b * SEQ + r * 64 + cg * 16; }
    else qrow0 = NLAT + b * NCTX + R * 128 + wave * 16;
    SEC_B(7);
    __syncthreads();
    na_stage(P, kv, C_NK + h * 64, b, U0, nwin, tid);
    const bf16_t* qp = P + (size_t)(qrow0 + li) * NP + C_NQ + h * 64 + 8 * g;
    const bf16x8 qf0 = *(const bf16x8*)qp, qf1 = *(const bf16x8*)(qp + 32);
    __syncthreads();
    const LAS unsigned char* kwin = kv + (256 + wo * 64 + CB + li) * 128; const LAS unsigned char* kctx = kv + li * 128;
    const int sw0 = (g ^ (li & 7)) << 4, sw1 = ((4 + g) ^ (li & 7)) << 4;
    bf16x8 pfw[8], pfc[8];
    float mw = -INFINITY, lw = 0.f, mc, lc;
    if (WIN) na_half<true>(kwin, sw0, sw1, qf0, qf1, rpb + h * 465, R0, r, CB, cg, li, g, pfw, mw, lw);
    na_half<false>(kctx, sw0, sw1, qf0, qf1, rpb, 0, 0, 0, 0, li, g, pfc, mc, lc);
    __syncthreads();
    SEC_E(7);
    SEC_B(8);
    na_stage(P, kv, C_NV + h * 64, b, U0, nwin, tid);
    __syncthreads();
    const int trow = 4 * g + (li >> 2), rl = trow & 7;
    LAS unsigned char* twin = kv + (256 + wo * 64 + CB + trow) * 128 + (li & 1) * 8; LAS unsigned char* tctx = kv + trow * 128 + (li & 1) * 8;
    int trs[4];
#pragma unroll
    for (int mt = 0; mt < 4; ++mt) trs[mt] = ((2 * mt + ((li & 3) >> 1)) ^ rl) << 4;
    f32x4 accw[4], acc[4];
#pragma unroll
    for (int mt = 0; mt < 4; ++mt) { accw[mt] = (f32x4){0.f, 0.f, 0.f, 0.f}; acc[mt] = (f32x4){0.f, 0.f, 0.f, 0.f}; }
    if (WIN) {
#pragma unroll
        for (int u = 0; u < 8; ++u)
#pragma unroll
            for (int mt = 0; mt < 4; ++mt) { const LAS unsigned char* tp = twin + trs[mt] + u * 8192;
                const v4i16_t lo = __builtin_amdgcn_ds_read_tr16_b64_v4i16((LAS v4i16_t*)tp), hi = __builtin_amdgcn_ds_read_tr16_b64_v4i16((LAS v4i16_t*)(tp + 2048));
                const bf16x8 af = {lo[0], lo[1], lo[2], lo[3], hi[0], hi[1], hi[2], hi[3]};
                accw[mt] = MFMA16(af, pfw[u], accw[mt]); }
    }
#pragma unroll
    for (int u = 0; u < 8; ++u)
#pragma unroll
        for (int mt = 0; mt < 4; ++mt) { const LAS unsigned char* tp = tctx + trs[mt] + u * 4096;
            const v4i16_t lo = __builtin_amdgcn_ds_read_tr16_b64_v4i16((LAS v4i16_t*)tp), hi = __builtin_amdgcn_ds_read_tr16_b64_v4i16((LAS v4i16_t*)(tp + 2048));
            const bf16x8 af = {lo[0], lo[1], lo[2], lo[3], hi[0], hi[1], hi[2], hi[3]};
            acc[mt] = MFMA16(af, pfc[u], acc[mt]); }
    float lsum = lc;
    if (WIN) { const float mm = fmaxf(mw, mc); const float f0 = fast_exp(mw - mm), f1 = fast_exp(mc - mm);
#pragma unroll
        for (int mt = 0; mt < 4; ++mt) acc[mt] = accw[mt] * f0 + acc[mt] * f1;
        lsum = lw * f0 + lc * f1; }
    const float inv = 1.f / lsum;
    const size_t row = (size_t)(qrow0 + li);
#pragma unroll
    for (int mt = 0; mt < 4; ++mt) {
        const int col = 256 + h * 64 + 16 * mt + 4 * g;
        const u32x2 gt = *(const u32x2*)(P + row * NP + C_GATE + col);
        u32x2 w;
        w.x = cvtpk(acc[mt][0] * inv * fast_silu(lo_bf(gt.x)), acc[mt][1] * inv * fast_silu(hi_bf(gt.x)));
        w.y = cvtpk(acc[mt][2] * inv * fast_silu(lo_bf(gt.y)), acc[mt][3] * inv * fast_silu(hi_bf(gt.y)));
        *(u32x2*)(Y + row * DM + col) = w;
    }
    SEC_E(8);
}

__device__ __forceinline__ void pool_item(const KArgs& a, int l, LAS unsigned char* lds, int cid, int tid, int wave, int lane) {
    const bf16_t* P = (const bf16_t*)(a.ws + OFF_P); bf16_t* Y = (bf16_t*)(a.ws + OFF_H);
    const bf16_t* WPT = (const bf16_t*)(a.ws + OFF_WPT) + (size_t)l * 4 * 64 * 64;
    const float* pscale = a.in.pool_scale + l * 256;
    LAS bf16_t* U = (LAS bf16_t*)lds;
    LAS bf16_t* M = U + 80 * 264;
    const bool lat = cid < 256;
    const int seq_len = lat ? SEQ : NCTX;
    const int seq_base = lat ? (cid >> 6) * SEQ : NLAT + ((cid - 256) >> 2) * NCTX;
    const int t0 = lat ? (cid & 63) * 64 : ((cid - 256) & 3) * 64;
    SEC_B(9);
    for (int i = tid; i < 80 * 32; i += NTHR) { const int tr = i >> 5, c8 = i & 31, tt = t0 - 8 + tr;
        u32x4 v = {0u, 0u, 0u, 0u};
        if (tt >= 0 && tt < seq_len) v = *(const u32x4*)(P + (size_t)(seq_base + tt) * NP + C_PU + c8 * 8);
        *(LAS u32x4*)(U + tr * 264 + c8 * 8) = v; }
    __syncthreads();
    {
        const int col = tid & 255, th = tid >> 8, part = col >> 6, w = 2 << part;
        for (int t = 32 * th; t < 32 * th + 32; ++t) {
            const int tt = t0 + t; const int lo = min(max(tt - w / 2, 0), seq_len), hi = min(max(tt - w / 2 + w, 0), seq_len);
            float s = 0.f;
            for (int ss = lo; ss < hi; ++ss) s += bf2f(U[(ss - t0 + 8) * 264 + col]);
            const float mv = s / (float)(hi - lo) - bf2f(U[(t + 8) * 264 + col]);
            M[t * 264 + col] = (bf16_t)cvtpk(mv, 0.f);
        }
    }
    __syncthreads();
    {
        const int part = wave >> 1, th = wave & 1, li = lane & 15, g = lane >> 4;
        f32x4 acc[4][2];
#pragma unroll
        for (int mt = 0; mt < 4; ++mt) { acc[mt][0] = (f32x4){0.f, 0.f, 0.f, 0.f}; acc[mt][1] = (f32x4){0.f, 0.f, 0.f, 0.f}; }
#pragma unroll
        for (int s = 0; s < 2; ++s) {
            bf16x8 bfr[2];
#pragma unroll
            for (int nt = 0; nt < 2; ++nt) bfr[nt] = *(const LAS bf16x8*)(M + (32 * th + 16 * nt + li) * 264 + part * 64 + 32 * s + 8 * g);
#pragma unroll
            for (int mt = 0; mt < 4; ++mt) {
                const bf16x8 af = *(const bf16x8*)(WPT + ((size_t)(part * 64 + 16 * mt + li)) * 64 + 32 * s + 8 * g);
#pragma unroll
                for (int nt = 0; nt < 2; ++nt) acc[mt][nt] = MFMA16(af, bfr[nt], acc[mt][nt]);
            }
        }
#pragma unroll
        for (int nt = 0; nt < 2; ++nt) {
            const size_t row = (size_t)(seq_base + t0 + 32 * th + 16 * nt + li);
#pragma unroll
            for (int mt = 0; mt < 4; ++mt) {
                const int cl = part * 64 + 16 * mt + 4 * g;
                const f32x4 sc = *(const f32x4*)(pscale + cl);
                const u32x2 gt = *(const u32x2*)(P + row * NP + C_GATE + 768 + cl);
                u32x2 w;
                w.x = cvtpk(acc[mt][nt][0] * sc.x * fast_silu(lo_bf(gt.x)), acc[mt][nt][1] * sc.y * fast_silu(hi_bf(gt.x)));
                w.y = cvtpk(acc[mt][nt][2] * sc.z * fast_silu(lo_bf(gt.y)), acc[mt][nt][3] * sc.w * fast_silu(hi_bf(gt.y)));
                *(u32x2*)(Y + row * DM + 768 + cl) = w;
            }
        }
    }
    __syncthreads();
    SEC_E(9);
}

__device__ __forceinline__ void phC_na_ctx(const KArgs& a, int l, LAS unsigned char* lds, int tid, int wave, int lane) {
    if (l != 0) return;
    for (int u = blockIdx.x; u < 32; u += gridDim.x) na_block<false>(a, lds, u >> 3, (u >> 1) & 3, u & 1, tid, wave, lane);
    __syncthreads();
}
__device__ __forceinline__ void phD_na_pool(const KArgs& a, int l, LAS unsigned char* lds, int tid, int wave, int lane) {
    const int ncid = (l == 1) ? 256 : 272;
    for (int q = 0; q <= kRep[13]; ++q) for (int cid = gridDim.x - 1 - blockIdx.x; cid < ncid; cid += gridDim.x) pool_item(a, l, lds, cid, tid, wave, lane);
    LAS float* rpb = (LAS float*)(lds + NA_RPB_OFF);
    for (int i = tid; i < 4 * 465; i += NTHR) rpb[i] = a.in.na_rpb[l * 4 * 465 + i];
    for (int q = 0; q <= kRep[14]; ++q) for (int u = blockIdx.x; u < 512; u += gridDim.x) { const int ln = fresh_lane(); na_block<true>(a, lds, u >> 7, (u >> 5) & 3, u & 31, wave * 64 + ln, wave, ln); }
    __syncthreads();
}
constexpr int GL_QR = 0, GL_KR = 8192, GL_GFB = 16384, GL_ROPE = 24576, GL_TOT = 28672, GL_QC = 30720, GL_KF = 49152, GL_KB = 59392,
              GL_VT = 69632, GL_KFT = 88064, GL_KBT = 97280, GL_ATT = 106496;

__device__ __forceinline__ float logsigmoid_fast(float z) { return fminf(z, 0.f) - __logf(1.f + __expf(-fabsf(z))); }

template <bool LOCAL>
__device__ __forceinline__ void gla_prep(const KArgs& a, int l, LAS unsigned char* lds, int cid, int hp, int tid) {
    const bf16_t* P = (const bf16_t*)(a.ws + OFF_P);
    const size_t row0 = (size_t)cid * 64;
    const bool lat = cid < 256;
    LAS bf16_t* QR = (LAS bf16_t*)(lds + GL_QR); LAS bf16_t* KR = (LAS bf16_t*)(lds + GL_KR);
    LAS float* GFB = (LAS float*)(lds + GL_GFB); LAS float* ROPE = (LAS float*)(lds + GL_ROPE); LAS float* TOT = (LAS float*)(lds + GL_TOT);
    LAS bf16_t* QC = (LAS bf16_t*)(lds + GL_QC); LAS bf16_t* KF = (LAS bf16_t*)(lds + GL_KF); LAS bf16_t* KB = (LAS bf16_t*)(lds + GL_KB);
    LAS bf16_t* VT = (LAS bf16_t*)(lds + GL_VT); LAS bf16_t* KFT = (LAS bf16_t*)(lds + GL_KFT); LAS bf16_t* KBT = (LAS bf16_t*)(lds + GL_KBT);
    { const int t = tid >> 3, c8 = tid & 7;
      *(LAS u32x4*)(QR + t * 64 + c8 * 8) = *(const u32x4*)(P + (row0 + t) * NP + C_GQ + hp * 64 + c8 * 8);
      *(LAS u32x4*)(KR + t * 64 + c8 * 8) = *(const u32x4*)(P + (row0 + t) * NP + C_GK + hp * 64 + c8 * 8); }
    if (tid < 256) { const int t = tid >> 2, c8 = tid & 3; const u32x4 v = *(const u32x4*)(P + (row0 + t) * NP + C_GF + c8 * 8);
        LAS float* gp = GFB + t * 32 + c8 * 8;
        gp[0] = lo_bf(v.x); gp[1] = hi_bf(v.x); gp[2] = lo_bf(v.y); gp[3] = hi_bf(v.y); gp[4] = lo_bf(v.z); gp[5] = hi_bf(v.z); gp[6] = lo_bf(v.w); gp[7] = hi_bf(v.w); }
    { const float* rt = (const float*)(a.ws + OFF_ROPE); ROPE[tid] = rt[tid]; ROPE[tid + 512] = rt[tid + 512]; }
#pragma unroll
    for (int rep = 0; rep < 2; ++rep) { const int i = tid + rep * NTHR, t = i & 63, c16 = i >> 6;
        const u32x4 v = *(const u32x4*)(P + (row0 + t) * NP + C_GV + hp * 128 + c16 * 8);
        const int h2 = c16 >> 3, e0 = (c16 & 7) * 8; LAS bf16_t* vp = VT + (h2 * 64 + e0) * 72 + t;
        vp[0 * 72] = (bf16_t)(v.x & 0xffff); vp[1 * 72] = (bf16_t)(v.x >> 16); vp[2 * 72] = (bf16_t)(v.y & 0xffff); vp[3 * 72] = (bf16_t)(v.y >> 16);
        vp[4 * 72] = (bf16_t)(v.z & 0xffff); vp[5 * 72] = (bf16_t)(v.z >> 16); vp[6 * 72] = (bf16_t)(v.w & 0xffff); vp[7 * 72] = (bf16_t)(v.w >> 16); }
    __syncthreads();
    const int col = tid & 127, dir = col >> 6, h2 = (col >> 5) & 1, d = col & 31, tq = tid >> 7;
    const int h = 2 * hp + h2;
    float wg[16];
    { const float* wp = a.in.gla_w_gate + ((size_t)(l * 2 + dir) * 16) * 128 + h * 32 + d;
#pragma unroll
      for (int r = 0; r < 16; ++r) wg[r] = wp[r * 128]; }
    const float bg = a.in.gla_b_gate[(l * 2 + dir) * 128 + h * 32 + d];
    float lgv[16], pf[16]; float run = 0.f;
#pragma unroll
    for (int tt = 0; tt < 16; ++tt) { const LAS float* gp = GFB + (16 * tq + tt) * 32 + dir * 16;
        float z = bg;
#pragma unroll
        for (int r = 0; r < 16; ++r) z += gp[r] * wg[r];
        lgv[tt] = logsigmoid_fast(z) * (1.f / 16.f); run += lgv[tt]; pf[tt] = run; }
    TOT[tq * 128 + col] = run;
    __syncthreads();
    float off = 0.f, total = 0.f;
#pragma unroll
    for (int q = 0; q < 4; ++q) { const float v = TOT[q * 128 + col]; total += v; if (dir ? (q > tq) : (q < tq)) off += v; }
    const float qs = 0.17677669529663687f;
    const int i16 = d & 15, j8 = d & 7, dp = (i16 < 8) ? d + 8 : d - 8; const float sg = (i16 < 8) ? -1.f : 1.f;
#pragma unroll
    for (int tl = 0; tl < 16; ++tl) { const int t = 16 * tq + tl; const float cv = (dir ? run - pf[tl] + lgv[tl] : pf[tl]) + off;
        float k = bf2f(KR[t * 64 + h2 * 32 + d]), q = bf2f(QR[t * 64 + h2 * 32 + d]);
        if (lat) { const int tokpos = (cid & 63) * 64 + t; const int pos = (d & 16) ? (tokpos & 63) : (tokpos >> 6);
            const float cs = ROPE[pos * 8 + j8], sn = ROPE[512 + pos * 8 + j8];
            k = k * cs + sg * bf2f(KR[t * 64 + h2 * 32 + dp]) * sn; q = q * cs + sg * bf2f(QR[t * 64 + h2 * 32 + dp]) * sn; }
        if (LOCAL) { (dir ? KBT : KFT)[(h2 * 32 + d) * 72 + t] = (bf16_t)cvtpk(k * __expf(total - cv), 0.f); }
        else { { const unsigned w_ = cvtpk(q * qs * __expf(cv), k * __expf(-cv)); QC[(h2 * 64 + t) * 72 + dir * 32 + d] = (bf16_t)w_; (dir ? KB : KF)[(h2 * 64 + t) * 40 + d] = (bf16_t)(w_ >> 16); } }
    }
    if (LOCAL && tq == 0) { const int b = lat ? cid >> 6 : (cid - 256) >> 2; const int slot = lat ? 4 + (cid & 63) : (cid - 256) & 3;
        float* DEC = (float*)(a.ws + OFF_GDEC); DEC[((size_t)((b * 4 + h) * 2 + dir) * 68 + slot) * 32 + d] = __expf(total); }
    __syncthreads();
}

__device__ __forceinline__ void gla_local_unit(const KArgs& a, int l, LAS unsigned char* lds, int cid, int hp, int tid, int wave, int lane) {
    SEC_B(6);
    gla_prep<true>(a, l, lds, cid, hp, tid);
    if (wave < 4) {
        const int h2 = wave >> 1, dir = wave & 1, h = 2 * hp + h2, lr = lane & 31, hi = lane >> 5;
        const LAS bf16_t* VT = (const LAS bf16_t*)(lds + GL_VT) + h2 * 64 * 72;
        const LAS bf16_t* KT = (const LAS bf16_t*)(lds + (dir ? GL_KBT : GL_KFT)) + h2 * 32 * 72;
        f32x16 acc[2];
#pragma unroll
        for (int mt = 0; mt < 2; ++mt)
#pragma unroll
            for (int r = 0; r < 16; ++r) acc[mt][r] = 0.f;
#pragma unroll
        for (int s = 0; s < 4; ++s) {
            const bf16x8 bfr = *(const LAS bf16x8*)(KT + lr * 72 + 16 * s + 8 * hi);
#pragma unroll
            for (int mt = 0; mt < 2; ++mt) { const bf16x8 afr = *(const LAS bf16x8*)(VT + (32 * mt + lr) * 72 + 16 * s + 8 * hi); acc[mt] = MFMA32(afr, bfr, acc[mt]); }
        }
        const bool lat = cid < 256; const int b = lat ? cid >> 6 : (cid - 256) >> 2; const int slot = lat ? 4 + (cid & 63) : (cid - 256) & 3;
        float* LOC = (float*)(a.ws + OFF_GLOC) + ((size_t)((b * 4 + h) * 2 + dir) * 68 + slot) * 2048;
#pragma unroll
        for (int mt = 0; mt < 2; ++mt)
#pragma unroll
            for (int r = 0; r < 16; ++r) { const int e = 32 * mt + (r & 3) + 8 * (r >> 2) + 4 * hi; LOC[e * 32 + lr] = acc[mt][r]; }
    }
    __syncthreads();
    SEC_E(6);
}

__device__ __forceinline__ void gla_scan_item(const KArgs& a, int item, int tid) {
    const int chain = item >> 2, elem = (item & 3) * 512 + tid, d = elem & 31, dir = chain & 1;
    const float* LOC = (const float*)(a.ws + OFF_GLOC) + (size_t)chain * 68 * 2048 + elem;
    const float* DEC = (const float*)(a.ws + OFF_GDEC) + (size_t)chain * 68 * 32 + d;
    bf16_t* SIN = (bf16_t*)(a.ws + OFF_GSIN) + (size_t)chain * 68 * 2048 + elem;
    float S = 0.f;
    for (int st = 0; st < 68; st += 4) {
        float lv[4], dv[4]; int sl[4];
#pragma unroll
        for (int k = 0; k < 4; ++k) { sl[k] = dir ? 71 - (st + k) : st + k; if (dir && st + k < 4) sl[k] = 3 - (st + k); lv[k] = LOC[(size_t)sl[k] * 2048]; dv[k] = DEC[sl[k] * 32]; }
#pragma unroll
        for (int k = 0; k < 4; ++k) { SIN[(size_t)sl[k] * 2048] = f2bf(S); S = dv[k] * S + lv[k]; }
    }
}

__device__ __forceinline__ void gla_out_unit(const KArgs& a, int l, LAS unsigned char* lds, int cid, int hp, int tid, int wave, int lane) {
    SEC_B(3);
    gla_prep<false>(a, l, lds, cid, hp, tid);
    SEC_E(3);
    SEC_B(4);
    if (wave < 4) {
        const int h2 = wave >> 1, ih = wave & 1, h = 2 * hp + h2, lr = lane & 31, hi = lane >> 5;
        const LAS bf16_t* QC = (const LAS bf16_t*)(lds + GL_QC) + h2 * 64 * 72;
        const LAS bf16_t* KF = (const LAS bf16_t*)(lds + GL_KF) + h2 * 64 * 40;
        const LAS bf16_t* KB = (const LAS bf16_t*)(lds + GL_KB) + h2 * 64 * 40;
        const LAS bf16_t* VT = (const LAS bf16_t*)(lds + GL_VT) + h2 * 64 * 72;
        LAS bf16_t* ATT = (LAS bf16_t*)(lds + GL_ATT) + wave * 32 * 72;
        const int icol = 32 * ih + lr;
#pragma unroll
        for (int jt = 0; jt < 2; ++jt) {
            f32x16 df, db;
#pragma unroll
            for (int r = 0; r < 16; ++r) { df[r] = 0.f; db[r] = 0.f; }
#pragma unroll
            for (int s = 0; s < 2; ++s) {
                const bf16x8 af = *(const LAS bf16x8*)(KF + (32 * jt + lr) * 40 + 16 * s + 8 * hi), ab = *(const LAS bf16x8*)(KB + (32 * jt + lr) * 40 + 16 * s + 8 * hi);
                const bf16x8 bf_ = *(const LAS bf16x8*)(QC + icol * 72 + 16 * s + 8 * hi), bb_ = *(const LAS bf16x8*)(QC + icol * 72 + 32 + 16 * s + 8 * hi);
                df = MFMA32(af, bf_, df); db = MFMA32(ab, bb_, db);
            }
#pragma unroll
            for (int qd = 0; qd < 4; ++qd) { float v[4];
#pragma unroll
                for (int k = 0; k < 4; ++k) { const int j = 32 * jt + 8 * qd + 4 * hi + k; v[k] = (j <= icol ? df[4 * qd + k] : 0.f) + (j >= icol ? db[4 * qd + k] : 0.f); }
                u32x2 w; w.x = cvtpk(v[0], v[1]); w.y = cvtpk(v[2], v[3]);
                *(LAS u32x2*)(ATT + lr * 72 + 32 * jt + 8 * qd + 4 * hi) = w; }
        }
        LDS_FENCE();
        const bool lat = cid < 256; const int b = lat ? cid >> 6 : (cid - 256) >> 2; const int slot = lat ? 4 + (cid & 63) : (cid - 256) & 3;
        const bf16_t* SF = (const bf16_t*)(a.ws + OFF_GSIN) + ((size_t)((b * 4 + h) * 2 + 0) * 68 + slot) * 2048;
        const bf16_t* SB = SF + (size_t)68 * 2048;
        f32x16 acc[2];
#pragma unroll
        for (int mt = 0; mt < 2; ++mt)
#pragma unroll
            for (int r = 0; r < 16; ++r) acc[mt][r] = 0.f;
#pragma unroll
        for (int s = 0; s < 4; ++s) {
            const bf16x8 b1 = *(const LAS bf16x8*)(ATT + lr * 72 + 16 * s + 8 * hi);
            const bf16x8 b2 = *(const LAS bf16x8*)(QC + icol * 72 + 16 * s + 8 * hi);
#pragma unroll
            for (int mt = 0; mt < 2; ++mt) {
                const bf16x8 a1 = *(const LAS bf16x8*)(VT + (32 * mt + lr) * 72 + 16 * s + 8 * hi);
                const bf16_t* sp = (s < 2 ? SF : SB) + (32 * mt + lr) * 32 + 16 * (s & 1) + 8 * hi;
                const bf16x8 a2 = *(const bf16x8*)sp;
                acc[mt] = MFMA32(a1, b1, acc[mt]); acc[mt] = MFMA32(a2, b2, acc[mt]);
            }
        }
        float ss = 0.f;
#pragma unroll
        for (int mt = 0; mt < 2; ++mt)
#pragma unroll
            for (int r = 0; r < 16; ++r) ss += acc[mt][r] * acc[mt][r];
        ss += __shfl_xor(ss, 32);
        const float rstd = rsqrtf(ss * (1.f / 64.f) + EPS);
        const bf16_t* P = (const bf16_t*)(a.ws + OFF_P); bf16_t* Y = (bf16_t*)(a.ws + OFF_H);
        const float* gn = a.in.gla_g_norm + l * 64;
        const size_t row = (size_t)cid * 64 + icol;
#pragma unroll
        for (int mt = 0; mt < 2; ++mt)
#pragma unroll
            for (int qd = 0; qd < 4; ++qd) { const int e0 = 32 * mt + 8 * qd + 4 * hi;
                const f32x4 g4 = *(const f32x4*)(gn + e0);
                const u32x2 gt = *(const u32x2*)(P + row * NP + C_GATE + h * 64 + e0);
                u32x2 w;
                w.x = cvtpk(acc[mt][4 * qd + 0] * rstd * g4.x * fast_silu(lo_bf(gt.x)), acc[mt][4 * qd + 1] * rstd * g4.y * fast_silu(hi_bf(gt.x)));
                w.y = cvtpk(acc[mt][4 * qd + 2] * rstd * g4.z * fast_silu(lo_bf(gt.y)), acc[mt][4 * qd + 3] * rstd * g4.w * fast_silu(hi_bf(gt.y)));
                *(u32x2*)(Y + row * DM + h * 64 + e0) = w; }
    }
    __syncthreads();
    SEC_E(4);
}

__device__ __forceinline__ void phC_gla(const KArgs& a, int l, LAS unsigned char* lds, int tid, int wave, int lane) {
    for (int u = blockIdx.x; u < 544; u += gridDim.x) gla_local_unit(a, l, lds, u >> 1, u & 1, tid, wave, lane);
}
__device__ __forceinline__ void phD_gla(const KArgs& a, int tid) {
    for (int it = blockIdx.x; it < 128; it += gridDim.x) gla_scan_item(a, it, tid);
}
__device__ __forceinline__ void phE_gla(const KArgs& a, int l, LAS unsigned char* lds, int tid, int wave, int lane) {
    const int nu = (l == 1) ? 512 : 544;
    for (int u = blockIdx.x; u < nu; u += gridDim.x) gla_out_unit(a, l, lds, u >> 1, u & 1, tid, wave, lane);
}
constexpr int S5_WAVE_BYTES = 12544;
constexpr int S5_GT = 8 * S5_WAVE_BYTES;

__device__ __forceinline__ float gelu_tanh_fast(float v) { const float u = 0.7978845608028654f * (v + 0.044715f * v * v * v); return v * __builtin_amdgcn_rcpf(1.f + fast_exp(-2.f * u)); }

template <int DIR, bool READOUT>
__device__ __forceinline__ void s5_dir(const KArgs& a, int l, LAS unsigned char* wl, size_t row0, int g, int lane, float& xr, float& xi, f32x4 (&D2)[4]) {
    const bf16_t* P = (const bf16_t*)(a.ws + OFF_P);
    const int dgl = (l * 2 + DIR) * 16 + g;
    const bf16_t* BBT = (const bf16_t*)(a.ws + OFF_BBT) + (size_t)dgl * 128 * 16;
    const bf16_t* CMT = (const bf16_t*)(a.ws + OFF_CMT) + (size_t)dgl * 16 * 128;
    const f32x4 lb = *(const f32x4*)((const float*)(a.ws + OFF_SLB) + ((size_t)dgl * 64 + lane) * 4);
    const float lbr = lb.x, lbi = lb.y;
    LAS float* SCAN = (LAS float*)wl; LAS bf16_t* XB = (LAS bf16_t*)(wl + 8192);
    const int li = lane & 15, g4 = lane >> 4;
    const bf16x8 zero8 = {0, 0, 0, 0, 0, 0, 0, 0};
    bf16x8 bfr[8];
#pragma unroll
    for (int nt = 0; nt < 8; ++nt) bfr[nt] = (g4 < 2) ? *(const bf16x8*)(BBT + (16 * nt + li) * 16 + 8 * g4) : zero8;
    bf16x8 afr[4], cbf[4];
#pragma unroll
    for (int sb = 0; sb < 4; ++sb) afr[sb] = (g4 < 2) ? *(const bf16x8*)(P + (row0 + 16 * sb + li) * NP + C_SU + 16 * g + 8 * g4) : zero8;
    if (READOUT) {
#pragma unroll
        for (int s = 0; s < 4; ++s) cbf[s] = *(const bf16x8*)(CMT + li * 128 + 32 * s + 8 * g4);
    }
#pragma unroll
    for (int step = 0; step < 4; ++step) {
        const int sb = DIR ? 3 - step : step;
#pragma unroll
        for (int nt = 0; nt < 8; ++nt) { f32x4 d = {0.f, 0.f, 0.f, 0.f}; d = MFMA16(afr[sb], bfr[nt], d);
#pragma unroll
            for (int r = 0; r < 4; ++r) SCAN[(4 * g4 + r) * 128 + 16 * nt + li] = d[r]; }
        LDS_FENCE();
#pragma unroll
        for (int hh = 0; hh < 2; ++hh) {
            const int tb = (DIR ? 1 - hh : hh) * 8;
            float br[8], bi[8];
#pragma unroll
            for (int t = 0; t < 8; ++t) { const f32x2_t v2 = *(const LAS f32x2_t*)(SCAN + (tb + t) * 128 + 2 * lane); br[t] = v2.x; bi[t] = v2.y; }
#pragma unroll
            for (int tt = 0; tt < 8; ++tt) { const int t = DIR ? 7 - tt : tt;
                const float nxr = lbr * xr - lbi * xi + br[t], nxi = lbr * xi + lbi * xr + bi[t]; xr = nxr; xi = nxi;
                if (READOUT) { br[t] = xr; bi[t] = xi; } }
            if (READOUT) {
#pragma unroll
                for (int t = 0; t < 8; ++t) *(LAS unsigned*)(XB + (tb + t) * 136 + 2 * lane) = cvtpk(br[t], bi[t]);
            }
        }
        LDS_FENCE();
        if (READOUT) {
#pragma unroll
            for (int s = 0; s < 4; ++s) { const bf16x8 xa = *(const LAS bf16x8*)(XB + li * 136 + 32 * s + 8 * g4);
                D2[sb] = MFMA16(xa, cbf[s], D2[sb]); }
            LDS_FENCE();
        }
    }
}

__device__ __forceinline__ void s5_local_unit(const KArgs& a, int l, LAS unsigned char* lds, int cid, int wave, int lane) {
    const int tid = wave * 64 + lane; SEC_B(5);
    const bool lat = cid < 256; const int b = lat ? cid >> 6 : (cid - 256) >> 2; const int slot = lat ? 4 + (cid & 63) : (cid - 256) & 3;
    LAS unsigned char* wl = lds + wave * S5_WAVE_BYTES;
    float* SXL = (float*)(a.ws + OFF_SXL);
    f32x4 dummy[4];
#pragma unroll
    for (int gi = 0; gi < 2; ++gi) { const int g = 2 * wave + gi;
        { float xr = 0.f, xi = 0.f; s5_dir<0, false>(a, l, wl, (size_t)cid * 64, g, lane, xr, xi, dummy);
          float* o = SXL + ((size_t)((b * 16 + g) * 2 + 0) * 68 + slot) * 128; o[lane] = xr; o[64 + lane] = xi; }
        { float xr = 0.f, xi = 0.f; s5_dir<1, false>(a, l, wl, (size_t)cid * 64, g, lane, xr, xi, dummy);
          float* o = SXL + ((size_t)((b * 16 + g) * 2 + 1) * 68 + slot) * 128; o[lane] = xr; o[64 + lane] = xi; }
    }
    SEC_E(5);
}

__device__ __forceinline__ void s5_scan_item(const KArgs& a, int l, int item, int tid) {
    const int chain = item * 8 + (tid >> 6), p = tid & 63, dir = chain & 1, g = (chain >> 1) & 15;
    const int dgl = (l * 2 + dir) * 16 + g;
    const f32x4 lb = *(const f32x4*)((const float*)(a.ws + OFF_SLB) + ((size_t)dgl * 64 + p) * 4);
    const float* SXL = (const float*)(a.ws + OFF_SXL) + (size_t)chain * 68 * 128 + p;
    float* SX0 = (float*)(a.ws + OFF_SX0) + (size_t)chain * 68 * 128 + p;
    float xr = 0.f, xi = 0.f;
    for (int st = 0; st < 68; st += 4) {
        float vr[4], vi[4]; int sl[4];
#pragma unroll
        for (int k = 0; k < 4; ++k) { sl[k] = dir ? 71 - (st + k) : st + k; if (dir && st + k < 4) sl[k] = 3 - (st + k); vr[k] = SXL[sl[k] * 128]; vi[k] = SXL[sl[k] * 128 + 64]; }
#pragma unroll
        for (int k = 0; k < 4; ++k) { SX0[sl[k] * 128] = xr; SX0[sl[k] * 128 + 64] = xi;
            const float nr = lb.z * xr - lb.w * xi + vr[k], ni = lb.z * xi + lb.w * xr + vi[k]; xr = nr; xi = ni; }
    }
}

__device__ __forceinline__ void s5_out_unit(const KArgs& a, int l, LAS unsigned char* lds, int cid, int tid, int wave, int lane) {
    const bf16_t* P = (const bf16_t*)(a.ws + OFF_P); bf16_t* Y = (bf16_t*)(a.ws + OFF_H);
    const bool lat = cid < 256; const int b = lat ? cid >> 6 : (cid - 256) >> 2; const int slot = lat ? 4 + (cid & 63) : (cid - 256) & 3;
    const size_t row0 = (size_t)cid * 64;
    LAS unsigned char* wl = lds + wave * S5_WAVE_BYTES;
    LAS bf16_t* GT = (LAS bf16_t*)(lds + S5_GT);
    const float* SX0 = (const float*)(a.ws + OFF_SX0);
    const float* dsk = a.in.s5_d + l * 256;
    const int li = lane & 15, g4 = lane >> 4;
    SEC_B(1);
#pragma unroll 1
    for (int gi = 0; gi < 2; ++gi) { const int g = 2 * wave + gi;
        f32x4 D2[4];
#pragma unroll
        for (int k = 0; k < 4; ++k) D2[k] = (f32x4){0.f, 0.f, 0.f, 0.f};
        { const float* x0 = SX0 + ((size_t)((b * 16 + g) * 2 + 0) * 68 + slot) * 128; float xr = x0[lane], xi = x0[64 + lane];
          s5_dir<0, true>(a, l, wl, row0, g, lane, xr, xi, D2); }
        { const float* x0 = SX0 + ((size_t)((b * 16 + g) * 2 + 1) * 68 + slot) * 128; float xr = x0[lane], xi = x0[64 + lane];
          s5_dir<1, true>(a, l, wl, row0, g, lane, xr, xi, D2); }
        const float dk = dsk[16 * g + li];
        const unsigned uoff = (unsigned)(4 * g4) * NP + li;
#pragma unroll
        for (int sb = 0; sb < 4; ++sb)
#pragma unroll
            for (int r = 0; r < 4; ++r) { const int t = 16 * sb + 4 * g4 + r;
                const bf16_t* urow = P + (row0 + 16 * sb + r) * NP + C_SU + 16 * g;
                const float u = bf2f(urow[uoff]);
                GT[t * 264 + 16 * g + li] = (bf16_t)cvtpk(gelu_tanh_fast(D2[sb][r] + u * dk), 0.f); }
    }
    __syncthreads();
    SEC_E(1);
    SEC_B(2);
    {
        const bf16_t* WGT = (const bf16_t*)(a.ws + OFF_WGT) + (size_t)l * 65536;
        f32x4 acc[2][4];
#pragma unroll
        for (int mi = 0; mi < 2; ++mi)
#pragma unroll
            for (int nt = 0; nt < 4; ++nt) acc[mi][nt] = (f32x4){0.f, 0.f, 0.f, 0.f};
#pragma unroll
        for (int s = 0; s < 8; ++s) {
            bf16x8 af[2], bfr[4];
#pragma unroll
            for (int mi = 0; mi < 2; ++mi) af[mi] = *(const bf16x8*)(WGT + (size_t)(16 * (2 * wave + mi) + li) * 256 + 32 * s + 8 * g4);
#pragma unroll
            for (int nt = 0; nt < 4; ++nt) bfr[nt] = *(const LAS bf16x8*)(GT + (16 * nt + li) * 264 + 32 * s + 8 * g4);
#pragma unroll
            for (int mi = 0; mi < 2; ++mi)
#pragma unroll
                for (int nt = 0; nt < 4; ++nt) acc[mi][nt] = MFMA16(af[mi], bfr[nt], acc[mi][nt]);
        }
        const float* bgl = a.in.s5_b_glu + l * 256;
#pragma unroll
        for (int mi = 0; mi < 2; ++mi) { const int m0 = 16 * (2 * wave + mi) + 4 * g4; const f32x4 bv = *(const f32x4*)(bgl + m0);
#pragma unroll
            for (int nt = 0; nt < 4; ++nt) { const int t = 16 * nt + li; const size_t row = row0 + t;
                const u32x2 gv = *(const LAS u32x2*)(GT + t * 264 + m0);
                const u32x2 gt = *(const u32x2*)(P + row * NP + C_GATE + 512 + m0);
                const float o0 = lo_bf(gv.x) * __builtin_amdgcn_rcpf(1.f + fast_exp(-(acc[mi][nt][0] + bv.x))) * fast_silu(lo_bf(gt.x));
                const float o1 = hi_bf(gv.x) * __builtin_amdgcn_rcpf(1.f + fast_exp(-(acc[mi][nt][1] + bv.y))) * fast_silu(hi_bf(gt.x));
                const float o2 = lo_bf(gv.y) * __builtin_amdgcn_rcpf(1.f + fast_exp(-(acc[mi][nt][2] + bv.z))) * fast_silu(lo_bf(gt.y));
                const float o3 = hi_bf(gv.y) * __builtin_amdgcn_rcpf(1.f + fast_exp(-(acc[mi][nt][3] + bv.w))) * fast_silu(hi_bf(gt.y));
                u32x2 w; w.x = cvtpk(o0, o1); w.y = cvtpk(o2, o3);
                *(u32x2*)(Y + row * DM + 512 + m0) = w; }
        }
    }
    __syncthreads();
    SEC_E(2);
}

__device__ __forceinline__ void phC_s5(const KArgs& a, int l, LAS unsigned char* lds, int wave, int lane) {
    for (int cid = blockIdx.x; cid < 272; cid += gridDim.x) s5_local_unit(a, l, lds, cid, wave, lane);
    __syncthreads();
}
__device__ __forceinline__ void phD_s5(const KArgs& a, int l, int tid) {
    const int vb = gridDim.x - 1 - blockIdx.x;
    for (int it = vb; it < 16; it += gridDim.x) s5_scan_item(a, l, it, tid);
}
__device__ __forceinline__ void phE_s5(const KArgs& a, int l, LAS unsigned char* lds, int tid, int wave, int lane) {
    const int nc = (l == 1) ? 256 : 272;
    for (int cid = blockIdx.x; cid < nc; cid += gridDim.x) s5_out_unit(a, l, lds, cid, tid, wave, lane);
}

__device__ __forceinline__ void pro_s5_tables(const KArgs& a, int tid) {
    const Inputs& in = a.in;
    const int gt = blockIdx.x * NTHR + tid, NGT = gridDim.x * NTHR;
    bf16_t* BBT = (bf16_t*)(a.ws + OFF_BBT); bf16_t* CMT = (bf16_t*)(a.ws + OFF_CMT); float* SLB = (float*)(a.ws + OFF_SLB); bf16_t* WGT = (bf16_t*)(a.ws + OFF_WGT);
    if (gt < 2 * 2 * 16 * 64) {
        const int p = gt & 63, dgl = gt >> 6;
        const float dt = expf(in.s5_log_dt[dgl]);
        const float lre = in.s5_lam_re[dgl * 64 + p], lim = in.s5_lam_im[dgl * 64 + p];
        const float mag = expf(lre * dt), ang = lim * dt;
        const float lbr = mag * cosf(ang), lbi = mag * sinf(ang);
        const float nr = lbr - 1.f, ni = lbi, den = lre * lre + lim * lim;
        const float cr = (nr * lre + ni * lim) / den, ci = (ni * lre - nr * lim) / den;
        for (int h = 0; h < 16; ++h) { const float br = in.s5_b_re[((size_t)dgl * 64 + p) * 16 + h], bi = in.s5_b_im[((size_t)dgl * 64 + p) * 16 + h];
            BBT[((size_t)dgl * 128 + 2 * p) * 16 + h] = f2bf(cr * br - ci * bi); BBT[((size_t)dgl * 128 + 2 * p + 1) * 16 + h] = f2bf(cr * bi + ci * br); }
        float pr = lbr, pi = lbi;
        for (int k = 0; k < 6; ++k) { const float tr = pr * pr - pi * pi, ti = 2.f * pr * pi; pr = tr; pi = ti; }
        *(f32x4*)(SLB + ((size_t)dgl * 64 + p) * 4) = (f32x4){lbr, lbi, pr, pi};
    }
    for (int i = gt; i < 2 * 2 * 16 * 16 * 128; i += NGT) { const int pri = i & 127, h = (i >> 7) & 15, dgl = i >> 11;
        const float v = (pri & 1) ? -in.s5_c_im[((size_t)dgl * 16 + h) * 64 + (pri >> 1)] : in.s5_c_re[((size_t)dgl * 16 + h) * 64 + (pri >> 1)];
        CMT[i] = f2bf(v); }
    for (int i = gt; i < 2 * 65536; i += NGT) { const int n = i & 255, m = (i >> 8) & 255, li = i >> 16; WGT[i] = f2bf(in.s5_w_glu[(size_t)li * 65536 + n * 256 + m]); }
}
#define WQ_LOOP(ctr_, nitems_, ...) do { unsigned nxt_ = 0u; if (tid == 0) nxt_ = atomicAdd((ctr_), 1u); \
    for (;;) { __syncthreads(); if (tid == 0) wq[0] = nxt_; __syncthreads(); const int item = (int)wq[0]; if (item >= (nitems_)) break; \
        if (tid == 0) nxt_ = atomicAdd((ctr_), 1u); __VA_ARGS__ } __syncthreads(); } while (0)
#define WQ_CTR(l, idx) ((unsigned*)(a.ws + OFF_CTL) + 32 + 16 * ((l) * 16 + (idx)))

__device__ __forceinline__ void phC_dyn(const KArgs& a, int l, LAS unsigned char* lds, volatile LAS unsigned* wq, int tid, int wave, int lane) {
    WQ_LOOP(WQ_CTR(l, 0), 272, { s5_local_unit(a, l, lds, item, wave, lane); });
    if (l == 0) WQ_LOOP(WQ_CTR(l, 1), 32, { na_block<false>(a, lds, item >> 3, (item >> 1) & 3, item & 1, tid, wave, lane); });
    WQ_LOOP(WQ_CTR(l, 2), 544, { gla_local_unit(a, l, lds, item >> 1, item & 1, tid, wave, lane); });
}
__device__ __forceinline__ void phD_dyn(const KArgs& a, int l, LAS unsigned char* lds, volatile LAS unsigned* wq, int tid, int wave, int lane) {
    LAS float* rpb = (LAS float*)(lds + NA_RPB_OFF);
    for (int i = tid; i < 4 * 465; i += NTHR) rpb[i] = a.in.na_rpb[l * 4 * 465 + i];
    WQ_LOOP(WQ_CTR(l, 3), 512, { const int ln = fresh_lane(); na_block<true>(a, lds, item >> 7, (item >> 5) & 3, item & 31, wave * 64 + ln, wave, ln); });
    WQ_LOOP(WQ_CTR(l, 4), (l == 1) ? 256 : 272, { pool_item(a, l, lds, item, tid, wave, lane); });
    WQ_LOOP(WQ_CTR(l, 5), 128, { gla_scan_item(a, item, tid); });
    WQ_LOOP(WQ_CTR(l, 6), 16, { s5_scan_item(a, l, item, tid); });
}
__device__ __forceinline__ void phE_dyn(const KArgs& a, int l, LAS unsigned char* lds, volatile LAS unsigned* wq, int tid, int wave, int lane) {
    WQ_LOOP(WQ_CTR(l, 7), (l == 1) ? 256 : 272, { s5_out_unit(a, l, lds, item, tid, wave, lane); });
    WQ_LOOP(WQ_CTR(l, 8), (l == 1) ? 512 : 544, { gla_out_unit(a, l, lds, item >> 1, item & 1, tid, wave, lane); });
}
__global__ void __launch_bounds__(NTHR, 2) mega(KArgs a_by_value) {
    unsigned long long kp_ = (unsigned long long)__builtin_amdgcn_kernarg_segment_ptr();
    asm volatile("" : "+s"(kp_));
    const KArgs& a = *(const KArgs*)(const GAS KArgs*)kp_;
    extern __shared__ __attribute__((aligned(16))) unsigned char lds_raw[];
    LAS unsigned char* lds = (LAS unsigned char*)lds_raw;
    const int wave = __builtin_amdgcn_readfirstlane((int)threadIdx.x >> 6);
#define MY_LANE() fresh_lane()
#define T0() (wave == 0 && MY_LANE() == 0)
    const int tid = wave * 64 + MY_LANE();
    volatile LAS unsigned* MISC = (volatile LAS unsigned*)(lds + MISC_OFF);
    for (int u = tid; u < (LDS_BYTES - RING_BYTES) / 4; u += NTHR) ((LAS unsigned*)(lds + RING_BYTES))[u] = 0u;
    __syncthreads();
    unsigned* ctl = (unsigned*)(a.ws + OFF_CTL);
    XcdBarrier bar = xcd_barrier_post(ctl + CW_BAR + a.li * XCD_BAR_WORDS, MISC + 8, T0());
    const int lo = a.ph_lo, hi = a.ph_hi;
    cooperative_groups::this_grid().sync();
#define IN(k) (lo <= (k) && (k) < hi)
#define REP(i, ...) do { _Pragma("unroll") for (int rr = 0; rr <= kRep[i]; ++rr) { __VA_ARGS__; if (rr < kRep[i]) xcd_barrier(bar, T0()); } } while (0)
#define PHV const int lane_ = MY_LANE(); const int tid_ = wave * 64 + lane_
#ifdef PROBE_TSEL
    unsigned long long tp_prev = __builtin_amdgcn_s_memrealtime(), tp_acc = 0ull;
#define TSTAMP(k) do { const unsigned long long tn_ = __builtin_amdgcn_s_memrealtime(); if ((PROBE_TSEL >> (k)) & 1) tp_acc += tn_ - tp_prev; tp_prev = tn_; } while (0)
#else
#define TSTAMP(k) do { } while (0)
#endif
#define SEAM(k) do { if (IN(k) && IN((k) + 1)) { xcd_barrier(bar, T0()); } TSTAMP(k); } while (0)
    if (IN(PH_PRO)) { PHV; REP(0, { ph_prologue(a, lds, tid_, wave, lane_); pro_s5_tables(a, tid_); }); for (int rr = 0; rr < kRep[7]; ++rr) xcd_barrier(bar, T0()); }
    SEAM(PH_PRO);
#define LAYER(l) do { \
        constexpr int pb = PH_L0 + (l) * PH_PER_LAYER; \
        constexpr int nrows_out = ((l) == 1) ? NLAT : MTOT; \
        if (IN(pb + 0)) { PHV; REP(1, ph_post_pre(a, (l) - 1, (l), wave, lane_)); } \
        SEAM(pb + 0); \
        if (IN(pb + 1)) { PHV; REP(2, { \
            pg8::Gemm g{(const bf16_t*)(a.ws + OFF_H), (const bf16_t*)(a.ws + OFF_WIN) + (size_t)(l) * NP * DM, MTOT, NP, DM}; \
            pg8::StaticOrder S; S.init(MTOT, NP, gridDim.x, blockIdx.x); \
            pg8::EpiBf16<0> E{(bf16_t*)(a.ws + OFF_P), NP, nullptr, 0, 0, 1.f}; \
            pg8::gemm_phase<pg8::EpiBf16<0>, pg8::StaticOrder, true, true>(lds, g, S, E, wave); }); \
        } \
        SEAM(pb + 1); \
        if (IN(pb + 2)) { PHV; REP(3, phC_dyn(a, (l), lds, MISC + 16, tid_, wave, lane_)); } \
        SEAM(pb + 2); \
        if (IN(pb + 3)) { PHV; REP(4, phD_dyn(a, (l), lds, MISC + 16, tid_, wave, lane_)); } \
        SEAM(pb + 3); \
        if (IN(pb + 4)) { PHV; REP(5, phE_dyn(a, (l), lds, MISC + 16, tid_, wave, lane_)); } \
        SEAM(pb + 4); \
        if (IN(pb + 5)) { PHV; REP(6, { \
            pg8::Gemm g{(const bf16_t*)(a.ws + OFF_H), (const bf16_t*)(a.ws + OFF_WOUT) + (size_t)(l) * DM * DM, nrows_out, DM, DM}; \
            pg8::StaticOrder S; S.init(nrows_out, DM, gridDim.x, blockIdx.x); \
            pg8::EpiF32 E{(float*)(a.ws + OFF_P), DM, nullptr}; \
            pg8::gemm_phase<pg8::EpiF32, pg8::StaticOrder, true, true>(lds, g, S, E, wave); }); \
        } \
        SEAM(pb + 5); \
    } while (0)
    LAYER(0);
    LAYER(1);
#undef LAYER
    if (IN(PH_FIN)) { PHV; ph_post_pre(a, 1, 2, wave, lane_); }
#ifdef PROBE_SEC
    if (blockIdx.x == 0 && wave == 0) { const unsigned long long acc_ = ((volatile LAS unsigned*)(lds + MISC_OFF + 96))[0]; const unsigned long long t0_ = __builtin_amdgcn_s_memrealtime(); while (__builtin_amdgcn_s_memrealtime() - t0_ < 4ull * acc_) __builtin_amdgcn_s_sleep(8); }
#endif
#ifdef PROBE_TSEL
    TSTAMP(PH_FIN);
    if (blockIdx.x == 0 && wave == 0) { const unsigned long long t0_ = __builtin_amdgcn_s_memrealtime(); while (__builtin_amdgcn_s_memrealtime() - t0_ < 4ull * tp_acc) __builtin_amdgcn_s_sleep(8); }
#endif
#undef IN
#undef SEAM
}

static int g_grid = 0;
static void launch_mega(const KArgs& base, int lo, int hi, int li, hipStream_t stream) {
    KArgs a = base; a.ph_lo = lo; a.ph_hi = hi; a.li = li;
    void* args[] = {(void*)&a};
    hipError_t e = hipLaunchCooperativeKernel((const void*)mega, dim3(g_grid), dim3(NTHR), args, LDS_BYTES, stream);
    if (e != hipSuccess) fprintf(stderr, "cooperative launch failed: %s (grid %d)\n", hipGetErrorString(e), g_grid);
}

extern "C" void kernel_launch(void* const* d_in, const int* in_sizes, int n_in, void* d_out, int out_size, void* d_ws, size_t ws_size, hipStream_t stream) {
    if (g_grid == 0) {
        int dev = 0, cus = 0, per_cu = 0;
        hipGetDevice(&dev);
        hipDeviceGetAttribute(&cus, hipDeviceAttributeMultiprocessorCount, dev);
        hipFuncSetAttribute((const void*)mega, hipFuncAttributeMaxDynamicSharedMemorySize, LDS_BYTES);
        hipOccupancyMaxActiveBlocksPerMultiprocessor(&per_cu, (const void*)mega, NTHR, LDS_BYTES);
        if (per_cu < 1) per_cu = 1;
        g_grid = cus * per_cu;
        if (g_grid != 256) fprintf(stderr, "note: grid %d (cus %d x %d)\n", g_grid, cus, per_cu);
    }
    KArgs base;
    memset(&base, 0, sizeof(base));
    const float** ip = (const float**)&base.in;
    for (int i = 0; i < 26; ++i) ip[i] = (const float*)d_in[i];
    base.out = (float*)d_out; base.ws = (unsigned char*)d_ws; base.mask = 7;
    hipMemsetAsync((char*)d_ws + OFF_CTL, 0, CTL_BYTES, stream);
    launch_mega(base, PH_PRO, PH_END, 0, stream);
}
```

```cpp
#include <hip/hip_runtime.h>
#include <hip/hip_cooperative_groups.h>
#include <stdint.h>
#include <math.h>
#include <cstdio>
#include <cstring>

typedef unsigned short bf16_t;
__device__ __forceinline__ float bf2f(bf16_t v) { return __uint_as_float(((unsigned)v) << 16); }
__device__ __forceinline__ bf16_t f2bf(float f) { unsigned u = __float_as_uint(f); return (bf16_t)((u + 0x7fffu + ((u >> 16) & 1u)) >> 16); }

constexpr int DM = 1024, NB = 4, SEQ = 4096, NCTX = 256, GW = 64;
constexpr int NLAT = NB * SEQ;
constexpr int NCT = NB * NCTX;
constexpr int MTOT = NLAT + NCT;
constexpr int NIN = 2848, NP = 3072;
constexpr int C_GK = 0, C_GV = 128, C_GF = 384, C_GB = 400, C_NK = 416, C_NV = 672, C_SU = 928, C_GQ = 1184, C_NQ = 1312, C_PU = 1568, C_GATE = 1824;
constexpr float EPS = 1e-6f;

constexpr size_t OFF_CTL = 0, CTL_BYTES = 256 * 1024;
constexpr size_t OFF_WIN = OFF_CTL + CTL_BYTES;
constexpr size_t OFF_WOUT = OFF_WIN + (size_t)2 * NP * DM * 2;
constexpr size_t OFF_MOD = OFF_WOUT + (size_t)2 * DM * DM * 2;
constexpr size_t OFF_H = OFF_MOD + (size_t)2 * 5 * 3072 * 4 + 1024;
constexpr size_t OFF_P = OFF_H + (size_t)MTOT * DM * 2;
constexpr size_t OFF_XC = OFF_P + (size_t)MTOT * NP * 2;
constexpr size_t OFF_VTL = OFF_XC + (size_t)NCT * DM * 4;
constexpr size_t OFF_VTC = OFF_VTL + (size_t)1024 * SEQ * 2;
constexpr size_t OFF_WPT = OFF_VTC + (size_t)1024 * NCTX * 2;
constexpr size_t OFF_ROPE = OFF_WPT + (size_t)2 * 4 * 64 * 64 * 2;
constexpr size_t OFF_GLOC = OFF_ROPE + 4096;
constexpr size_t OFF_GDEC = OFF_GLOC + (size_t)32 * 68 * 2048 * 4;
constexpr size_t OFF_GSIN = OFF_GDEC + (size_t)32 * 68 * 32 * 4;
constexpr size_t OFF_BBT = OFF_GSIN + (size_t)32 * 68 * 2048 * 2;
constexpr size_t OFF_CMT = OFF_BBT + (size_t)64 * 128 * 16 * 2;
constexpr size_t OFF_SLB = OFF_CMT + (size_t)64 * 16 * 128 * 2;
constexpr size_t OFF_WGT = OFF_SLB + (size_t)64 * 64 * 16;
constexpr size_t OFF_SXL = OFF_WGT + (size_t)2 * 65536 * 2;
constexpr size_t OFF_SX0 = OFF_SXL + (size_t)128 * 68 * 128 * 4;
constexpr size_t OFF_END = OFF_SX0 + (size_t)128 * 68 * 128 * 4;
static_assert(OFF_END <= (size_t)256 * 1024 * 1024, "ws");

struct Inputs {
    const float *x, *c, *ctx, *c_ctx, *w_mod, *b_mod, *g_pre, *g_post, *w_in, *w_out, *gla_w_gate, *gla_b_gate, *gla_g_norm, *na_rpb,
        *s5_lam_re, *s5_lam_im, *s5_log_dt, *s5_b_re, *s5_b_im, *s5_c_re, *s5_c_im, *s5_d, *s5_w_glu, *s5_b_glu, *pool_w, *pool_scale;
};

__device__ __forceinline__ float silu_f(float v) { return v / (1.f + expf(-v)); }
__device__ __forceinline__ float sigmoid_f(float v) { return 1.f / (1.f + expf(-v)); }
__device__ __forceinline__ float gelu_tanh_f(float v) { const float k = 0.7978845608028654f; return 0.5f * v * (1.f + tanhf(k * (v + 0.044715f * v * v * v))); }
__device__ __forceinline__ float logsigmoid_f(float z) { return fminf(z, 0.f) - log1pf(expf(-fabsf(z))); }

#define LAS __attribute__((address_space(3)))
__device__ __forceinline__ int fresh_lane();
namespace pg8 {
#define PG8_LAS __attribute__((address_space(3)))
typedef unsigned short bf16_t;
typedef short bf16x8 __attribute__((ext_vector_type(8)));
typedef float f32x4 __attribute__((ext_vector_type(4)));
typedef unsigned u32x4 __attribute__((ext_vector_type(4)));
constexpr int BM = 256, BK = 64, HALF = 128, HTB = HALF * BK * 2  , STAGE_BYTES = 8 * HTB, NXCD = 8, WGM = 8;

__host__ __device__ __forceinline__ int lds_byte(int r, int c) { const int st = (r >> 4) * 2 + (c >> 5), rr = r & 15, cc = c & 31, ob = rr * 64 + cc * 2; return st * 1024 + (ob ^ (((ob >> 9) & 1) << 5)); }
__host__ __device__ __forceinline__ void stage_rc(int b, int& R, int& C) { const int st = b / 1024, sb = b % 1024, swz = sb ^ (((sb >> 9) & 1) << 5); R = (st >> 1) * 16 + swz / 64; C = (st & 1) * 32 + (swz % 64) / 2; }
__host__ __device__ __forceinline__ int perm32(int rho) { const int n = rho >> 4, i = rho & 15; return 8 * (i >> 2) + 4 * n + (i & 3); }

struct Unit { int pm, pn; };
struct Gemm { const bf16_t* A; const bf16_t* Bt; int M, N, K; };

struct StaticOrder {
    int nM, nN, nwg, G, c;
    __host__ __device__ void init(int M, int N, int G_, int c_) { nM = M / BM; nN = N / BM; nwg = nM * nN; G = G_; c = c_; }
    __host__ __device__ bool next(int i, Unit& u) const {
        const long L = (long)i * G + c; if (L >= nwg) return false;
        int wgid = (int)L; { const int q = nwg / NXCD, r = nwg % NXCD, xcd = wgid % NXCD, off = wgid / NXCD; wgid = (xcd < r ? xcd * (q + 1) : r * (q + 1) + (xcd - r) * q) + off; }
        const int nig = WGM * nN, gid = wgid / nig, fm = gid * WGM, gsz = (nM - fm) < WGM ? (nM - fm) : WGM;
        u.pm = fm + ((wgid % nig) % gsz); u.pn = (wgid % nig) / gsz; return true;
    }
    __device__ __forceinline__ void a_ready(const Unit&) const {}
    __device__ __forceinline__ void done(const Unit&) const {}
};

__device__ __forceinline__ unsigned cvt_pk_bf16(float lo, float hi) { unsigned r; asm volatile("v_cvt_pk_bf16_f32 %0, %1, %2" : "=v"(r) : "v"(lo), "v"(hi)); return r; }
typedef float f32x2 __attribute__((ext_vector_type(2)));
__device__ __forceinline__ f32x2 gelu_pk(f32x2 v) {
    const f32x2 av = __builtin_elementwise_abs(v), d = av * 0.2316418882f + 1.0f;
    f32x2 t; t.x = __builtin_amdgcn_rcpf(d.x); t.y = __builtin_amdgcn_rcpf(d.y);
    f32x2 q = t * 0.5307027145f + (-0.7265760135f); q = q * t + 0.7107068705f; q = q * t + (-0.142248368f); q = q * t + 0.127414796f; q = q * t;
    const f32x2 s = (v * v) * (-0.72134752044f);
    f32x2 e; e.x = __builtin_amdgcn_exp2f(s.x); e.y = __builtin_amdgcn_exp2f(s.y);
    const f32x2 m = v * (q * e), r = v - m;
    f32x2 o; o.x = v.x < 0.f ? m.x : r.x; o.y = v.y < 0.f ? m.y : r.y; return o;
}

template <int ACT  > struct EpiBf16 {
    static constexpr bool PERM = true, AFTER_DRAIN = false; static_assert(ACT == 0 || ACT == 1, "EpiBf16: ACT is 0 (none) or 1 (gelu_pk)");
    bf16_t* O; int ldc; const float* bias; int split_cols; size_t split_stride; float scale0;
    __device__ __forceinline__ void operator()(const f32x4 (&acc)[2][2][4][2], const Unit& u, int wr, int wc, int fr, int fq) const {
        const int row0 = u.pm * BM + wr * 64 + fr; int colt = u.pn * BM; bf16_t* base = O;
        float sc = 1.f; if (split_cols) { const int t = colt / split_cols; base += (size_t)t * split_stride; colt -= t * split_cols; if (t == 0) sc = scale0; }
        const int col0 = colt + wc * 32 + 8 * fq, bcol0 = u.pn * BM + wc * 32 + 8 * fq;
        f32x4 bv[2][2];
#pragma unroll
        for (int bj = 0; bj < 2; ++bj)
#pragma unroll
            for (int n = 0; n < 2; ++n) bv[bj][n] = bias ? *(const f32x4*)(bias + bcol0 + bj * HALF + 4 * n) : (f32x4){0.f, 0.f, 0.f, 0.f};
#pragma unroll
        for (int ai = 0; ai < 2; ++ai)
#pragma unroll
            for (int m = 0; m < 4; ++m) { bf16_t* rowp = base + (size_t)(row0 + ai * HALF + m * 16) * ldc + col0;
#pragma unroll
                for (int bj = 0; bj < 2; ++bj) { f32x4 v0 = acc[ai][bj][m][0] + bv[bj][0], v1 = acc[ai][bj][m][1] + bv[bj][1];
                    if (ACT == 1) { f32x2 a = gelu_pk((f32x2){v0[0], v0[1]}), b = gelu_pk((f32x2){v0[2], v0[3]}), c = gelu_pk((f32x2){v1[0], v1[1]}), d = gelu_pk((f32x2){v1[2], v1[3]});
                        v0 = (f32x4){a.x, a.y, b.x, b.y}; v1 = (f32x4){c.x, c.y, d.x, d.y}; }
                    v0 = v0 * sc; v1 = v1 * sc; u32x4 w; w.x = cvt_pk_bf16(v0[0], v0[1]); w.y = cvt_pk_bf16(v0[2], v0[3]); w.z = cvt_pk_bf16(v1[0], v1[1]); w.w = cvt_pk_bf16(v1[2], v1[3]);
                    *(u32x4*)(rowp + bj * HALF) = w; } }
    }
};
struct EpiF32 {
    static constexpr bool PERM = false, AFTER_DRAIN = false;
    float* C; int ldc; const float* bias;
    __device__ __forceinline__ void operator()(const f32x4 (&acc)[2][2][4][2], const Unit& u, int wr, int wc, int fr, int fq) const {
        const int row0 = u.pm * BM + wr * 64 + fr, col0 = u.pn * BM + wc * 32 + 4 * fq;
        f32x4 bv[2][2];
#pragma unroll
        for (int bj = 0; bj < 2; ++bj)
#pragma unroll
            for (int n = 0; n < 2; ++n) bv[bj][n] = bias ? *(const f32x4*)(bias + col0 + bj * HALF + n * 16) : (f32x4){0.f, 0.f, 0.f, 0.f};
#pragma unroll
        for (int ai = 0; ai < 2; ++ai)
#pragma unroll
            for (int m = 0; m < 4; ++m) { float* rowp = C + (size_t)(row0 + ai * HALF + m * 16) * ldc + col0;
#pragma unroll
                for (int bj = 0; bj < 2; ++bj)
#pragma unroll
                    for (int n = 0; n < 2; ++n) *(f32x4*)(rowp + bj * HALF + n * 16) = acc[ai][bj][m][n] + bv[bj][n]; }
    }
};
template <class Epi, class Sched, bool ALIGN_EPI = false, bool SP2 = false>
__device__ __forceinline__ void gemm_phase(PG8_LAS unsigned char* lds, const Gemm g, const Sched& S, const Epi& E, const int wave_in) {
    const int lane = fresh_lane(), wid = wave_in, tid = wid * 64 + lane, wr = wid >> 2, wc = wid & 3, fr = lane & 15, fq = lane >> 4;
    const int K = g.K, nt = K / BK;
    unsigned voffA[2], voffB[2];
#pragma unroll
    for (int i = 0; i < 2; ++i) { int R, C; stage_rc(tid * 16 + i * 8192, R, C); const int Rb = Epi::PERM ? ((R & ~31) + perm32(R & 31)) : R;
        voffA[i] = (unsigned)(R * K + C) * 2u; voffB[i] = (unsigned)(Rb * K + C) * 2u; }
    const size_t kstep = (size_t)(BK * 2);
    const size_t hstep = (size_t)HALF * K * 2;
    const size_t tstep = 2 * hstep;
    const unsigned ldsw = (unsigned)wid * 1024u;
    const int aoff = lds_byte(wr * 64 + fr, fq * 8), boff = lds_byte(wc * 32 + fr, fq * 8);
#define PG8_SA(b, h) (((b) * 2 + (h)) * HTB)
#define PG8_SB(b, h) ((4 + (b) * 2 + (h)) * HTB)
#define PG8_STAGE(bufoff, gbase, voff) do { _Pragma("unroll") for (int _i = 0; _i < 2; ++_i) \
        __builtin_amdgcn_global_load_lds((const unsigned*)((const char*)(gbase) + (voff)[_i]), (PG8_LAS unsigned*)(lds + (bufoff) + ldsw + _i * 8192), 16, 0, 0); } while (0)
#define PG8_LDA(dst, b, h) do { _Pragma("unroll") for (int m = 0; m < 4; ++m) _Pragma("unroll") for (int k = 0; k < 2; ++k) dst[m][k] = *(const PG8_LAS bf16x8*)(lds + PG8_SA(b, h) + aoff + m * 2048 + k * 1024); } while (0)
#define PG8_LDB(dst, b, h) do { _Pragma("unroll") for (int n = 0; n < 2; ++n) _Pragma("unroll") for (int k = 0; k < 2; ++k) dst[n][k] = *(const PG8_LAS bf16x8*)(lds + PG8_SB(b, h) + boff + n * 2048 + k * 1024); } while (0)
#define PG8_MMA(ai, bj, At, Bt) do { __builtin_amdgcn_s_setprio(1); _Pragma("unroll") for (int m = 0; m < 4; ++m) _Pragma("unroll") for (int n = 0; n < 2; ++n) _Pragma("unroll") for (int k = 0; k < 2; ++k) \
        acc[ai][bj][m][n] = __builtin_amdgcn_mfma_f32_16x16x32_bf16(Bt[n][k], At[m][k], acc[ai][bj][m][n], 0, 0, 0); __builtin_amdgcn_s_setprio(0); } while (0)
#define PG8_WAIT_V(n) asm volatile("s_waitcnt vmcnt(" #n ")" ::: "memory")
#define PG8_WAIT_L(n) asm volatile("s_waitcnt lgkmcnt(" #n ")" ::: "memory")
#define PG8_BAR __builtin_amdgcn_s_barrier()
#define PG8_SCHED __builtin_amdgcn_sched_barrier(0)
    Unit cur, nxt; int ui = 0;
    if (!S.next(0, cur)) return;
    f32x4 acc[2][2][4][2];
#pragma unroll
    for (int a = 0; a < 2; ++a)
#pragma unroll
        for (int b = 0; b < 2; ++b)
#pragma unroll
            for (int m = 0; m < 4; ++m)
#pragma unroll
                for (int n = 0; n < 2; ++n) acc[a][b][m][n] = (f32x4){0.f, 0.f, 0.f, 0.f};
    bf16x8 At[4][2], B0[2][2], B1[2][2];
    const char* cA = (const char*)g.A + (size_t)cur.pm * tstep; const char* cB = (const char*)g.Bt + (size_t)cur.pn * tstep;
    S.a_ready(cur);
    if constexpr (SP2) {
        PG8_STAGE(PG8_SB(0, 0), cB, voffB); PG8_STAGE(PG8_SB(0, 1), cB + hstep, voffB); PG8_STAGE(PG8_SA(0, 0), cA, voffA); PG8_STAGE(PG8_SA(0, 1), cA + hstep, voffA);
        if (wr == 1) PG8_BAR;
        PG8_WAIT_V(2); PG8_BAR;
        PG8_STAGE(PG8_SB(1, 0), cB + kstep, voffB); PG8_STAGE(PG8_SA(1, 0), cA + kstep, voffA); PG8_STAGE(PG8_SB(1, 1), cB + hstep + kstep, voffB);
        PG8_WAIT_V(6); PG8_BAR;
    } else {
        PG8_STAGE(PG8_SB(0, 0), cB, voffB); PG8_STAGE(PG8_SA(0, 0), cA, voffA); PG8_STAGE(PG8_SB(0, 1), cB + hstep, voffB); PG8_STAGE(PG8_SA(0, 1), cA + hstep, voffA);
        if (wr == 1) PG8_BAR;
        PG8_WAIT_V(4); PG8_BAR;
        PG8_STAGE(PG8_SB(1, 0), cB + kstep, voffB); PG8_STAGE(PG8_SA(1, 0), cA + kstep, voffA); PG8_STAGE(PG8_SB(1, 1), cB + hstep + kstep, voffB);
        PG8_WAIT_V(6); PG8_BAR;
    }
    for (;;) {
        const bool has_next = S.next(ui + 1, nxt);
        const char* nA = has_next ? (const char*)g.A + (size_t)nxt.pm * tstep : cA; const char* nB = has_next ? (const char*)g.Bt + (size_t)nxt.pn * tstep : cB;
        for (int t = 0; t < nt; t += 2) {
            const bool last = (t == nt - 2);
            const char* a1 = cA + (size_t)(t + 1) * kstep;
            const char* a2 = last ? nA : cA + (size_t)(t + 2) * kstep; const char* b2 = last ? nB : cB + (size_t)(t + 2) * kstep;
            const char* a3 = a2 + kstep; const char* b3 = b2 + kstep;
            if (last && has_next) S.a_ready(nxt);
            if constexpr (SP2) {
            PG8_LDB(B0, 0, 0); PG8_LDB(B1, 0, 1); PG8_SCHED; PG8_LDA(At, 0, 0); PG8_STAGE(PG8_SA(1, 1), a1 + hstep, voffA);
            PG8_WAIT_V(8); PG8_WAIT_L(0); PG8_BAR; PG8_MMA(0, 0, At, B0); PG8_MMA(0, 1, At, B1); PG8_BAR; PG8_SCHED;
            PG8_LDA(At, 0, 1); PG8_STAGE(PG8_SB(0, 0), b2, voffB); PG8_STAGE(PG8_SB(0, 1), b2 + hstep, voffB); PG8_STAGE(PG8_SA(0, 0), a2, voffA);
            PG8_WAIT_V(8); PG8_WAIT_L(0); PG8_BAR; PG8_MMA(1, 0, At, B0); PG8_MMA(1, 1, At, B1); PG8_BAR; PG8_SCHED;
            PG8_LDB(B0, 1, 0); PG8_LDB(B1, 1, 1); PG8_SCHED; PG8_LDA(At, 1, 0); PG8_STAGE(PG8_SA(0, 1), a2 + hstep, voffA);
            PG8_WAIT_V(8); PG8_WAIT_L(0); PG8_BAR; PG8_MMA(0, 0, At, B0); PG8_MMA(0, 1, At, B1); PG8_BAR; PG8_SCHED;
            PG8_LDA(At, 1, 1); PG8_STAGE(PG8_SB(1, 0), b3, voffB); PG8_STAGE(PG8_SB(1, 1), b3 + hstep, voffB); PG8_STAGE(PG8_SA(1, 0), a3, voffA);
            PG8_WAIT_V(8); PG8_WAIT_L(0); PG8_BAR; PG8_MMA(1, 0, At, B0); PG8_MMA(1, 1, At, B1); PG8_BAR; PG8_SCHED;
            } else {
            PG8_LDB(B0, 0, 0); PG8_SCHED; PG8_LDA(At, 0, 0); PG8_STAGE(PG8_SA(1, 1), a1 + hstep, voffA);
            PG8_WAIT_L(8); PG8_BAR; PG8_WAIT_L(0); PG8_MMA(0, 0, At, B0); PG8_BAR; PG8_SCHED;
            PG8_LDB(B1, 0, 1); PG8_STAGE(PG8_SB(0, 0), b2, voffB);
            PG8_BAR; PG8_WAIT_L(0); PG8_MMA(0, 1, At, B1); PG8_BAR;
            PG8_LDA(At, 0, 1); PG8_STAGE(PG8_SA(0, 0), a2, voffA);
            PG8_BAR; PG8_WAIT_L(0); PG8_MMA(1, 0, At, B0); PG8_BAR; PG8_SCHED;
            PG8_STAGE(PG8_SB(0, 1), b2 + hstep, voffB);
            PG8_WAIT_V(6); PG8_BAR; PG8_MMA(1, 1, At, B1); PG8_BAR;
            PG8_LDB(B0, 1, 0); PG8_SCHED; PG8_LDA(At, 1, 0); PG8_STAGE(PG8_SA(0, 1), a2 + hstep, voffA);
            PG8_WAIT_L(8); PG8_BAR; PG8_WAIT_L(0); PG8_MMA(0, 0, At, B0); PG8_BAR; PG8_SCHED;
            PG8_LDB(B1, 1, 1); PG8_STAGE(PG8_SB(1, 0), b3, voffB);
            PG8_BAR; PG8_WAIT_L(0); PG8_MMA(0, 1, At, B1); PG8_BAR;
            PG8_LDA(At, 1, 1); PG8_STAGE(PG8_SA(1, 0), a3, voffA);
            PG8_BAR; PG8_WAIT_L(0); PG8_MMA(1, 0, At, B0); PG8_BAR; PG8_SCHED;
            PG8_STAGE(PG8_SB(1, 1), b3 + hstep, voffB);
            PG8_WAIT_V(6); PG8_BAR; PG8_MMA(1, 1, At, B1); PG8_BAR;
            }
        }
        if constexpr (ALIGN_EPI) { if (wr == 0) PG8_BAR; }
        if constexpr (!Epi::AFTER_DRAIN) { E(acc, cur, wr, wc, fr, fq); S.done(cur); }
        if (!has_next) break;
#pragma unroll
        for (int a = 0; a < 2; ++a)
#pragma unroll
            for (int b = 0; b < 2; ++b)
#pragma unroll
                for (int m = 0; m < 4; ++m)
#pragma unroll
                    for (int n = 0; n < 2; ++n) acc[a][b][m][n] = (f32x4){0.f, 0.f, 0.f, 0.f};
        cur = nxt; cA = nA; cB = nB; ++ui;
        if constexpr (ALIGN_EPI) { if (wr == 1) PG8_BAR; }
    }
    PG8_WAIT_V(0);
    if constexpr (!ALIGN_EPI) { if (wr == 0) PG8_BAR; }
    PG8_BAR;
    if constexpr (Epi::AFTER_DRAIN) { E.fused(acc, cur, wr, wc, fr, fq, lds, wid, lane); S.done(cur); }
#undef PG8_SA
#undef PG8_SB
#undef PG8_STAGE
#undef PG8_LDA
#undef PG8_LDB
#undef PG8_MMA
#undef PG8_WAIT_V
#undef PG8_WAIT_L
#undef PG8_BAR
#undef PG8_SCHED
}
}
#define XB_TMO      128
#define XB_XCNT(j)  (256  + 64 * (j))
#define XB_XSUB(j)  (1280 + 64 * (j))
#define XB_XGEN(j)  (2304 + 64 * (j))
#define XB_TOP      3328
#define XB_TOPGEN   3392
#define XCD_BAR_WORDS 3456
#define XB_SPIN_CAP (1u << 18)

__device__ __forceinline__ unsigned xb_ld(unsigned* p)              { return __hip_atomic_load(p, __ATOMIC_RELAXED, __HIP_MEMORY_SCOPE_AGENT); }
__device__ __forceinline__ unsigned xb_add(unsigned* p, unsigned v) { return __hip_atomic_fetch_add(p, v, __ATOMIC_RELAXED, __HIP_MEMORY_SCOPE_AGENT); }
__device__ __forceinline__ unsigned xb_xcc_id() { return (unsigned)__builtin_amdgcn_s_getreg((3 << 11) | 20) & 0xFu; }
#define XB_SPIN(cond, bar) do { unsigned _sp = 0; while (cond) { __builtin_amdgcn_s_sleep(1); \
    if ((++_sp & 255u) == 0u) { if (xb_ld(&(bar)[XB_TMO])) break; if (_sp > XB_SPIN_CAP) { atomicAdd(&(bar)[XB_TMO], 1u); break; } } } } while (0)

struct XcdBarrier {
    unsigned* bar; unsigned x;
    volatile LAS unsigned* st;
};

__device__ __forceinline__ XcdBarrier xcd_barrier_post(unsigned* bar, volatile LAS unsigned* st, const bool t0) {
    XcdBarrier b; b.bar = bar; b.x = xb_xcc_id(); b.st = st;
    if (t0) (void)xb_add(&bar[XB_XCNT(b.x)], 1u);
    return b;
}
__device__ __forceinline__ void xcd_barrier_complete(unsigned* bar, unsigned x, unsigned& nloc, unsigned& nx) {
    const unsigned G = gridDim.x * gridDim.y * gridDim.z;
    unsigned sum, cnt, mine, sp = 0u;
    for (;;) {
        sum = 0u; cnt = 0u; mine = 0u;
#pragma unroll
        for (unsigned j = 0; j < 16; ++j) { const unsigned c = xb_ld(&bar[XB_XCNT(j)]); sum += c; cnt += (c > 0u) ? 1u : 0u; mine = (j == x) ? c : mine; }
        if (sum == G) break;
        __builtin_amdgcn_s_sleep(1);
        if ((++sp & 255u) == 0u) { if (xb_ld(&bar[XB_TMO])) break; if (sp > XB_SPIN_CAP) { atomicAdd(&bar[XB_TMO], 1u); break; } }
    }
    nloc = mine > 0u ? mine : 1u; nx = cnt > 0u ? cnt : 1u;
}

__device__ __forceinline__ void xcd_barrier(const XcdBarrier& b, const bool t0) {
    asm volatile("s_waitcnt vmcnt(0)" ::: "memory");
    __syncthreads();
    if (t0) {
        unsigned* bar = b.bar;
        __builtin_amdgcn_s_waitcnt(0);
        unsigned nloc = b.st[0], nx = b.st[1];
        if (nloc == 0u) { xcd_barrier_complete(bar, b.x, nloc, nx); b.st[0] = nloc; b.st[1] = nx; }
        const unsigned old = xb_add(&bar[XB_XSUB(b.x)], 1u);
        const unsigned gen = old / nloc;
        if (old + 1u == (gen + 1u) * nloc) {
            __builtin_amdgcn_fence(__ATOMIC_RELEASE, "agent");
            asm volatile("s_waitcnt vmcnt(0)" ::: "memory");
            const unsigned og = xb_add(&bar[XB_TOP], 1u);
            const unsigned tg = og / nx;
            if (og + 1u == (tg + 1u) * nx) xb_add(&bar[XB_TOPGEN], 1u);
            else XB_SPIN(xb_ld(&bar[XB_TOPGEN]) == tg, bar);
            __builtin_amdgcn_fence(__ATOMIC_ACQUIRE, "agent");
            xb_add(&bar[XB_XGEN(b.x)], 1u);
            asm volatile("s_waitcnt vmcnt(0)" ::: "memory");
        } else {
            XB_SPIN(xb_ld(&bar[XB_XGEN(b.x)]) == gen, bar);
            __builtin_amdgcn_fence(__ATOMIC_ACQUIRE, "agent");
            asm volatile("s_waitcnt vmcnt(0)" ::: "memory");
        }
    }
    __syncthreads();
}
#define GAS __attribute__((address_space(1)))
typedef float f32x4 __attribute__((ext_vector_type(4)));
typedef unsigned u32x2 __attribute__((ext_vector_type(2)));
typedef unsigned u32x4 __attribute__((ext_vector_type(4)));
typedef short bf16x8 __attribute__((ext_vector_type(8)));
constexpr int NTHR = 512, NWV = 8;
constexpr int RING_BYTES = 139264, MISC_OFF = RING_BYTES + 320, LDS_BYTES = 147456;
constexpr int CW_BAR = 1024;

struct KArgs { Inputs in; float* out; unsigned char* ws; int ph_lo, ph_hi, li, mask; };
#ifndef PROBE_REP
#define PROBE_REP {0, 0, 0, 0, 0, 0, 0, 0, 0, 0, 0, 0, 0, 0, 0, 0, 0}
#endif
constexpr int kRep[17] = PROBE_REP;

__device__ __forceinline__ float wave_sum(float v) {
#pragma unroll
    for (int o = 1; o < 64; o <<= 1) v += __shfl_xor(v, o);
    return v;
}
typedef float f32x2_t __attribute__((ext_vector_type(2)));
typedef __bf16 bf16x2_t __attribute__((ext_vector_type(2)));
__device__ __forceinline__ unsigned cvtpk(float lo, float hi) { f32x2_t v = {lo, hi}; bf16x2_t b = __builtin_convertvector(v, bf16x2_t); return __builtin_bit_cast(unsigned, b); }
__device__ __forceinline__ unsigned pk2(float lo, float hi) { return cvtpk(lo, hi); }
__device__ __forceinline__ int fresh_lane() { int l; asm volatile("v_mbcnt_lo_u32_b32 %0, -1, 0\n\tv_mbcnt_hi_u32_b32 %0, -1, %0" : "=v"(l)); return l; }
#ifdef PROBE_SEC
#define SEC_B(k) unsigned long long sec_t0_##k = 0; if ((k) == PROBE_SEC && blockIdx.x == 0 && tid == 0) sec_t0_##k = __builtin_amdgcn_s_memrealtime()
#define SEC_E(k) do { if ((k) == PROBE_SEC && blockIdx.x == 0 && tid == 0) { volatile LAS unsigned* sw_ = (volatile LAS unsigned*)(lds + MISC_OFF + 96); sw_[0] = sw_[0] + (unsigned)(__builtin_amdgcn_s_memrealtime() - sec_t0_##k); } } while (0)
#else
#define SEC_B(k)
#define SEC_E(k) do { } while (0)
#endif
#define LDS_FENCE() asm volatile("s_waitcnt lgkmcnt(0)" ::: "memory")

constexpr int PH_PRO = 0;
constexpr int PH_L0 = 1, PH_PER_LAYER = 6;
constexpr int PH_FIN = PH_L0 + 2 * PH_PER_LAYER;
constexpr int PH_END = PH_FIN + 1;

__device__ __forceinline__ void transpose_item(const float* W, int K, int N, bf16_t* WT, LAS float* scr, int item, int lane) {
    const int nblk = N / 32, kb = item / nblk, nb = item % nblk, k0 = 64 * kb, n0 = 32 * nb;
    float wv[32];
#pragma unroll
    for (int i = 0; i < 32; ++i) wv[i] = W[(size_t)(k0 + 2 * i + (lane >> 5)) * N + n0 + (lane & 31)];
#pragma unroll
    for (int i = 0; i < 32; ++i) scr[(2 * i + (lane >> 5)) * 33 + (lane & 31)] = wv[i];
    LDS_FENCE();
    const int c = lane & 7;
#pragma unroll
    for (int j = 0; j < 4; ++j) { const int n = (lane >> 3) + 8 * j; const LAS float* s = scr + (8 * c) * 33 + n;
        u32x4 o; o.x = pk2(s[0 * 33], s[1 * 33]); o.y = pk2(s[2 * 33], s[3 * 33]); o.z = pk2(s[4 * 33], s[5 * 33]); o.w = pk2(s[6 * 33], s[7 * 33]);
        *(u32x4*)(WT + (size_t)(n0 + n) * K + k0 + 8 * c) = o; }
    LDS_FENCE();
}

__device__ __forceinline__ void ph_prologue(const KArgs& a, LAS unsigned char* lds, int tid, int wave, int lane) {
    const Inputs& in = a.in;
    float* MOD = (float*)(a.ws + OFF_MOD);
    LAS float* sil = (LAS float*)lds;
    LAS float* part = (LAS float*)(lds + 5 * 1024 * 4);
    if ((int)blockIdx.x < 192) {
        for (int i = tid; i < 5 * 1024; i += NTHR) { const int j = i >> 10, k = i & 1023; const float cv = j < 4 ? in.c[j * DM + k] : in.c_ctx[k]; sil[i] = cv / (1.f + expf(-cv)); }
        __syncthreads();
        for (int it = blockIdx.x; it < 192; it += gridDim.x) {
            const int l = it / 96, nb = it % 96, n = nb * 32 + (lane & 31), k0 = wave * 128 + (lane >> 5) * 64;
            const float* w = in.w_mod + (size_t)l * DM * 3072 + n;
            float acc[5] = {0.f, 0.f, 0.f, 0.f, 0.f};
#pragma unroll 32
            for (int kk = 0; kk < 64; ++kk) { const float wv = w[(size_t)(k0 + kk) * 3072];
#pragma unroll
                for (int j = 0; j < 5; ++j) acc[j] += sil[j * 1024 + k0 + kk] * wv; }
#pragma unroll
            for (int j = 0; j < 5; ++j) { acc[j] += __shfl_xor(acc[j], 32); if (lane < 32) part[(wave * 5 + j) * 32 + lane] = acc[j]; }
            __syncthreads();
            if (tid < 160) { const int j = tid >> 5, c = tid & 31; float s = in.b_mod[l * 3072 + nb * 32 + c];
#pragma unroll
                for (int w8 = 0; w8 < 8; ++w8) s += part[(w8 * 5 + j) * 32 + c];
                MOD[((size_t)l * 5 + j) * 3072 + nb * 32 + c] = s; }
            __syncthreads();
        }
    }
    __syncthreads();
    LAS float* scr = (LAS float*)(lds + wave * 16384);
    const int gw = blockIdx.x * NWV + wave, NGW = gridDim.x * NWV;
    constexpr int I_IN = (DM / 64) * (NIN / 32), I_OUT = (DM / 64) * (DM / 32), I_PAD = NP - NIN;
    constexpr int I_L = I_IN + I_OUT + I_PAD;
    bf16_t* WIN = (bf16_t*)(a.ws + OFF_WIN); bf16_t* WOUT = (bf16_t*)(a.ws + OFF_WOUT);
    for (int it = gw; it < 2 * I_L; it += NGW) {
        const int l = it / I_L; int r = it % I_L;
        if (r < I_IN) { transpose_item(in.w_in + (size_t)l * DM * NIN, DM, NIN, WIN + (size_t)l * NP * DM, scr, r, lane); continue; } r -= I_IN;
        if (r < I_OUT) { transpose_item(in.w_out + (size_t)l * DM * DM, DM, DM, WOUT + (size_t)l * DM * DM, scr, r, lane); continue; } r -= I_OUT;
        u32x4* zp = (u32x4*)(WIN + ((size_t)l * NP + NIN + r) * DM);
        zp[lane] = (u32x4){0u, 0u, 0u, 0u}; zp[lane + 64] = (u32x4){0u, 0u, 0u, 0u};
    }
    const int gt = blockIdx.x * NTHR + tid, NGT = gridDim.x * NTHR;
    bf16_t* WPT = (bf16_t*)(a.ws + OFF_WPT);
    if (gt < 512) { float* rt = (float*)(a.ws + OFF_ROPE); const int pos = gt >> 3, j = gt & 7; const float f = powf(10000.f, -(float)j / 8.f), ang = (float)pos * f; rt[gt] = cosf(ang); rt[512 + gt] = sinf(ang); }
    for (int i = gt; i < 2 * 4 * 64 * 64; i += NGT) { const int c = i & 63, e = (i >> 6) & 63, li = i >> 12; WPT[i] = f2bf(in.pool_w[(size_t)li * 4096 + c * 64 + e]); }
}

__device__ __forceinline__ void ph_post_pre(const KArgs& a, int lprev, int lnext, int wave, int lane) {
    const Inputs& in = a.in;
    const float* MOD = (const float*)(a.ws + OFF_MOD);
    const bf16_t* O = (const bf16_t*)(a.ws + OFF_P);
    float* XC = (float*)(a.ws + OFF_XC);
    bf16_t* H = (bf16_t*)(a.ws + OFF_H);
    const int gw = blockIdx.x * NWV + wave, NGW = gridDim.x * NWV;
    const int nrows = (lnext < 2) ? MTOT : NLAT;
    for (int row = gw; row < nrows; row += NGW) {
        const bool lat = row < NLAT; const int j = lat ? row / SEQ : 4;
        const float* xr; float* xw = nullptr;
        if (lprev <= 0) xr = lat ? in.x + (size_t)row * DM : in.ctx + (size_t)(row - NLAT) * DM;
        else xr = lat ? a.out + (size_t)row * DM : XC + (size_t)(row - NLAT) * DM;
        const bool post = (lprev >= 0) && (lat || lprev == 0);
        if (post) xw = lat ? a.out + (size_t)row * DM : XC + (size_t)(row - NLAT) * DM;
        f32x4 v[4];
#pragma unroll
        for (int q = 0; q < 4; ++q) v[q] = *(const f32x4*)(xr + 4 * lane + 256 * q);
        if (post) {
            f32x4 o[4]; float s = 0.f;
#pragma unroll
            for (int q = 0; q < 4; ++q) { const u32x2 w = *(const u32x2*)(O + (size_t)row * DM + 4 * lane + 256 * q);
                o[q] = (f32x4){__uint_as_float(w.x << 16), __uint_as_float(w.x & 0xffff0000u), __uint_as_float(w.y << 16), __uint_as_float(w.y & 0xffff0000u)};
                s += (o[q].x * o[q].x + o[q].y * o[q].y) + (o[q].z * o[q].z + o[q].w * o[q].w); }
            const float rstd = rsqrtf(wave_sum(s) * (1.f / DM) + EPS);
            const float* gate = MOD + ((size_t)lprev * 5 + j) * 3072 + 2048; const float* gp = in.g_post + lprev * DM;
#pragma unroll
            for (int q = 0; q < 4; ++q) { const f32x4 gt = *(const f32x4*)(gate + 4 * lane + 256 * q), gg = *(const f32x4*)(gp + 4 * lane + 256 * q);
                v[q] = v[q] + gt * (o[q] * rstd * gg); *(f32x4*)(xw + 4 * lane + 256 * q) = v[q]; }
        }
        if (lnext < 2) {
            float s = 0.f;
#pragma unroll
            for (int q = 0; q < 4; ++q) s += (v[q].x * v[q].x + v[q].y * v[q].y) + (v[q].z * v[q].z + v[q].w * v[q].w);
            const float rstd = rsqrtf(wave_sum(s) * (1.f / DM) + EPS);
            const float* shift = MOD + ((size_t)lnext * 5 + j) * 3072; const float* scale = shift + 1024; const float* gp = in.g_pre + lnext * DM;
#pragma unroll
            for (int q = 0; q < 4; ++q) { const int k = 4 * lane + 256 * q; const f32x4 sh = *(const f32x4*)(shift + k), sc = *(const f32x4*)(scale + k), gg = *(const f32x4*)(gp + k);
                const f32x4 hv = (v[q] * rstd * gg) * (sc + 1.f) + sh;
                u32x2 w; w.x = pk2(hv.x, hv.y); w.y = pk2(hv.z, hv.w); *(u32x2*)(H + (size_t)row * DM + k) = w; }
        }
    }
}

typedef float f32x16 __attribute__((ext_vector_type(16)));
#define MFMA16(a, b, c) __builtin_amdgcn_mfma_f32_16x16x32_bf16(a, b, c, 0, 0, 0)
#define MFMA32(a, b, c) __builtin_amdgcn_mfma_f32_32x32x16_bf16(a, b, c, 0, 0, 0)
__device__ __forceinline__ float fast_exp(float x) { return __builtin_amdgcn_exp2f(x * 1.4426950408889634f); }
__device__ __forceinline__ float fast_silu(float v) { return v * __builtin_amdgcn_rcpf(1.f + fast_exp(-v)); }
__device__ __forceinline__ float lo_bf(unsigned w) { return __uint_as_float(w << 16); }
__device__ __forceinline__ float hi_bf(unsigned w) { return __uint_as_float(w & 0xffff0000u); }


typedef short v4i16_t __attribute__((ext_vector_type(4)));
constexpr int NA_KV_BYTES = 832 * 128, NA_RPB_OFF = NA_KV_BYTES;

__device__ __forceinline__ void na_stage(const bf16_t* P, LAS unsigned char* kv, int colbase, int b, int U0, int nwin, int tid) {
    const int kr0 = tid >> 3, c = tid & 7;
    const unsigned toff = (unsigned)kr0 * NP + 8u * c;
    const bf16_t* gctx = P + (size_t)(NLAT + b * NCTX) * NP + colbase;
    const bf16_t* gwin = P + (size_t)(b * SEQ + U0 * 64) * NP + colbase;
    LAS unsigned char* lb = kv + kr0 * 128 + ((c ^ (kr0 & 7)) << 4);
    u32x4 v[7];
#pragma unroll
    for (int it = 0; it < 4; ++it) v[it] = *(const u32x4*)(gctx + (size_t)it * 64 * NP + toff);
#pragma unroll
    for (int it = 4; it < 7; ++it) if (it - 4 < nwin) v[it] = *(const u32x4*)(gwin + (size_t)(it - 4) * 64 * NP + toff);
#pragma unroll
    for (int it = 0; it < 4; ++it) *(LAS u32x4*)(lb + it * 8192) = v[it];
#pragma unroll
    for (int it = 4; it < 7; ++it) if (it - 4 < nwin) *(LAS u32x4*)(lb + it * 8192) = v[it];
#pragma unroll
    for (int it = 7; it < 13; ++it) if (it - 4 < nwin) v[it - 7] = *(const u32x4*)(gwin + (size_t)(it - 4) * 64 * NP + toff);
#pragma unroll
    for (int it = 7; it < 13; ++it) if (it - 4 < nwin) *(LAS u32x4*)(lb + it * 8192) = v[it - 7];
}

template <bool HW>
__device__ __forceinline__ void na_half(const LAS unsigned char* kbase, int sw0, int sw1, bf16x8 qf0, bf16x8 qf1, const LAS float* rp, int R0, int r, int CB, int cg, int li, int g,
                                        bf16x8 (&pf)[8], float& mo, float& lo_) {
    f32x4 S[16];
#pragma unroll
    for (int t = 0; t < 16; ++t) {
        const LAS unsigned char* kb = HW ? kbase + (t >> 1) * 8192 + (t & 1) * 2048 : kbase + t * 2048;
        const bf16x8 k0 = *(const LAS bf16x8*)(kb + sw0), k1 = *(const LAS bf16x8*)(kb + sw1);
        f32x4 acc = {0.f, 0.f, 0.f, 0.f};
        acc = MFMA16(k0, qf0, acc); acc = MFMA16(k1, qf1, acc); S[t] = acc;
    }
    float m = -INFINITY;
    if (HW) {
        const int c = cg * 16 + li, cs = min(max(c - 8, 0), 48);
        const LAS float* rb = rp + (R0 - r + 7) * 31 + (CB - c + 4 * g + 15);
        bool vld[8];
#pragma unroll
        for (int k = 0; k < 8; ++k) { const int kcol = CB + 16 * (k >> 2) + 4 * g + (k & 3); vld[k] = (kcol >= cs) && (kcol < cs + 16); }
#pragma unroll
        for (int wt = 0; wt < 16; ++wt) {
#pragma unroll
            for (int q = 0; q < 4; ++q) { const float bias = rb[(wt >> 1) * 31 + 16 * (wt & 1) + q];
                const float s = vld[4 * (wt & 1) + q] ? S[wt][q] * 0.125f + bias : -INFINITY; S[wt][q] = s; m = fmaxf(m, s); }
        }
    } else {
#pragma unroll
        for (int ct = 0; ct < 16; ++ct)
#pragma unroll
            for (int q = 0; q < 4; ++q) { const float s = S[ct][q] * 0.125f; S[ct][q] = s; m = fmaxf(m, s); }
    }
    m = fmaxf(m, __shfl_xor(m, 16)); m = fmaxf(m, __shfl_xor(m, 32));
    float lsum = 0.f;
#pragma unroll
    for (int u = 0; u < 8; ++u) {
        float p[8];
#pragma unroll
        for (int q = 0; q < 4; ++q) { p[q] = fast_exp(S[2 * u][q] - m); p[4 + q] = fast_exp(S[2 * u + 1][q] - m); }
#pragma unroll
        for (int q = 0; q < 8; ++q) lsum += p[q];
        u32x4 w; w.x = cvtpk(p[0], p[1]); w.y = cvtpk(p[2], p[3]); w.z = cvtpk(p[4], p[5]); w.w = cvtpk(p[6], p[7]);
        pf[u] = __builtin_bit_cast(bf16x8, w);
    }
    lsum += __shfl_xor(lsum, 16); lsum += __shfl_xor(lsum, 32);
    mo = m; lo_ = lsum;
}

template <bool WIN>
__device__ __forceinline__ void na_block(const KArgs& a, LAS unsigned char* lds, int b, int h, int R, int tid, int wave, int lane) {
    const bf16_t* P = (const bf16_t*)(a.ws + OFF_P); bf16_t* Y = (bf16_t*)(a.ws + OFF_H);
    LAS unsigned char* kv = lds; const LAS float* rpb = (const LAS float*)(lds + NA_RPB_OFF);
    const int li = lane & 15, g = lane >> 4;
    int r = 0, cg = 0, U0 = 0, nwin = 0, wo = 0, CB = 0, R0 = 0, qrow0;
    if (WIN) { r = 2 * R + (wave >> 2); cg = wave & 3; U0 = min(max(2 * R - 4, 0), 56); nwin = min(9, 64 - U0); R0 = min(max(r - 4, 0), 56); wo = R0 - U0;
        CB = min(max(cg * 16 - 8, 0), 32); qrow0 = b * SEQ + r * 64 + cg * 16; }
    else qrow0 = NLAT + b * NCTX + R * 128 + wave * 16;
    SEC_B(7);
    __syncthreads();
    na_stage(P, kv, C_NK + h * 64, b, U0, nwin, tid);
    const bf16_t* qp = P + (size_t)(qrow0 + li) * NP + C_NQ + h * 64 + 8 * g;
    const bf16x8 qf0 = *(const bf16x8*)qp, qf1 = *(const bf16x8*)(qp + 32);
    __syncthreads();
    const LAS unsigned char* kwin = kv + (256 + wo * 64 + CB + li) * 128; const LAS unsigned char* kctx = kv + li * 128;
    const int sw0 = (g ^ (li & 7)) << 4, sw1 = ((4 + g) ^ (li & 7)) << 4;
    bf16x8 pfw[8], pfc[8];
    float mw = -INFINITY, lw = 0.f, mc, lc;
    if (WIN) na_half<true>(kwin, sw0, sw1, qf0, qf1, rpb + h * 465, R0, r, CB, cg, li, g, pfw, mw, lw);
    na_half<false>(kctx, sw0, sw1, qf0, qf1, rpb, 0, 0, 0, 0, li, g, pfc, mc, lc);
    __syncthreads();
    SEC_E(7);
    SEC_B(8);
    na_stage(P, kv, C_NV + h * 64, b, U0, nwin, tid);
    __syncthreads();
    const int trow = 4 * g + (li >> 2), rl = trow & 7;
    LAS unsigned char* twin = kv + (256 + wo * 64 + CB + trow) * 128 + (li & 1) * 8; LAS unsigned char* tctx = kv + trow * 128 + (li & 1) * 8;
    int trs[4];
#pragma unroll
    for (int mt = 0; mt < 4; ++mt) trs[mt] = ((2 * mt + ((li & 3) >> 1)) ^ rl) << 4;
    f32x4 accw[4], acc[4];
#pragma unroll
    for (int mt = 0; mt < 4; ++mt) { accw[mt] = (f32x4){0.f, 0.f, 0.f, 0.f}; acc[mt] = (f32x4){0.f, 0.f, 0.f, 0.f}; }
    if (WIN) {
#pragma unroll
        for (int u = 0; u < 8; ++u)
#pragma unroll
            for (int mt = 0; mt < 4; ++mt) { const LAS unsigned char* tp = twin + trs[mt] + u * 8192;
                const v4i16_t lo = __builtin_amdgcn_ds_read_tr16_b64_v4i16((LAS v4i16_t*)tp), hi = __builtin_amdgcn_ds_read_tr16_b64_v4i16((LAS v4i16_t*)(tp + 2048));
                const bf16x8 af = {lo[0], lo[1], lo[2], lo[3], hi[0], hi[1], hi[2], hi[3]};
                accw[mt] = MFMA16(af, pfw[u], accw[mt]); }
    }
#pragma unroll
    for (int u = 0; u < 8; ++u)
#pragma unroll
        for (int mt = 0; mt < 4; ++mt) { const LAS unsigned char* tp = tctx + trs[mt] + u * 4096;
            const v4i16_t lo = __builtin_amdgcn_ds_read_tr16_b64_v4i16((LAS v4i16_t*)tp), hi = __builtin_amdgcn_ds_read_tr16_b64_v4i16((LAS v4i16_t*)(tp + 2048));
            const bf16x8 af = {lo[0], lo[1], lo[2], lo[3], hi[0], hi[1], hi[2], hi[3]};
            acc[mt] = MFMA16(af, pfc[u], acc[mt]); }
    float lsum = lc;
    if (WIN) { const float mm = fmaxf(mw, mc); const float f0 = fast_exp(mw - mm), f1 = fast_exp(mc - mm);
#pragma unroll
        for (int mt = 0; mt < 4; ++mt) acc[mt] = accw[mt] * f0 + acc[mt] * f1;
        lsum = lw * f0 + lc * f1; }
    const float inv = 1.f / lsum;
    const size_t row = (size_t)(qrow0 + li);
#pragma unroll
    for (int mt = 0; mt < 4; ++mt) {
        const int col = 256 + h * 64 + 16 * mt + 4 * g;
        const u32x2 gt = *(const u32x2*)(P + row * NP + C_GATE + col);
        u32x2 w;
        w.x = cvtpk(acc[mt][0] * inv * fast_silu(lo_bf(gt.x)), acc[mt][1] * inv * fast_silu(hi_bf(gt.x)));
        w.y = cvtpk(acc[mt][2] * inv * fast_silu(lo_bf(gt.y)), acc[mt][3] * inv * fast_silu(hi_bf(gt.y)));
        *(u32x2*)(Y + row * DM + col) = w;
    }
    SEC_E(8);
}

__device__ __forceinline__ void pool_item(const KArgs& a, int l, LAS unsigned char* lds, int cid, int tid, int wave, int lane) {
    const bf16_t* P = (const bf16_t*)(a.ws + OFF_P); bf16_t* Y = (bf16_t*)(a.ws + OFF_H);
    const bf16_t* WPT = (const bf16_t*)(a.ws + OFF_WPT) + (size_t)l * 4 * 64 * 64;
    const float* pscale = a.in.pool_scale + l * 256;
    LAS bf16_t* U = (LAS bf16_t*)lds;
    LAS bf16_t* M = U + 80 * 264;
    const bool lat = cid < 256;
    const int seq_len = lat ? SEQ : NCTX;
    const int seq_base = lat ? (cid >> 6) * SEQ : NLAT + ((cid - 256) >> 2) * NCTX;
    const int t0 = lat ? (cid & 63) * 64 : ((cid - 256) & 3) * 64;
    SEC_B(9);
    for (int i = tid; i < 80 * 32; i += NTHR) { const int tr = i >> 5, c8 = i & 31, tt = t0 - 8 + tr;
        u32x4 v = {0u, 0u, 0u, 0u};
        if (tt >= 0 && tt < seq_len) v = *(const u32x4*)(P + (size_t)(seq_base + tt) * NP + C_PU + c8 * 8);
        *(LAS u32x4*)(U + tr * 264 + c8 * 8) = v; }
    __syncthreads();
    {
        const int col = tid & 255, th = tid >> 8, part = col >> 6, w = 2 << part;
        for (int t = 32 * th; t < 32 * th + 32; ++t) {
            const int tt = t0 + t; const int lo = min(max(tt - w / 2, 0), seq_len), hi = min(max(tt - w / 2 + w, 0), seq_len);
            float s = 0.f;
            for (int ss = lo; ss < hi; ++ss) s += bf2f(U[(ss - t0 + 8) * 264 + col]);
            const float mv = s / (float)(hi - lo) - bf2f(U[(t + 8) * 264 + col]);
            M[t * 264 + col] = (bf16_t)cvtpk(mv, 0.f);
        }
    }
    __syncthreads();
    {
        const int part = wave >> 1, th = wave & 1, li = lane & 15, g = lane >> 4;
        f32x4 acc[4][2];
#pragma unroll
        for (int mt = 0; mt < 4; ++mt) { acc[mt][0] = (f32x4){0.f, 0.f, 0.f, 0.f}; acc[mt][1] = (f32x4){0.f, 0.f, 0.f, 0.f}; }
#pragma unroll
        for (int s = 0; s < 2; ++s) {
            bf16x8 bfr[2];
#pragma unroll
            for (int nt = 0; nt < 2; ++nt) bfr[nt] = *(const LAS bf16x8*)(M + (32 * th + 16 * nt + li) * 264 + part * 64 + 32 * s + 8 * g);
#pragma unroll
            for (int mt = 0; mt < 4; ++mt) {
                const bf16x8 af = *(const bf16x8*)(WPT + ((size_t)(part * 64 + 16 * mt + li)) * 64 + 32 * s + 8 * g);
#pragma unroll
                for (int nt = 0; nt < 2; ++nt) acc[mt][nt] = MFMA16(af, bfr[nt], acc[mt][nt]);
            }
        }
#pragma unroll
        for (int nt = 0; nt < 2; ++nt) {
            const size_t row = (size_t)(seq_base + t0 + 32 * th + 16 * nt + li);
#pragma unroll
            for (int mt = 0; mt < 4; ++mt) {
                const int cl = part * 64 + 16 * mt + 4 * g;
                const f32x4 sc = *(const f32x4*)(pscale + cl);
                const u32x2 gt = *(const u32x2*)(P + row * NP + C_GATE + 768 + cl);
                u32x2 w;
                w.x = cvtpk(acc[mt][nt][0] * sc.x * fast_silu(lo_bf(gt.x)), acc[mt][nt][1] * sc.y * fast_silu(hi_bf(gt.x)));
                w.y = cvtpk(acc[mt][nt][2] * sc.z * fast_silu(lo_bf(gt.y)), acc[mt][nt][3] * sc.w * fast_silu(hi_bf(gt.y)));
                *(u32x2*)(Y + row * DM + 768 + cl) = w;
            }
        }
    }
    __syncthreads();
    SEC_E(9);
}

__device__ __forceinline__ void phC_na_ctx(const KArgs& a, int l, LAS unsigned char* lds, int tid, int wave, int lane) {
    if (l != 0) return;
    for (int u = blockIdx.x; u < 32; u += gridDim.x) na_block<false>(a, lds, u >> 3, (u >> 1) & 3, u & 1, tid, wave, lane);
    __syncthreads();
}
__device__ __forceinline__ void phD_na_pool(const KArgs& a, int l, LAS unsigned char* lds, int tid, int wave, int lane) {
    const int ncid = (l == 1) ? 256 : 272;
    for (int q = 0; q <= kRep[13]; ++q) for (int cid = gridDim.x - 1 - blockIdx.x; cid < ncid; cid += gridDim.x) pool_item(a, l, lds, cid, tid, wave, lane);
    LAS float* rpb = (LAS float*)(lds + NA_RPB_OFF);
    for (int i = tid; i < 4 * 465; i += NTHR) rpb[i] = a.in.na_rpb[l * 4 * 465 + i];
    for (int q = 0; q <= kRep[14]; ++q) for (int u = blockIdx.x; u < 512; u += gridDim.x) { const int ln = fresh_lane(); na_block<true>(a, lds, u >> 7, (u >> 5) & 3, u & 31, wave * 64 + ln, wave, ln); }
    __syncthreads();
}
constexpr int GL_QR = 0, GL_KR = 8192, GL_GFB = 16384, GL_ROPE = 24576, GL_TOT = 28672, GL_QC = 30720, GL_KF = 49152, GL_KB = 59392,
              GL_VT = 69632, GL_KFT = 88064, GL_KBT = 97280, GL_ATT = 106496;

__device__ __forceinline__ float logsigmoid_fast(float z) { return fminf(z, 0.f) - __logf(1.f + __expf(-fabsf(z))); }

template <bool LOCAL>
__device__ __forceinline__ void gla_prep(const KArgs& a, int l, LAS unsigned char* lds, int cid, int hp, int tid) {
    const bf16_t* P = (const bf16_t*)(a.ws + OFF_P);
    const size_t row0 = (size_t)cid * 64;
    const bool lat = cid < 256;
    LAS bf16_t* QR = (LAS bf16_t*)(lds + GL_QR); LAS bf16_t* KR = (LAS bf16_t*)(lds + GL_KR);
    LAS float* GFB = (LAS float*)(lds + GL_GFB); LAS float* ROPE = (LAS float*)(lds + GL_ROPE); LAS float* TOT = (LAS float*)(lds + GL_TOT);
    LAS bf16_t* QC = (LAS bf16_t*)(lds + GL_QC); LAS bf16_t* KF = (LAS bf16_t*)(lds + GL_KF); LAS bf16_t* KB = (LAS bf16_t*)(lds + GL_KB);
    LAS bf16_t* VT = (LAS bf16_t*)(lds + GL_VT); LAS bf16_t* KFT = (LAS bf16_t*)(lds + GL_KFT); LAS bf16_t* KBT = (LAS bf16_t*)(lds + GL_KBT);
    { const int t = tid >> 3, c8 = tid & 7;
      *(LAS u32x4*)(QR + t * 64 + c8 * 8) = *(const u32x4*)(P + (row0 + t) * NP + C_GQ + hp * 64 + c8 * 8);
      *(LAS u32x4*)(KR + t * 64 + c8 * 8) = *(const u32x4*)(P + (row0 + t) * NP + C_GK + hp * 64 + c8 * 8); }
    if (tid < 256) { const int t = tid >> 2, c8 = tid & 3; const u32x4 v = *(const u32x4*)(P + (row0 + t) * NP + C_GF + c8 * 8);
        LAS float* gp = GFB + t * 32 + c8 * 8;
        gp[0] = lo_bf(v.x); gp[1] = hi_bf(v.x); gp[2] = lo_bf(v.y); gp[3] = hi_bf(v.y); gp[4] = lo_bf(v.z); gp[5] = hi_bf(v.z); gp[6] = lo_bf(v.w); gp[7] = hi_bf(v.w); }
    { const float* rt = (const float*)(a.ws + OFF_ROPE); ROPE[tid] = rt[tid]; ROPE[tid + 512] = rt[tid + 512]; }
#pragma unroll
    for (int rep = 0; rep < 2; ++rep) { const int i = tid + rep * NTHR, t = i & 63, c16 = i >> 6;
        const u32x4 v = *(const u32x4*)(P + (row0 + t) * NP + C_GV + hp * 128 + c16 * 8);
        const int h2 = c16 >> 3, e0 = (c16 & 7) * 8; LAS bf16_t* vp = VT + (h2 * 64 + e0) * 72 + t;
        vp[0 * 72] = (bf16_t)(v.x & 0xffff); vp[1 * 72] = (bf16_t)(v.x >> 16); vp[2 * 72] = (bf16_t)(v.y & 0xffff); vp[3 * 72] = (bf16_t)(v.y >> 16);
        vp[4 * 72] = (bf16_t)(v.z & 0xffff); vp[5 * 72] = (bf16_t)(v.z >> 16); vp[6 * 72] = (bf16_t)(v.w & 0xffff); vp[7 * 72] = (bf16_t)(v.w >> 16); }
    __syncthreads();
    const int col = tid & 127, dir = col >> 6, h2 = (col >> 5) & 1, d = col & 31, tq = tid >> 7;
    const int h = 2 * hp + h2;
    float wg[16];
    { const float* wp = a.in.gla_w_gate + ((size_t)(l * 2 + dir) * 16) * 128 + h * 32 + d;
#pragma unroll
      for (int r = 0; r < 16; ++r) wg[r] = wp[r * 128]; }
    const float bg = a.in.gla_b_gate[(l * 2 + dir) * 128 + h * 32 + d];
    float lgv[16], pf[16]; float run = 0.f;
#pragma unroll
    for (int tt = 0; tt < 16; ++tt) { const LAS float* gp = GFB + (16 * tq + tt) * 32 + dir * 16;
        float z = bg;
#pragma unroll
        for (int r = 0; r < 16; ++r) z += gp[r] * wg[r];
        lgv[tt] = logsigmoid_fast(z) * (1.f / 16.f); run += lgv[tt]; pf[tt] = run; }
    TOT[tq * 128 + col] = run;
    __syncthreads();
    float off = 0.f, total = 0.f;
#pragma unroll
    for (int q = 0; q < 4; ++q) { const float v = TOT[q * 128 + col]; total += v; if (dir ? (q > tq) : (q < tq)) off += v; }
    const float qs = 0.17677669529663687f;
    const int i16 = d & 15, j8 = d & 7, dp = (i16 < 8) ? d + 8 : d - 8; const float sg = (i16 < 8) ? -1.f : 1.f;
#pragma unroll
    for (int tl = 0; tl < 16; ++tl) { const int t = 16 * tq + tl; const float cv = (dir ? run - pf[tl] + lgv[tl] : pf[tl]) + off;
        float k = bf2f(KR[t * 64 + h2 * 32 + d]), q = bf2f(QR[t * 64 + h2 * 32 + d]);
        if (lat) { const int tokpos = (cid & 63) * 64 + t; const int pos = (d & 16) ? (tokpos & 63) : (tokpos >> 6);
            const float cs = ROPE[pos * 8 + j8], sn = ROPE[512 + pos * 8 + j8];
            k = k * cs + sg * bf2f(KR[t * 64 + h2 * 32 + dp]) * sn; q = q * cs + sg * bf2f(QR[t * 64 + h2 * 32 + dp]) * sn; }
        if (LOCAL) { (dir ? KBT : KFT)[(h2 * 32 + d) * 72 + t] = (bf16_t)cvtpk(k * __expf(total - cv), 0.f); }
        else { { const unsigned w_ = cvtpk(q * qs * __expf(cv), k * __expf(-cv)); QC[(h2 * 64 + t) * 72 + dir * 32 + d] = (bf16_t)w_; (dir ? KB : KF)[(h2 * 64 + t) * 40 + d] = (bf16_t)(w_ >> 16); } }
    }
    if (LOCAL && tq == 0) { const int b = lat ? cid >> 6 : (cid - 256) >> 2; const int slot = lat ? 4 + (cid & 63) : (cid - 256) & 3;
        float* DEC = (float*)(a.ws + OFF_GDEC); DEC[((size_t)((b * 4 + h) * 2 + dir) * 68 + slot) * 32 + d] = __expf(total); }
    __syncthreads();
}

__device__ __forceinline__ void gla_local_unit(const KArgs& a, int l, LAS unsigned char* lds, int cid, int hp, int tid, int wave, int lane) {
    SEC_B(6);
    gla_prep<true>(a, l, lds, cid, hp, tid);
    if (wave < 4) {
        const int h2 = wave >> 1, dir = wave & 1, h = 2 * hp + h2, lr = lane & 31, hi = lane >> 5;
        const LAS bf16_t* VT = (const LAS bf16_t*)(lds + GL_VT) + h2 * 64 * 72;
        const LAS bf16_t* KT = (const LAS bf16_t*)(lds + (dir ? GL_KBT : GL_KFT)) + h2 * 32 * 72;
        f32x16 acc[2];
#pragma unroll
        for (int mt = 0; mt < 2; ++mt)
#pragma unroll
            for (int r = 0; r < 16; ++r) acc[mt][r] = 0.f;
#pragma unroll
        for (int s = 0; s < 4; ++s) {
            const bf16x8 bfr = *(const LAS bf16x8*)(KT + lr * 72 + 16 * s + 8 * hi);
#pragma unroll
            for (int mt = 0; mt < 2; ++mt) { const bf16x8 afr = *(const LAS bf16x8*)(VT + (32 * mt + lr) * 72 + 16 * s + 8 * hi); acc[mt] = MFMA32(afr, bfr, acc[mt]); }
        }
        const bool lat = cid < 256; const int b = lat ? cid >> 6 : (cid - 256) >> 2; const int slot = lat ? 4 + (cid & 63) : (cid - 256) & 3;
        float* LOC = (float*)(a.ws + OFF_GLOC) + ((size_t)((b * 4 + h) * 2 + dir) * 68 + slot) * 2048;
#pragma unroll
        for (int mt = 0; mt < 2; ++mt)
#pragma unroll
            for (int r = 0; r < 16; ++r) { const int e = 32 * mt + (r & 3) + 8 * (r >> 2) + 4 * hi; LOC[e * 32 + lr] = acc[mt][r]; }
    }
    __syncthreads();
    SEC_E(6);
}

__device__ __forceinline__ void gla_scan_item(const KArgs& a, int item, int tid) {
    const int chain = item >> 2, elem = (item & 3) * 512 + tid, d = elem & 31, dir = chain & 1;
    const float* LOC = (const float*)(a.ws + OFF_GLOC) + (size_t)chain * 68 * 2048 + elem;
    const float* DEC = (const float*)(a.ws + OFF_GDEC) + (size_t)chain * 68 * 32 + d;
    bf16_t* SIN = (bf16_t*)(a.ws + OFF_GSIN) + (size_t)chain * 68 * 2048 + elem;
    float S = 0.f;
    for (int st = 0; st < 68; st += 4) {
        float lv[4], dv[4]; int sl[4];
#pragma unroll
        for (int k = 0; k < 4; ++k) { sl[k] = dir ? 71 - (st + k) : st + k; if (dir && st + k < 4) sl[k] = 3 - (st + k); lv[k] = LOC[(size_t)sl[k] * 2048]; dv[k] = DEC[sl[k] * 32]; }
#pragma unroll
        for (int k = 0; k < 4; ++k) { SIN[(size_t)sl[k] * 2048] = f2bf(S); S = dv[k] * S + lv[k]; }
    }
}

__device__ __forceinline__ void gla_out_unit(const KArgs& a, int l, LAS unsigned char* lds, int cid, int hp, int tid, int wave, int lane) {
    SEC_B(3);
    gla_prep<false>(a, l, lds, cid, hp, tid);
    SEC_E(3);
    SEC_B(4);
    if (wave < 4) {
        const int h2 = wave >> 1, ih = wave & 1, h = 2 * hp + h2, lr = lane & 31, hi = lane >> 5;
        const LAS bf16_t* QC = (const LAS bf16_t*)(lds + GL_QC) + h2 * 64 * 72;
        const LAS bf16_t* KF = (const LAS bf16_t*)(lds + GL_KF) + h2 * 64 * 40;
        const LAS bf16_t* KB = (const LAS bf16_t*)(lds + GL_KB) + h2 * 64 * 40;
        const LAS bf16_t* VT = (const LAS bf16_t*)(lds + GL_VT) + h2 * 64 * 72;
        LAS bf16_t* ATT = (LAS bf16_t*)(lds + GL_ATT) + wave * 32 * 72;
        const int icol = 32 * ih + lr;
#pragma unroll
        for (int jt = 0; jt < 2; ++jt) {
            f32x16 df, db;
#pragma unroll
            for (int r = 0; r < 16; ++r) { df[r] = 0.f; db[r] = 0.f; }
#pragma unroll
            for (int s = 0; s < 2; ++s) {
                const bf16x8 af = *(const LAS bf16x8*)(KF + (32 * jt + lr) * 40 + 16 * s + 8 * hi), ab = *(const LAS bf16x8*)(KB + (32 * jt + lr) * 40 + 16 * s + 8 * hi);
                const bf16x8 bf_ = *(const LAS bf16x8*)(QC + icol * 72 + 16 * s + 8 * hi), bb_ = *(const LAS bf16x8*)(QC + icol * 72 + 32 + 16 * s + 8 * hi);
                df = MFMA32(af, bf_, df); db = MFMA32(ab, bb_, db);
            }
#pragma unroll
            for (int qd = 0; qd < 4; ++qd) { float v[4];
#pragma unroll
                for (int k = 0; k < 4; ++k) { const int j = 32 * jt + 8 * qd + 4 * hi + k; v[k] = (j <= icol ? df[4 * qd + k] : 0.f) + (j >= icol ? db[4 * qd + k] : 0.f); }
                u32x2 w; w.x = cvtpk(v[0], v[1]); w.y = cvtpk(v[2], v[3]);
                *(LAS u32x2*)(ATT + lr * 72 + 32 * jt + 8 * qd + 4 * hi) = w; }
        }
        LDS_FENCE();
        const bool lat = cid < 256; const int b = lat ? cid >> 6 : (cid - 256) >> 2; const int slot = lat ? 4 + (cid & 63) : (cid - 256) & 3;
        const bf16_t* SF = (const bf16_t*)(a.ws + OFF_GSIN) + ((size_t)((b * 4 + h) * 2 + 0) * 68 + slot) * 2048;
        const bf16_t* SB = SF + (size_t)68 * 2048;
        f32x16 acc[2];
#pragma unroll
        for (int mt = 0; mt < 2; ++mt)
#pragma unroll
            for (int r = 0; r < 16; ++r) acc[mt][r] = 0.f;
#pragma unroll
        for (int s = 0; s < 4; ++s) {
            const bf16x8 b1 = *(const LAS bf16x8*)(ATT + lr * 72 + 16 * s + 8 * hi);
            const bf16x8 b2 = *(const LAS bf16x8*)(QC + icol * 72 + 16 * s + 8 * hi);
#pragma unroll
            for (int mt = 0; mt < 2; ++mt) {
                const bf16x8 a1 = *(const LAS bf16x8*)(VT + (32 * mt + lr) * 72 + 16 * s + 8 * hi);
                const bf16_t* sp = (s < 2 ? SF : SB) + (32 * mt + lr) * 32 + 16 * (s & 1) + 8 * hi;
                const bf16x8 a2 = *(const bf16x8*)sp;
                acc[mt] = MFMA32(a1, b1, acc[mt]); acc[mt] = MFMA32(a2, b2, acc[mt]);
            }
        }
        float ss = 0.f;
#pragma unroll
        for (int mt = 0; mt < 2; ++mt)
#pragma unroll
            for (int r = 0; r < 16; ++r) ss += acc[mt][r] * acc[mt][r];
        ss += __shfl_xor(ss, 32);
        const float rstd = rsqrtf(ss * (1.f / 64.f) + EPS);
        const bf16_t* P = (const bf16_t*)(a.ws + OFF_P); bf16_t* Y = (bf16_t*)(a.ws + OFF_H);
        const float* gn = a.in.gla_g_norm + l * 64;
        const size_t row = (size_t)cid * 64 + icol;
#pragma unroll
        for (int mt = 0; mt < 2; ++mt)
#pragma unroll
            for (int qd = 0; qd < 4; ++qd) { const int e0 = 32 * mt + 8 * qd + 4 * hi;
                const f32x4 g4 = *(const f32x4*)(gn + e0);
                const u32x2 gt = *(const u32x2*)(P + row * NP + C_GATE + h * 64 + e0);
                u32x2 w;
                w.x = cvtpk(acc[mt][4 * qd + 0] * rstd * g4.x * fast_silu(lo_bf(gt.x)), acc[mt][4 * qd + 1] * rstd * g4.y * fast_silu(hi_bf(gt.x)));
                w.y = cvtpk(acc[mt][4 * qd + 2] * rstd * g4.z * fast_silu(lo_bf(gt.y)), acc[mt][4 * qd + 3] * rstd * g4.w * fast_silu(hi_bf(gt.y)));
                *(u32x2*)(Y + row * DM + h * 64 + e0) = w; }
    }
    __syncthreads();
    SEC_E(4);
}

__device__ __forceinline__ void phC_gla(const KArgs& a, int l, LAS unsigned char* lds, int tid, int wave, int lane) {
    for (int u = blockIdx.x; u < 544; u += gridDim.x) gla_local_unit(a, l, lds, u >> 1, u & 1, tid, wave, lane);
}
__device__ __forceinline__ void phD_gla(const KArgs& a, int tid) {
    for (int it = blockIdx.x; it < 128; it += gridDim.x) gla_scan_item(a, it, tid);
}
__device__ __forceinline__ void phE_gla(const KArgs& a, int l, LAS unsigned char* lds, int tid, int wave, int lane) {
    const int nu = (l == 1) ? 512 : 544;
    for (int u = blockIdx.x; u < nu; u += gridDim.x) gla_out_unit(a, l, lds, u >> 1, u & 1, tid, wave, lane);
}
constexpr int S5_WAVE_BYTES = 12544;
constexpr int S5_GT = 8 * S5_WAVE_BYTES;

__device__ __forceinline__ float gelu_tanh_fast(float v) { const float u = 0.7978845608028654f * (v + 0.044715f * v * v * v); return v * __builtin_amdgcn_rcpf(1.f + fast_exp(-2.f * u)); }

template <int DIR, bool READOUT>
__device__ __forceinline__ void s5_dir(const KArgs& a, int l, LAS unsigned char* wl, size_t row0, int g, int lane, float& xr, float& xi, f32x4 (&D2)[4]) {
    const bf16_t* P = (const bf16_t*)(a.ws + OFF_P);
    const int dgl = (l * 2 + DIR) * 16 + g;
    const bf16_t* BBT = (const bf16_t*)(a.ws + OFF_BBT) + (size_t)dgl * 128 * 16;
    const bf16_t* CMT = (const bf16_t*)(a.ws + OFF_CMT) + (size_t)dgl * 16 * 128;
    const f32x4 lb = *(const f32x4*)((const float*)(a.ws + OFF_SLB) + ((size_t)dgl * 64 + lane) * 4);
    const float lbr = lb.x, lbi = lb.y;
    LAS float* SCAN = (LAS float*)wl; LAS bf16_t* XB = (LAS bf16_t*)(wl + 8192);
    const int li = lane & 15, g4 = lane >> 4;
    const bf16x8 zero8 = {0, 0, 0, 0, 0, 0, 0, 0};
    bf16x8 bfr[8];
#pragma unroll
    for (int nt = 0; nt < 8; ++nt) bfr[nt] = (g4 < 2) ? *(const bf16x8*)(BBT + (16 * nt + li) * 16 + 8 * g4) : zero8;
    bf16x8 afr[4], cbf[4];
#pragma unroll
    for (int sb = 0; sb < 4; ++sb) afr[sb] = (g4 < 2) ? *(const bf16x8*)(P + (row0 + 16 * sb + li) * NP + C_SU + 16 * g + 8 * g4) : zero8;
    if (READOUT) {
#pragma unroll
        for (int s = 0; s < 4; ++s) cbf[s] = *(const bf16x8*)(CMT + li * 128 + 32 * s + 8 * g4);
    }
#pragma unroll
    for (int step = 0; step < 4; ++step) {
        const int sb = DIR ? 3 - step : step;
#pragma unroll
        for (int nt = 0; nt < 8; ++nt) { f32x4 d = {0.f, 0.f, 0.f, 0.f}; d = MFMA16(afr[sb], bfr[nt], d);
#pragma unroll
            for (int r = 0; r < 4; ++r) SCAN[(4 * g4 + r) * 128 + 16 * nt + li] = d[r]; }
        LDS_FENCE();
#pragma unroll
        for (int hh = 0; hh < 2; ++hh) {
            const int tb = (DIR ? 1 - hh : hh) * 8;
            float br[8], bi[8];
#pragma unroll
            for (int t = 0; t < 8; ++t) { const f32x2_t v2 = *(const LAS f32x2_t*)(SCAN + (tb + t) * 128 + 2 * lane); br[t] = v2.x; bi[t] = v2.y; }
#pragma unroll
            for (int tt = 0; tt < 8; ++tt) { const int t = DIR ? 7 - tt : tt;
                const float nxr = lbr * xr - lbi * xi + br[t], nxi = lbr * xi + lbi * xr + bi[t]; xr = nxr; xi = nxi;
                if (READOUT) { br[t] = xr; bi[t] = xi; } }
            if (READOUT) {
#pragma unroll
                for (int t = 0; t < 8; ++t) *(LAS unsigned*)(XB + (tb + t) * 136 + 2 * lane) = cvtpk(br[t], bi[t]);
            }
        }
        LDS_FENCE();
        if (READOUT) {
#pragma unroll
            for (int s = 0; s < 4; ++s) { const bf16x8 xa = *(const LAS bf16x8*)(XB + li * 136 + 32 * s + 8 * g4);
                D2[sb] = MFMA16(xa, cbf[s], D2[sb]); }
            LDS_FENCE();
        }
    }
}

__device__ __forceinline__ void s5_local_unit(const KArgs& a, int l, LAS unsigned char* lds, int cid, int wave, int lane) {
    const int tid = wave * 64 + lane; SEC_B(5);
    const bool lat = cid < 256; const int b = lat ? cid >> 6 : (cid - 256) >> 2; const int slot = lat ? 4 + (cid & 63) : (cid - 256) & 3;
    LAS unsigned char* wl = lds + wave * S5_WAVE_BYTES;
    float* SXL = (float*)(a.ws + OFF_SXL);
    f32x4 dummy[4];
#pragma unroll
    for (int gi = 0; gi < 2; ++gi) { const int g = 2 * wave + gi;
        { float xr = 0.f, xi = 0.f; s5_dir<0, false>(a, l, wl, (size_t)cid * 64, g, lane, xr, xi, dummy);
          float* o = SXL + ((size_t)((b * 16 + g) * 2 + 0) * 68 + slot) * 128; o[lane] = xr; o[64 + lane] = xi; }
        { float xr = 0.f, xi = 0.f; s5_dir<1, false>(a, l, wl, (size_t)cid * 64, g, lane, xr, xi, dummy);
          float* o = SXL + ((size_t)((b * 16 + g) * 2 + 1) * 68 + slot) * 128; o[lane] = xr; o[64 + lane] = xi; }
    }
    SEC_E(5);
}

__device__ __forceinline__ void s5_scan_item(const KArgs& a, int l, int item, int tid) {
    const int chain = item * 8 + (tid >> 6), p = tid & 63, dir = chain & 1, g = (chain >> 1) & 15;
    const int dgl = (l * 2 + dir) * 16 + g;
    const f32x4 lb = *(const f32x4*)((const float*)(a.ws + OFF_SLB) + ((size_t)dgl * 64 + p) * 4);
    const float* SXL = (const float*)(a.ws + OFF_SXL) + (size_t)chain * 68 * 128 + p;
    float* SX0 = (float*)(a.ws + OFF_SX0) + (size_t)chain * 68 * 128 + p;
    float xr = 0.f, xi = 0.f;
    for (int st = 0; st < 68; st += 4) {
        float vr[4], vi[4]; int sl[4];
#pragma unroll
        for (int k = 0; k < 4; ++k) { sl[k] = dir ? 71 - (st + k) : st + k; if (dir && st + k < 4) sl[k] = 3 - (st + k); vr[k] = SXL[sl[k] * 128]; vi[k] = SXL[sl[k] * 128 + 64]; }
#pragma unroll
        for (int k = 0; k < 4; ++k) { SX0[sl[k] * 128] = xr; SX0[sl[k] * 128 + 64] = xi;
            const float nr = lb.z * xr - lb.w * xi + vr[k], ni = lb.z * xi + lb.w * xr + vi[k]; xr = nr; xi = ni; }
    }
}

__device__ __forceinline__ void s5_out_unit(const KArgs& a, int l, LAS unsigned char* lds, int cid, int tid, int wave, int lane) {
    const bf16_t* P = (const bf16_t*)(a.ws + OFF_P); bf16_t* Y = (bf16_t*)(a.ws + OFF_H);
    const bool lat = cid < 256; const int b = lat ? cid >> 6 : (cid - 256) >> 2; const int slot = lat ? 4 + (cid & 63) : (cid - 256) & 3;
    const size_t row0 = (size_t)cid * 64;
    LAS unsigned char* wl = lds + wave * S5_WAVE_BYTES;
    LAS bf16_t* GT = (LAS bf16_t*)(lds + S5_GT);
    const float* SX0 = (const float*)(a.ws + OFF_SX0);
    const float* dsk = a.in.s5_d + l * 256;
    const int li = lane & 15, g4 = lane >> 4;
    SEC_B(1);
#pragma unroll 1
    for (int gi = 0; gi < 2; ++gi) { const int g = 2 * wave + gi;
        f32x4 D2[4];
#pragma unroll
        for (int k = 0; k < 4; ++k) D2[k] = (f32x4){0.f, 0.f, 0.f, 0.f};
        { const float* x0 = SX0 + ((size_t)((b * 16 + g) * 2 + 0) * 68 + slot) * 128; float xr = x0[lane], xi = x0[64 + lane];
          s5_dir<0, true>(a, l, wl, row0, g, lane, xr, xi, D2); }
        { const float* x0 = SX0 + ((size_t)((b * 16 + g) * 2 + 1) * 68 + slot) * 128; float xr = x0[lane], xi = x0[64 + lane];
          s5_dir<1, true>(a, l, wl, row0, g, lane, xr, xi, D2); }
        const float dk = dsk[16 * g + li];
        const unsigned uoff = (unsigned)(4 * g4) * NP + li;
#pragma unroll
        for (int sb = 0; sb < 4; ++sb)
#pragma unroll
            for (int r = 0; r < 4; ++r) { const int t = 16 * sb + 4 * g4 + r;
                const bf16_t* urow = P + (row0 + 16 * sb + r) * NP + C_SU + 16 * g;
                const float u = bf2f(urow[uoff]);
                GT[t * 264 + 16 * g + li] = (bf16_t)cvtpk(gelu_tanh_fast(D2[sb][r] + u * dk), 0.f); }
    }
    __syncthreads();
    SEC_E(1);
    SEC_B(2);
    {
        const bf16_t* WGT = (const bf16_t*)(a.ws + OFF_WGT) + (size_t)l * 65536;
        f32x4 acc[2][4];
#pragma unroll
        for (int mi = 0; mi < 2; ++mi)
#pragma unroll
            for (int nt = 0; nt < 4; ++nt) acc[mi][nt] = (f32x4){0.f, 0.f, 0.f, 0.f};
#pragma unroll
        for (int s = 0; s < 8; ++s) {
            bf16x8 af[2], bfr[4];
#pragma unroll
            for (int mi = 0; mi < 2; ++mi) af[mi] = *(const bf16x8*)(WGT + (size_t)(16 * (2 * wave + mi) + li) * 256 + 32 * s + 8 * g4);
#pragma unroll
            for (int nt = 0; nt < 4; ++nt) bfr[nt] = *(const LAS bf16x8*)(GT + (16 * nt + li) * 264 + 32 * s + 8 * g4);
#pragma unroll
            for (int mi = 0; mi < 2; ++mi)
#pragma unroll
                for (int nt = 0; nt < 4; ++nt) acc[mi][nt] = MFMA16(af[mi], bfr[nt], acc[mi][nt]);
        }
        const float* bgl = a.in.s5_b_glu + l * 256;
#pragma unroll
        for (int mi = 0; mi < 2; ++mi) { const int m0 = 16 * (2 * wave + mi) + 4 * g4; const f32x4 bv = *(const f32x4*)(bgl + m0);
#pragma unroll
            for (int nt = 0; nt < 4; ++nt) { const int t = 16 * nt + li; const size_t row = row0 + t;
                const u32x2 gv = *(const LAS u32x2*)(GT + t * 264 + m0);
                const u32x2 gt = *(const u32x2*)(P + row * NP + C_GATE + 512 + m0);
                const float o0 = lo_bf(gv.x) * __builtin_amdgcn_rcpf(1.f + fast_exp(-(acc[mi][nt][0] + bv.x))) * fast_silu(lo_bf(gt.x));
                const float o1 = hi_bf(gv.x) * __builtin_amdgcn_rcpf(1.f + fast_exp(-(acc[mi][nt][1] + bv.y))) * fast_silu(hi_bf(gt.x));
                const float o2 = lo_bf(gv.y) * __builtin_amdgcn_rcpf(1.f + fast_exp(-(acc[mi][nt][2] + bv.z))) * fast_silu(lo_bf(gt.y));
                const float o3 = hi_bf(gv.y) * __builtin_amdgcn_rcpf(1.f + fast_exp(-(acc[mi][nt][3] + bv.w))) * fast_silu(hi_bf(gt.y));
                u32x2 w; w.x = cvtpk(o0, o1); w.y = cvtpk(o2, o3);
                *(u32x2*)(Y + row * DM + 512 + m0) = w; }
        }
    }
    __syncthreads();
    SEC_E(2);
}

__device__ __forceinline__ void phC_s5(const KArgs& a, int l, LAS unsigned char* lds, int wave, int lane) {
    for (int cid = blockIdx.x; cid < 272; cid += gridDim.x) s5_local_unit(a, l, lds, cid, wave, lane);
    __syncthreads();
}
__device__ __forceinline__ void phD_s5(const KArgs& a, int l, int tid) {
    const int vb = gridDim.x - 1 - blockIdx.x;
    for (int it = vb; it < 16; it += gridDim.x) s5_scan_item(a, l, it, tid);
}
__device__ __forceinline__ void phE_s5(const KArgs& a, int l, LAS unsigned char* lds, int tid, int wave, int lane) {
    const int nc = (l == 1) ? 256 : 272;
    for (int cid = blockIdx.x; cid < nc; cid += gridDim.x) s5_out_unit(a, l, lds, cid, tid, wave, lane);
}

__device__ __forceinline__ void pro_s5_tables(const KArgs& a, int tid) {
    const Inputs& in = a.in;
    const int gt = blockIdx.x * NTHR + tid, NGT = gridDim.x * NTHR;
    bf16_t* BBT = (bf16_t*)(a.ws + OFF_BBT); bf16_t* CMT = (bf16_t*)(a.ws + OFF_CMT); float* SLB = (float*)(a.ws + OFF_SLB); bf16_t* WGT = (bf16_t*)(a.ws + OFF_WGT);
    if (gt < 2 * 2 * 16 * 64) {
        const int p = gt & 63, dgl = gt >> 6;
        const float dt = expf(in.s5_log_dt[dgl]);
        const float lre = in.s5_lam_re[dgl * 64 + p], lim = in.s5_lam_im[dgl * 64 + p];
        const float mag = expf(lre * dt), ang = lim * dt;
        const float lbr = mag * cosf(ang), lbi = mag * sinf(ang);
        const float nr = lbr - 1.f, ni = lbi, den = lre * lre + lim * lim;
        const float cr = (nr * lre + ni * lim) / den, ci = (ni * lre - nr * lim) / den;
        for (int h = 0; h < 16; ++h) { const float br = in.s5_b_re[((size_t)dgl * 64 + p) * 16 + h], bi = in.s5_b_im[((size_t)dgl * 64 + p) * 16 + h];
            BBT[((size_t)dgl * 128 + 2 * p) * 16 + h] = f2bf(cr * br - ci * bi); BBT[((size_t)dgl * 128 + 2 * p + 1) * 16 + h] = f2bf(cr * bi + ci * br); }
        float pr = lbr, pi = lbi;
        for (int k = 0; k < 6; ++k) { const float tr = pr * pr - pi * pi, ti = 2.f * pr * pi; pr = tr; pi = ti; }
        *(f32x4*)(SLB + ((size_t)dgl * 64 + p) * 4) = (f32x4){lbr, lbi, pr, pi};
    }
    for (int i = gt; i < 2 * 2 * 16 * 16 * 128; i += NGT) { const int pri = i & 127, h = (i >> 7) & 15, dgl = i >> 11;
        const float v = (pri & 1) ? -in.s5_c_im[((size_t)dgl * 16 + h) * 64 + (pri >> 1)] : in.s5_c_re[((size_t)dgl * 16 + h) * 64 + (pri >> 1)];
        CMT[i] = f2bf(v); }
    for (int i = gt; i < 2 * 65536; i += NGT) { const int n = i & 255, m = (i >> 8) & 255, li = i >> 16; WGT[i] = f2bf(in.s5_w_glu[(size_t)li * 65536 + n * 256 + m]); }
}
#define WQ_LOOP(ctr_, nitems_, ...) do { unsigned nxt_ = 0u; if (tid == 0) nxt_ = atomicAdd((ctr_), 1u); \
    for (;;) { __syncthreads(); if (tid == 0) wq[0] = nxt_; __syncthreads(); const int item = (int)wq[0]; if (item >= (nitems_)) break; \
        if (tid == 0) nxt_ = atomicAdd((ctr_), 1u); __VA_ARGS__ } __syncthreads(); } while (0)
#define WQ_CTR(l, idx) ((unsigned*)(a.ws + OFF_CTL) + 32 + 16 * ((l) * 16 + (idx)))

__device__ __forceinline__ void phC_dyn(const KArgs& a, int l, LAS unsigned char* lds, volatile LAS unsigned* wq, int tid, int wave, int lane) {
    WQ_LOOP(WQ_CTR(l, 0), 272, { s5_local_unit(a, l, lds, item, wave, lane); });
    if (l == 0) WQ_LOOP(WQ_CTR(l, 1), 32, { na_block<false>(a, lds, item >> 3, (item >> 1) & 3, item & 1, tid, wave, lane); });
    WQ_LOOP(WQ_CTR(l, 2), 544, { gla_local_unit(a, l, lds, item >> 1, item & 1, tid, wave, lane); });
}
__device__ __forceinline__ void phD_dyn(const KArgs& a, int l, LAS unsigned char* lds, volatile LAS unsigned* wq, int tid, int wave, int lane) {
    LAS float* rpb = (LAS float*)(lds + NA_RPB_OFF);
    for (int i = tid; i < 4 * 465; i += NTHR) rpb[i] = a.in.na_rpb[l * 4 * 465 + i];
    WQ_LOOP(WQ_CTR(l, 3), 512, { const int ln = fresh_lane(); na_block<true>(a, lds, item >> 7, (item >> 5) & 3, item & 31, wave * 64 + ln, wave, ln); });
    WQ_LOOP(WQ_CTR(l, 4), (l == 1) ? 256 : 272, { pool_item(a, l, lds, item, tid, wave, lane); });
    WQ_LOOP(WQ_CTR(l, 5), 128, { gla_scan_item(a, item, tid); });
    WQ_LOOP(WQ_CTR(l, 6), 16, { s5_scan_item(a, l, item, tid); });
}
__device__ __forceinline__ void phE_dyn(const KArgs& a, int l, LAS unsigned char* lds, volatile LAS unsigned* wq, int tid, int wave, int lane) {
    WQ_LOOP(WQ_CTR(l, 7), (l == 1) ? 256 : 272, { s5_out_unit(a, l, lds, item, tid, wave, lane); });
    WQ_LOOP(WQ_CTR(l, 8), (l == 1) ? 512 : 544, { gla_out_unit(a, l, lds, item >> 1, item & 1, tid, wave, lane); });
}
__global__ void __launch_bounds__(NTHR, 2) mega(KArgs a_by_value) {
    unsigned long long kp_ = (unsigned long long)__builtin_amdgcn_kernarg_segment_ptr();
    asm volatile("" : "+s"(kp_));
    const KArgs& a = *(const KArgs*)(const GAS KArgs*)kp_;
    extern __shared__ __attribute__((aligned(16))) unsigned char lds_raw[];
    LAS unsigned char* lds = (LAS unsigned char*)lds_raw;
    const int wave = __builtin_amdgcn_readfirstlane((int)threadIdx.x >> 6);
#define MY_LANE() fresh_lane()
#define T0() (wave == 0 && MY_LANE() == 0)
    const int tid = wave * 64 + MY_LANE();
    volatile LAS unsigned* MISC = (volatile LAS unsigned*)(lds + MISC_OFF);
    for (int u = tid; u < (LDS_BYTES - RING_BYTES) / 4; u += NTHR) ((LAS unsigned*)(lds + RING_BYTES))[u] = 0u;
    __syncthreads();
    unsigned* ctl = (unsigned*)(a.ws + OFF_CTL);
    XcdBarrier bar = xcd_barrier_post(ctl + CW_BAR + a.li * XCD_BAR_WORDS, MISC + 8, T0());
    const int lo = a.ph_lo, hi = a.ph_hi;
    cooperative_groups::this_grid().sync();
#define IN(k) (lo <= (k) && (k) < hi)
#define REP(i, ...) do { _Pragma("unroll") for (int rr = 0; rr <= kRep[i]; ++rr) { __VA_ARGS__; if (rr < kRep[i]) xcd_barrier(bar, T0()); } } while (0)
#define PHV const int lane_ = MY_LANE(); const int tid_ = wave * 64 + lane_
#ifdef PROBE_TSEL
    unsigned long long tp_prev = __builtin_amdgcn_s_memrealtime(), tp_acc = 0ull;
#define TSTAMP(k) do { const unsigned long long tn_ = __builtin_amdgcn_s_memrealtime(); if ((PROBE_TSEL >> (k)) & 1) tp_acc += tn_ - tp_prev; tp_prev = tn_; } while (0)
#else
#define TSTAMP(k) do { } while (0)
#endif
#define SEAM(k) do { if (IN(k) && IN((k) + 1)) { xcd_barrier(bar, T0()); } TSTAMP(k); } while (0)
    if (IN(PH_PRO)) { PHV; REP(0, { ph_prologue(a, lds, tid_, wave, lane_); pro_s5_tables(a, tid_); }); for (int rr = 0; rr < kRep[7]; ++rr) xcd_barrier(bar, T0()); }
    SEAM(PH_PRO);
#define LAYER(l) do { \
        constexpr int pb = PH_L0 + (l) * PH_PER_LAYER; \
        constexpr int nrows_out = ((l) == 1) ? NLAT : MTOT; \
        if (IN(pb + 0)) { PHV; REP(1, ph_post_pre(a, (l) - 1, (l), wave, lane_)); } \
        SEAM(pb + 0); \
        if (IN(pb + 1)) { PHV; REP(2, { \
            pg8::Gemm g{(const bf16_t*)(a.ws + OFF_H), (const bf16_t*)(a.ws + OFF_WIN) + (size_t)(l) * NP * DM, MTOT, NP, DM}; \
            pg8::StaticOrder S; S.init(MTOT, NP, gridDim.x, blockIdx.x); \
            pg8::EpiBf16<0> E{(bf16_t*)(a.ws + OFF_P), NP, nullptr, 0, 0, 1.f}; \
            pg8::gemm_phase<pg8::EpiBf16<0>, pg8::StaticOrder, true, true>(lds, g, S, E, wave); }); \
        } \
        SEAM(pb + 1); \
        if (IN(pb + 2)) { PHV; REP(3, phC_dyn(a, (l), lds, MISC + 16, tid_, wave, lane_)); } \
        SEAM(pb + 2); \
        if (IN(pb + 3)) { PHV; REP(4, phD_dyn(a, (l), lds, MISC + 16, tid_, wave, lane_)); } \
        SEAM(pb + 3); \
        if (IN(pb + 4)) { PHV; REP(5, phE_dyn(a, (l), lds, MISC + 16, tid_, wave, lane_)); } \
        SEAM(pb + 4); \
        if (IN(pb + 5)) { PHV; REP(6, { \
            pg8::Gemm g{(const bf16_t*)(a.ws + OFF_H), (const bf16_t*)(a.ws + OFF_WOUT) + (size_t)(l) * DM * DM, nrows_out, DM, DM}; \
            pg8::StaticOrder S; S.init(nrows_out, DM, gridDim.x, blockIdx.x); \
            pg8::EpiBf16<0> E{(bf16_t*)(a.ws + OFF_P), DM, nullptr, 0, 0, 1.f}; \
            pg8::gemm_phase<pg8::EpiBf16<0>, pg8::StaticOrder, true, true>(lds, g, S, E, wave); }); \
        } \
        SEAM(pb + 5); \
    } while (0)
    LAYER(0);
    LAYER(1);
#undef LAYER
    if (IN(PH_FIN)) { PHV; ph_post_pre(a, 1, 2, wave, lane_); }
#ifdef PROBE_SEC
    if (blockIdx.x == 0 && wave == 0) { const unsigned long long acc_ = ((volatile LAS unsigned*)(lds + MISC_OFF + 96))[0]; const unsigned long long t0_ = __builtin_amdgcn_s_memrealtime(); while (__builtin_amdgcn_s_memrealtime() - t0_ < 4ull * acc_) __builtin_amdgcn_s_sleep(8); }
#endif
#ifdef PROBE_TSEL
    TSTAMP(PH_FIN);
    if (blockIdx.x == 0 && wave == 0) { const unsigned long long t0_ = __builtin_amdgcn_s_memrealtime(); while (__builtin_amdgcn_s_memrealtime() - t0_ < 4ull * tp_acc) __builtin_amdgcn_s_sleep(8); }
#endif
#undef IN
#undef SEAM
}

static int g_grid = 0;
static void launch_mega(const KArgs& base, int lo, int hi, int li, hipStream_t stream) {
    KArgs a = base; a.ph_lo = lo; a.ph_hi = hi; a.li = li;
    void* args[] = {(void*)&a};
    hipError_t e = hipLaunchCooperativeKernel((const void*)mega, dim3(g_grid), dim3(NTHR), args, LDS_BYTES, stream);
    if (e != hipSuccess) fprintf(stderr, "cooperative launch failed: %s (grid %d)\n", hipGetErrorString(e), g_grid);
}

extern "C" void kernel_launch(void* const* d_in, const int* in_sizes, int n_in, void* d_out, int out_size, void* d_ws, size_t ws_size, hipStream_t stream) {
    if (g_grid == 0) {
        int dev = 0, cus = 0, per_cu = 0;
        hipGetDevice(&dev);
        hipDeviceGetAttribute(&cus, hipDeviceAttributeMultiprocessorCount, dev);
        hipFuncSetAttribute((const void*)mega, hipFuncAttributeMaxDynamicSharedMemorySize, LDS_BYTES);
        hipOccupancyMaxActiveBlocksPerMultiprocessor(&per_cu, (const void*)mega, NTHR, LDS_BYTES);
        if (per_cu < 1) per_cu = 1;
        g_grid = cus * per_cu;
        if (g_grid != 256) fprintf(stderr, "note: grid %d (cus %d x %d)\n", g_grid, cus, per_cu);
    }
    KArgs base;
    memset(&base, 0, sizeof(base));
    const float** ip = (const float**)&base.in;
    for (int i = 0; i < 26; ++i) ip[i] = (const float*)d_in[i];
    base.out = (float*)d_out; base.ws = (unsigned char*)d_ws; base.mask = 7;
    hipMemsetAsync((char*)d_ws + OFF_CTL, 0, CTL_BYTES, stream);
    launch_mega(base, PH_PRO, PH_END, 0, stream);
}
```

```cpp
#include <hip/hip_runtime.h>
#include <hip/hip_cooperative_groups.h>
#include <stdint.h>
#include <math.h>
#include <cstdio>
#include <cstring>

typedef unsigned short bf16_t;
__device__ __forceinline__ float bf2f(bf16_t v) { return __uint_as_float(((unsigned)v) << 16); }
__device__ __forceinline__ bf16_t f2bf(float f) { unsigned u = __float_as_uint(f); return (bf16_t)((u + 0x7fffu + ((u >> 16) & 1u)) >> 16); }

constexpr int DM = 1024, NB = 4, SEQ = 4096, NCTX = 256, GW = 64;
constexpr int NLAT = NB * SEQ;
constexpr int NCT = NB * NCTX;
constexpr int MTOT = NLAT + NCT;
constexpr int NIN = 2848, NP = 3072;
constexpr int C_GK = 0, C_GV = 128, C_GF = 384, C_GB = 400, C_NK = 416, C_NV = 672, C_SU = 928, C_GQ = 1184, C_NQ = 1312, C_PU = 1568, C_GATE = 1824;
constexpr float EPS = 1e-6f;

constexpr size_t OFF_CTL = 0, CTL_BYTES = 256 * 1024;
constexpr size_t OFF_WIN = OFF_CTL + CTL_BYTES;
constexpr size_t OFF_WOUT = OFF_WIN + (size_t)2 * NP * DM * 2;
constexpr size_t OFF_MOD = OFF_WOUT + (size_t)2 * DM * DM * 2;
constexpr size_t OFF_H = OFF_MOD + (size_t)2 * 5 * 3072 * 4 + 1024;
constexpr size_t OFF_P = OFF_H + (size_t)MTOT * DM * 2;
constexpr size_t OFF_XC = OFF_P + (size_t)MTOT * NP * 2;
constexpr size_t OFF_VTL = OFF_XC + (size_t)NCT * DM * 4;
constexpr size_t OFF_VTC = OFF_VTL + (size_t)1024 * SEQ * 2;
constexpr size_t OFF_WPT = OFF_VTC + (size_t)1024 * NCTX * 2;
constexpr size_t OFF_ROPE = OFF_WPT + (size_t)2 * 4 * 64 * 64 * 2;
constexpr size_t OFF_GLOC = OFF_ROPE + 4096;
constexpr size_t OFF_GDEC = OFF_GLOC + (size_t)32 * 68 * 2048 * 4;
constexpr size_t OFF_GSIN = OFF_GDEC + (size_t)32 * 68 * 32 * 4;
constexpr size_t OFF_BBT = OFF_GSIN + (size_t)32 * 68 * 2048 * 2;
constexpr size_t OFF_CMT = OFF_BBT + (size_t)64 * 128 * 16 * 2;
constexpr size_t OFF_SLB = OFF_CMT + (size_t)64 * 16 * 128 * 2;
constexpr size_t OFF_WGT = OFF_SLB + (size_t)64 * 64 * 16;
constexpr size_t OFF_SXL = OFF_WGT + (size_t)2 * 65536 * 2;
constexpr size_t OFF_SX0 = OFF_SXL + (size_t)128 * 68 * 128 * 4;
constexpr size_t OFF_END = OFF_SX0 + (size_t)128 * 68 * 128 * 4;
static_assert(OFF_END <= (size_t)256 * 1024 * 1024, "ws");

struct Inputs {
    const float *x, *c, *ctx, *c_ctx, *w_mod, *b_mod, *g_pre, *g_post, *w_in, *w_out, *gla_w_gate, *gla_b_gate, *gla_g_norm, *na_rpb,
        *s5_lam_re, *s5_lam_im, *s5_log_dt, *s5_b_re, *s5_b_im, *s5_c_re, *s5_c_im, *s5_d, *s5_w_glu, *s5_b_glu, *pool_w, *pool_scale;
};

__device__ __forceinline__ float silu_f(float v) { return v / (1.f + expf(-v)); }
__device__ __forceinline__ float sigmoid_f(float v) { return 1.f / (1.f + expf(-v)); }
__device__ __forceinline__ float gelu_tanh_f(float v) { const float k = 0.7978845608028654f; return 0.5f * v * (1.f + tanhf(k * (v + 0.044715f * v * v * v))); }
__device__ __forceinline__ float logsigmoid_f(float z) { return fminf(z, 0.f) - log1pf(expf(-fabsf(z))); }

#define LAS __attribute__((address_space(3)))
__device__ __forceinline__ int fresh_lane();
namespace pg8 {
#define PG8_LAS __attribute__((address_space(3)))
typedef unsigned short bf16_t;
typedef short bf16x8 __attribute__((ext_vector_type(8)));
typedef float f32x4 __attribute__((ext_vector_type(4)));
typedef unsigned u32x4 __attribute__((ext_vector_type(4)));
constexpr int BM = 256, BK = 64, HALF = 128, HTB = HALF * BK * 2  , STAGE_BYTES = 8 * HTB, NXCD = 8, WGM = 8;

__host__ __device__ __forceinline__ int lds_byte(int r, int c) { const int st = (r >> 4) * 2 + (c >> 5), rr = r & 15, cc = c & 31, ob = rr * 64 + cc * 2; return st * 1024 + (ob ^ (((ob >> 9) & 1) << 5)); }
__host__ __device__ __forceinline__ void stage_rc(int b, int& R, int& C) { const int st = b / 1024, sb = b % 1024, swz = sb ^ (((sb >> 9) & 1) << 5); R = (st >> 1) * 16 + swz / 64; C = (st & 1) * 32 + (swz % 64) / 2; }
__host__ __device__ __forceinline__ int perm32(int rho) { const int n = rho >> 4, i = rho & 15; return 8 * (i >> 2) + 4 * n + (i & 3); }

struct Unit { int pm, pn; };
struct Gemm { const bf16_t* A; const bf16_t* Bt; int M, N, K; };

struct StaticOrder {
    int nM, nN, nwg, G, c;
    __host__ __device__ void init(int M, int N, int G_, int c_) { nM = M / BM; nN = N / BM; nwg = nM * nN; G = G_; c = c_; }
    __host__ __device__ bool next(int i, Unit& u) const {
        const long L = (long)i * G + c; if (L >= nwg) return false;
        int wgid = (int)L; { const int q = nwg / NXCD, r = nwg % NXCD, xcd = wgid % NXCD, off = wgid / NXCD; wgid = (xcd < r ? xcd * (q + 1) : r * (q + 1) + (xcd - r) * q) + off; }
        const int nig = WGM * nN, gid = wgid / nig, fm = gid * WGM, gsz = (nM - fm) < WGM ? (nM - fm) : WGM;
        u.pm = fm + ((wgid % nig) % gsz); u.pn = (wgid % nig) / gsz; return true;
    }
    __device__ __forceinline__ void a_ready(const Unit&) const {}
    __device__ __forceinline__ void done(const Unit&) const {}
};

__device__ __forceinline__ unsigned cvt_pk_bf16(float lo, float hi) { unsigned r; asm volatile("v_cvt_pk_bf16_f32 %0, %1, %2" : "=v"(r) : "v"(lo), "v"(hi)); return r; }
typedef float f32x2 __attribute__((ext_vector_type(2)));
__device__ __forceinline__ f32x2 gelu_pk(f32x2 v) {
    const f32x2 av = __builtin_elementwise_abs(v), d = av * 0.2316418882f + 1.0f;
    f32x2 t; t.x = __builtin_amdgcn_rcpf(d.x); t.y = __builtin_amdgcn_rcpf(d.y);
    f32x2 q = t * 0.5307027145f + (-0.7265760135f); q = q * t + 0.7107068705f; q = q * t + (-0.142248368f); q = q * t + 0.127414796f; q = q * t;
    const f32x2 s = (v * v) * (-0.72134752044f);
    f32x2 e; e.x = __builtin_amdgcn_exp2f(s.x); e.y = __builtin_amdgcn_exp2f(s.y);
    const f32x2 m = v * (q * e), r = v - m;
    f32x2 o; o.x = v.x < 0.f ? m.x : r.x; o.y = v.y < 0.f ? m.y : r.y; return o;
}

template <int ACT  > struct EpiBf16 {
    static constexpr bool PERM = true, AFTER_DRAIN = false; static_assert(ACT == 0 || ACT == 1, "EpiBf16: ACT is 0 (none) or 1 (gelu_pk)");
    bf16_t* O; int ldc; const float* bias; int split_cols; size_t split_stride; float scale0;
    __device__ __forceinline__ void operator()(const f32x4 (&acc)[2][2][4][2], const Unit& u, int wr, int wc, int fr, int fq) const {
        const int row0 = u.pm * BM + wr * 64 + fr; int colt = u.pn * BM; bf16_t* base = O;
        float sc = 1.f; if (split_cols) { const int t = colt / split_cols; base += (size_t)t * split_stride; colt -= t * split_cols; if (t == 0) sc = scale0; }
        const int col0 = colt + wc * 32 + 8 * fq, bcol0 = u.pn * BM + wc * 32 + 8 * fq;
        f32x4 bv[2][2];
#pragma unroll
        for (int bj = 0; bj < 2; ++bj)
#pragma unroll
            for (int n = 0; n < 2; ++n) bv[bj][n] = bias ? *(const f32x4*)(bias + bcol0 + bj * HALF + 4 * n) : (f32x4){0.f, 0.f, 0.f, 0.f};
#pragma unroll
        for (int ai = 0; ai < 2; ++ai)
#pragma unroll
            for (int m = 0; m < 4; ++m) { bf16_t* rowp = base + (size_t)(row0 + ai * HALF + m * 16) * ldc + col0;
#pragma unroll
                for (int bj = 0; bj < 2; ++bj) { f32x4 v0 = acc[ai][bj][m][0] + bv[bj][0], v1 = acc[ai][bj][m][1] + bv[bj][1];
                    if (ACT == 1) { f32x2 a = gelu_pk((f32x2){v0[0], v0[1]}), b = gelu_pk((f32x2){v0[2], v0[3]}), c = gelu_pk((f32x2){v1[0], v1[1]}), d = gelu_pk((f32x2){v1[2], v1[3]});
                        v0 = (f32x4){a.x, a.y, b.x, b.y}; v1 = (f32x4){c.x, c.y, d.x, d.y}; }
                    v0 = v0 * sc; v1 = v1 * sc; u32x4 w; w.x = cvt_pk_bf16(v0[0], v0[1]); w.y = cvt_pk_bf16(v0[2], v0[3]); w.z = cvt_pk_bf16(v1[0], v1[1]); w.w = cvt_pk_bf16(v1[2], v1[3]);
                    *(u32x4*)(rowp + bj * HALF) = w; } }
    }
};
struct EpiF32 {
    static constexpr bool PERM = false, AFTER_DRAIN = false;
    float* C; int ldc; const float* bias;
    __device__ __forceinline__ void operator()(const f32x4 (&acc)[2][2][4][2], const Unit& u, int wr, int wc, int fr, int fq) const {
        const int row0 = u.pm * BM + wr * 64 + fr, col0 = u.pn * BM + wc * 32 + 4 * fq;
        f32x4 bv[2][2];
#pragma unroll
        for (int bj = 0; bj < 2; ++bj)
#pragma unroll
            for (int n = 0; n < 2; ++n) bv[bj][n] = bias ? *(const f32x4*)(bias + col0 + bj * HALF + n * 16) : (f32x4){0.f, 0.f, 0.f, 0.f};
#pragma unroll
        for (int ai = 0; ai < 2; ++ai)
#pragma unroll
            for (int m = 0; m < 4; ++m) { float* rowp = C + (size_t)(row0 + ai * HALF + m * 16) * ldc + col0;
#pragma unroll
                for (int bj = 0; bj < 2; ++bj)
#pragma unroll
                    for (int n = 0; n < 2; ++n) *(f32x4*)(rowp + bj * HALF + n * 16) = acc[ai][bj][m][n] + bv[bj][n]; }
    }
};
template <class Epi, class Sched, bool ALIGN_EPI = false, bool SP2 = false>
__device__ __forceinline__ void gemm_phase(PG8_LAS unsigned char* lds, const Gemm g, const Sched& S, const Epi& E, const int wave_in) {
    const int lane = fresh_lane(), wid = wave_in, tid = wid * 64 + lane, wr = wid >> 2, wc = wid & 3, fr = lane & 15, fq = lane >> 4;
    const int K = g.K, nt = K / BK;
    unsigned voffA[2], voffB[2];
#pragma unroll
    for (int i = 0; i < 2; ++i) { int R, C; stage_rc(tid * 16 + i * 8192, R, C); const int Rb = Epi::PERM ? ((R & ~31) + perm32(R & 31)) : R;
        voffA[i] = (unsigned)(R * K + C) * 2u; voffB[i] = (unsigned)(Rb * K + C) * 2u; }
    const size_t kstep = (size_t)(BK * 2);
    const size_t hstep = (size_t)HALF * K * 2;
    const size_t tstep = 2 * hstep;
    const unsigned ldsw = (unsigned)wid * 1024u;
    const int aoff = lds_byte(wr * 64 + fr, fq * 8), boff = lds_byte(wc * 32 + fr, fq * 8);
#define PG8_SA(b, h) (((b) * 2 + (h)) * HTB)
#define PG8_SB(b, h) ((4 + (b) * 2 + (h)) * HTB)
#define PG8_STAGE(bufoff, gbase, voff) do { _Pragma("unroll") for (int _i = 0; _i < 2; ++_i) \
        __builtin_amdgcn_global_load_lds((const unsigned*)((const char*)(gbase) + (voff)[_i]), (PG8_LAS unsigned*)(lds + (bufoff) + ldsw + _i * 8192), 16, 0, 0); } while (0)
#define PG8_LDA(dst, b, h) do { _Pragma("unroll") for (int m = 0; m < 4; ++m) _Pragma("unroll") for (int k = 0; k < 2; ++k) dst[m][k] = *(const PG8_LAS bf16x8*)(lds + PG8_SA(b, h) + aoff + m * 2048 + k * 1024); } while (0)
#define PG8_LDB(dst, b, h) do { _Pragma("unroll") for (int n = 0; n < 2; ++n) _Pragma("unroll") for (int k = 0; k < 2; ++k) dst[n][k] = *(const PG8_LAS bf16x8*)(lds + PG8_SB(b, h) + boff + n * 2048 + k * 1024); } while (0)
#define PG8_MMA(ai, bj, At, Bt) do { __builtin_amdgcn_s_setprio(1); _Pragma("unroll") for (int m = 0; m < 4; ++m) _Pragma("unroll") for (int n = 0; n < 2; ++n) _Pragma("unroll") for (int k = 0; k < 2; ++k) \
        acc[ai][bj][m][n] = __builtin_amdgcn_mfma_f32_16x16x32_bf16(Bt[n][k], At[m][k], acc[ai][bj][m][n], 0, 0, 0); __builtin_amdgcn_s_setprio(0); } while (0)
#define PG8_WAIT_V(n) asm volatile("s_waitcnt vmcnt(" #n ")" ::: "memory")
#define PG8_WAIT_L(n) asm volatile("s_waitcnt lgkmcnt(" #n ")" ::: "memory")
#define PG8_BAR __builtin_amdgcn_s_barrier()
#define PG8_SCHED __builtin_amdgcn_sched_barrier(0)
    Unit cur, nxt; int ui = 0;
    if (!S.next(0, cur)) return;
    f32x4 acc[2][2][4][2];
#pragma unroll
    for (int a = 0; a < 2; ++a)
#pragma unroll
        for (int b = 0; b < 2; ++b)
#pragma unroll
            for (int m = 0; m < 4; ++m)
#pragma unroll
                for (int n = 0; n < 2; ++n) acc[a][b][m][n] = (f32x4){0.f, 0.f, 0.f, 0.f};
    bf16x8 At[4][2], B0[2][2], B1[2][2];
    const char* cA = (const char*)g.A + (size_t)cur.pm * tstep; const char* cB = (const char*)g.Bt + (size_t)cur.pn * tstep;
    S.a_ready(cur);
    if constexpr (SP2) {
        PG8_STAGE(PG8_SB(0, 0), cB, voffB); PG8_STAGE(PG8_SB(0, 1), cB + hstep, voffB); PG8_STAGE(PG8_SA(0, 0), cA, voffA); PG8_STAGE(PG8_SA(0, 1), cA + hstep, voffA);
        if (wr == 1) PG8_BAR;
        PG8_WAIT_V(2); PG8_BAR;
        PG8_STAGE(PG8_SB(1, 0), cB + kstep, voffB); PG8_STAGE(PG8_SA(1, 0), cA + kstep, voffA); PG8_STAGE(PG8_SB(1, 1), cB + hstep + kstep, voffB);
        PG8_WAIT_V(6); PG8_BAR;
    } else {
        PG8_STAGE(PG8_SB(0, 0), cB, voffB); PG8_STAGE(PG8_SA(0, 0), cA, voffA); PG8_STAGE(PG8_SB(0, 1), cB + hstep, voffB); PG8_STAGE(PG8_SA(0, 1), cA + hstep, voffA);
        if (wr == 1) PG8_BAR;
        PG8_WAIT_V(4); PG8_BAR;
        PG8_STAGE(PG8_SB(1, 0), cB + kstep, voffB); PG8_STAGE(PG8_SA(1, 0), cA + kstep, voffA); PG8_STAGE(PG8_SB(1, 1), cB + hstep + kstep, voffB);
        PG8_WAIT_V(6); PG8_BAR;
    }
    for (;;) {
        const bool has_next = S.next(ui + 1, nxt);
        const char* nA = has_next ? (const char*)g.A + (size_t)nxt.pm * tstep : cA; const char* nB = has_next ? (const char*)g.Bt + (size_t)nxt.pn * tstep : cB;
        for (int t = 0; t < nt; t += 2) {
            const bool last = (t == nt - 2);
            const char* a1 = cA + (size_t)(t + 1) * kstep;
            const char* a2 = last ? nA : cA + (size_t)(t + 2) * kstep; const char* b2 = last ? nB : cB + (size_t)(t + 2) * kstep;
            const char* a3 = a2 + kstep; const char* b3 = b2 + kstep;
            if (last && has_next) S.a_ready(nxt);
            if constexpr (SP2) {
            PG8_LDB(B0, 0, 0); PG8_LDB(B1, 0, 1); PG8_SCHED; PG8_LDA(At, 0, 0); PG8_STAGE(PG8_SA(1, 1), a1 + hstep, voffA);
            PG8_WAIT_V(8); PG8_WAIT_L(0); PG8_BAR; PG8_MMA(0, 0, At, B0); PG8_MMA(0, 1, At, B1); PG8_BAR; PG8_SCHED;
            PG8_LDA(At, 0, 1); PG8_STAGE(PG8_SB(0, 0), b2, voffB); PG8_STAGE(PG8_SB(0, 1), b2 + hstep, voffB); PG8_STAGE(PG8_SA(0, 0), a2, voffA);
            PG8_WAIT_V(8); PG8_WAIT_L(0); PG8_BAR; PG8_MMA(1, 0, At, B0); PG8_MMA(1, 1, At, B1); PG8_BAR; PG8_SCHED;
            PG8_LDB(B0, 1, 0); PG8_LDB(B1, 1, 1); PG8_SCHED; PG8_LDA(At, 1, 0); PG8_STAGE(PG8_SA(0, 1), a2 + hstep, voffA);
            PG8_WAIT_V(8); PG8_WAIT_L(0); PG8_BAR; PG8_MMA(0, 0, At, B0); PG8_MMA(0, 1, At, B1); PG8_BAR; PG8_SCHED;
            PG8_LDA(At, 1, 1); PG8_STAGE(PG8_SB(1, 0), b3, voffB); PG8_STAGE(PG8_SB(1, 1), b3 + hstep, voffB); PG8_STAGE(PG8_SA(1, 0), a3, voffA);
            PG8_WAIT_V(8); PG8_WAIT_L(0); PG8_BAR; PG8_MMA(1, 0, At, B0); PG8_MMA(1, 1, At, B1); PG8_BAR; PG8_SCHED;
            } else {
            PG8_LDB(B0, 0, 0); PG8_SCHED; PG8_LDA(At, 0, 0); PG8_STAGE(PG8_SA(1, 1), a1 + hstep, voffA);
            PG8_WAIT_L(8); PG8_BAR; PG8_WAIT_L(0); PG8_MMA(0, 0, At, B0); PG8_BAR; PG8_SCHED;
            PG8_LDB(B1, 0, 1); PG8_STAGE(PG8_SB(0, 0), b2, voffB);
            PG8_BAR; PG8_WAIT_L(0); PG8_MMA(0, 1, At, B1); PG8_BAR;
            PG8_LDA(At, 0, 1); PG8_STAGE(PG8_SA(0, 0), a2, voffA);
            PG8_BAR; PG8_WAIT_L(0); PG8_MMA(1, 0, At, B0); PG8_BAR; PG8_SCHED;
            PG8_STAGE(PG8_SB(0, 1), b2 + hstep, voffB);
            PG8_WAIT_V(6); PG8_BAR; PG8_MMA(1, 1, At, B1); PG8_BAR;
            PG8_LDB(B0, 1, 0); PG8_SCHED; PG8_LDA(At, 1, 0); PG8_STAGE(PG8_SA(0, 1), a2 + hstep, voffA);
            PG8_WAIT_L(8); PG8_BAR; PG8_WAIT_L(0); PG8_MMA(0, 0, At, B0); PG8_BAR; PG8_SCHED;
            PG8_LDB(B1, 1, 1); PG8_STAGE(PG8_SB(1, 0), b3, voffB);
            PG8_BAR; PG8_WAIT_L(0); PG8_MMA(0, 1, At, B1); PG8_BAR;
            PG8_LDA(At, 1, 1); PG8_STAGE(PG8_SA(1, 0), a3, voffA);
            PG8_BAR; PG8_WAIT_L(0); PG8_MMA(1, 0, At, B0); PG8_BAR; PG8_SCHED;
            PG8_STAGE(PG8_SB(1, 1), b3 + hstep, voffB);
            PG8_WAIT_V(6); PG8_BAR; PG8_MMA(1, 1, At, B1); PG8_BAR;
            }
        }
        if constexpr (ALIGN_EPI) { if (wr == 0) PG8_BAR; }
        if constexpr (!Epi::AFTER_DRAIN) { E(acc, cur, wr, wc, fr, fq); S.done(cur); }
        if (!has_next) break;
#pragma unroll
        for (int a = 0; a < 2; ++a)
#pragma unroll
            for (int b = 0; b < 2; ++b)
#pragma unroll
                for (int m = 0; m < 4; ++m)
#pragma unroll
                    for (int n = 0; n < 2; ++n) acc[a][b][m][n] = (f32x4){0.f, 0.f, 0.f, 0.f};
        cur = nxt; cA = nA; cB = nB; ++ui;
        if constexpr (ALIGN_EPI) { if (wr == 1) PG8_BAR; }
    }
    PG8_WAIT_V(0);
    if constexpr (!ALIGN_EPI) { if (wr == 0) PG8_BAR; }
    PG8_BAR;
    if constexpr (Epi::AFTER_DRAIN) { E.fused(acc, cur, wr, wc, fr, fq, lds, wid, lane); S.done(cur); }
#undef PG8_SA
#undef PG8_SB
#undef PG8_STAGE
#undef PG8_LDA
#undef PG8_LDB
#undef PG8_MMA
#undef PG8_WAIT_V
#undef PG8_WAIT_L
#undef PG8_BAR
#undef PG8_SCHED
}
}
#define XB_TMO      128
#define XB_XCNT(j)  (256  + 64 * (j))
#define XB_XSUB(j)  (1280 + 64 * (j))
#define XB_XGEN(j)  (2304 + 64 * (j))
#define XB_TOP      3328
#define XB_TOPGEN   3392
#define XCD_BAR_WORDS 3456
#define XB_SPIN_CAP (1u << 18)

__device__ __forceinline__ unsigned xb_ld(unsigned* p)              { return __hip_atomic_load(p, __ATOMIC_RELAXED, __HIP_MEMORY_SCOPE_AGENT); }
__device__ __forceinline__ unsigned xb_add(unsigned* p, unsigned v) { return __hip_atomic_fetch_add(p, v, __ATOMIC_RELAXED, __HIP_MEMORY_SCOPE_AGENT); }
__device__ __forceinline__ unsigned xb_xcc_id() { return (unsigned)__builtin_amdgcn_s_getreg((3 << 11) | 20) & 0xFu; }
#define XB_SPIN(cond, bar) do { unsigned _sp = 0; while (cond) { __builtin_amdgcn_s_sleep(1); \
    if ((++_sp & 255u) == 0u) { if (xb_ld(&(bar)[XB_TMO])) break; if (_sp > XB_SPIN_CAP) { atomicAdd(&(bar)[XB_TMO], 1u); break; } } } } while (0)

struct XcdBarrier {
    unsigned* bar; unsigned x;
    volatile LAS unsigned* st;
};

__device__ __forceinline__ XcdBarrier xcd_barrier_post(unsigned* bar, volatile LAS unsigned* st, const bool t0) {
    XcdBarrier b; b.bar = bar; b.x = xb_xcc_id(); b.st = st;
    if (t0) (void)xb_add(&bar[XB_XCNT(b.x)], 1u);
    return b;
}
__device__ __forceinline__ void xcd_barrier_complete(unsigned* bar, unsigned x, unsigned& nloc, unsigned& nx) {
    const unsigned G = gridDim.x * gridDim.y * gridDim.z;
    unsigned sum, cnt, mine, sp = 0u;
    for (;;) {
        sum = 0u; cnt = 0u; mine = 0u;
#pragma unroll
        for (unsigned j = 0; j < 16; ++j) { const unsigned c = xb_ld(&bar[XB_XCNT(j)]); sum += c; cnt += (c > 0u) ? 1u : 0u; mine = (j == x) ? c : mine; }
        if (sum == G) break;
        __builtin_amdgcn_s_sleep(1);
        if ((++sp & 255u) == 0u) { if (xb_ld(&bar[XB_TMO])) break; if (sp > XB_SPIN_CAP) { atomicAdd(&bar[XB_TMO], 1u); break; } }
    }
    nloc = mine > 0u ? mine : 1u; nx = cnt > 0u ? cnt : 1u;
}

__device__ __forceinline__ void xcd_barrier(const XcdBarrier& b, const bool t0) {
    asm volatile("s_waitcnt vmcnt(0)" ::: "memory");
    __syncthreads();
    if (t0) {
        unsigned* bar = b.bar;
        __builtin_amdgcn_s_waitcnt(0);
        unsigned nloc = b.st[0], nx = b.st[1];
        if (nloc == 0u) { xcd_barrier_complete(bar, b.x, nloc, nx); b.st[0] = nloc; b.st[1] = nx; }
        const unsigned old = xb_add(&bar[XB_XSUB(b.x)], 1u);
        const unsigned gen = old / nloc;
        if (old + 1u == (gen + 1u) * nloc) {
            __builtin_amdgcn_fence(__ATOMIC_RELEASE, "agent");
            asm volatile("s_waitcnt vmcnt(0)" ::: "memory");
            const unsigned og = xb_add(&bar[XB_TOP], 1u);
            const unsigned tg = og / nx;
            if (og + 1u == (tg + 1u) * nx) xb_add(&bar[XB_TOPGEN], 1u);
            else XB_SPIN(xb_ld(&bar[XB_TOPGEN]) == tg, bar);
            __builtin_amdgcn_fence(__ATOMIC_ACQUIRE, "agent");
            xb_add(&bar[XB_XGEN(b.x)], 1u);
            asm volatile("s_waitcnt vmcnt(0)" ::: "memory");
        } else {
            XB_SPIN(xb_ld(&bar[XB_XGEN(b.x)]) == gen, bar);
            __builtin_amdgcn_fence(__ATOMIC_ACQUIRE, "agent");
            asm volatile("s_waitcnt vmcnt(0)" ::: "memory");
        }
    }
    __syncthreads();
}
#define GAS __attribute__((address_space(1)))
typedef float f32x4 __attribute__((ext_vector_type(4)));
typedef unsigned u32x2 __attribute__((ext_vector_type(2)));
typedef unsigned u32x4 __attribute__((ext_vector_type(4)));
typedef short bf16x8 __attribute__((ext_vector_type(8)));
constexpr int NTHR = 512, NWV = 8;
constexpr int RING_BYTES = 139264, MISC_OFF = RING_BYTES + 320, LDS_BYTES = 147456;
constexpr int CW_BAR = 1024;

struct KArgs { Inputs in; float* out; unsigned char* ws; int ph_lo, ph_hi, li, mask; };
#ifndef PROBE_REP
#define PROBE_REP {0, 0, 0, 0, 0, 0, 0, 0, 0, 0, 0, 0, 0, 0, 0, 0, 0}
#endif
constexpr int kRep[17] = PROBE_REP;

__device__ __forceinline__ float wave_sum(float v) {
#pragma unroll
    for (int o = 1; o < 64; o <<= 1) v += __shfl_xor(v, o);
    return v;
}
typedef float f32x2_t __attribute__((ext_vector_type(2)));
typedef __bf16 bf16x2_t __attribute__((ext_vector_type(2)));
__device__ __forceinline__ unsigned cvtpk(float lo, float hi) { f32x2_t v = {lo, hi}; bf16x2_t b = __builtin_convertvector(v, bf16x2_t); return __builtin_bit_cast(unsigned, b); }
__device__ __forceinline__ unsigned pk2(float lo, float hi) { return cvtpk(lo, hi); }
__device__ __forceinline__ int fresh_lane() { int l; asm volatile("v_mbcnt_lo_u32_b32 %0, -1, 0\n\tv_mbcnt_hi_u32_b32 %0, -1, %0" : "=v"(l)); return l; }
#ifdef PROBE_SEC
#define SEC_B(k) unsigned long long sec_t0_##k = 0; if ((k) == PROBE_SEC && blockIdx.x == 0 && tid == 0) sec_t0_##k = __builtin_amdgcn_s_memrealtime()
#define SEC_E(k) do { if ((k) == PROBE_SEC && blockIdx.x == 0 && tid == 0) { volatile LAS unsigned* sw_ = (volatile LAS unsigned*)(lds + MISC_OFF + 96); sw_[0] = sw_[0] + (unsigned)(__builtin_amdgcn_s_memrealtime() - sec_t0_##k); } } while (0)
#else
#define SEC_B(k)
#define SEC_E(k) do { } while (0)
#endif
#define LDS_FENCE() asm volatile("s_waitcnt lgkmcnt(0)" ::: "memory")

constexpr int PH_PRO = 0;
constexpr int PH_L0 = 1, PH_PER_LAYER = 6;
constexpr int PH_FIN = PH_L0 + 2 * PH_PER_LAYER;
constexpr int PH_END = PH_FIN + 1;

__device__ __forceinline__ void transpose_item(const float* W, int K, int N, bf16_t* WT, LAS float* scr, int item, int lane) {
    const int nblk = N / 32, kb = item / nblk, nb = item % nblk, k0 = 64 * kb, n0 = 32 * nb;
    float wv[32];
#pragma unroll
    for (int i = 0; i < 32; ++i) wv[i] = W[(size_t)(k0 + 2 * i + (lane >> 5)) * N + n0 + (lane & 31)];
#pragma unroll
    for (int i = 0; i < 32; ++i) scr[(2 * i + (lane >> 5)) * 33 + (lane & 31)] = wv[i];
    LDS_FENCE();
    const int c = lane & 7;
#pragma unroll
    for (int j = 0; j < 4; ++j) { const int n = (lane >> 3) + 8 * j; const LAS float* s = scr + (8 * c) * 33 + n;
        u32x4 o; o.x = pk2(s[0 * 33], s[1 * 33]); o.y = pk2(s[2 * 33], s[3 * 33]); o.z = pk2(s[4 * 33], s[5 * 33]); o.w = pk2(s[6 * 33], s[7 * 33]);
        *(u32x4*)(WT + (size_t)(n0 + n) * K + k0 + 8 * c) = o; }
    LDS_FENCE();
}

__device__ __forceinline__ void ph_prologue(const KArgs& a, LAS unsigned char* lds, int tid, int wave, int lane) {
    const Inputs& in = a.in;
    float* MOD = (float*)(a.ws + OFF_MOD);
    LAS float* sil = (LAS float*)lds;
    LAS float* part = (LAS float*)(lds + 5 * 1024 * 4);
    if ((int)blockIdx.x < 192) {
        for (int i = tid; i < 5 * 1024; i += NTHR) { const int j = i >> 10, k = i & 1023; const float cv = j < 4 ? in.c[j * DM + k] : in.c_ctx[k]; sil[i] = cv / (1.f + expf(-cv)); }
        __syncthreads();
        for (int it = blockIdx.x; it < 192; it += gridDim.x) {
            const int l = it / 96, nb = it % 96, n = nb * 32 + (lane & 31), k0 = wave * 128 + (lane >> 5) * 64;
            const float* w = in.w_mod + (size_t)l * DM * 3072 + n;
            float acc[5] = {0.f, 0.f, 0.f, 0.f, 0.f};
#pragma unroll 32
            for (int kk = 0; kk < 64; ++kk) { const float wv = w[(size_t)(k0 + kk) * 3072];
#pragma unroll
                for (int j = 0; j < 5; ++j) acc[j] += sil[j * 1024 + k0 + kk] * wv; }
#pragma unroll
            for (int j = 0; j < 5; ++j) { acc[j] += __shfl_xor(acc[j], 32); if (lane < 32) part[(wave * 5 + j) * 32 + lane] = acc[j]; }
            __syncthreads();
            if (tid < 160) { const int j = tid >> 5, c = tid & 31; float s = in.b_mod[l * 3072 + nb * 32 + c];
#pragma unroll
                for (int w8 = 0; w8 < 8; ++w8) s += part[(w8 * 5 + j) * 32 + c];
                MOD[((size_t)l * 5 + j) * 3072 + nb * 32 + c] = s; }
            __syncthreads();
        }
    }
    __syncthreads();
    LAS float* scr = (LAS float*)(lds + wave * 16384);
    const int gw = blockIdx.x * NWV + wave, NGW = gridDim.x * NWV;
    constexpr int I_IN = (DM / 64) * (NIN / 32), I_OUT = (DM / 64) * (DM / 32), I_PAD = NP - NIN;
    constexpr int I_L = I_IN + I_OUT + I_PAD;
    bf16_t* WIN = (bf16_t*)(a.ws + OFF_WIN); bf16_t* WOUT = (bf16_t*)(a.ws + OFF_WOUT);
    for (int it = gw; it < 2 * I_L; it += NGW) {
        const int l = it / I_L; int r = it % I_L;
        if (r < I_IN) { transpose_item(in.w_in + (size_t)l * DM * NIN, DM, NIN, WIN + (size_t)l * NP * DM, scr, r, lane); continue; } r -= I_IN;
        if (r < I_OUT) { transpose_item(in.w_out + (size_t)l * DM * DM, DM, DM, WOUT + (size_t)l * DM * DM, scr, r, lane); continue; } r -= I_OUT;
        u32x4* zp = (u32x4*)(WIN + ((size_t)l * NP + NIN + r) * DM);
        zp[lane] = (u32x4){0u, 0u, 0u, 0u}; zp[lane + 64] = (u32x4){0u, 0u, 0u, 0u};
    }
    const int gt = blockIdx.x * NTHR + tid, NGT = gridDim.x * NTHR;
    bf16_t* WPT = (bf16_t*)(a.ws + OFF_WPT);
    if (gt < 512) { float* rt = (float*)(a.ws + OFF_ROPE); const int pos = gt >> 3, j = gt & 7; const float f = powf(10000.f, -(float)j / 8.f), ang = (float)pos * f; rt[gt] = cosf(ang); rt[512 + gt] = sinf(ang); }
    for (int i = gt; i < 2 * 4 * 64 * 64; i += NGT) { const int c = i & 63, e = (i >> 6) & 63, li = i >> 12; WPT[i] = f2bf(in.pool_w[(size_t)li * 4096 + c * 64 + e]); }
}

__device__ __forceinline__ void ph_post_pre(const KArgs& a, int lprev, int lnext, int wave, int lane) {
    const Inputs& in = a.in;
    const float* MOD = (const float*)(a.ws + OFF_MOD);
    const bf16_t* O = (const bf16_t*)(a.ws + OFF_P);
    float* XC = (float*)(a.ws + OFF_XC);
    bf16_t* H = (bf16_t*)(a.ws + OFF_H);
    const int gw = blockIdx.x * NWV + wave, NGW = gridDim.x * NWV;
    const int nrows = (lnext < 2) ? MTOT : NLAT;
    for (int row = gw; row < nrows; row += NGW) {
        const bool lat = row < NLAT; const int j = lat ? row / SEQ : 4;
        const float* xr; float* xw = nullptr;
        if (lprev <= 0) xr = lat ? in.x + (size_t)row * DM : in.ctx + (size_t)(row - NLAT) * DM;
        else xr = lat ? a.out + (size_t)row * DM : XC + (size_t)(row - NLAT) * DM;
        const bool post = (lprev >= 0) && (lat || lprev == 0);
        if (post) xw = lat ? a.out + (size_t)row * DM : XC + (size_t)(row - NLAT) * DM;
        f32x4 v[4];
#pragma unroll
        for (int q = 0; q < 4; ++q) v[q] = *(const f32x4*)(xr + 4 * lane + 256 * q);
        if (post) {
            f32x4 o[4]; float s = 0.f;
#pragma unroll
            for (int q = 0; q < 4; ++q) { const u32x2 w = *(const u32x2*)(O + (size_t)row * DM + 4 * lane + 256 * q);
                o[q] = (f32x4){__uint_as_float(w.x << 16), __uint_as_float(w.x & 0xffff0000u), __uint_as_float(w.y << 16), __uint_as_float(w.y & 0xffff0000u)};
                s += (o[q].x * o[q].x + o[q].y * o[q].y) + (o[q].z * o[q].z + o[q].w * o[q].w); }
            const float rstd = rsqrtf(wave_sum(s) * (1.f / DM) + EPS);
            const float* gate = MOD + ((size_t)lprev * 5 + j) * 3072 + 2048; const float* gp = in.g_post + lprev * DM;
#pragma unroll
            for (int q = 0; q < 4; ++q) { const f32x4 gt = *(const f32x4*)(gate + 4 * lane + 256 * q), gg = *(const f32x4*)(gp + 4 * lane + 256 * q);
                v[q] = v[q] + gt * (o[q] * rstd * gg); *(f32x4*)(xw + 4 * lane + 256 * q) = v[q]; }
        }
        if (lnext < 2) {
            float s = 0.f;
#pragma unroll
            for (int q = 0; q < 4; ++q) s += (v[q].x * v[q].x + v[q].y * v[q].y) + (v[q].z * v[q].z + v[q].w * v[q].w);
            const float rstd = rsqrtf(wave_sum(s) * (1.f / DM) + EPS);
            const float* shift = MOD + ((size_t)lnext * 5 + j) * 3072; const float* scale = shift + 1024; const float* gp = in.g_pre + lnext * DM;
#pragma unroll
            for (int q = 0; q < 4; ++q) { const int k = 4 * lane + 256 * q; const f32x4 sh = *(const f32x4*)(shift + k), sc = *(const f32x4*)(scale + k), gg = *(const f32x4*)(gp + k);
                const f32x4 hv = (v[q] * rstd * gg) * (sc + 1.f) + sh;
                u32x2 w; w.x = pk2(hv.x, hv.y); w.y = pk2(hv.z, hv.w); *(u32x2*)(H + (size_t)row * DM + k) = w; }
        }
    }
}

typedef float f32x16 __attribute__((ext_vector_type(16)));
#define MFMA16(a, b, c) __builtin_amdgcn_mfma_f32_16x16x32_bf16(a, b, c, 0, 0, 0)
#define MFMA32(a, b, c) __builtin_amdgcn_mfma_f32_32x32x16_bf16(a, b, c, 0, 0, 0)
__device__ __forceinline__ float fast_exp(float x) { return __builtin_amdgcn_exp2f(x * 1.4426950408889634f); }
__device__ __forceinline__ float fast_silu(float v) { return v * __builtin_amdgcn_rcpf(1.f + fast_exp(-v)); }
__device__ __forceinline__ float lo_bf(unsigned w) { return __uint_as_float(w << 16); }
__device__ __forceinline__ float hi_bf(unsigned w) { return __uint_as_float(w & 0xffff0000u); }


typedef short v4i16_t __attribute__((ext_vector_type(4)));
constexpr int NA_KV_BYTES = 832 * 128, NA_RPB_OFF = NA_KV_BYTES;

__device__ __forceinline__ void na_stage(const bf16_t* P, LAS unsigned char* kv, int colbase, int b, int U0, int nwin, int tid) {
    const int kr0 = tid >> 3, c = tid & 7;
    const unsigned toff = (unsigned)kr0 * NP + 8u * c;
    const bf16_t* gctx = P + (size_t)(NLAT + b * NCTX) * NP + colbase;
    const bf16_t* gwin = P + (size_t)(b * SEQ + U0 * 64) * NP + colbase;
    LAS unsigned char* lb = kv + kr0 * 128 + ((c ^ (kr0 & 7)) << 4);
    u32x4 v[7];
#pragma unroll
    for (int it = 0; it < 4; ++it) v[it] = *(const u32x4*)(gctx + (size_t)it * 64 * NP + toff);
#pragma unroll
    for (int it = 4; it < 7; ++it) if (it - 4 < nwin) v[it] = *(const u32x4*)(gwin + (size_t)(it - 4) * 64 * NP + toff);
#pragma unroll
    for (int it = 0; it < 4; ++it) *(LAS u32x4*)(lb + it * 8192) = v[it];
#pragma unroll
    for (int it = 4; it < 7; ++it) if (it - 4 < nwin) *(LAS u32x4*)(lb + it * 8192) = v[it];
#pragma unroll
    for (int it = 7; it < 13; ++it) if (it - 4 < nwin) v[it - 7] = *(const u32x4*)(gwin + (size_t)(it - 4) * 64 * NP + toff);
#pragma unroll
    for (int it = 7; it < 13; ++it) if (it - 4 < nwin) *(LAS u32x4*)(lb + it * 8192) = v[it - 7];
}

template <bool HW>
__device__ __forceinline__ void na_half(const LAS unsigned char* kbase, int sw0, int sw1, bf16x8 qf0, bf16x8 qf1, const LAS float* rp, int R0, int r, int CB, int cg, int li, int g,
                                        bf16x8 (&pf)[8], float& mo, float& lo_) {
    f32x4 S[16];
#pragma unroll
    for (int t = 0; t < 16; ++t) {
        const LAS unsigned char* kb = HW ? kbase + (t >> 1) * 8192 + (t & 1) * 2048 : kbase + t * 2048;
        const bf16x8 k0 = *(const LAS bf16x8*)(kb + sw0), k1 = *(const LAS bf16x8*)(kb + sw1);
        f32x4 acc = {0.f, 0.f, 0.f, 0.f};
        acc = MFMA16(k0, qf0, acc); acc = MFMA16(k1, qf1, acc); S[t] = acc;
    }
    float m = -INFINITY;
    if (HW) {
        const int c = cg * 16 + li, cs = min(max(c - 8, 0), 48);
        const LAS float* rb = rp + (R0 - r + 7) * 31 + (CB - c + 4 * g + 15);
        bool vld[8];
#pragma unroll
        for (int k = 0; k < 8; ++k) { const int kcol = CB + 16 * (k >> 2) + 4 * g + (k & 3); vld[k] = (kcol >= cs) && (kcol < cs + 16); }
#pragma unroll
        for (int wt = 0; wt < 16; ++wt) {
#pragma unroll
            for (int q = 0; q < 4; ++q) { const float bias = rb[(wt >> 1) * 31 + 16 * (wt & 1) + q];
                const float s = vld[4 * (wt & 1) + q] ? S[wt][q] * 0.125f + bias : -INFINITY; S[wt][q] = s; m = fmaxf(m, s); }
        }
    } else {
#pragma unroll
        for (int ct = 0; ct < 16; ++ct)
#pragma unroll
            for (int q = 0; q < 4; ++q) { const float s = S[ct][q] * 0.125f; S[ct][q] = s; m = fmaxf(m, s); }
    }
    m = fmaxf(m, __shfl_xor(m, 16)); m = fmaxf(m, __shfl_xor(m, 32));
    float lsum = 0.f;
#pragma unroll
    for (int u = 0; u < 8; ++u) {
        float p[8];
#pragma unroll
        for (int q = 0; q < 4; ++q) { p[q] = fast_exp(S[2 * u][q] - m); p[4 + q] = fast_exp(S[2 * u + 1][q] - m); }
#pragma unroll
        for (int q = 0; q < 8; ++q) lsum += p[q];
        u32x4 w; w.x = cvtpk(p[0], p[1]); w.y = cvtpk(p[2], p[3]); w.z = cvtpk(p[4], p[5]); w.w = cvtpk(p[6], p[7]);
        pf[u] = __builtin_bit_cast(bf16x8, w);
    }
    lsum += __shfl_xor(lsum, 16); lsum += __shfl_xor(lsum, 32);
    mo = m; lo_ = lsum;
}

template <bool WIN>
__device__ __forceinline__ void na_block(const KArgs& a, LAS unsigned char* lds, int b, int h, int R, int tid, int wave, int lane) {
    const bf16_t* P = (const bf16_t*)(a.ws + OFF_P); bf16_t* Y = (bf16_t*)(a.ws + OFF_H);
    LAS unsigned char* kv = lds; const LAS float* rpb = (const LAS float*)(lds + NA_RPB_OFF);
    const int li = lane & 15, g = lane >> 4;
    int r = 0, cg = 0, U0 = 0, nwin = 0, wo = 0, CB = 0, R0 = 0, qrow0;
    if (WIN) { r = 2 * R + (wave >> 2); cg = wave & 3; U0 = min(max(2 * R - 4, 0), 56); nwin = min(9, 64 - U0); R0 = min(max(r - 4, 0), 56); wo = R0 - U0;
        CB = min(max(cg * 16 - 8, 0), 32); qrow0 = b * SEQ + r * 64 + cg * 16; }
    else qrow0 = NLAT + b * NCTX + R * 128 + wave * 16;
    SEC_B(7);
    __syncthreads();
    na_stage(P, kv, C_NK + h * 64, b, U0, nwin, tid);
    const bf16_t* qp = P + (size_t)(qrow0 + li) * NP + C_NQ + h * 64 + 8 * g;
    const bf16x8 qf0 = *(const bf16x8*)qp, qf1 = *(const bf16x8*)(qp + 32);
    __syncthreads();
    const LAS unsigned char* kwin = kv + (256 + wo * 64 + CB + li) * 128; const LAS unsigned char* kctx = kv + li * 128;
    const int sw0 = (g ^ (li & 7)) << 4, sw1 = ((4 + g) ^ (li & 7)) << 4;
    bf16x8 pfw[8], pfc[8];
    float mw = -INFINITY, lw = 0.f, mc, lc;
    if (WIN) na_half<true>(kwin, sw0, sw1, qf0, qf1, rpb + h * 465, R0, r, CB, cg, li, g, pfw, mw, lw);
    na_half<false>(kctx, sw0, sw1, qf0, qf1, rpb, 0, 0, 0, 0, li, g, pfc, mc, lc);
    __syncthreads();
    SEC_E(7);
    SEC_B(8);
    na_stage(P, kv, C_NV + h * 64, b, U0, nwin, tid);
    __syncthreads();
    const int trow = 4 * g + (li >> 2), rl = trow & 7;
    LAS unsigned char* twin = kv + (256 + wo * 64 + CB + trow) * 128 + (li & 1) * 8; LAS unsigned char* tctx = kv + trow * 128 + (li & 1) * 8;
    int trs[4];
#pragma unroll
    for (int mt = 0; mt < 4; ++mt) trs[mt] = ((2 * mt + ((li & 3) >> 1)) ^ rl) << 4;
    f32x4 accw[4], acc[4];
#pragma unroll
    for (int mt = 0; mt < 4; ++mt) { accw[mt] = (f32x4){0.f, 0.f, 0.f, 0.f}; acc[mt] = (f32x4){0.f, 0.f, 0.f, 0.f}; }
    if (WIN) {
#pragma unroll
        for (int u = 0; u < 8; ++u)
#pragma unroll
            for (int mt = 0; mt < 4; ++mt) { const LAS unsigned char* tp = twin + trs[mt] + u * 8192;
                const v4i16_t lo = __builtin_amdgcn_ds_read_tr16_b64_v4i16((LAS v4i16_t*)tp), hi = __builtin_amdgcn_ds_read_tr16_b64_v4i16((LAS v4i16_t*)(tp + 2048));
                const bf16x8 af = {lo[0], lo[1], lo[2], lo[3], hi[0], hi[1], hi[2], hi[3]};
                accw[mt] = MFMA16(af, pfw[u], accw[mt]); }
    }
#pragma unroll
    for (int u = 0; u < 8; ++u)
#pragma unroll
        for (int mt = 0; mt < 4; ++mt) { const LAS unsigned char* tp = tctx + trs[mt] + u * 4096;
            const v4i16_t lo = __builtin_amdgcn_ds_read_tr16_b64_v4i16((LAS v4i16_t*)tp), hi = __builtin_amdgcn_ds_read_tr16_b64_v4i16((LAS v4i16_t*)(tp + 2048));
            const bf16x8 af = {lo[0], lo[1], lo[2], lo[3], hi[0], hi[1], hi[2], hi[3]};
            acc[mt] = MFMA16(af, pfc[u], acc[mt]); }
    float lsum = lc;
    if (WIN) { const float mm = fmaxf(mw, mc); const float f0 = fast_exp(mw - mm), f1 = fast_exp(mc - mm);
#pragma unroll
        for (int mt = 0; mt < 4; ++mt) acc[mt] = accw[mt] * f0 + acc[mt] * f1;
        lsum = lw * f0 + lc * f1; }
    const float inv = 1.f / lsum;
    const size_t row = (size_t)(qrow0 + li);
#pragma unroll
    for (int mt = 0; mt < 4; ++mt) {
        const int col = 256 + h * 64 + 16 * mt + 4 * g;
        const u32x2 gt = *(const u32x2*)(P + row * NP + C_GATE + col);
        u32x2 w;
        w.x = cvtpk(acc[mt][0] * inv * fast_silu(lo_bf(gt.x)), acc[mt][1] * inv * fast_silu(hi_bf(gt.x)));
        w.y = cvtpk(acc[mt][2] * inv * fast_silu(lo_bf(gt.y)), acc[mt][3] * inv * fast_silu(hi_bf(gt.y)));
        *(u32x2*)(Y + row * DM + col) = w;
    }
    SEC_E(8);
}

__device__ __forceinline__ void pool_item(const KArgs& a, int l, LAS unsigned char* lds, int cid, int tid, int wave, int lane) {
    const bf16_t* P = (const bf16_t*)(a.ws + OFF_P); bf16_t* Y = (bf16_t*)(a.ws + OFF_H);
    const bf16_t* WPT = (const bf16_t*)(a.ws + OFF_WPT) + (size_t)l * 4 * 64 * 64;
    const float* pscale = a.in.pool_scale + l * 256;
    LAS bf16_t* U = (LAS bf16_t*)lds;
    LAS bf16_t* M = U + 80 * 264;
    const bool lat = cid < 256;
    const int seq_len = lat ? SEQ : NCTX;
    const int seq_base = lat ? (cid >> 6) * SEQ : NLAT + ((cid - 256) >> 2) * NCTX;
    const int t0 = lat ? (cid & 63) * 64 : ((cid - 256) & 3) * 64;
    SEC_B(9);
    for (int i = tid; i < 80 * 32; i += NTHR) { const int tr = i >> 5, c8 = i & 31, tt = t0 - 8 + tr;
        u32x4 v = {0u, 0u, 0u, 0u};
        if (tt >= 0 && tt < seq_len) v = *(const u32x4*)(P + (size_t)(seq_base + tt) * NP + C_PU + c8 * 8);
        *(LAS u32x4*)(U + tr * 264 + c8 * 8) = v; }
    __syncthreads();
    {
        const int col = tid & 255, th = tid >> 8, part = col >> 6, w = 2 << part;
        for (int t = 32 * th; t < 32 * th + 32; ++t) {
            const int tt = t0 + t; const int lo = min(max(tt - w / 2, 0), seq_len), hi = min(max(tt - w / 2 + w, 0), seq_len);
            float s = 0.f;
            for (int ss = lo; ss < hi; ++ss) s += bf2f(U[(ss - t0 + 8) * 264 + col]);
            const float mv = s / (float)(hi - lo) - bf2f(U[(t + 8) * 264 + col]);
            M[t * 264 + col] = (bf16_t)cvtpk(mv, 0.f);
        }
    }
    __syncthreads();
    {
        const int part = wave >> 1, th = wave & 1, li = lane & 15, g = lane >> 4;
        f32x4 acc[4][2];
#pragma unroll
        for (int mt = 0; mt < 4; ++mt) { acc[mt][0] = (f32x4){0.f, 0.f, 0.f, 0.f}; acc[mt][1] = (f32x4){0.f, 0.f, 0.f, 0.f}; }
#pragma unroll
        for (int s = 0; s < 2; ++s) {
            bf16x8 bfr[2];
#pragma unroll
            for (int nt = 0; nt < 2; ++nt) bfr[nt] = *(const LAS bf16x8*)(M + (32 * th + 16 * nt + li) * 264 + part * 64 + 32 * s + 8 * g);
#pragma unroll
            for (int mt = 0; mt < 4; ++mt) {
                const bf16x8 af = *(const bf16x8*)(WPT + ((size_t)(part * 64 + 16 * mt + li)) * 64 + 32 * s + 8 * g);
#pragma unroll
                for (int nt = 0; nt < 2; ++nt) acc[mt][nt] = MFMA16(af, bfr[nt], acc[mt][nt]);
            }
        }
#pragma unroll
        for (int nt = 0; nt < 2; ++nt) {
            const size_t row = (size_t)(seq_base + t0 + 32 * th + 16 * nt + li);
#pragma unroll
            for (int mt = 0; mt < 4; ++mt) {
                const int cl = part * 64 + 16 * mt + 4 * g;
                const f32x4 sc = *(const f32x4*)(pscale + cl);
                const u32x2 gt = *(const u32x2*)(P + row * NP + C_GATE + 768 + cl);
                u32x2 w;
                w.x = cvtpk(acc[mt][nt][0] * sc.x * fast_silu(lo_bf(gt.x)), acc[mt][nt][1] * sc.y * fast_silu(hi_bf(gt.x)));
                w.y = cvtpk(acc[mt][nt][2] * sc.z * fast_silu(lo_bf(gt.y)), acc[mt][nt][3] * sc.w * fast_silu(hi_bf(gt.y)));
                *(u32x2*)(Y + row * DM + 768 + cl) = w;
            }
        }
    }
    __syncthreads();
    SEC_E(9);
}

__device__ __forceinline__ void phC_na_ctx(const KArgs& a, int l, LAS unsigned char* lds, int tid, int wave, int lane) {
    if (l != 0) return;
    for (int u = blockIdx.x; u < 32; u += gridDim.x) na_block<false>(a, lds, u >> 3, (u >> 1) & 3, u & 1, tid, wave, lane);
    __syncthreads();
}
__device__ __forceinline__ void phD_na_pool(const KArgs& a, int l, LAS unsigned char* lds, int tid, int wave, int lane) {
    const int ncid = (l == 1) ? 256 : 272;
    for (int q = 0; q <= kRep[13]; ++q) for (int cid = gridDim.x - 1 - blockIdx.x; cid < ncid; cid += gridDim.x) pool_item(a, l, lds, cid, tid, wave, lane);
    LAS float* rpb = (LAS float*)(lds + NA_RPB_OFF);
    for (int i = tid; i < 4 * 465; i += NTHR) rpb[i] = a.in.na_rpb[l * 4 * 465 + i];
    for (int q = 0; q <= kRep[14]; ++q) for (int u = blockIdx.x; u < 512; u += gridDim.x) { const int ln = fresh_lane(); na_block<true>(a, lds, u >> 7, (u >> 5) & 3, u & 31, wave * 64 + ln, wave, ln); }
    __syncthreads();
}
constexpr int GL_QR = 0, GL_KR = 8192, GL_GFB = 16384, GL_ROPE = 24576, GL_TOT = 28672, GL_QC = 30720, GL_KF = 49152, GL_KB = 59392,
              GL_VT = 69632, GL_KFT = 88064, GL_KBT = 97280, GL_ATT = 106496;

__device__ __forceinline__ float logsigmoid_fast(float z) { return fminf(z, 0.f) - __logf(1.f + __expf(-fabsf(z))); }

template <bool LOCAL>
__device__ __forceinline__ void gla_prep(const KArgs& a, int l, LAS unsigned char* lds, int cid, int hp, int tid) {
    const bf16_t* P = (const bf16_t*)(a.ws + OFF_P);
    const size_t row0 = (size_t)cid * 64;
    const bool lat = cid < 256;
    LAS bf16_t* QR = (LAS bf16_t*)(lds + GL_QR); LAS bf16_t* KR = (LAS bf16_t*)(lds + GL_KR);
    LAS float* GFB = (LAS float*)(lds + GL_GFB); LAS float* ROPE = (LAS float*)(lds + GL_ROPE); LAS float* TOT = (LAS float*)(lds + GL_TOT);
    LAS bf16_t* QC = (LAS bf16_t*)(lds + GL_QC); LAS bf16_t* KF = (LAS bf16_t*)(lds + GL_KF); LAS bf16_t* KB = (LAS bf16_t*)(lds + GL_KB);
    LAS bf16_t* VT = (LAS bf16_t*)(lds + GL_VT); LAS bf16_t* KFT = (LAS bf16_t*)(lds + GL_KFT); LAS bf16_t* KBT = (LAS bf16_t*)(lds + GL_KBT);
    { const int t = tid >> 3, c8 = tid & 7;
      *(LAS u32x4*)(QR + t * 64 + c8 * 8) = *(const u32x4*)(P + (row0 + t) * NP + C_GQ + hp * 64 + c8 * 8);
      *(LAS u32x4*)(KR + t * 64 + c8 * 8) = *(const u32x4*)(P + (row0 + t) * NP + C_GK + hp * 64 + c8 * 8); }
    if (tid < 256) { const int t = tid >> 2, c8 = tid & 3; const u32x4 v = *(const u32x4*)(P + (row0 + t) * NP + C_GF + c8 * 8);
        LAS float* gp = GFB + t * 32 + c8 * 8;
        gp[0] = lo_bf(v.x); gp[1] = hi_bf(v.x); gp[2] = lo_bf(v.y); gp[3] = hi_bf(v.y); gp[4] = lo_bf(v.z); gp[5] = hi_bf(v.z); gp[6] = lo_bf(v.w); gp[7] = hi_bf(v.w); }
    { const float* rt = (const float*)(a.ws + OFF_ROPE); ROPE[tid] = rt[tid]; ROPE[tid + 512] = rt[tid + 512]; }
#pragma unroll
    for (int rep = 0; rep < 2; ++rep) { const int i = tid + rep * NTHR, t = i & 63, c16 = i >> 6;
        const u32x4 v = *(const u32x4*)(P + (row0 + t) * NP + C_GV + hp * 128 + c16 * 8);
        const int h2 = c16 >> 3, e0 = (c16 & 7) * 8; LAS bf16_t* vp = VT + (h2 * 64 + e0) * 72 + t;
        vp[0 * 72] = (bf16_t)(v.x & 0xffff); vp[1 * 72] = (bf16_t)(v.x >> 16); vp[2 * 72] = (bf16_t)(v.y & 0xffff); vp[3 * 72] = (bf16_t)(v.y >> 16);
        vp[4 * 72] = (bf16_t)(v.z & 0xffff); vp[5 * 72] = (bf16_t)(v.z >> 16); vp[6 * 72] = (bf16_t)(v.w & 0xffff); vp[7 * 72] = (bf16_t)(v.w >> 16); }
    __syncthreads();
    const int col = tid & 127, dir = col >> 6, h2 = (col >> 5) & 1, d = col & 31, tq = tid >> 7;
    const int h = 2 * hp + h2;
    float wg[16];
    { const float* wp = a.in.gla_w_gate + ((size_t)(l * 2 + dir) * 16) * 128 + h * 32 + d;
#pragma unroll
      for (int r = 0; r < 16; ++r) wg[r] = wp[r * 128]; }
    const float bg = a.in.gla_b_gate[(l * 2 + dir) * 128 + h * 32 + d];
    float lgv[16], pf[16]; float run = 0.f;
#pragma unroll
    for (int tt = 0; tt < 16; ++tt) { const LAS float* gp = GFB + (16 * tq + tt) * 32 + dir * 16;
        float z = bg;
#pragma unroll
        for (int r = 0; r < 16; ++r) z += gp[r] * wg[r];
        lgv[tt] = logsigmoid_fast(z) * (1.f / 16.f); run += lgv[tt]; pf[tt] = run; }
    TOT[tq * 128 + col] = run;
    __syncthreads();
    float off = 0.f, total = 0.f;
#pragma unroll
    for (int q = 0; q < 4; ++q) { const float v = TOT[q * 128 + col]; total += v; if (dir ? (q > tq) : (q < tq)) off += v; }
    const float qs = 0.17677669529663687f;
    const int i16 = d & 15, j8 = d & 7, dp = (i16 < 8) ? d + 8 : d - 8; const float sg = (i16 < 8) ? -1.f : 1.f;
#pragma unroll
    for (int tl = 0; tl < 16; ++tl) { const int t = 16 * tq + tl; const float cv = (dir ? run - pf[tl] + lgv[tl] : pf[tl]) + off;
        float k = bf2f(KR[t * 64 + h2 * 32 + d]), q = bf2f(QR[t * 64 + h2 * 32 + d]);
        if (lat) { const int tokpos = (cid & 63) * 64 + t; const int pos = (d & 16) ? (tokpos & 63) : (tokpos >> 6);
            const float cs = ROPE[pos * 8 + j8], sn = ROPE[512 + pos * 8 + j8];
            k = k * cs + sg * bf2f(KR[t * 64 + h2 * 32 + dp]) * sn; q = q * cs + sg * bf2f(QR[t * 64 + h2 * 32 + dp]) * sn; }
        if (LOCAL) { (dir ? KBT : KFT)[(h2 * 32 + d) * 72 + t] = (bf16_t)cvtpk(k * __expf(total - cv), 0.f); }
        else { { const unsigned w_ = cvtpk(q * qs * __expf(cv), k * __expf(-cv)); QC[(h2 * 64 + t) * 72 + dir * 32 + d] = (bf16_t)w_; (dir ? KB : KF)[(h2 * 64 + t) * 40 + d] = (bf16_t)(w_ >> 16); } }
    }
    if (LOCAL && tq == 0) { const int b = lat ? cid >> 6 : (cid - 256) >> 2; const int slot = lat ? 4 + (cid & 63) : (cid - 256) & 3;
        float* DEC = (float*)(a.ws + OFF_GDEC); DEC[((size_t)((b * 4 + h) * 2 + dir) * 68 + slot) * 32 + d] = __expf(total); }
    __syncthreads();
}

__device__ __forceinline__ void gla_local_unit(const KArgs& a, int l, LAS unsigned char* lds, int cid, int hp, int tid, int wave, int lane) {
    SEC_B(6);
    gla_prep<true>(a, l, lds, cid, hp, tid);
    if (wave < 4) {
        const int h2 = wave >> 1, dir = wave & 1, h = 2 * hp + h2, lr = lane & 31, hi = lane >> 5;
        const LAS bf16_t* VT = (const LAS bf16_t*)(lds + GL_VT) + h2 * 64 * 72;
        const LAS bf16_t* KT = (const LAS bf16_t*)(lds + (dir ? GL_KBT : GL_KFT)) + h2 * 32 * 72;
        f32x16 acc[2];
#pragma unroll
        for (int mt = 0; mt < 2; ++mt)
#pragma unroll
            for (int r = 0; r < 16; ++r) acc[mt][r] = 0.f;
#pragma unroll
        for (int s = 0; s < 4; ++s) {
            const bf16x8 bfr = *(const LAS bf16x8*)(KT + lr * 72 + 16 * s + 8 * hi);
#pragma unroll
            for (int mt = 0; mt < 2; ++mt) { const bf16x8 afr = *(const LAS bf16x8*)(VT + (32 * mt + lr) * 72 + 16 * s + 8 * hi); acc[mt] = MFMA32(afr, bfr, acc[mt]); }
        }
        const bool lat = cid < 256; const int b = lat ? cid >> 6 : (cid - 256) >> 2; const int slot = lat ? 4 + (cid & 63) : (cid - 256) & 3;
        float* LOC = (float*)(a.ws + OFF_GLOC) + ((size_t)((b * 4 + h) * 2 + dir) * 68 + slot) * 2048;
#pragma unroll
        for (int mt = 0; mt < 2; ++mt)
#pragma unroll
            for (int r = 0; r < 16; ++r) { const int e = 32 * mt + (r & 3) + 8 * (r >> 2) + 4 * hi; LOC[e * 32 + lr] = acc[mt][r]; }
    }
    __syncthreads();
    SEC_E(6);
}

__device__ __forceinline__ void gla_scan_item(const KArgs& a, int item, int tid) {
    const int chain = item >> 2, elem = (item & 3) * 512 + tid, d = elem & 31, dir = chain & 1;
    const float* LOC = (const float*)(a.ws + OFF_GLOC) + (size_t)chain * 68 * 2048 + elem;
    const float* DEC = (const float*)(a.ws + OFF_GDEC) + (size_t)chain * 68 * 32 + d;
    bf16_t* SIN = (bf16_t*)(a.ws + OFF_GSIN) + (size_t)chain * 68 * 2048 + elem;
    float S = 0.f;
    for (int st = 0; st < 68; st += 4) {
        float lv[4], dv[4]; int sl[4];
#pragma unroll
        for (int k = 0; k < 4; ++k) { sl[k] = dir ? 71 - (st + k) : st + k; if (dir && st + k < 4) sl[k] = 3 - (st + k); lv[k] = LOC[(size_t)sl[k] * 2048]; dv[k] = DEC[sl[k] * 32]; }
#pragma unroll
        for (int k = 0; k < 4; ++k) { SIN[(size_t)sl[k] * 2048] = f2bf(S); S = dv[k] * S + lv[k]; }
    }
}

__device__ __forceinline__ void gla_out_unit(const KArgs& a, int l, LAS unsigned char* lds, int cid, int hp, int tid, int wave, int lane) {
    SEC_B(3);
    gla_prep<false>(a, l, lds, cid, hp, tid);
    SEC_E(3);
    SEC_B(4);
    if (wave < 4) {
        const int h2 = wave >> 1, ih = wave & 1, h = 2 * hp + h2, lr = lane & 31, hi = lane >> 5;
        const LAS bf16_t* QC = (const LAS bf16_t*)(lds + GL_QC) + h2 * 64 * 72;
        const LAS bf16_t* KF = (const LAS bf16_t*)(lds + GL_KF) + h2 * 64 * 40;
        const LAS bf16_t* KB = (const LAS bf16_t*)(lds + GL_KB) + h2 * 64 * 40;
        const LAS bf16_t* VT = (const LAS bf16_t*)(lds + GL_VT) + h2 * 64 * 72;
        LAS bf16_t* ATT = (LAS bf16_t*)(lds + GL_ATT) + wave * 32 * 72;
        const int icol = 32 * ih + lr;
#pragma unroll
        for (int jt = 0; jt < 2; ++jt) {
            f32x16 df, db;
#pragma unroll
            for (int r = 0; r < 16; ++r) { df[r] = 0.f; db[r] = 0.f; }
#pragma unroll
            for (int s = 0; s < 2; ++s) {
                const bf16x8 af = *(const LAS bf16x8*)(KF + (32 * jt + lr) * 40 + 16 * s + 8 * hi), ab = *(const LAS bf16x8*)(KB + (32 * jt + lr) * 40 + 16 * s + 8 * hi);
                const bf16x8 bf_ = *(const LAS bf16x8*)(QC + icol * 72 + 16 * s + 8 * hi), bb_ = *(const LAS bf16x8*)(QC + icol * 72 + 32 + 16 * s + 8 * hi);
                df = MFMA32(af, bf_, df); db = MFMA32(ab, bb_, db);
            }
#pragma unroll
            for (int qd = 0; qd < 4; ++qd) { float v[4];
#pragma unroll
                for (int k = 0; k < 4; ++k) { const int j = 32 * jt + 8 * qd + 4 * hi + k; v[k] = (j <= icol ? df[4 * qd + k] : 0.f) + (j >= icol ? db[4 * qd + k] : 0.f); }
                u32x2 w; w.x = cvtpk(v[0], v[1]); w.y = cvtpk(v[2], v[3]);
                *(LAS u32x2*)(ATT + lr * 72 + 32 * jt + 8 * qd + 4 * hi) = w; }
        }
        LDS_FENCE();
        const bool lat = cid < 256; const int b = lat ? cid >> 6 : (cid - 256) >> 2; const int slot = lat ? 4 + (cid & 63) : (cid - 256) & 3;
        const bf16_t* SF = (const bf16_t*)(a.ws + OFF_GSIN) + ((size_t)((b * 4 + h) * 2 + 0) * 68 + slot) * 2048;
        const bf16_t* SB = SF + (size_t)68 * 2048;
        f32x16 acc[2];
#pragma unroll
        for (int mt = 0; mt < 2; ++mt)
#pragma unroll
            for (int r = 0; r < 16; ++r) acc[mt][r] = 0.f;
#pragma unroll
        for (int s = 0; s < 4; ++s) {
            const bf16x8 b1 = *(const LAS bf16x8*)(ATT + lr * 72 + 16 * s + 8 * hi);
            const bf16x8 b2 = *(const LAS bf16x8*)(QC + icol * 72 + 16 * s + 8 * hi);
#pragma unroll
            for (int mt = 0; mt < 2; ++mt) {
                const bf16x8 a1 = *(const LAS bf16x8*)(VT + (32 * mt + lr) * 72 + 16 * s + 8 * hi);
                const bf16_t* sp = (s < 2 ? SF : SB) + (32 * mt + lr) * 32 + 16 * (s & 1) + 8 * hi;
                const bf16x8 a2 = *(const bf16x8*)sp;
                acc[mt] = MFMA32(a1, b1, acc[mt]); acc[mt] = MFMA32(a2, b2, acc[mt]);
            }
        }
        float ss = 0.f;
#pragma unroll
        for (int mt = 0; mt < 2; ++mt)
#pragma unroll
            for (int r = 0; r < 16; ++r) ss += acc[mt][r] * acc[mt][r];
        ss += __shfl_xor(ss, 32);
        const float rstd = rsqrtf(ss * (1.f / 64.f) + EPS);
        const bf16_t* P = (const bf16_t*)(a.ws + OFF_P); bf16_t* Y = (bf16_t*)(a.ws + OFF_H);
        const float* gn = a.in.gla_g_norm + l * 64;
        const size_t row = (size_t)cid * 64 + icol;
#pragma unroll
        for (int mt = 0; mt < 2; ++mt)
#pragma unroll
            for (int qd = 0; qd < 4; ++qd) { const int e0 = 32 * mt + 8 * qd + 4 * hi;
                const f32x4 g4 = *(const f32x4*)(gn + e0);
                const u32x2 gt = *(const u32x2*)(P + row * NP + C_GATE + h * 64 + e0);
                u32x2 w;
                w.x = cvtpk(acc[mt][4 * qd + 0] * rstd * g4.x * fast_silu(lo_bf(gt.x)), acc[mt][4 * qd + 1] * rstd * g4.y * fast_silu(hi_bf(gt.x)));
                w.y = cvtpk(acc[mt][4 * qd + 2] * rstd * g4.z * fast_silu(lo_bf(gt.y)), acc[mt][4 * qd + 3] * rstd * g4.w * fast_silu(hi_bf(gt.y)));
                *(u32x2*)(Y + row * DM + h * 64 + e0) = w; }
    }
    __syncthreads();
    SEC_E(4);
}

__device__ __forceinline__ void phC_gla(const KArgs& a, int l, LAS unsigned char* lds, int tid, int wave, int lane) {
    for (int u = blockIdx.x; u < 544; u += gridDim.x) gla_local_unit(a, l, lds, u >> 1, u & 1, tid, wave, lane);
}
__device__ __forceinline__ void phD_gla(const KArgs& a, int tid) {
    for (int it = blockIdx.x; it < 128; it += gridDim.x) gla_scan_item(a, it, tid);
}
__device__ __forceinline__ void phE_gla(const KArgs& a, int l, LAS unsigned char* lds, int tid, int wave, int lane) {
    const int nu = (l == 1) ? 512 : 544;
    for (int u = blockIdx.x; u < nu; u += gridDim.x) gla_out_unit(a, l, lds, u >> 1, u & 1, tid, wave, lane);
}
constexpr int S5_WAVE_BYTES = 12544;
constexpr int S5_GT = 8 * S5_WAVE_BYTES;

__device__ __forceinline__ float gelu_tanh_fast(float v) { const float u = 0.7978845608028654f * (v + 0.044715f * v * v * v); return v * __builtin_amdgcn_rcpf(1.f + fast_exp(-2.f * u)); }

template <int DIR, bool READOUT>
__device__ __forceinline__ void s5_dir(const KArgs& a, int l, LAS unsigned char* wl, size_t row0, int g, int lane, float& xr, float& xi, f32x4 (&D2)[4]) {
    const bf16_t* P = (const bf16_t*)(a.ws + OFF_P);
    const int dgl = (l * 2 + DIR) * 16 + g;
    const bf16_t* BBT = (const bf16_t*)(a.ws + OFF_BBT) + (size_t)dgl * 128 * 16;
    const bf16_t* CMT = (const bf16_t*)(a.ws + OFF_CMT) + (size_t)dgl * 16 * 128;
    const f32x4 lb = *(const f32x4*)((const float*)(a.ws + OFF_SLB) + ((size_t)dgl * 64 + lane) * 4);
    const float lbr = lb.x, lbi = lb.y;
    LAS float* SCAN = (LAS float*)wl; LAS bf16_t* XB = (LAS bf16_t*)(wl + 8192);
    const int li = lane & 15, g4 = lane >> 4;
    const bf16x8 zero8 = {0, 0, 0, 0, 0, 0, 0, 0};
    bf16x8 bfr[8];
#pragma unroll
    for (int nt = 0; nt < 8; ++nt) bfr[nt] = (g4 < 2) ? *(const bf16x8*)(BBT + (16 * nt + li) * 16 + 8 * g4) : zero8;
    bf16x8 afr[4], cbf[4];
#pragma unroll
    for (int sb = 0; sb < 4; ++sb) afr[sb] = (g4 < 2) ? *(const bf16x8*)(P + (row0 + 16 * sb + li) * NP + C_SU + 16 * g + 8 * g4) : zero8;
    if (READOUT) {
#pragma unroll
        for (int s = 0; s < 4; ++s) cbf[s] = *(const bf16x8*)(CMT + li * 128 + 32 * s + 8 * g4);
    }
#pragma unroll
    for (int step = 0; step < 4; ++step) {
        const int sb = DIR ? 3 - step : step;
#pragma unroll
        for (int nt = 0; nt < 8; ++nt) { f32x4 d = {0.f, 0.f, 0.f, 0.f}; d = MFMA16(afr[sb], bfr[nt], d);
#pragma unroll
            for (int r = 0; r < 4; ++r) SCAN[(4 * g4 + r) * 128 + 16 * nt + li] = d[r]; }
        LDS_FENCE();
#pragma unroll
        for (int hh = 0; hh < 2; ++hh) {
            const int tb = (DIR ? 1 - hh : hh) * 8;
            float br[8], bi[8];
#pragma unroll
            for (int t = 0; t < 8; ++t) { const f32x2_t v2 = *(const LAS f32x2_t*)(SCAN + (tb + t) * 128 + 2 * lane); br[t] = v2.x; bi[t] = v2.y; }
#pragma unroll
            for (int tt = 0; tt < 8; ++tt) { const int t = DIR ? 7 - tt : tt;
                const float nxr = lbr * xr - lbi * xi + br[t], nxi = lbr * xi + lbi * xr + bi[t]; xr = nxr; xi = nxi;
                if (READOUT) { br[t] = xr; bi[t] = xi; } }
            if (READOUT) {
#pragma unroll
                for (int t = 0; t < 8; ++t) *(LAS unsigned*)(XB + (tb + t) * 136 + 2 * lane) = cvtpk(br[t], bi[t]);
            }
        }
        LDS_FENCE();
        if (READOUT) {
#pragma unroll
            for (int s = 0; s < 4; ++s) { const bf16x8 xa = *(const LAS bf16x8*)(XB + li * 136 + 32 * s + 8 * g4);
                D2[sb] = MFMA16(xa, cbf[s], D2[sb]); }
            LDS_FENCE();
        }
    }
}

__device__ __forceinline__ void s5_local_unit(const KArgs& a, int l, LAS unsigned char* lds, int cid, int wave, int lane) {
    const int tid = wave * 64 + lane; SEC_B(5);
    const bool lat = cid < 256; const int b = lat ? cid >> 6 : (cid - 256) >> 2; const int slot = lat ? 4 + (cid & 63) : (cid - 256) & 3;
    LAS unsigned char* wl = lds + wave * S5_WAVE_BYTES;
    float* SXL = (float*)(a.ws + OFF_SXL);
    f32x4 dummy[4];
#pragma unroll
    for (int gi = 0; gi < 2; ++gi) { const int g = 2 * wave + gi;
        { float xr = 0.f, xi = 0.f; s5_dir<0, false>(a, l, wl, (size_t)cid * 64, g, lane, xr, xi, dummy);
          float* o = SXL + ((size_t)((b * 16 + g) * 2 + 0) * 68 + slot) * 128; o[lane] = xr; o[64 + lane] = xi; }
        { float xr = 0.f, xi = 0.f; s5_dir<1, false>(a, l, wl, (size_t)cid * 64, g, lane, xr, xi, dummy);
          float* o = SXL + ((size_t)((b * 16 + g) * 2 + 1) * 68 + slot) * 128; o[lane] = xr; o[64 + lane] = xi; }
    }
    SEC_E(5);
}

__device__ __forceinline__ void s5_scan_item(const KArgs& a, int l, int item, int tid) {
    const int chain = item * 8 + (tid >> 6), p = tid & 63, dir = chain & 1, g = (chain >> 1) & 15;
    const int dgl = (l * 2 + dir) * 16 + g;
    const f32x4 lb = *(const f32x4*)((const float*)(a.ws + OFF_SLB) + ((size_t)dgl * 64 + p) * 4);
    const float* SXL = (const float*)(a.ws + OFF_SXL) + (size_t)chain * 68 * 128 + p;
    float* SX0 = (float*)(a.ws + OFF_SX0) + (size_t)chain * 68 * 128 + p;
    float xr = 0.f, xi = 0.f;
    for (int st = 0; st < 68; st += 4) {
        float vr[4], vi[4]; int sl[4];
#pragma unroll
        for (int k = 0; k < 4; ++k) { sl[k] = dir ? 71 - (st + k) : st + k; if (dir && st + k < 4) sl[k] = 3 - (st + k); vr[k] = SXL[sl[k] * 128]; vi[k] = SXL[sl[k] * 128 + 64]; }
#pragma unroll
        for (int k = 0; k < 4; ++k) { SX0[sl[k] * 128] = xr; SX0[sl[k] * 128 + 64] = xi;
            const float nr = lb.z * xr - lb.w * xi + vr[k], ni = lb.z * xi + lb.w * xr + vi[k]; xr = nr; xi = ni; }
    }
}

__device__ __forceinline__ void s5_out_unit(const KArgs& a, int l, LAS unsigned char* lds, int cid, int tid, int wave, int lane) {
    const bf16_t* P = (const bf16_t*)(a.ws + OFF_P); bf16_t* Y = (bf16_t*)(a.ws + OFF_H);
    const bool lat = cid < 256; const int b = lat ? cid >> 6 : (cid - 256) >> 2; const int slot = lat ? 4 + (cid & 63) : (cid - 256) & 3;
    const size_t row0 = (size_t)cid * 64;
    LAS unsigned char* wl = lds + wave * S5_WAVE_BYTES;
    LAS bf16_t* GT = (LAS bf16_t*)(lds + S5_GT);
    const float* SX0 = (const float*)(a.ws + OFF_SX0);
    const float* dsk = a.in.s5_d + l * 256;
    const int li = lane & 15, g4 = lane >> 4;
    SEC_B(1);
#pragma unroll 1
    for (int gi = 0; gi < 2; ++gi) { const int g = 2 * wave + gi;
        f32x4 D2[4];
#pragma unroll
        for (int k = 0; k < 4; ++k) D2[k] = (f32x4){0.f, 0.f, 0.f, 0.f};
        { const float* x0 = SX0 + ((size_t)((b * 16 + g) * 2 + 0) * 68 + slot) * 128; float xr = x0[lane], xi = x0[64 + lane];
          s5_dir<0, true>(a, l, wl, row0, g, lane, xr, xi, D2); }
        { const float* x0 = SX0 + ((size_t)((b * 16 + g) * 2 + 1) * 68 + slot) * 128; float xr = x0[lane], xi = x0[64 + lane];
          s5_dir<1, true>(a, l, wl, row0, g, lane, xr, xi, D2); }
        const float dk = dsk[16 * g + li];
        const unsigned uoff = (unsigned)(4 * g4) * NP + li;
#pragma unroll
        for (int sb = 0; sb < 4; ++sb)
#pragma unroll
            for (int r = 0; r < 4; ++r) { const int t = 16 * sb + 4 * g4 + r;
                const bf16_t* urow = P + (row0 + 16 * sb + r) * NP + C_SU + 16 * g;
                const float u = bf2f(urow[uoff]);
                GT[t * 264 + 16 * g + li] = (bf16_t)cvtpk(gelu_tanh_fast(D2[sb][r] + u * dk), 0.f); }
    }
    __syncthreads();
    SEC_E(1);
    SEC_B(2);
    {
        const bf16_t* WGT = (const bf16_t*)(a.ws + OFF_WGT) + (size_t)l * 65536;
        f32x4 acc[2][4];
#pragma unroll
        for (int mi = 0; mi < 2; ++mi)
#pragma unroll
            for (int nt = 0; nt < 4; ++nt) acc[mi][nt] = (f32x4){0.f, 0.f, 0.f, 0.f};
#pragma unroll
        for (int s = 0; s < 8; ++s) {
            bf16x8 af[2], bfr[4];
#pragma unroll
            for (int mi = 0; mi < 2; ++mi) af[mi] = *(const bf16x8*)(WGT + (size_t)(16 * (2 * wave + mi) + li) * 256 + 32 * s + 8 * g4);
#pragma unroll
            for (int nt = 0; nt < 4; ++nt) bfr[nt] = *(const LAS bf16x8*)(GT + (16 * nt + li) * 264 + 32 * s + 8 * g4);
#pragma unroll
            for (int mi = 0; mi < 2; ++mi)
#pragma unroll
                for (int nt = 0; nt < 4; ++nt) acc[mi][nt] = MFMA16(af[mi], bfr[nt], acc[mi][nt]);
        }
        const float* bgl = a.in.s5_b_glu + l * 256;
#pragma unroll
        for (int mi = 0; mi < 2; ++mi) { const int m0 = 16 * (2 * wave + mi) + 4 * g4; const f32x4 bv = *(const f32x4*)(bgl + m0);
#pragma unroll
            for (int nt = 0; nt < 4; ++nt) { const int t = 16 * nt + li; const size_t row = row0 + t;
                const u32x2 gv = *(const LAS u32x2*)(GT + t * 264 + m0);
                const u32x2 gt = *(const u32x2*)(P + row * NP + C_GATE + 512 + m0);
                const float o0 = lo_bf(gv.x) * __builtin_amdgcn_rcpf(1.f + fast_exp(-(acc[mi][nt][0] + bv.x))) * fast_silu(lo_bf(gt.x));
                const float o1 = hi_bf(gv.x) * __builtin_amdgcn_rcpf(1.f + fast_exp(-(acc[mi][nt][1] + bv.y))) * fast_silu(hi_bf(gt.x));
                const float o2 = lo_bf(gv.y) * __builtin_amdgcn_rcpf(1.f + fast_exp(-(acc[mi][nt][2] + bv.z))) * fast_silu(lo_bf(gt.y));
                const float o3 = hi_bf(gv.y) * __builtin_amdgcn_rcpf(1.f + fast_exp(-(acc[mi][nt][3] + bv.w))) * fast_silu(hi_bf(gt.y));
                u32x2 w; w.x = cvtpk(o0, o1); w.y = cvtpk(o2, o3);
                *(u32x2*)(Y + row * DM + 512 + m0) = w; }
        }
    }
    __syncthreads();
    SEC_E(2);
}

__device__ __forceinline__ void phC_s5(const KArgs& a, int l, LAS unsigned char* lds, int wave, int lane) {
    for (int cid = blockIdx.x; cid < 272; cid += gridDim.x) s5_local_unit(a, l, lds, cid, wave, lane);
    __syncthreads();
}
__device__ __forceinline__ void phD_s5(const KArgs& a, int l, int tid) {
    const int vb = gridDim.x - 1 - blockIdx.x;
    for (int it = vb; it < 16; it += gridDim.x) s5_scan_item(a, l, it, tid);
}
__device__ __forceinline__ void phE_s5(const KArgs& a, int l, LAS unsigned char* lds, int tid, int wave, int lane) {
    const int nc = (l == 1) ? 256 : 272;
    for (int cid = blockIdx.x; cid < nc; cid += gridDim.x) s5_out_unit(a, l, lds, cid, tid, wave, lane);
}

__device__ __forceinline__ void pro_s5_tables(const KArgs& a, int tid) {
    const Inputs& in = a.in;
    const int gt = blockIdx.x * NTHR + tid, NGT = gridDim.x * NTHR;
    bf16_t* BBT = (bf16_t*)(a.ws + OFF_BBT); bf16_t* CMT = (bf16_t*)(a.ws + OFF_CMT); float* SLB = (float*)(a.ws + OFF_SLB); bf16_t* WGT = (bf16_t*)(a.ws + OFF_WGT);
    if (gt < 2 * 2 * 16 * 64) {
        const int p = gt & 63, dgl = gt >> 6;
        const float dt = expf(in.s5_log_dt[dgl]);
        const float lre = in.s5_lam_re[dgl * 64 + p], lim = in.s5_lam_im[dgl * 64 + p];
        const float mag = expf(lre * dt), ang = lim * dt;
        const float lbr = mag * cosf(ang), lbi = mag * sinf(ang);
        const float nr = lbr - 1.f, ni = lbi, den = lre * lre + lim * lim;
        const float cr = (nr * lre + ni * lim) / den, ci = (ni * lre - nr * lim) / den;
        for (int h = 0; h < 16; ++h) { const float br = in.s5_b_re[((size_t)dgl * 64 + p) * 16 + h], bi = in.s5_b_im[((size_t)dgl * 64 + p) * 16 + h];
            BBT[((size_t)dgl * 128 + 2 * p) * 16 + h] = f2bf(cr * br - ci * bi); BBT[((size_t)dgl * 128 + 2 * p + 1) * 16 + h] = f2bf(cr * bi + ci * br); }
        float pr = lbr, pi = lbi;
        for (int k = 0; k < 6; ++k) { const float tr = pr * pr - pi * pi, ti = 2.f * pr * pi; pr = tr; pi = ti; }
        *(f32x4*)(SLB + ((size_t)dgl * 64 + p) * 4) = (f32x4){lbr, lbi, pr, pi};
    }
    for (int i = gt; i < 2 * 2 * 16 * 16 * 128; i += NGT) { const int pri = i & 127, h = (i >> 7) & 15, dgl = i >> 11;
        const float v = (pri & 1) ? -in.s5_c_im[((size_t)dgl * 16 + h) * 64 + (pri >> 1)] : in.s5_c_re[((size_t)dgl * 16 + h) * 64 + (pri >> 1)];
        CMT[i] = f2bf(v); }
    for (int i = gt; i < 2 * 65536; i += NGT) { const int n = i & 255, m = (i >> 8) & 255, li = i >> 16; WGT[i] = f2bf(in.s5_w_glu[(size_t)li * 65536 + n * 256 + m]); }
}
#define WQ_LOOP(ctr_, nitems_, ...) do { unsigned nxt_ = 0u; if (tid == 0) nxt_ = atomicAdd((ctr_), 1u); \
    for (;;) { __syncthreads(); if (tid == 0) wq[0] = nxt_; __syncthreads(); const int item = (int)wq[0]; if (item >= (nitems_)) break; \
        if (tid == 0) nxt_ = atomicAdd((ctr_), 1u); __VA_ARGS__ } __syncthreads(); } while (0)
#define WQ_CTR(l, idx) ((unsigned*)(a.ws + OFF_CTL) + 32 + 16 * ((l) * 16 + (idx)))

__device__ __forceinline__ void phC_dyn(const KArgs& a, int l, LAS unsigned char* lds, volatile LAS unsigned* wq, int tid, int wave, int lane) {
    WQ_LOOP(WQ_CTR(l, 0), 272, { s5_local_unit(a, l, lds, item, wave, lane); });
    if (l == 0) WQ_LOOP(WQ_CTR(l, 1), 32, { na_block<false>(a, lds, item >> 3, (item >> 1) & 3, item & 1, tid, wave, lane); });
    WQ_LOOP(WQ_CTR(l, 2), 544, { gla_local_unit(a, l, lds, item >> 1, item & 1, tid, wave, lane); });
}
__device__ __forceinline__ void phD_dyn(const KArgs& a, int l, LAS unsigned char* lds, volatile LAS unsigned* wq, int tid, int wave, int lane) {
    LAS float* rpb = (LAS float*)(lds + NA_RPB_OFF);
    for (int i = tid; i < 4 * 465; i += NTHR) rpb[i] = a.in.na_rpb[l * 4 * 465 + i];
    WQ_LOOP(WQ_CTR(l, 3), 512, { const int ln = fresh_lane(); na_block<true>(a, lds, item >> 7, (item >> 5) & 3, item & 31, wave * 64 + ln, wave, ln); });
    WQ_LOOP(WQ_CTR(l, 4), (l == 1) ? 256 : 272, { pool_item(a, l, lds, item, tid, wave, lane); });
    WQ_LOOP(WQ_CTR(l, 5), 128, { gla_scan_item(a, item, tid); });
    WQ_LOOP(WQ_CTR(l, 6), 16, { s5_scan_item(a, l, item, tid); });
}
__device__ __forceinline__ void phE_dyn(const KArgs& a, int l, LAS unsigned char* lds, volatile LAS unsigned* wq, int tid, int wave, int lane) {
    WQ_LOOP(WQ_CTR(l, 7), (l == 1) ? 256 : 272, { s5_out_unit(a, l, lds, item, tid, wave, lane); });
    WQ_LOOP(WQ_CTR(l, 8), (l == 1) ? 512 : 544, { gla_out_unit(a, l, lds, item >> 1, item & 1, tid, wave, lane); });
}
__global__ void __launch_bounds__(NTHR, 2) mega(KArgs a_by_value) {
    unsigned long long kp_ = (unsigned long long)__builtin_amdgcn_kernarg_segment_ptr();
    asm volatile("" : "+s"(kp_));
    const KArgs& a = *(const KArgs*)(const GAS KArgs*)kp_;
    extern __shared__ __attribute__((aligned(16))) unsigned char lds_raw[];
    LAS unsigned char* lds = (LAS unsigned char*)lds_raw;
    const int wave = __builtin_amdgcn_readfirstlane((int)threadIdx.x >> 6);
#define MY_LANE() fresh_lane()
#define T0() (wave == 0 && MY_LANE() == 0)
    const int tid = wave * 64 + MY_LANE();
    volatile LAS unsigned* MISC = (volatile LAS unsigned*)(lds + MISC_OFF);
    for (int u = tid; u < (LDS_BYTES - RING_BYTES) / 4; u += NTHR) ((LAS unsigned*)(lds + RING_BYTES))[u] = 0u;
    __syncthreads();
    unsigned* ctl = (unsigned*)(a.ws + OFF_CTL);
    XcdBarrier bar = xcd_barrier_post(ctl + CW_BAR + a.li * XCD_BAR_WORDS, MISC + 8, T0());
    const int lo = a.ph_lo, hi = a.ph_hi;
#define IN(k) (lo <= (k) && (k) < hi)
#define REP(i, ...) do { _Pragma("unroll") for (int rr = 0; rr <= kRep[i]; ++rr) { __VA_ARGS__; if (rr < kRep[i]) xcd_barrier(bar, T0()); } } while (0)
#define PHV const int lane_ = MY_LANE(); const int tid_ = wave * 64 + lane_
#ifdef PROBE_TSEL
    unsigned long long tp_prev = __builtin_amdgcn_s_memrealtime(), tp_acc = 0ull;
#define TSTAMP(k) do { const unsigned long long tn_ = __builtin_amdgcn_s_memrealtime(); if ((PROBE_TSEL >> (k)) & 1) tp_acc += tn_ - tp_prev; tp_prev = tn_; } while (0)
#else
#define TSTAMP(k) do { } while (0)
#endif
#define SEAM(k) do { if (IN(k) && IN((k) + 1)) { xcd_barrier(bar, T0()); } TSTAMP(k); } while (0)
    if (IN(PH_PRO)) { PHV; REP(0, { ph_prologue(a, lds, tid_, wave, lane_); pro_s5_tables(a, tid_); }); for (int rr = 0; rr < kRep[7]; ++rr) xcd_barrier(bar, T0()); }
    SEAM(PH_PRO);
#define LAYER(l) do { \
        constexpr int pb = PH_L0 + (l) * PH_PER_LAYER; \
        constexpr int nrows_out = ((l) == 1) ? NLAT : MTOT; \
        if (IN(pb + 0)) { PHV; REP(1, ph_post_pre(a, (l) - 1, (l), wave, lane_)); } \
        SEAM(pb + 0); \
        if (IN(pb + 1)) { PHV; REP(2, { \
            pg8::Gemm g{(const bf16_t*)(a.ws + OFF_H), (const bf16_t*)(a.ws + OFF_WIN) + (size_t)(l) * NP * DM, MTOT, NP, DM}; \
            pg8::StaticOrder S; S.init(MTOT, NP, gridDim.x, blockIdx.x); \
            pg8::EpiBf16<0> E{(bf16_t*)(a.ws + OFF_P), NP, nullptr, 0, 0, 1.f}; \
            pg8::gemm_phase<pg8::EpiBf16<0>, pg8::StaticOrder, true, true>(lds, g, S, E, wave); }); \
        } \
        SEAM(pb + 1); \
        if (IN(pb + 2)) { PHV; REP(3, phC_dyn(a, (l), lds, MISC + 16, tid_, wave, lane_)); } \
        SEAM(pb + 2); \
        if (IN(pb + 3)) { PHV; REP(4, phD_dyn(a, (l), lds, MISC + 16, tid_, wave, lane_)); } \
        SEAM(pb + 3); \
        if (IN(pb + 4)) { PHV; REP(5, phE_dyn(a, (l), lds, MISC + 16, tid_, wave, lane_)); } \
        SEAM(pb + 4); \
        if (IN(pb + 5)) { PHV; REP(6, { \
            pg8::Gemm g{(const bf16_t*)(a.ws + OFF_H), (const bf16_t*)(a.ws + OFF_WOUT) + (size_t)(l) * DM * DM, nrows_out, DM, DM}; \
            pg8::StaticOrder S; S.init(nrows_out, DM, gridDim.x, blockIdx.x); \
            pg8::EpiBf16<0> E{(bf16_t*)(a.ws + OFF_P), DM, nullptr, 0, 0, 1.f}; \
            pg8::gemm_phase<pg8::EpiBf16<0>, pg8::StaticOrder, true, true>(lds, g, S, E, wave); }); \
        } \
        SEAM(pb + 5); \
    } while (0)
    LAYER(0);
    LAYER(1);
#undef LAYER
    if (IN(PH_FIN)) { PHV; ph_post_pre(a, 1, 2, wave, lane_); }
#ifdef PROBE_SEC
    if (blockIdx.x == 0 && wave == 0) { const unsigned long long acc_ = ((volatile LAS unsigned*)(lds + MISC_OFF + 96))[0]; const unsigned long long t0_ = __builtin_amdgcn_s_memrealtime(); while (__builtin_amdgcn_s_memrealtime() - t0_ < 4ull * acc_) __builtin_amdgcn_s_sleep(8); }
#endif
#ifdef PROBE_TSEL
    TSTAMP(PH_FIN);
    if (blockIdx.x == 0 && wave == 0) { const unsigned long long t0_ = __builtin_amdgcn_s_memrealtime(); while (__builtin_amdgcn_s_memrealtime() - t0_ < 4ull * tp_acc) __builtin_amdgcn_s_sleep(8); }
#endif
#undef IN
#undef SEAM
}

static int g_grid = 0;
static void launch_mega(const KArgs& base, int lo, int hi, int li, hipStream_t stream) {
    KArgs a = base; a.ph_lo = lo; a.ph_hi = hi; a.li = li;
    void* args[] = {(void*)&a};
    hipError_t e = hipLaunchCooperativeKernel((const void*)mega, dim3(g_grid), dim3(NTHR), args, LDS_BYTES, stream);
    if (e != hipSuccess) fprintf(stderr, "cooperative launch failed: %s (grid %d)\n", hipGetErrorString(e), g_grid);
}

extern "C" void kernel_launch(void* const* d_in, const int* in_sizes, int n_in, void* d_out, int out_size, void* d_ws, size_t ws_size, hipStream_t stream) {
    if (g_grid == 0) {
        int dev = 0, cus = 0, per_cu = 0;
        hipGetDevice(&dev);
        hipDeviceGetAttribute(&cus, hipDeviceAttributeMultiprocessorCount, dev);
        hipFuncSetAttribute((const void*)mega, hipFuncAttributeMaxDynamicSharedMemorySize, LDS_BYTES);
        hipOccupancyMaxActiveBlocksPerMultiprocessor(&per_cu, (const void*)mega, NTHR, LDS_BYTES);
        if (per_cu < 1) per_cu = 1;
        g_grid = cus * per_cu;
        if (g_grid != 256) fprintf(stderr, "note: grid %d (cus %d x %d)\n", g_grid, cus, per_cu);
    }
    KArgs base;
    memset(&base, 0, sizeof(base));
    const float** ip = (const float**)&base.in;
    for (int i = 0; i < 26; ++i) ip[i] = (const float*)d_in[i];
    base.out = (float*)d_out; base.ws = (unsigned char*)d_ws; base.mask = 7;
    hipMemsetAsync((char*)d_ws + OFF_CTL, 0, CTL_BYTES, stream);
    launch_mega(base, PH_PRO, PH_END, 0, stream);
}
```
